# Optimizing an MI355X kernel written in HIP

```python
import jax, jax.numpy as jnp
from jax import lax
import numpy as np

D_MODEL = 2048
BATCH = 16
SEQ = 256
DEPTH = 4
DEC_BATCH = 4
DEC_SEQ = 4096
PAST_LEN = 512

GRID_W = 64
Q_BLOCK = 128
ROPE_BASE = 10000.0
EPS = 1e-6
A_HEADS = 8
A_KV_HEADS = 2
A_GROUP = A_HEADS // A_KV_HEADS
HEAD_DIM = 128
A_SCALE = HEAD_DIM ** -0.5
B_HEADS = 8
B_NOPE = 128
B_ROPE = 64
B_V = 128
KV_RANK = 512
B_SCALE = (B_NOPE + B_ROPE) ** -0.5
A_Q_W = A_HEADS * HEAD_DIM
A_KV_W = A_KV_HEADS * HEAD_DIM
B_Q_W = B_HEADS * (B_NOPE + B_ROPE)
ATTN_SPLITS = (A_Q_W, A_Q_W + A_KV_W, A_Q_W + 2 * A_KV_W, A_Q_W + 2 * A_KV_W + B_Q_W,
               A_Q_W + 2 * A_KV_W + B_Q_W + KV_RANK)
ATTN_IN = A_Q_W + 2 * A_KV_W + B_Q_W + KV_RANK + B_ROPE
ATTN_CAT = A_HEADS * HEAD_DIM + B_HEADS * B_V
CHUNK = 128
C_WIDTH = D_MODEL
C_GROUPS = 8
C_GROUP_W = C_WIDTH // C_GROUPS
FFN_HIDDEN = ((8 * D_MODEL + 3 * 256 - 1) // (3 * 256)) * 256
N_ATTN_LAYERS = (DEPTH + 1) // 2
N_CMLP_LAYERS = DEPTH // 2

kernel_name = "hybrid_diffusion_gqa_mla_chunkmlp_step"

F32 = jnp.float32


def rmsnorm(x, g):
    xf = x.astype(F32)
    y = xf * lax.rsqrt(jnp.mean(xf * xf, axis=-1, keepdims=True) + EPS)
    return (y * g.astype(F32)).astype(x.dtype)


def _rotate(x, ang):
    m = x.shape[-1] // 2
    xf = x.astype(F32)
    x1, x2 = xf[..., :m], xf[..., m:]
    shape = (1, ang.shape[0]) + (1,) * (x.ndim - 3) + (m,)
    cos = jnp.cos(ang).reshape(shape)
    sin = jnp.sin(ang).reshape(shape)
    return jnp.concatenate([x1 * cos - x2 * sin, x1 * sin + x2 * cos], axis=-1)


def axial_rope(x):
    n = x.shape[1]
    rows = n // GRID_W
    t = jnp.arange(rows * GRID_W)
    row = (t // GRID_W).astype(F32)
    col = (t % GRID_W).astype(F32)
    half = x.shape[-1] // 2
    inv = 1.0 / (ROPE_BASE ** (jnp.arange(0, half, 2, dtype=F32) / half))
    out = jnp.concatenate([_rotate(x[..., :half], row[:, None] * inv),
                           _rotate(x[..., half:], col[:, None] * inv)], axis=-1)
    return out.astype(x.dtype)


def blocked_attention(q, k, v, scale):
    b, sq, hk, g, dk = q.shape
    nb = sq // Q_BLOCK
    qb = jnp.moveaxis(q.reshape(b, nb, Q_BLOCK, hk, g, dk), 1, 0)

    def one_block(qi):
        s = jnp.einsum('bqhgd,bkhd->bhgqk', qi, k, preferred_element_type=F32) * scale
        p = jax.nn.softmax(s, axis=-1).astype(v.dtype)
        return jnp.einsum('bhgqk,bkhe->bqhge', p, v)

    o = lax.map(one_block, qb)
    return jnp.moveaxis(o, 0, 1).reshape(b, sq, hk, g, v.shape[-1])


def _attn_project(h, w_in, q_norm, k_norm, kv_norm):
    b, s, _ = h.shape
    z = h @ w_in
    qa, ka, va, qb, ckv, krope = jnp.split(z, list(ATTN_SPLITS), axis=-1)
    qa = rmsnorm(qa.reshape(b, s, A_KV_HEADS, A_GROUP, HEAD_DIM), q_norm)
    ka = rmsnorm(ka.reshape(b, s, A_KV_HEADS, HEAD_DIM), k_norm)
    va = va.reshape(b, s, A_KV_HEADS, HEAD_DIM)
    qb = qb.reshape(b, s, B_HEADS, B_NOPE + B_ROPE)
    ckv = rmsnorm(ckv, kv_norm)
    return qa, ka, va, qb, ckv, krope


def _mla_expand(ckv, krope, w_kv_up):
    b, s, _ = ckv.shape
    kv = (ckv @ w_kv_up).reshape(b, s, B_HEADS, B_NOPE + B_V)
    k_nope, v = kv[..., :B_NOPE], kv[..., B_NOPE:]
    k = jnp.concatenate([k_nope, jnp.broadcast_to(krope[:, :, None, :], (b, s, B_HEADS, B_ROPE))], axis=-1)
    return k, v


def attn_mixer(h, w_in, q_norm, k_norm, kv_norm, w_kv_up, w_out, ctx=None):
    b, s, _ = h.shape
    qa, ka, va, qb, ckv, krope = _attn_project(h, w_in, q_norm, k_norm, kv_norm)
    if ctx is None:
        keys_a, vals_a, ckv_all, krope_all = ka, va, ckv, krope
    else:
        ctx_k, ctx_v, ctx_ckv, ctx_krope = ctx
        qa = axial_rope(qa)
        qb = jnp.concatenate([qb[..., :B_NOPE], axial_rope(qb[..., B_NOPE:])], axis=-1)
        keys_a = jnp.concatenate([axial_rope(ka), ctx_k], axis=1)
        vals_a = jnp.concatenate([va, ctx_v], axis=1)
        ckv_all = jnp.concatenate([ckv, ctx_ckv], axis=1)
        krope_all = jnp.concatenate([axial_rope(krope[:, :, None, :])[:, :, 0, :], ctx_krope], axis=1)
    oa = blocked_attention(qa, keys_a, vals_a, A_SCALE)
    kb, vb = _mla_expand(ckv_all, krope_all, w_kv_up)
    ob = blocked_attention(qb[:, :, :, None, :], kb, vb, B_SCALE)
    o = jnp.concatenate([oa.reshape(b, s, A_HEADS * HEAD_DIM), ob.reshape(b, s, B_HEADS * B_V)], axis=-1)
    return o @ w_out, (ka, va, ckv, krope)


def chunk_mlp(h, w_in, v_norm, w_s, b_s, w_out):
    b, s, _ = h.shape
    z = jax.nn.gelu(h @ w_in)
    u, v = z[..., :C_WIDTH], z[..., C_WIDTH:]
    v = rmsnorm(v, v_norm).reshape(b, s // CHUNK, CHUNK, C_GROUPS, C_GROUP_W)
    sv = jnp.einsum('gpq,bnqgc->bnpgc', w_s, v) + b_s.T[None, None, :, :, None]
    return (u * sv.reshape(b, s, C_WIDTH)) @ w_out


def swiglu(h, w_gate, w_up, w_down):
    return (jax.nn.silu(h @ w_gate) * (h @ w_up)) @ w_down


def ada_mod(cond, w, bias):
    m = jax.nn.silu(cond) @ w + bias
    return jnp.split(m[:, None, :], 6, axis=-1)


def modulate(x, g, shift, scale):
    return rmsnorm(x, g) * (1 + scale) + shift


def setup_inputs(seed: int = 0) -> dict:
    key = jax.random.key(seed)
    ks = jax.random.split(key, 32)

    def nrm(k, shape, scale):
        return jax.random.normal(k, shape, F32) * scale

    def gain(k, shape):
        return 1.0 + 0.02 * jax.random.normal(k, shape, F32)

    D = D_MODEL
    return {
        'x_prompt': nrm(ks[0], (BATCH, SEQ, D), 1.0),
        'x_sample': nrm(ks[1], (DEC_BATCH, DEC_SEQ, D), 1.0),
        'c': nrm(ks[2], (DEC_BATCH, D), 1.0),
        'cache_gqa_k': nrm(ks[3], (DEC_BATCH, N_ATTN_LAYERS, PAST_LEN, A_KV_HEADS, HEAD_DIM), 1.0),
        'cache_gqa_v': nrm(ks[4], (DEC_BATCH, N_ATTN_LAYERS, PAST_LEN, A_KV_HEADS, HEAD_DIM), 1.0),
        'cache_mla_ckv': nrm(ks[5], (DEC_BATCH, N_ATTN_LAYERS, PAST_LEN, KV_RANK), 1.0),
        'cache_mla_krope': nrm(ks[6], (DEC_BATCH, N_ATTN_LAYERS, PAST_LEN, B_ROPE), 1.0),
        'c_ctx': nrm(ks[7], (D,), 1.0),
        'ada_w': nrm(ks[8], (DEPTH, D, 6 * D), 0.5 * D ** -0.5),
        'ada_b': nrm(ks[9], (DEPTH, 6 * D), 0.02),
        'norm_mix': gain(ks[10], (DEPTH, D)),
        'norm_ffn': gain(ks[11], (DEPTH, D)),
        'ffn_gate': nrm(ks[12], (DEPTH, D, FFN_HIDDEN), D ** -0.5),
        'ffn_up': nrm(ks[13], (DEPTH, D, FFN_HIDDEN), D ** -0.5),
        'ffn_down': nrm(ks[14], (DEPTH, FFN_HIDDEN, D), FFN_HIDDEN ** -0.5),
        'attn_w_in': nrm(ks[15], (N_ATTN_LAYERS, D, ATTN_IN), D ** -0.5),
        'attn_q_norm': gain(ks[16], (N_ATTN_LAYERS, HEAD_DIM)),
        'attn_k_norm': gain(ks[17], (N_ATTN_LAYERS, HEAD_DIM)),
        'attn_kv_norm': gain(ks[18], (N_ATTN_LAYERS, KV_RANK)),
        'attn_w_kv_up': nrm(ks[19], (N_ATTN_LAYERS, KV_RANK, B_HEADS * (B_NOPE + B_V)), KV_RANK ** -0.5),
        'attn_w_out': nrm(ks[20], (N_ATTN_LAYERS, ATTN_CAT, D), ATTN_CAT ** -0.5),
        'cmlp_w_in': nrm(ks[21], (N_CMLP_LAYERS, D, 2 * C_WIDTH), D ** -0.5),
        'cmlp_v_norm': gain(ks[22], (N_CMLP_LAYERS, C_WIDTH)),
        'cmlp_w_s': nrm(ks[23], (N_CMLP_LAYERS, C_GROUPS, CHUNK, CHUNK), CHUNK ** -0.5),
        'cmlp_b_s': gain(ks[24], (N_CMLP_LAYERS, C_GROUPS, CHUNK)),
        'cmlp_w_out': nrm(ks[25], (N_CMLP_LAYERS, C_WIDTH, D), C_WIDTH ** -0.5),
        'final_norm': gain(ks[26], (D,)),
    }


def reference(x_prompt, x_sample, c, cache_gqa_k, cache_gqa_v, cache_mla_ckv, cache_mla_krope,
              c_ctx, ada_w, ada_b, norm_mix, norm_ffn, ffn_gate, ffn_up, ffn_down,
              attn_w_in, attn_q_norm, attn_k_norm, attn_kv_norm, attn_w_kv_up, attn_w_out,
              cmlp_w_in, cmlp_v_norm, cmlp_w_s, cmlp_b_s, cmlp_w_out, final_norm):
    xp, xs = x_prompt, x_sample
    cond_p = jnp.broadcast_to(c_ctx[None, :], (xp.shape[0], c_ctx.shape[0]))
    new_k, new_v, new_ckv, new_kr = [], [], [], []
    for i in range(DEPTH):
        j = i // 2
        sh1p, sc1p, g1p, sh2p, sc2p, g2p = ada_mod(cond_p, ada_w[i], ada_b[i])
        sh1s, sc1s, g1s, sh2s, sc2s, g2s = ada_mod(c, ada_w[i], ada_b[i])
        hp = modulate(xp, norm_mix[i], sh1p, sc1p)
        hs = modulate(xs, norm_mix[i], sh1s, sc1s)
        if i % 2 == 0:
            wts = (attn_w_in[j], attn_q_norm[j], attn_k_norm[j], attn_kv_norm[j], attn_w_kv_up[j], attn_w_out[j])
            op, (k_c, v_c, ckv_c, kr_c) = attn_mixer(hp, *wts)
            new_k.append(k_c)
            new_v.append(v_c)
            new_ckv.append(ckv_c)
            new_kr.append(kr_c)
            os_, _ = attn_mixer(hs, *wts, ctx=(cache_gqa_k[:, j], cache_gqa_v[:, j],
                                               cache_mla_ckv[:, j], cache_mla_krope[:, j]))
        else:
            wts = (cmlp_w_in[j], cmlp_v_norm[j], cmlp_w_s[j], cmlp_b_s[j], cmlp_w_out[j])
            op = chunk_mlp(hp, *wts)
            os_ = chunk_mlp(hs, *wts)
        xp = xp + g1p * op
        xs = xs + g1s * os_
        fw = (ffn_gate[i], ffn_up[i], ffn_down[i])
        xp = xp + g2p * swiglu(modulate(xp, norm_ffn[i], sh2p, sc2p), *fw)
        xs = xs + g2s * swiglu(modulate(xs, norm_ffn[i], sh2s, sc2s), *fw)
    y_prompt = rmsnorm(xp, final_norm)
    y_sample = rmsnorm(xs, final_norm)
    state_gqa_k = jnp.stack(new_k, axis=1)
    state_gqa_v = jnp.stack(new_v, axis=1)
    state_mla_ckv = jnp.stack(new_ckv, axis=1)
    state_mla_krope = jnp.stack(new_kr, axis=1)
    return (y_prompt, y_sample, state_gqa_k, state_gqa_v, state_mla_ckv, state_mla_krope)
```

```cpp
#define MK_ONE_LAUNCH 1
#define ATT_MLA_SD 2
#define ATT_MLA_NQR 3
#define LDS_KB 160
#include <hip/hip_runtime.h>
#include <cstdio>
#include <cstdint>
namespace pg8 {
#define PG8_LAS __attribute__((address_space(3)))
typedef unsigned short bf16_t;
typedef short bf16x8 __attribute__((ext_vector_type(8)));
typedef float f32x4 __attribute__((ext_vector_type(4)));
typedef unsigned u32x4 __attribute__((ext_vector_type(4)));
constexpr int BM = 256, BK = 64, HALF = 128, HTB = HALF * BK * 2  , STAGE_BYTES = 8 * HTB, NXCD = 8, WGM = 8;

__host__ __device__ __forceinline__ int lds_byte(int r, int c) { const int st = (r >> 4) * 2 + (c >> 5), rr = r & 15, cc = c & 31, ob = rr * 64 + cc * 2; return st * 1024 + (ob ^ (((ob >> 9) & 1) << 5)); }
__host__ __device__ __forceinline__ void stage_rc(int b, int& R, int& C) { const int st = b / 1024, sb = b % 1024, swz = sb ^ (((sb >> 9) & 1) << 5); R = (st >> 1) * 16 + swz / 64; C = (st & 1) * 32 + (swz % 64) / 2; }
__host__ __device__ __forceinline__ int perm32(int rho) { const int n = rho >> 4, i = rho & 15; return 8 * (i >> 2) + 4 * n + (i & 3); }

struct Unit { int pm, pn; };
struct Gemm { const bf16_t* A; const bf16_t* Bt; int M, N, K; };

struct StaticOrder {
    int nM, nN, nwg, G, c;
    __host__ __device__ void init(int M, int N, int G_, int c_) { nM = M / BM; nN = N / BM; nwg = nM * nN; G = G_; c = c_; }
    __host__ __device__ bool next(int i, Unit& u) const {
        const int L = i * G + c; if (L >= nwg) return false;
        int wgid = L; { const int q = nwg / NXCD, r = nwg % NXCD, xcd = wgid % NXCD, off = wgid / NXCD; wgid = (xcd < r ? xcd * (q + 1) : r * (q + 1) + (xcd - r) * q) + off; }
        const int nig = WGM * nN, gid = wgid / nig, fm = gid * WGM, gsz = (nM - fm) < WGM ? (nM - fm) : WGM;
        u.pm = fm + ((wgid % nig) % gsz); u.pn = (wgid % nig) / gsz; return true;
    }
    __device__ __forceinline__ void a_ready(const Unit&) const {}
    __device__ __forceinline__ void done(const Unit&) const {}
};
__device__ __forceinline__ unsigned cvt_pk_bf16(float lo, float hi) { unsigned r; asm volatile("v_cvt_pk_bf16_f32 %0, %1, %2" : "=v"(r) : "v"(lo), "v"(hi)); return r; }
constexpr int ROWS_P = 4096;
__device__ __forceinline__ int cond_of_pm(int pm) { return pm < 16 ? 0 : 1 + ((pm - 16) >> 4); }

__device__ __forceinline__ float epi_add_x16_x32(float v) {
    v += __int_as_float(__builtin_amdgcn_ds_swizzle(__float_as_int(v), (16 << 10) | 0x1f));
    auto rr = __builtin_amdgcn_permlane32_swap(__float_as_uint(v), __float_as_uint(v), false, false); return __uint_as_float(rr[0]) + __uint_as_float(rr[1]);
}
__device__ __forceinline__ void epi_row_rstd(const float* SSX, int row0, int fq, float (&rs)[2][4]) {
#pragma unroll
    for (int ai = 0; ai < 2; ++ai)
#pragma unroll
        for (int m = 0; m < 4; ++m) { const f32x4* p = (const f32x4*)(SSX + (size_t)(row0 + ai * HALF + m * 16) * 32 + 8 * fq); const f32x4 a = p[0], b = p[1];
            const float s = epi_add_x16_x32(((a[0] + a[1]) + (a[2] + a[3])) + ((b[0] + b[1]) + (b[2] + b[3])));
            rs[ai][m] = 1.0f / __builtin_sqrtf(s * (1.0f / 2048.0f) + 1e-6f); }
}

struct EpiBf16Plain {
    static constexpr bool PERM = true, AFTER_DRAIN = false;
    bf16_t* O; int ldc; const float* SSX; const float* bias; int ldb;
    mutable int pm_; PG8_LAS const float* lb; mutable int ui_;
    mutable float rs[2][4];
    __device__ __forceinline__ void operator()(const f32x4 (&acc)[2][2][4][2], const Unit& u, int wr, int wc, int fr, int fq) const {
        const int row0 = u.pm * BM + wr * 64 + fr, col0 = u.pn * BM + wc * 32 + 8 * fq;
        f32x4 bv[2][2];
        if (SSX) { if (u.pm != pm_) { epi_row_rstd(SSX, row0, fq, rs); pm_ = u.pm; } PG8_LAS const float* bp = lb + ui_ * 256 + wc * 32 + 8 * fq; ++ui_;
#pragma unroll
            for (int bj = 0; bj < 2; ++bj)
#pragma unroll
                for (int n = 0; n < 2; ++n) bv[bj][n] = *(PG8_LAS const f32x4*)(bp + bj * HALF + 4 * n); }
#pragma unroll
        for (int ai = 0; ai < 2; ++ai)
#pragma unroll
            for (int m = 0; m < 4; ++m) { bf16_t* rowp = O + (size_t)(row0 + ai * HALF + m * 16) * ldc + col0;
#pragma unroll
                for (int bj = 0; bj < 2; ++bj) { f32x4 v0 = acc[ai][bj][m][0], v1 = acc[ai][bj][m][1];
                    if (SSX) { v0 = v0 * rs[ai][m] + bv[bj][0]; v1 = v1 * rs[ai][m] + bv[bj][1]; }
                    u32x4 w; w.x = cvt_pk_bf16(v0[0], v0[1]); w.y = cvt_pk_bf16(v0[2], v0[3]); w.z = cvt_pk_bf16(v1[0], v1[1]); w.w = cvt_pk_bf16(v1[2], v1[3]);
                    *(u32x4*)(rowp + bj * HALF) = w; } }
    }
};
struct EpiRes {
    static constexpr bool PERM = false, AFTER_DRAIN = false;
    const float* base_lo; const float* base_hi; float* out; const float* gate;
    bf16_t* H; const float* gnorm; const float* scale; float* SSX;
    __device__ __forceinline__ void operator()(const f32x4 (&acc)[2][2][4][2], const Unit& u, int wr, int wc, int fr, int fq) const {
        const int row0 = u.pm * BM + wr * 64 + fr, col0 = u.pn * BM + wc * 32 + 4 * fq, cd = cond_of_pm(u.pm);
        const float* gv = gate + cd * 12288 + col0;
        const float* bp = (u.pm < 16) ? base_lo + (size_t)row0 * 2048 + col0 : base_hi + (size_t)(row0 - ROWS_P) * 2048 + col0;
        float* op = out + (size_t)row0 * 2048 + col0;
        f32x4 g[2][2], gs[2][2];
#pragma unroll
        for (int bj = 0; bj < 2; ++bj)
#pragma unroll
            for (int n = 0; n < 2; ++n) { g[bj][n] = *(const f32x4*)(gv + bj * HALF + n * 16);
                if (H) gs[bj][n] = *(const f32x4*)(gnorm + col0 + bj * HALF + n * 16) * (*(const f32x4*)(scale + cd * 12288 + col0 + bj * HALF + n * 16) + 1.0f); }
#pragma unroll
        for (int ai = 0; ai < 2; ++ai)
#pragma unroll
            for (int m = 0; m < 4; ++m) { const size_t ro = (size_t)(ai * HALF + m * 16) * 2048; float ss = 0.f;
#pragma unroll
                for (int bj = 0; bj < 2; ++bj)
#pragma unroll
                    for (int n = 0; n < 2; ++n) { const f32x4 b = *(const f32x4*)(bp + ro + bj * HALF + n * 16);
                        const f32x4 x = b + g[bj][n] * acc[ai][bj][m][n];
                        *(f32x4*)(op + ro + bj * HALF + n * 16) = x;
                        if (H) { ss += (x[0] * x[0] + x[1] * x[1]) + (x[2] * x[2] + x[3] * x[3]); const f32x4 a = x * gs[bj][n];
                            typedef unsigned u32x2_ __attribute__((ext_vector_type(2))); u32x2_ w; w.x = cvt_pk_bf16(a[0], a[1]); w.y = cvt_pk_bf16(a[2], a[3]);
                            *(u32x2_*)(H + (size_t)row0 * 2048 + col0 + ro + bj * HALF + n * 16) = w; } }
                if (H) { ss = epi_add_x16_x32(ss); if (fq == 0) SSX[(size_t)(row0 + ai * HALF + m * 16) * 32 + u.pn * 4 + wc] = ss; } }
    }
};
struct EpiSwiGLU {
    static constexpr bool PERM = true, AFTER_DRAIN = false;
    bf16_t* O; int ldc; const float* SSX; const float* bias; int ldb;
    mutable int pm_; PG8_LAS const float* lb; mutable int ui_; mutable float rs[2][4];
    __device__ __forceinline__ void operator()(const f32x4 (&acc)[2][2][4][2], const Unit& u, int wr, int wc, int fr, int fq) const {
        const int row0 = u.pm * BM + wr * 64 + fr, col0 = u.pn * HALF + wc * 32 + 8 * fq;
        if (u.pm != pm_) { epi_row_rstd(SSX, row0, fq, rs); pm_ = u.pm; } f32x4 bv[2][2]; { PG8_LAS const float* bp = lb + ui_ * 256 + wc * 32 + 8 * fq; ++ui_;
#pragma unroll
            for (int bj = 0; bj < 2; ++bj)
#pragma unroll
                for (int n = 0; n < 2; ++n) bv[bj][n] = *(PG8_LAS const f32x4*)(bp + bj * HALF + 4 * n); }
#pragma unroll
        for (int ai = 0; ai < 2; ++ai)
#pragma unroll
            for (int m = 0; m < 4; ++m) { bf16_t* rowp = O + (size_t)(row0 + ai * HALF + m * 16) * ldc + col0;
                float r[8];
#pragma unroll
                for (int n = 0; n < 2; ++n)
#pragma unroll
                    for (int j = 0; j < 4; ++j) { const float gt = acc[ai][0][m][n][j] * rs[ai][m] + bv[0][n][j], up = acc[ai][1][m][n][j] * rs[ai][m] + bv[1][n][j];
                        const float e = __builtin_amdgcn_exp2f(gt * -1.4426950408889634f);
                        r[n * 4 + j] = gt * up * __builtin_amdgcn_rcpf(1.0f + e); }
                u32x4 w; w.x = cvt_pk_bf16(r[0], r[1]); w.y = cvt_pk_bf16(r[2], r[3]); w.z = cvt_pk_bf16(r[4], r[5]); w.w = cvt_pk_bf16(r[6], r[7]);
                *(u32x4*)rowp = w; }
    }
};
__device__ __forceinline__ float gelu_tanh(float x) {
    const float u = 0.7978845608028654f * (x + 0.044715f * x * x * x);
    const float e = __builtin_amdgcn_exp2f(u * -2.8853900817779268f);
    return x * __builtin_amdgcn_rcpf(1.0f + e);
}
struct EpiGeluUV {
    static constexpr bool PERM = true, AFTER_DRAIN = false;
    bf16_t* U; bf16_t* V; float* SS; const float* SSX; const float* bias; int ldb;
    mutable int pm_; PG8_LAS const float* lb; mutable int ui_; mutable float rs[2][4];
    __device__ __forceinline__ void operator()(const f32x4 (&acc)[2][2][4][2], const Unit& u, int wr, int wc, int fr, int fq) const {
        const bool isv = u.pn >= 8; const int pn = isv ? u.pn - 8 : u.pn;
        const int row0 = u.pm * BM + wr * 64 + fr, col0 = pn * BM + wc * 32 + 8 * fq;
        if (u.pm != pm_) { epi_row_rstd(SSX, row0, fq, rs); pm_ = u.pm; } f32x4 bv[2][2]; { PG8_LAS const float* bp = lb + ui_ * 256 + wc * 32 + 8 * fq; ++ui_;
#pragma unroll
            for (int bj = 0; bj < 2; ++bj)
#pragma unroll
                for (int n = 0; n < 2; ++n) bv[bj][n] = *(PG8_LAS const f32x4*)(bp + bj * HALF + 4 * n); }
        bf16_t* O = isv ? V : U;
#pragma unroll
        for (int ai = 0; ai < 2; ++ai)
#pragma unroll
            for (int m = 0; m < 4; ++m) { const int row = row0 + ai * HALF + m * 16; bf16_t* rowp = O + (size_t)row * 2048 + col0; float ss = 0.f;
#pragma unroll
                for (int bj = 0; bj < 2; ++bj) { float r[8];
#pragma unroll
                    for (int n = 0; n < 2; ++n)
#pragma unroll
                        for (int j = 0; j < 4; ++j) { const float z = gelu_tanh(acc[ai][bj][m][n][j] * rs[ai][m] + bv[bj][n][j]); r[n * 4 + j] = z; ss += z * z; }
                    u32x4 w; w.x = cvt_pk_bf16(r[0], r[1]); w.y = cvt_pk_bf16(r[2], r[3]); w.z = cvt_pk_bf16(r[4], r[5]); w.w = cvt_pk_bf16(r[6], r[7]);
                    *(u32x4*)(rowp + bj * HALF) = w; }
                if (isv) { ss += __int_as_float(__builtin_amdgcn_ds_swizzle(__float_as_int(ss), (16 << 10) | 0x1f)); { auto rr = __builtin_amdgcn_permlane32_swap(__float_as_uint(ss), __float_as_uint(ss), false, false); ss = __uint_as_float(rr[0]) + __uint_as_float(rr[1]); } if (fq == 0) SS[(size_t)row * 32 + pn * 4 + wc] = ss; } }
    }
};
template <class Epi, class Sched, bool ALIGN_EPI = false, bool SP2 = false>
__device__ __forceinline__ void gemm_phase(PG8_LAS unsigned char* lds, const Gemm g, const Sched& S, const Epi& E) {
    int tid_ = threadIdx.x; asm volatile("" : "+v"(tid_));
    const int tid = tid_, wid = __builtin_amdgcn_readfirstlane(tid >> 6), lane = tid & 63, wr = wid >> 2, wc = wid & 3, fr = lane & 15, fq = lane >> 4;
    const int K = g.K, nt = K / BK;
    unsigned voffA[2], voffB[2];
#pragma unroll
    for (int i = 0; i < 2; ++i) { int R, C; stage_rc(tid * 16 + i * 8192, R, C); const int Rb = Epi::PERM ? ((R & ~31) + perm32(R & 31)) : R;
        voffA[i] = (unsigned)(R * K + C) * 2u; voffB[i] = (unsigned)(Rb * K + C) * 2u; }
    const size_t kstep = (size_t)(BK * 2);
    const size_t hstep = (size_t)HALF * K * 2;
    const size_t tstep = 2 * hstep;
    const unsigned ldsw = (unsigned)wid * 1024u;
    const int aoff = lds_byte(wr * 64 + fr, fq * 8), boff = lds_byte(wc * 32 + fr, fq * 8);
#define PG8_SA(b, h) (((b) * 2 + (h)) * HTB)
#define PG8_SB(b, h) ((4 + (b) * 2 + (h)) * HTB)
#define PG8_STAGE(bufoff, gbase, voff) do { _Pragma("unroll") for (int _i = 0; _i < 2; ++_i) \
        __builtin_amdgcn_global_load_lds((const unsigned*)((const char*)(gbase) + (voff)[_i]), (PG8_LAS unsigned*)(lds + (bufoff) + ldsw + _i * 8192), 16, 0, 0); } while (0)
#define PG8_LDA(dst, b, h) do { _Pragma("unroll") for (int m = 0; m < 4; ++m) _Pragma("unroll") for (int k = 0; k < 2; ++k) dst[m][k] = *(const PG8_LAS bf16x8*)(lds + PG8_SA(b, h) + aoff + m * 2048 + k * 1024); } while (0)
#define PG8_LDB(dst, b, h) do { _Pragma("unroll") for (int n = 0; n < 2; ++n) _Pragma("unroll") for (int k = 0; k < 2; ++k) dst[n][k] = *(const PG8_LAS bf16x8*)(lds + PG8_SB(b, h) + boff + n * 2048 + k * 1024); } while (0)
#define PG8_MMA(ai, bj, At, Bt) do { __builtin_amdgcn_s_setprio(1); _Pragma("unroll") for (int m = 0; m < 4; ++m) _Pragma("unroll") for (int n = 0; n < 2; ++n) _Pragma("unroll") for (int k = 0; k < 2; ++k) \
        acc[ai][bj][m][n] = __builtin_amdgcn_mfma_f32_16x16x32_bf16(Bt[n][k], At[m][k], acc[ai][bj][m][n], 0, 0, 0); __builtin_amdgcn_s_setprio(0); } while (0)
#define PG8_WAIT_V(n) asm volatile("s_waitcnt vmcnt(" #n ")" ::: "memory")
#define PG8_WAIT_L(n) asm volatile("s_waitcnt lgkmcnt(" #n ")" ::: "memory")
#define PG8_BAR __builtin_amdgcn_s_barrier()
#define PG8_SCHED __builtin_amdgcn_sched_barrier(0)
    Unit cur, nxt; int ui = 0;
    if (!S.next(0, cur)) return;
    f32x4 acc[2][2][4][2];
#pragma unroll
    for (int a = 0; a < 2; ++a)
#pragma unroll
        for (int b = 0; b < 2; ++b)
#pragma unroll
            for (int m = 0; m < 4; ++m)
#pragma unroll
                for (int n = 0; n < 2; ++n) acc[a][b][m][n] = (f32x4){0.f, 0.f, 0.f, 0.f};
    bf16x8 At[4][2], B0[2][2], B1[2][2];
    const char* cA = (const char*)g.A + (size_t)cur.pm * tstep; const char* cB = (const char*)g.Bt + (size_t)cur.pn * tstep;
    S.a_ready(cur);
    if constexpr (SP2) {
        PG8_STAGE(PG8_SB(0, 0), cB, voffB); PG8_STAGE(PG8_SB(0, 1), cB + hstep, voffB); PG8_STAGE(PG8_SA(0, 0), cA, voffA); PG8_STAGE(PG8_SA(0, 1), cA + hstep, voffA);
        if (wr == 1) PG8_BAR;
        PG8_WAIT_V(2); PG8_BAR;
        PG8_STAGE(PG8_SB(1, 0), cB + kstep, voffB); PG8_STAGE(PG8_SA(1, 0), cA + kstep, voffA); PG8_STAGE(PG8_SB(1, 1), cB + hstep + kstep, voffB);
        PG8_WAIT_V(6); PG8_BAR;
    } else {
        PG8_STAGE(PG8_SB(0, 0), cB, voffB); PG8_STAGE(PG8_SA(0, 0), cA, voffA); PG8_STAGE(PG8_SB(0, 1), cB + hstep, voffB); PG8_STAGE(PG8_SA(0, 1), cA + hstep, voffA);
        if (wr == 1) PG8_BAR;
        PG8_WAIT_V(4); PG8_BAR;
        PG8_STAGE(PG8_SB(1, 0), cB + kstep, voffB); PG8_STAGE(PG8_SA(1, 0), cA + kstep, voffA); PG8_STAGE(PG8_SB(1, 1), cB + hstep + kstep, voffB);
        PG8_WAIT_V(6); PG8_BAR;
    }
    for (;;) {
        const bool has_next = S.next(ui + 1, nxt);
        const char* nA = has_next ? (const char*)g.A + (size_t)nxt.pm * tstep : cA; const char* nB = has_next ? (const char*)g.Bt + (size_t)nxt.pn * tstep : cB;
        for (int t = 0; t < nt; t += 2) {
            const bool last = (t == nt - 2);
            const char* a1 = cA + (size_t)(t + 1) * kstep;
            const char* a2 = last ? nA : cA + (size_t)(t + 2) * kstep; const char* b2 = last ? nB : cB + (size_t)(t + 2) * kstep;
            const char* a3 = a2 + kstep; const char* b3 = b2 + kstep;
            if (last && has_next) S.a_ready(nxt);
            if constexpr (SP2) {
            PG8_LDB(B0, 0, 0); PG8_LDB(B1, 0, 1); PG8_SCHED; PG8_LDA(At, 0, 0); PG8_STAGE(PG8_SA(1, 1), a1 + hstep, voffA);
            PG8_WAIT_V(8); PG8_WAIT_L(0); PG8_BAR; PG8_MMA(0, 0, At, B0); PG8_MMA(0, 1, At, B1); PG8_BAR; PG8_SCHED;
            PG8_LDA(At, 0, 1); PG8_STAGE(PG8_SB(0, 0), b2, voffB); PG8_STAGE(PG8_SB(0, 1), b2 + hstep, voffB); PG8_STAGE(PG8_SA(0, 0), a2, voffA);
            PG8_WAIT_V(8); PG8_WAIT_L(0); PG8_BAR; PG8_MMA(1, 0, At, B0); PG8_MMA(1, 1, At, B1); PG8_BAR; PG8_SCHED;
            PG8_LDB(B0, 1, 0); PG8_LDB(B1, 1, 1); PG8_SCHED; PG8_LDA(At, 1, 0); PG8_STAGE(PG8_SA(0, 1), a2 + hstep, voffA);
            PG8_WAIT_V(8); PG8_WAIT_L(0); PG8_BAR; PG8_MMA(0, 0, At, B0); PG8_MMA(0, 1, At, B1); PG8_BAR; PG8_SCHED;
            PG8_LDA(At, 1, 1); PG8_STAGE(PG8_SB(1, 0), b3, voffB); PG8_STAGE(PG8_SB(1, 1), b3 + hstep, voffB); PG8_STAGE(PG8_SA(1, 0), a3, voffA);
            PG8_WAIT_V(8); PG8_WAIT_L(0); PG8_BAR; PG8_MMA(1, 0, At, B0); PG8_MMA(1, 1, At, B1); PG8_BAR; PG8_SCHED;
            } else {
            PG8_LDB(B0, 0, 0); PG8_SCHED; PG8_LDA(At, 0, 0); PG8_STAGE(PG8_SA(1, 1), a1 + hstep, voffA);
            PG8_WAIT_L(8); PG8_BAR; PG8_WAIT_L(0); PG8_MMA(0, 0, At, B0); PG8_BAR; PG8_SCHED;
            PG8_LDB(B1, 0, 1); PG8_STAGE(PG8_SB(0, 0), b2, voffB);
            PG8_BAR; PG8_WAIT_L(0); PG8_MMA(0, 1, At, B1); PG8_BAR;
            PG8_LDA(At, 0, 1); PG8_STAGE(PG8_SA(0, 0), a2, voffA);
            PG8_BAR; PG8_WAIT_L(0); PG8_MMA(1, 0, At, B0); PG8_BAR; PG8_SCHED;
            PG8_STAGE(PG8_SB(0, 1), b2 + hstep, voffB);
            PG8_WAIT_V(6); PG8_BAR; PG8_MMA(1, 1, At, B1); PG8_BAR;
            PG8_LDB(B0, 1, 0); PG8_SCHED; PG8_LDA(At, 1, 0); PG8_STAGE(PG8_SA(0, 1), a2 + hstep, voffA);
            PG8_WAIT_L(8); PG8_BAR; PG8_WAIT_L(0); PG8_MMA(0, 0, At, B0); PG8_BAR; PG8_SCHED;
            PG8_LDB(B1, 1, 1); PG8_STAGE(PG8_SB(1, 0), b3, voffB);
            PG8_BAR; PG8_WAIT_L(0); PG8_MMA(0, 1, At, B1); PG8_BAR;
            PG8_LDA(At, 1, 1); PG8_STAGE(PG8_SA(1, 0), a3, voffA);
            PG8_BAR; PG8_WAIT_L(0); PG8_MMA(1, 0, At, B0); PG8_BAR; PG8_SCHED;
            PG8_STAGE(PG8_SB(1, 1), b3 + hstep, voffB);
            PG8_WAIT_V(6); PG8_BAR; PG8_MMA(1, 1, At, B1); PG8_BAR;
            }
        }
        if constexpr (ALIGN_EPI) { if (wr == 0) PG8_BAR; }
        if constexpr (!Epi::AFTER_DRAIN) { E(acc, cur, wr, wc, fr, fq); S.done(cur); }
        if (!has_next) break;
#pragma unroll
        for (int a = 0; a < 2; ++a)
#pragma unroll
            for (int b = 0; b < 2; ++b)
#pragma unroll
                for (int m = 0; m < 4; ++m)
#pragma unroll
                    for (int n = 0; n < 2; ++n) acc[a][b][m][n] = (f32x4){0.f, 0.f, 0.f, 0.f};
        cur = nxt; cA = nA; cB = nB; ++ui;
        if constexpr (ALIGN_EPI) { if (wr == 1) PG8_BAR; }
    }
    PG8_WAIT_V(0);
    if constexpr (!ALIGN_EPI) { if (wr == 0) PG8_BAR; }
    PG8_BAR;
    if constexpr (Epi::AFTER_DRAIN) { E.fused(acc, cur, wr, wc, fr, fq, lds, wid, lane); S.done(cur); }
#undef PG8_SA
#undef PG8_SB
#undef PG8_STAGE
#undef PG8_LDA
#undef PG8_LDB
#undef PG8_MMA
#undef PG8_WAIT_V
#undef PG8_WAIT_L
#undef PG8_BAR
#undef PG8_SCHED
}
}
namespace att {
typedef unsigned short bf16;
using bf16x8 = __attribute__((ext_vector_type(8))) short;
using s16x4  = __attribute__((ext_vector_type(4))) short;
using f32x16 = __attribute__((ext_vector_type(16))) float;
using u32x4  = __attribute__((ext_vector_type(4))) unsigned;
constexpr int NW = 8, QBLK = 32, KVBLK = 64;
constexpr float THR = 8.f;
#define ATT_SBAR() __builtin_amdgcn_sched_barrier(0)
template <int RS> __device__ __forceinline__ int kswz(int row, int colB) { return row * RS + (colB ^ ((row & 7) << 4)); }
__device__ __forceinline__ int crow(int r, int hi) { return (r & 3) + 8 * (r >> 2) + 4 * hi; }
__device__ __forceinline__ unsigned cvtpk(float lo, float hi) { unsigned r; asm volatile("v_cvt_pk_bf16_f32 %0, %1, %2" : "=v"(r) : "v"(lo), "v"(hi)); return r; }
__device__ __forceinline__ bf16x8 ld8(const bf16* p) { return *reinterpret_cast<const bf16x8*>(p); }

__device__ __forceinline__ void partialSM(f32x16& p0, f32x16& p1, float& m_reg, float& mn, float& alpha, const float C, const float TS) {
  float pmax = p0[0];
#pragma unroll
  for (int r = 1; r < 16; ++r) pmax = fmaxf(pmax, p0[r]);
#pragma unroll
  for (int r = 0; r < 16; ++r) pmax = fmaxf(pmax, p1[r]);
  { auto rr = __builtin_amdgcn_permlane32_swap(__float_as_uint(pmax), __float_as_uint(pmax), false, false);
    pmax = fmaxf(__uint_as_float(rr[0]), __uint_as_float(rr[1])); }
  if (__builtin_expect(__all(pmax - m_reg <= TS), 1)) { mn = m_reg; alpha = 1.f; }
  else { mn = fmaxf(m_reg, pmax); alpha = __builtin_amdgcn_exp2f((m_reg - mn) * C); m_reg = mn; }
  float mnC = -mn * C;
#pragma unroll
  for (int r = 0; r < 16; ++r) p0[r] = fmaf(p0[r], C, mnC);
#pragma unroll
  for (int r = 0; r < 16; ++r) p1[r] = fmaf(p1[r], C, mnC);
#pragma unroll
  for (int r = 0; r < 16; ++r) p0[r] = __builtin_amdgcn_exp2f(p0[r]);
}
__device__ __forceinline__ void finishSM(f32x16& p0, f32x16& p1, float alpha, float& l_reg, bf16x8& pa0, bf16x8& pa1, bf16x8& pa2, bf16x8& pa3) {
#pragma unroll
  for (int r = 0; r < 16; ++r) p1[r] = __builtin_amdgcn_exp2f(p1[r]);
  float ps = 0;
#pragma unroll
  for (int r = 0; r < 16; ++r) ps += p0[r];
#pragma unroll
  for (int r = 0; r < 16; ++r) ps += p1[r];
  { auto rr = __builtin_amdgcn_permlane32_swap(__float_as_uint(ps), __float_as_uint(ps), false, false);
    ps = __uint_as_float(rr[0]) + __uint_as_float(rr[1]); }
  l_reg = l_reg * alpha + ps;
#define ATT_PK4(P, BASE, OUT) do { unsigned a0 = cvtpk(P[BASE + 0], P[BASE + 1]), a1 = cvtpk(P[BASE + 2], P[BASE + 3]);   \
    unsigned b0 = cvtpk(P[BASE + 4], P[BASE + 5]), b1 = cvtpk(P[BASE + 6], P[BASE + 7]);                              \
    auto r0 = __builtin_amdgcn_permlane32_swap(a0, b0, false, false); auto r1 = __builtin_amdgcn_permlane32_swap(a1, b1, false, false); \
    u32x4 w = {r0[0], r1[0], r0[1], r1[1]}; OUT = *reinterpret_cast<bf16x8*>(&w); } while (0)
  ATT_PK4(p0, 0, pa0); ATT_PK4(p0, 8, pa1); ATT_PK4(p1, 0, pa2); ATT_PK4(p1, 8, pa3);
#undef ATT_PK4
}
#ifndef QKT_SB0
#define QKT_SB0 3
#endif
#ifndef QKT_SB1
#define QKT_SB1 7
#endif
template <int DK, int NQR> __device__ __forceinline__ void qkt(f32x16& p0, f32x16& p1, const char* Ks, const bf16x8* qr, const char* qrl, int r32, int hi) {
  p0 = f32x16{}; p1 = f32x16{};
#pragma unroll
  for (int d0 = 0; d0 < DK / 16; ++d0) { const int cb = (d0 * 16 + hi * 8) * 2;
    const bf16x8 qf = (d0 < NQR) ? qr[d0 < NQR ? d0 : 0] : *reinterpret_cast<const bf16x8*>(qrl + (d0 - NQR) * 1024);
    bf16x8 b0 = *reinterpret_cast<const bf16x8*>(Ks + kswz<DK * 2>(r32, cb));
    bf16x8 b1 = *reinterpret_cast<const bf16x8*>(Ks + kswz<DK * 2>(32 + r32, cb));
    p0 = __builtin_amdgcn_mfma_f32_32x32x16_bf16(b0, qf, p0, 0, 0, 0);
    p1 = __builtin_amdgcn_mfma_f32_32x32x16_bf16(b1, qf, p1, 0, 0, 0);
    if constexpr (DK == 192) { if (d0 == QKT_SB0 || d0 == QKT_SB1) ATT_SBAR(); } }
}
__device__ __forceinline__ int v_st(int k, int c) { const int kk = (k & ~0xC) | ((k & 4) << 1) | ((k & 8) >> 1); return ((kk >> 3) * 4 + (c >> 5)) * 512 + ((kk & 7) * 32 + (c & 31)) * 2; }
__device__ __forceinline__ int v_rd_base(int lane) { return ((lane & 3) << 3) | (((lane >> 2) & 3) << 6) | (((lane >> 4) & 1) << 5) | (((lane >> 5) & 1) << 8); }
constexpr int v_rd_off(int d0, int ks, int half) { return d0 * 512 + ks * 4096 + half * 2048; }
template <int OFF> __device__ __forceinline__ s16x4 tr_read(int vb) {
  s16x4 r; asm volatile("ds_read_b64_tr_b16 %0, %1 offset:%2" : "=&v"(r) : "v"(vb), "i"(OFF) : "memory"); return r;
}
template <int D0> __device__ __forceinline__ void pv_one(f32x16& od, int vb, bf16x8 pa0, bf16x8 pa1, bf16x8 pa2, bf16x8 pa3) {
  const s16x4 l0 = tr_read<v_rd_off(D0, 0, 0)>(vb), h0 = tr_read<v_rd_off(D0, 0, 1)>(vb), l1 = tr_read<v_rd_off(D0, 1, 0)>(vb), h1 = tr_read<v_rd_off(D0, 1, 1)>(vb);
  const s16x4 l2 = tr_read<v_rd_off(D0, 2, 0)>(vb), h2 = tr_read<v_rd_off(D0, 2, 1)>(vb), l3 = tr_read<v_rd_off(D0, 3, 0)>(vb), h3 = tr_read<v_rd_off(D0, 3, 1)>(vb);
  asm volatile("s_waitcnt lgkmcnt(0)" ::: "memory"); ATT_SBAR();
#define ATT_PK(L, H) (bf16x8){L[0], L[1], L[2], L[3], H[0], H[1], H[2], H[3]}
  od = __builtin_amdgcn_mfma_f32_32x32x16_bf16(pa0, ATT_PK(l0, h0), od, 0, 0, 0);
  od = __builtin_amdgcn_mfma_f32_32x32x16_bf16(pa1, ATT_PK(l1, h1), od, 0, 0, 0);
  od = __builtin_amdgcn_mfma_f32_32x32x16_bf16(pa2, ATT_PK(l2, h2), od, 0, 0, 0);
  od = __builtin_amdgcn_mfma_f32_32x32x16_bf16(pa3, ATT_PK(l3, h3), od, 0, 0, 0);
#undef ATT_PK
}
__device__ __forceinline__ void pv_d0(f32x16* o, int vb, bf16x8 pa0, bf16x8 pa1, bf16x8 pa2, bf16x8 pa3) {
  pv_one<0>(o[0], vb, pa0, pa1, pa2, pa3); pv_one<1>(o[1], vb, pa0, pa1, pa2, pa3); pv_one<2>(o[2], vb, pa0, pa1, pa2, pa3); pv_one<3>(o[3], vb, pa0, pa1, pa2, pa3);
}

template <int DK, int LDQ, int LDKN, int LDV, int LDO, int SDEPTH, int NQR>
__device__ __forceinline__ void attn_unit(const bf16* __restrict__ Qb, const bf16* __restrict__ Kn, const bf16* __restrict__ Kr, const bf16* __restrict__ Vh,
                                          bf16* __restrict__ Ob, int seq, char* lds) {
  constexpr int SHM_V = KVBLK * 128 * 2, SHM_K = KVBLK * DK * 2, KRS = DK * 2;
  constexpr float SCALE = (DK == 128) ? 0.088388347648318440f : 0.072168783648703220f;
  constexpr float C = SCALE * 1.4426950408889634f, TS = THR / SCALE;
  int tid_ = threadIdx.x; asm volatile("" : "+v"(tid_));
  const int tid = tid_, wid = tid >> 6, lane = tid & 63, r32 = lane & 31, hi = lane >> 5;
  char* V_lds = lds; char* K_lds = lds + 2 * SHM_V;
  float* ws = (float*)(lds + 2 * SHM_V + 2 * SHM_K) + wid * 64; float* li_l = ws; float* al_l = ws + 32;
  float m_reg = -1e30f, l_reg = 0; f32x16 o[4] = {}; bf16x8 qr[NQR]; constexpr int NQL = DK / 16 - NQR;
  char* qrl = lds + 2 * SHM_V + 2 * SHM_K + 2048 + (wid * NQL * 64 + lane) * 16;
  __syncthreads();
  const bf16* Qw = Qb + (long)(wid * QBLK + r32) * LDQ + hi * 8;
#pragma unroll
  for (int d0 = 0; d0 < NQR; ++d0) qr[d0] = ld8(Qw + d0 * 16);
  if constexpr (NQL > 0) {
#pragma unroll
    for (int f = 0; f < NQL; ++f) *reinterpret_cast<bf16x8*>(qrl + f * 1024) = ld8(Qw + (NQR + f) * 16); }
  const int sr = tid >> 4, sc = (tid & 15) * 8, vst0 = v_st(sr, sc), vst1 = v_st(32 + sr, sc);
  const int rr = tid >> 3, rc = (tid & 7) * 8;
  const int vb0 = (int)(uintptr_t)V_lds + v_rd_base(lane);
  struct { bf16x8 vs0, vs1, ks0, ks1, kr; } sr_[SDEPTH];
#define ATT_SLOAD(i, k0) do { sr_[i].vs0 = ld8(&Vh[(long)((k0) + sr) * LDV + sc]); sr_[i].vs1 = ld8(&Vh[(long)((k0) + 32 + sr) * LDV + sc]); \
    sr_[i].ks0 = ld8(&Kn[(long)((k0) + sr) * LDKN + sc]); sr_[i].ks1 = ld8(&Kn[(long)((k0) + 32 + sr) * LDKN + sc]); \
    if constexpr (DK == 192) sr_[i].kr = ld8(&Kr[(long)((k0) + rr) * 64 + rc]); } while (0)
#define ATT_SWRITE(b, i) do { *(bf16x8*)(V_lds + (b) * SHM_V + vst0) = sr_[i].vs0; *(bf16x8*)(V_lds + (b) * SHM_V + vst1) = sr_[i].vs1; const int kc = sc * 2; \
    *(bf16x8*)(K_lds + (b) * SHM_K + kswz<KRS>(sr, kc)) = sr_[i].ks0; *(bf16x8*)(K_lds + (b) * SHM_K + kswz<KRS>(32 + sr, kc)) = sr_[i].ks1; \
    if constexpr (DK == 192) *(bf16x8*)(K_lds + (b) * SHM_K + kswz<KRS>(rr, 256 + rc * 2)) = sr_[i].kr; } while (0)
#define ATT_SWAIT() do { if constexpr (SDEPTH == 1) asm volatile("s_waitcnt vmcnt(0)" ::: "memory"); else if constexpr (DK == 192) asm volatile("s_waitcnt vmcnt(5)" ::: "memory"); else asm volatile("s_waitcnt vmcnt(4)" ::: "memory"); } while (0)
#define ATT_RESC(a) do { if (__any((a) < 1.f)) { if (hi == 0) al_l[r32] = (a); asm volatile("s_waitcnt lgkmcnt(0)" ::: "memory"); \
    _Pragma("unroll") for (int d = 0; d < 4; ++d) _Pragma("unroll") for (int r = 0; r < 16; ++r) o[d][r] *= al_l[crow(r, hi)]; } } while (0)
  f32x16 pA0, pA1, pB0, pB1; float mnA, mnB, alA, alB; bf16x8 pa0, pa1, pa2, pa3; const int NT = seq / KVBLK;
  constexpr int SE = 0, SO = SDEPTH - 1;
  ATT_SLOAD(SE, 0); asm volatile("s_waitcnt vmcnt(0)" ::: "memory"); ATT_SWRITE(0, SE); __syncthreads();
  qkt<DK, NQR>(pA0, pA1, K_lds, qr, qrl, r32, hi); partialSM(pA0, pA1, m_reg, mnA, alA, C, TS);
  ATT_SLOAD(SO, KVBLK); if constexpr (SDEPTH == 2) { if (2 < NT) ATT_SLOAD(SE, 2 * KVBLK); }
  if (2 < NT) ATT_SWAIT(); else asm volatile("s_waitcnt vmcnt(0)" ::: "memory");
  ATT_SWRITE(1, SO); __syncthreads();
  for (int j = 1; j + 1 < NT; j += 2) {
    ATT_SBAR(); qkt<DK, NQR>(pB0, pB1, K_lds + SHM_K, qr, qrl, r32, hi);
    finishSM(pA0, pA1, alA, l_reg, pa0, pa1, pa2, pa3); ATT_SBAR();
    ATT_SLOAD(SO, (j + SDEPTH) * KVBLK); ATT_SBAR();
    pv_d0(o, vb0, pa0, pa1, pa2, pa3); partialSM(pB0, pB1, m_reg, mnB, alB, C, TS);
    __syncthreads(); ATT_SWAIT(); ATT_SWRITE(0, SE);
    ATT_RESC(alB); __syncthreads();
    ATT_SBAR(); qkt<DK, NQR>(pA0, pA1, K_lds, qr, qrl, r32, hi);
    finishSM(pB0, pB1, alB, l_reg, pa0, pa1, pa2, pa3); ATT_SBAR();
    if (SDEPTH == 1 || j + 3 < NT) ATT_SLOAD(SE, (j + 1 + SDEPTH) * KVBLK); ATT_SBAR();
    pv_d0(o, vb0 + SHM_V, pa0, pa1, pa2, pa3); partialSM(pA0, pA1, m_reg, mnA, alA, C, TS);
    __syncthreads(); if (SDEPTH == 1 || j + 3 < NT) ATT_SWAIT(); else asm volatile("s_waitcnt vmcnt(0)" ::: "memory");
    ATT_SWRITE(1, SO);
    ATT_RESC(alA); __syncthreads();
  }
  ATT_SBAR(); qkt<DK, NQR>(pB0, pB1, K_lds + SHM_K, qr, qrl, r32, hi);
  finishSM(pA0, pA1, alA, l_reg, pa0, pa1, pa2, pa3); ATT_SBAR();
  pv_d0(o, vb0, pa0, pa1, pa2, pa3); partialSM(pB0, pB1, m_reg, mnB, alB, C, TS);
  __syncthreads(); ATT_RESC(alB);
  finishSM(pB0, pB1, alB, l_reg, pa0, pa1, pa2, pa3); ATT_SBAR();
  pv_d0(o, vb0 + SHM_V, pa0, pa1, pa2, pa3);
  if (hi == 0) li_l[r32] = l_reg; asm volatile("s_waitcnt lgkmcnt(0)" ::: "memory");
  float rli[16];
#pragma unroll
  for (int r = 0; r < 16; ++r) rli[r] = __builtin_amdgcn_rcpf(li_l[crow(r, hi)]);
  bf16* Ow = Ob + (long)(wid * QBLK) * LDO;
#pragma unroll
  for (int r = 0; r < 16; ++r) { const int orow = crow(r, hi);
#pragma unroll
    for (int d0 = 0; d0 < 4; d0 += 1) { const unsigned w = cvtpk(o[d0][r] * rli[r], 0.f); Ow[(long)orow * LDO + d0 * 32 + r32] = (bf16)(w & 0xffffu); } }
#undef ATT_SLOAD
#undef ATT_SWRITE
#undef ATT_SWAIT
#undef ATT_RESC
}
}
constexpr int DM = 2048, NP = 4096  , NS = 16384  , MT = NP + NS  ;
constexpr int SEQ_P = 256, SEQ_S = 4096, PAST = 512, KEYS_S = SEQ_S + PAST  , MK = NP + 4 * KEYS_S  ;
constexpr int ZW = 3840  , AIN = 3648, FF = 5632, NLAYER = 4;
constexpr int ZC_QA = 0, ZC_KA = 1024, ZC_VA = 1280, ZC_QB = 1536, ZC_CKV = 3072, ZC_KR = 3584;
constexpr float EPS = 1e-6f;
constexpr size_t OUT_SK = (size_t)MT * DM, OUT_SV = OUT_SK + 2097152, OUT_SCKV = OUT_SV + 2097152, OUT_SKR = OUT_SCKV + 4194304;

constexpr size_t MiB = 1u << 20;
constexpr size_t WS_CTL = 0, CTL_ZERO_BYTES = 64 * 1024;
constexpr size_t WS_TAB = 1 * MiB;
constexpr size_t WS_MOD = 2 * MiB;
constexpr size_t WS_SS = 3 * MiB;
constexpr size_t WS_WIN = 6 * MiB;
constexpr size_t WS_WKV = 36 * MiB;
constexpr size_t WS_WOUT = 40 * MiB;
constexpr size_t WS_CWIN = 56 * MiB;
constexpr size_t WS_CWOUT = 88 * MiB;
constexpr size_t WS_FGU = 104 * MiB;
constexpr size_t WS_FD = 280 * MiB;
constexpr size_t WS_H = 368 * MiB;
constexpr size_t WS_ACT = 448 * MiB;
constexpr size_t WS_Z = WS_ACT;
constexpr size_t WS_KA = WS_Z + 150 * MiB;
constexpr size_t WS_VA = WS_KA + 11 * MiB;
constexpr size_t WS_CKV = WS_VA + 11 * MiB;
constexpr size_t WS_KR = WS_CKV + 22 * MiB;
constexpr size_t WS_KVB = WS_KR + 3 * MiB;
constexpr size_t WS_O = WS_KVB + 88 * MiB;
constexpr size_t WS_ACT_END = WS_O + 80 * MiB;
constexpr size_t WS_U = WS_ACT, WS_V = WS_ACT + 80 * MiB, WS_MC = WS_ACT + 160 * MiB;
constexpr size_t WS_HH = WS_ACT;
constexpr size_t WS_SSX = WS_ACT_END;
constexpr size_t WS_BIAS1 = WS_ACT_END + 3 * MiB;
constexpr size_t WS_BIAS2 = WS_ACT_END + 4 * MiB;
constexpr size_t WS_PROBE = WS_ACT_END + 8 * MiB;
constexpr size_t WS_END = WS_ACT_END + 8 * MiB;
constexpr int CW_BAR = 1024;

constexpr int RING_BYTES = 131072;
#ifndef LDS_KB
#define LDS_KB 144
#endif
constexpr int LDS_BYTES = LDS_KB * 1024;
constexpr int MISC_OFF = LDS_BYTES - 64;
constexpr int NWAVES = 8, NTHREADS = 512;

#define GAS __attribute__((address_space(1)))
#define LAS __attribute__((address_space(3)))
typedef unsigned short bf16;
typedef unsigned v4u __attribute__((ext_vector_type(4)));
typedef unsigned v2u __attribute__((ext_vector_type(2)));
typedef float f32x4 __attribute__((ext_vector_type(4)));
typedef short bf16x8 __attribute__((ext_vector_type(8)));
typedef float f32x16 __attribute__((ext_vector_type(16)));
#define LDS_WAIT() asm volatile("s_waitcnt lgkmcnt(0)" ::: "memory")
#define VM_WAIT() asm volatile("s_waitcnt vmcnt(0)" ::: "memory")
__device__ __forceinline__ unsigned pk2(float lo, float hi) { unsigned r; asm volatile("v_cvt_pk_bf16_f32 %0, %1, %2" : "=v"(r) : "v"(lo), "v"(hi)); return r; }
__device__ __forceinline__ float bf_lo(unsigned w) { return __uint_as_float(w << 16); }
__device__ __forceinline__ float bf_hi(unsigned w) { return __uint_as_float(w & 0xffff0000u); }
#define SWZ_XOR(v, m) __int_as_float(__builtin_amdgcn_ds_swizzle(__float_as_int(v), ((m) << 10) | 0x1f))
__device__ __forceinline__ float add_xor32(float v) { auto rr = __builtin_amdgcn_permlane32_swap(__float_as_uint(v), __float_as_uint(v), false, false); return __uint_as_float(rr[0]) + __uint_as_float(rr[1]); }
__device__ __forceinline__ float wave_sum(float v) {
    v += SWZ_XOR(v, 1); v += SWZ_XOR(v, 2); v += SWZ_XOR(v, 4); v += SWZ_XOR(v, 8); v += SWZ_XOR(v, 16);
    return add_xor32(v);
}

#define XB_TMO      128
#define XB_XCNT(j)  (256  + 64 * (j))
#define XB_XSUB(j)  (1280 + 64 * (j))
#define XB_XGEN(j)  (2304 + 64 * (j))
#define XB_TOP      3328
#define XB_TOPGEN   3392
#define XCD_BAR_WORDS 3456
#define XB_SPIN_CAP (1u << 18)
#define LAS __attribute__((address_space(3)))

__device__ __forceinline__ unsigned xb_ld(unsigned* p)              { return __hip_atomic_load(p, __ATOMIC_RELAXED, __HIP_MEMORY_SCOPE_AGENT); }
__device__ __forceinline__ unsigned xb_add(unsigned* p, unsigned v) { return __hip_atomic_fetch_add(p, v, __ATOMIC_RELAXED, __HIP_MEMORY_SCOPE_AGENT); }
__device__ __forceinline__ unsigned xb_xcc_id() { return (unsigned)__builtin_amdgcn_s_getreg((3 << 11) | 20) & 0xFu; }
#define XB_SPIN(cond, bar) do { unsigned _sp = 0; while (cond) { __builtin_amdgcn_s_sleep(1); \
    if ((++_sp & 255u) == 0u) { if (xb_ld(&(bar)[XB_TMO])) break; if (_sp > XB_SPIN_CAP) { atomicAdd(&(bar)[XB_TMO], 1u); break; } } } } while (0)

struct XcdBarrier {
    unsigned* bar; unsigned x;
    volatile LAS unsigned* st;
};

__device__ __forceinline__ XcdBarrier xcd_barrier_post(unsigned* bar, volatile LAS unsigned* st) {
    XcdBarrier b; b.bar = bar; b.x = xb_xcc_id(); b.st = st;
    if (threadIdx.x == 0) (void)xb_add(&bar[XB_XCNT(b.x)], 1u);
    return b;
}
__device__ __forceinline__ void xcd_barrier_complete(unsigned* bar, unsigned x, unsigned& nloc, unsigned& nx) {
    const unsigned G = gridDim.x * gridDim.y * gridDim.z;
    unsigned sum, cnt, mine, sp = 0u;
    for (;;) {
        sum = 0u; cnt = 0u; mine = 0u;
#pragma unroll
        for (unsigned j = 0; j < 16; ++j) { const unsigned c = xb_ld(&bar[XB_XCNT(j)]); sum += c; cnt += (c > 0u) ? 1u : 0u; mine = (j == x) ? c : mine; }
        if (sum == G) break;
        __builtin_amdgcn_s_sleep(1);
        if ((++sp & 255u) == 0u) { if (xb_ld(&bar[XB_TMO])) break; if (sp > XB_SPIN_CAP) { atomicAdd(&bar[XB_TMO], 1u); break; } }
    }
    nloc = mine > 0u ? mine : 1u; nx = cnt > 0u ? cnt : 1u;
}

__device__ __forceinline__ void xcd_barrier(const XcdBarrier& b) {
    asm volatile("s_waitcnt vmcnt(0)" ::: "memory");
    __syncthreads();
    if (threadIdx.x == 0) {
        unsigned* bar = b.bar;
        __builtin_amdgcn_s_waitcnt(0);
        unsigned nloc = b.st[0], nx = b.st[1];
        if (nloc == 0u) { xcd_barrier_complete(bar, b.x, nloc, nx); b.st[0] = nloc; b.st[1] = nx; }
        const unsigned old = xb_add(&bar[XB_XSUB(b.x)], 1u);
        const unsigned gen = old / nloc;
        if (old + 1u == (gen + 1u) * nloc) {
            __builtin_amdgcn_fence(__ATOMIC_RELEASE, "agent");
            asm volatile("s_waitcnt vmcnt(0)" ::: "memory");
            const unsigned og = xb_add(&bar[XB_TOP], 1u);
            const unsigned tg = og / nx;
            if (og + 1u == (tg + 1u) * nx) xb_add(&bar[XB_TOPGEN], 1u);
            else XB_SPIN(xb_ld(&bar[XB_TOPGEN]) == tg, bar);
            __builtin_amdgcn_fence(__ATOMIC_ACQUIRE, "agent");
            xb_add(&bar[XB_XGEN(b.x)], 1u);
            asm volatile("s_waitcnt vmcnt(0)" ::: "memory");
        } else {
            XB_SPIN(xb_ld(&bar[XB_XGEN(b.x)]) == gen, bar);
            __builtin_amdgcn_fence(__ATOMIC_ACQUIRE, "agent");
            asm volatile("s_waitcnt vmcnt(0)" ::: "memory");
        }
    }
    __syncthreads();
}

struct Args { const GAS float* in[27]; GAS float* out_f; GAS unsigned char* ws_b; int ph_lo, ph_hi; };
typedef __attribute__((address_space(4))) const Args* KArgsPtr;
struct InProxy { KArgsPtr ka; __device__ __forceinline__ const float* operator[](int i) const { return (const float*)ka->in[i]; } };
struct Frame {
    LAS unsigned char* lds;
    char* ldsg;
    int tid, lane, wave, bid, G;
    InProxy in;
    float* out; unsigned char* ws;
};
#define PHASE_BEGIN(F) do { GAS unsigned char* w_ = (F).in.ka->ws_b; GAS float* o_ = (F).in.ka->out_f; int g_ = (int)gridDim.x, b_ = (int)blockIdx.x, t_ = (int)threadIdx.x; \
    asm volatile("" : "+s"(w_), "+s"(o_), "+s"(g_), "+s"(b_), "+v"(t_)); (F).ws = (unsigned char*)w_; (F).out = (float*)o_; (F).G = g_; (F).bid = b_; (F).tid = t_; (F).lane = t_ & 63; (F).wave = __builtin_amdgcn_readfirstlane(t_ >> 6); } while (0)
#define FRAME_REFRESH(F) do { } while (0)
enum { I_XP = 0, I_XS, I_C, I_CK, I_CV, I_CCKV, I_CKR, I_CCTX, I_ADAW, I_ADAB, I_NMIX, I_NFFN, I_FG, I_FU, I_FD, I_AWIN, I_AQN, I_AKN, I_AKVN, I_AWKV, I_AWOUT, I_CWIN, I_CVN, I_CWS, I_CBS, I_CWOUT, I_FNORM };

__device__ __forceinline__ void p0_transpose_item(const float* W, int K, int N, bf16* WT, int k0, int n0, int drow0, LAS float* scr, int lane) {
    const int kr = lane >> 4, n4 = (lane & 15) * 4;
    f32x4 v[16];
#pragma unroll
    for (int i = 0; i < 16; ++i) v[i] = *(const GAS f32x4*)(W + (size_t)(k0 + 4 * i + kr) * N + n0 + n4);
#pragma unroll
    for (int i = 0; i < 16; ++i) { LAS float* d = scr + (4 * i + kr) * 65 + n4; d[0] = v[i].x; d[1] = v[i].y; d[2] = v[i].z; d[3] = v[i].w; }
    LDS_WAIT(); asm volatile("" ::: "memory");
    const int c = lane & 7;
#pragma unroll
    for (int j = 0; j < 8; ++j) { const int n = (lane >> 3) + 8 * j; const LAS float* s = scr + (8 * c) * 65 + n;
        v4u o; o.x = pk2(s[0 * 65], s[1 * 65]); o.y = pk2(s[2 * 65], s[3 * 65]); o.z = pk2(s[4 * 65], s[5 * 65]); o.w = pk2(s[6 * 65], s[7 * 65]);
        *(GAS v4u*)(WT + (size_t)(drow0 + n) * K + k0 + 8 * c) = o; }
    LDS_WAIT(); asm volatile("" ::: "memory");
}
__device__ __forceinline__ void rope_entry(int pos, int i, double r, float& co, float& si) {
    double inv = 1.0; for (int k = 0; k < i; ++k) inv *= r;
    const double ang = (double)pos * inv;
    const double n = __builtin_rint(ang * 0.63661977236758134308);
    const double x = (ang - n * 1.57079632679489655800) - n * 6.12323399573676603587e-17;
    const double x2 = x * x;
    const double s = x * (1.0 + x2 * (-1.0 / 6 + x2 * (1.0 / 120 + x2 * (-1.0 / 5040 + x2 * (1.0 / 362880 + x2 * (-1.0 / 39916800 + x2 * (1.0 / 6227020800.0 + x2 * (-1.0 / 1307674368000.0))))))));
    const double c = 1.0 + x2 * (-0.5 + x2 * (1.0 / 24 + x2 * (-1.0 / 720 + x2 * (1.0 / 40320 + x2 * (-1.0 / 3628800 + x2 * (1.0 / 479001600 + x2 * (-1.0 / 87178291200.0 + x2 * (1.0 / 20922789888000.0))))))));
    const int q = ((int)n) & 3;
    const double cc = (q == 0) ? c : (q == 1) ? -s : (q == 2) ? -c : s;
    const double ss = (q == 0) ? s : (q == 1) ? c : (q == 2) ? -s : -c;
    co = (float)cc; si = (float)ss;
}
__device__ __forceinline__ void ada_layer(Frame& F, int layer, int it_lo, int it_hi, int widx, int nwg) {
    LAS float* SC = (LAS float*)F.lds;
    LAS float* RED = (LAS float*)(F.lds + 40960);
    __syncthreads();
    for (int idx = F.tid; idx < 5 * DM; idx += NTHREADS) { const int cd = idx >> 11, k = idx & 2047; const float v = cd == 0 ? F.in[I_CCTX][k] : F.in[I_C][(cd - 1) * DM + k];
        SC[idx] = v / (1.0f + __expf(-v)); }
    __syncthreads();
    float* MOD = (float*)(F.ws + WS_MOD);
    for (int it = it_lo + widx; it < it_hi; it += nwg) {
        const int c0 = it * 32, cg = F.lane & 7, rsub = F.lane >> 3;
        const float* W = F.in[I_ADAW] + (size_t)layer * DM * 12288 + c0 + 4 * cg;
        f32x4 acc[5];
#pragma unroll
        for (int cd = 0; cd < 5; ++cd) acc[cd] = (f32x4){0.f, 0.f, 0.f, 0.f};
#pragma unroll 8
        for (int i = 0; i < 32; ++i) { const int k = 256 * F.wave + 8 * i + rsub; const f32x4 w = *(const f32x4*)(W + (size_t)k * 12288);
#pragma unroll
            for (int cd = 0; cd < 5; ++cd) acc[cd] += SC[cd * DM + k] * w; }
#pragma unroll
        for (int cd = 0; cd < 5; ++cd)
#pragma unroll
            for (int e = 0; e < 4; ++e) { float v = acc[cd][e]; v += SWZ_XOR(v, 8); v += SWZ_XOR(v, 16); v = add_xor32(v); acc[cd][e] = v; }
        if (rsub == 0) {
#pragma unroll
            for (int cd = 0; cd < 5; ++cd) *(LAS f32x4*)(RED + (F.wave * 5 + cd) * 32 + 4 * cg) = acc[cd]; }
        __syncthreads();
        if (F.tid < 160) { const int cd = F.tid >> 5, col = F.tid & 31; float s = 0.f;
#pragma unroll
            for (int w = 0; w < 8; ++w) s += RED[(w * 5 + cd) * 32 + col];
            MOD[((size_t)layer * 5 + cd) * 12288 + c0 + col] = s + F.in[I_ADAB][layer * 12288 + c0 + col]; }
        __syncthreads();
    }
}
__device__ __forceinline__ void conv_items(Frame& F, int L, int part, int widx, int nw) {
    LAS float* scr = (LAS float*)(F.lds + F.wave * 16640);
    constexpr int I_WIN = 32 * 57, I_WKV = 8 * 32, I_WOUT = 32 * 32, I_CWI = 32 * 64, I_FGU = 32 * 88, I_FDN = 88 * 32;
    const int j = L >> 1; const bool attn = (L & 1) == 0;
    const int count = part ? 3 * I_FGU : (attn ? I_WIN + I_WKV + I_WOUT : I_CWI + I_WOUT);
    for (int it = widx; it < count; it += nw) {
        const float* W; bf16* WT; int K, N, r, gu = -1;
        if (part) { const int m = it / I_FGU; r = it % I_FGU;
            if (m < 2) { gu = m; K = DM; N = FF; W = (gu ? F.in[I_FU] : F.in[I_FG]) + (size_t)L * DM * FF; WT = (bf16*)(F.ws + WS_FGU) + (size_t)L * 2 * FF * DM; }
            else { K = FF; N = DM; W = F.in[I_FD] + (size_t)L * FF * DM; WT = (bf16*)(F.ws + WS_FD) + (size_t)L * DM * FF; } }
        else if (attn) {
            if (it < I_WIN) { r = it; K = DM; N = AIN; W = F.in[I_AWIN] + (size_t)j * DM * AIN; WT = (bf16*)(F.ws + WS_WIN) + (size_t)j * ZW * DM; }
            else if (it < I_WIN + I_WKV) { r = it - I_WIN; K = 512; N = 2048; W = F.in[I_AWKV] + (size_t)j * 512 * 2048; WT = (bf16*)(F.ws + WS_WKV) + (size_t)j * 2048 * 512; }
            else { r = it - I_WIN - I_WKV; K = DM; N = DM; W = F.in[I_AWOUT] + (size_t)j * DM * DM; WT = (bf16*)(F.ws + WS_WOUT) + (size_t)j * DM * DM; } }
        else {
            if (it < I_CWI) { r = it; K = DM; N = 4096; W = F.in[I_CWIN] + (size_t)j * DM * 4096; WT = (bf16*)(F.ws + WS_CWIN) + (size_t)j * 4096 * DM; }
            else { r = it - I_CWI; K = DM; N = DM; W = F.in[I_CWOUT] + (size_t)j * DM * DM; WT = (bf16*)(F.ws + WS_CWOUT) + (size_t)j * DM * DM; } }
        const int nblk = N / 64, kb = r / nblk, nb = r % nblk, n0 = 64 * nb;
        const int drow0 = (gu < 0) ? n0 : ((n0 >> 7) * 256 + gu * 128 + (n0 & 127));
        p0_transpose_item(W, K, N, WT, 64 * kb, n0, drow0, scr, F.lane);
    }
}
__device__ __forceinline__ void tail_slot(Frame& F, int first_idle, int& widx, int& nwg) {
    const int fi = (first_idle > 0 && first_idle < F.G) ? first_idle : 0; widx = F.bid - fi; nwg = F.G - fi;
}
#ifndef TAIL_CONV
#define TAIL_CONV 1
#endif
__device__ __forceinline__ void p0_prologue(Frame& F) {
    FRAME_REFRESH(F);
    for (int layer = 0; layer < (TAIL_CONV ? 1 : NLAYER); ++layer) ada_layer(F, layer, 0, 384, F.bid, F.G);
    if (F.bid == F.G - 1) {
        float* T128 = (float*)(F.ws + WS_TAB); float* T64 = (float*)(F.ws + WS_TAB + 16384);
        for (int e = F.tid; e < 64 * 32 + 64 * 16; e += NTHREADS) {
            float co, si;
            if (e < 2048) { rope_entry(e >> 5, e & 31, 0.74989420933245582730, co, si); T128[2 * e] = co; T128[2 * e + 1] = si; }
            else { const int f = e - 2048; rope_entry(f >> 4, f & 15, 0.56234132519034908039, co, si); T64[2 * f] = co; T64[2 * f + 1] = si; }
        }
    }
    { const size_t n16 = (size_t)(ZW - AIN) * DM * 2 / 16;
      for (size_t i = (size_t)F.bid * NTHREADS + F.tid; i < 2 * n16; i += (size_t)F.G * NTHREADS) { const size_t l = i / n16, r = i % n16;
          *(GAS v4u*)(F.ws + WS_WIN + l * ((size_t)ZW * DM * 2) + (size_t)AIN * DM * 2 + r * 16) = (v4u){0u, 0u, 0u, 0u}; } }
    __syncthreads();
    const int gw = F.bid * NWAVES + F.wave, NGW = F.G * NWAVES;
    for (int L = 0; L < (TAIL_CONV ? 1 : NLAYER); ++L) { conv_items(F, L, 0, gw, NGW); conv_items(F, L, 1, gw, NGW); }
}

__device__ __forceinline__ void unpack8(const v4u w, float (&x)[8]) { x[0] = bf_lo(w.x); x[1] = bf_hi(w.x); x[2] = bf_lo(w.y); x[3] = bf_hi(w.y); x[4] = bf_lo(w.z); x[5] = bf_hi(w.z); x[6] = bf_lo(w.w); x[7] = bf_hi(w.w); }
__device__ __forceinline__ void mod0_phase(Frame& F, const float* x_lo, const float* x_hi, const float* gain, const float* modl  ) {
    bf16* H = (bf16*)(F.ws + WS_H); float* SSX = (float*)(F.ws + WS_SSX);
    const int gw = F.bid * NWAVES + F.wave, NGW = F.G * NWAVES;
    for (int m = gw; m < MT; m += NGW) {
        const float* xr = (m < NP) ? x_lo + (size_t)m * DM : x_hi + (size_t)(m - NP) * DM;
        const int cd = (m < NP) ? 0 : 1 + ((m - NP) >> 12);
        const float* sc = modl + (size_t)cd * 12288 + DM;
        f32x4 v[8]; float s = 0.f;
#pragma unroll
        for (int j = 0; j < 8; ++j) { v[j] = ((const GAS f32x4*)xr)[F.lane + 64 * j]; s += (v[j].x * v[j].x + v[j].y * v[j].y) + (v[j].z * v[j].z + v[j].w * v[j].w); }
        s = wave_sum(s);
        if (F.lane < 32) SSX[(size_t)m * 32 + F.lane] = F.lane == 0 ? s : 0.f;
        GAS v2u* o8 = (GAS v2u*)(H + (size_t)m * DM) + F.lane;
#pragma unroll
        for (int j = 0; j < 8; ++j) { const f32x4 g = ((const GAS f32x4*)gain)[F.lane + 64 * j], a = ((const GAS f32x4*)sc)[F.lane + 64 * j];
            const f32x4 y = v[j] * (g * (1.0f + a));
            v2u w; w.x = pk2(y.x, y.y); w.y = pk2(y.z, y.w); o8[64 * j] = w; }
    }
}
__device__ __forceinline__ void bias_rows(Frame& F, const bf16* Bt, int nrows, const float* sh  , float* out, int ldb, int widx, int nw) {
    LAS float* SH = (LAS float*)F.lds;
    __syncthreads();
    for (int idx = F.tid; idx < 5 * DM; idx += NTHREADS) SH[idx] = sh[(size_t)(idx >> 11) * 12288 + (idx & 2047)];
    __syncthreads();
    for (int n = widx; n < nrows; n += nw) {
        const GAS v4u* bp = (const GAS v4u*)(Bt + (size_t)n * DM) + F.lane;
        v4u w[4];
#pragma unroll
        for (int i = 0; i < 4; ++i) w[i] = bp[64 * i];
        float acc[5] = {0.f, 0.f, 0.f, 0.f, 0.f};
#pragma unroll
        for (int i = 0; i < 4; ++i) { float x[8]; unpack8(w[i], x);
#pragma unroll
            for (int cd = 0; cd < 5; ++cd) { const LAS f32x4* sp = (const LAS f32x4*)(SH + cd * DM + 8 * F.lane + 512 * i); const f32x4 a = sp[0], b = sp[1];
                acc[cd] += (x[0] * a.x + x[1] * a.y) + (x[2] * a.z + x[3] * a.w) + (x[4] * b.x + x[5] * b.y) + (x[6] * b.z + x[7] * b.w); } }
#pragma unroll
        for (int cd = 0; cd < 5; ++cd) { const float s = wave_sum(acc[cd]); if (F.lane == 0) out[(size_t)cd * ldb + n] = s; }
    }
    __syncthreads();
}
__device__ __forceinline__ void final_phase(Frame& F) {
    FRAME_REFRESH(F);
    const int gw = F.bid * NWAVES + F.wave, NGW = F.G * NWAVES; const float* gain = F.in[I_FNORM];
    for (int m = gw; m < MT; m += NGW) {
        GAS f32x4* xr = (GAS f32x4*)(F.out + (size_t)m * DM);
        f32x4 v[8]; float s = 0.f;
#pragma unroll
        for (int j = 0; j < 8; ++j) { v[j] = xr[F.lane + 64 * j]; s += (v[j].x * v[j].x + v[j].y * v[j].y) + (v[j].z * v[j].z + v[j].w * v[j].w); }
        const float rstd = 1.0f / sqrtf(wave_sum(s) * (1.0f / DM) + EPS);
#pragma unroll
        for (int j = 0; j < 8; ++j) { const f32x4 g = ((const GAS f32x4*)gain)[F.lane + 64 * j]; xr[F.lane + 64 * j] = v[j] * rstd * g; }
    }
}

__device__ __forceinline__ void head_norm_rope16(float (&x)[16], int s, const float* gain128, bool rope, int prow, int pcol, const float* T128) {
    float ss = 0.f;
#pragma unroll
    for (int e = 0; e < 16; ++e) ss += x[e] * x[e];
    ss += SWZ_XOR(ss, 1); ss += SWZ_XOR(ss, 2); ss += SWZ_XOR(ss, 4);
    const float rstd = 1.0f / sqrtf(ss * (1.0f / 128.0f) + EPS);
#pragma unroll
    for (int e = 0; e < 16; ++e) x[e] = x[e] * rstd * gain128[16 * s + e];
    if (rope) {
        const int pos = (s >> 2) ? pcol : prow; const bool second = (s >> 1) & 1; const float* t = T128 + ((size_t)pos * 32 + 16 * (s & 1)) * 2;
#pragma unroll
        for (int e = 0; e < 16; ++e) { const float xp = SWZ_XOR(x[e], 2); const float co = t[2 * e], si = t[2 * e + 1];
            x[e] = x[e] * co + (second ? xp * si : -xp * si); }
    }
}
__device__ __forceinline__ void rope8(float (&x)[8], int s, int prow, int pcol, const float* T64) {
    const int pos = (s >> 2) ? pcol : prow; const bool second = (s >> 1) & 1; const float* t = T64 + ((size_t)pos * 16 + 8 * (s & 1)) * 2;
#pragma unroll
    for (int e = 0; e < 8; ++e) { const float xp = SWZ_XOR(x[e], 2); const float co = t[2 * e], si = t[2 * e + 1];
        x[e] = x[e] * co + (second ? xp * si : -xp * si); }
}
__device__ __forceinline__ v4u pack8(const float* x) { v4u w; w.x = pk2(x[0], x[1]); w.y = pk2(x[2], x[3]); w.z = pk2(x[4], x[5]); w.w = pk2(x[6], x[7]); return w; }
__device__ __forceinline__ void post_phase(Frame& F, int j, bool dry = false) {
    FRAME_REFRESH(F);
    bf16* Z = (bf16*)(F.ws + WS_Z); bf16* KA = (bf16*)(F.ws + WS_KA); bf16* VA = (bf16*)(F.ws + WS_VA); bf16* CKV = (bf16*)(F.ws + WS_CKV); bf16* KR = (bf16*)(F.ws + WS_KR);
    const float* T128 = (const float*)(F.ws + WS_TAB); const float* T64 = (const float*)(F.ws + WS_TAB + 16384);
    const float* qn = F.in[I_AQN] + j * 128; const float* kn = F.in[I_AKN] + j * 128; const float* kvn = F.in[I_AKVN] + j * 512;
    const int gw = F.bid * NWAVES + F.wave, NGW = F.G * NWAVES, lane = F.lane, s = lane & 7;
    for (int m = gw; m < MT + 4 * PAST; m += NGW) {
        if (m >= MT) {
            const int ci = m - MT, b = ci >> 9, p = ci & 511; const size_t krow = (size_t)NP + (size_t)b * KEYS_S + SEQ_S + p; const size_t src = ((size_t)(b * 2 + j) * PAST + p);
            { const f32x4 a = ((const GAS f32x4*)(F.in[I_CK] + src * 256))[lane]; v2u w; w.x = pk2(a.x, a.y); w.y = pk2(a.z, a.w); ((GAS v2u*)(KA + krow * 256))[lane] = w; }
            { const f32x4 a = ((const GAS f32x4*)(F.in[I_CV] + src * 256))[lane]; v2u w; w.x = pk2(a.x, a.y); w.y = pk2(a.z, a.w); ((GAS v2u*)(VA + krow * 256))[lane] = w; }
            { const f32x4 a = ((const GAS f32x4*)(F.in[I_CCKV] + src * 512))[2 * lane], c = ((const GAS f32x4*)(F.in[I_CCKV] + src * 512))[2 * lane + 1];
              v4u w; w.x = pk2(a.x, a.y); w.y = pk2(a.z, a.w); w.z = pk2(c.x, c.y); w.w = pk2(c.z, c.w); ((GAS v4u*)(CKV + krow * 512))[lane] = w; }
            if (lane < 16) { const f32x4 a = ((const GAS f32x4*)(F.in[I_CKR] + src * 64))[lane]; v2u w; w.x = pk2(a.x, a.y); w.y = pk2(a.z, a.w); ((GAS v2u*)(KR + krow * 64))[lane] = w; }
            continue;
        }
        const bool lat = m >= NP; const int t = (m - NP) & 4095, prow = t >> 6, pcol = t & 63;
        const size_t krow = lat ? (size_t)NP + (size_t)((m - NP) >> 12) * KEYS_S + t : (size_t)m;
        bf16* zr = Z + (size_t)m * ZW;
        const v4u q0 = ((const GAS v4u*)(zr + ZC_QA))[2 * lane], q1 = ((const GAS v4u*)(zr + ZC_QA))[2 * lane + 1];
        const v4u k0 = ((const GAS v4u*)(zr + ZC_KA))[2 * (lane & 15)], k1 = ((const GAS v4u*)(zr + ZC_KA))[2 * (lane & 15) + 1];
        const v4u vv = ((const GAS v4u*)(zr + ZC_VA))[lane & 31];
        const v4u qb = *(const GAS v4u*)(zr + ZC_QB + (lane >> 3) * 192 + 128 + 8 * s);
        const v4u cw = ((const GAS v4u*)(zr + ZC_CKV))[lane];
        const v4u rw = ((const GAS v4u*)(zr + ZC_KR))[s];
        { float x[16]; float xa[8], xb[8]; unpack8(q0, xa); unpack8(q1, xb);
#pragma unroll
          for (int e = 0; e < 8; ++e) { x[e] = xa[e]; x[8 + e] = xb[e]; }
          head_norm_rope16(x, s, qn, lat, prow, pcol, T128);
          if (!dry) { ((GAS v4u*)(zr + ZC_QA))[2 * lane] = pack8(x); ((GAS v4u*)(zr + ZC_QA))[2 * lane + 1] = pack8(x + 8); } }
        { float x[16]; float xa[8], xb[8]; unpack8(k0, xa); unpack8(k1, xb);
#pragma unroll
          for (int e = 0; e < 8; ++e) { x[e] = xa[e]; x[8 + e] = xb[e]; }
          head_norm_rope16(x, s, kn, false, 0, 0, T128);
          if (!lat && lane < 16) { float* so = F.out + OUT_SK + ((size_t)((m >> 8) * 2 + j) * SEQ_P + (m & 255)) * 256 + 16 * lane;
#pragma unroll
              for (int e = 0; e < 4; ++e) ((GAS f32x4*)so)[e] = (f32x4){x[4 * e], x[4 * e + 1], x[4 * e + 2], x[4 * e + 3]}; }
          if (lat) { const int pos = (s >> 2) ? pcol : prow; const bool second = (s >> 1) & 1; const float* tt = T128 + ((size_t)pos * 32 + 16 * (s & 1)) * 2;
#pragma unroll
              for (int e = 0; e < 16; ++e) { const float xp = SWZ_XOR(x[e], 2); x[e] = x[e] * tt[2 * e] + (second ? xp * tt[2 * e + 1] : -xp * tt[2 * e + 1]); } }
          if (lane < 16) { ((GAS v4u*)(KA + krow * 256))[2 * lane] = pack8(x); ((GAS v4u*)(KA + krow * 256))[2 * lane + 1] = pack8(x + 8); } }
        if (lane < 32) { ((GAS v4u*)(VA + krow * 256))[lane] = vv;
            if (!lat) { float x[8]; unpack8(vv, x); float* so = F.out + OUT_SV + ((size_t)((m >> 8) * 2 + j) * SEQ_P + (m & 255)) * 256 + 8 * lane;
                ((GAS f32x4*)so)[0] = (f32x4){x[0], x[1], x[2], x[3]}; ((GAS f32x4*)so)[1] = (f32x4){x[4], x[5], x[6], x[7]}; } }
        if (lat) { float x[8]; unpack8(qb, x); rope8(x, s, prow, pcol, T64); if (!dry) *(GAS v4u*)(zr + ZC_QB + (lane >> 3) * 192 + 128 + 8 * s) = pack8(x); }
        { float x[8]; unpack8(cw, x); float ss = 0.f;
#pragma unroll
          for (int e = 0; e < 8; ++e) ss += x[e] * x[e];
          const float rstd = 1.0f / sqrtf(wave_sum(ss) * (1.0f / 512.0f) + EPS);
#pragma unroll
          for (int e = 0; e < 8; ++e) x[e] = x[e] * rstd * kvn[8 * lane + e];
          ((GAS v4u*)(CKV + krow * 512))[lane] = pack8(x);
          if (!lat) { float* so = F.out + OUT_SCKV + ((size_t)((m >> 8) * 2 + j) * SEQ_P + (m & 255)) * 512 + 8 * lane;
              ((GAS f32x4*)so)[0] = (f32x4){x[0], x[1], x[2], x[3]}; ((GAS f32x4*)so)[1] = (f32x4){x[4], x[5], x[6], x[7]}; } }
        { float x[8]; unpack8(rw, x);
          if (!lat && lane < 8) { float* so = F.out + OUT_SKR + ((size_t)((m >> 8) * 2 + j) * SEQ_P + (m & 255)) * 64 + 8 * lane;
              ((GAS f32x4*)so)[0] = (f32x4){x[0], x[1], x[2], x[3]}; ((GAS f32x4*)so)[1] = (f32x4){x[4], x[5], x[6], x[7]}; }
          if (lat) rope8(x, s, prow, pcol, T64);
          if (lane < 8) ((GAS v4u*)(KR + krow * 64))[lane] = pack8(x); }
    }
}

#ifndef ATT_MLA_SD
#define ATT_MLA_SD 1
#endif
#ifndef ATT_MLA_NQR
#define ATT_MLA_NQR 6
#endif
#ifndef EN_ATT_GQA
#define EN_ATT_GQA 1
#endif
#ifndef EN_ATT_MLA
#define EN_ATT_MLA 1
#endif
constexpr int BIAS_LDS_OFF = RING_BYTES, BIAS_LDS_UNITS = 14;
static_assert(BIAS_LDS_OFF + BIAS_LDS_UNITS * 1024 <= MISC_OFF, "bias table vs the LDS map");
__device__ __forceinline__ void bias_to_lds(Frame& F, const pg8::StaticOrder& S, const float* bias, int ldb) {
    LAS float* tb = (LAS float*)(F.lds + BIAS_LDS_OFF);
    __syncthreads();
    const int half = F.tid >> 8, t = F.tid & 255; pg8::Unit u;
#pragma unroll
    for (int i0 = 0; i0 < BIAS_LDS_UNITS; i0 += 2) { const int i = i0 + half; if (S.next(i, u)) tb[i * 256 + t] = bias[(size_t)pg8::cond_of_pm(u.pm) * ldb + u.pn * 256 + t]; }
    __syncthreads();
}
static_assert(2 * 16384 + 2 * 64 * 192 * 2 + 2048 + 8 * (12 - ATT_MLA_NQR) * 1024 <= MISC_OFF, "attention LDS use vs the LDS map");
static_assert(384 * 272 + 1024 <= MISC_OFF && 8 * 16640 <= MISC_OFF, "phase scratch vs the LDS map");
__device__ __forceinline__ void attn_phase(Frame& F) {
    const bf16* Z = (const bf16*)(F.ws + WS_Z); const bf16* KA = (const bf16*)(F.ws + WS_KA); const bf16* VA = (const bf16*)(F.ws + WS_VA);
    const bf16* KR = (const bf16*)(F.ws + WS_KR); const bf16* KVB = (const bf16*)(F.ws + WS_KVB); bf16* O = (bf16*)(F.ws + WS_O);
#if EN_ATT_GQA
    for (int L = F.bid; L < 512; L += F.G) {
        const int x = L & 7, s = L >> 3, b = x >> 1, kvh = x & 1, h = kvh * 4 + (s >> 4), qb = s & 15;
        const size_t qrow = (size_t)NP + (size_t)b * SEQ_S + qb * 256, krow = (size_t)NP + (size_t)b * KEYS_S;
        att::attn_unit<128, ZW, 256, 256, DM, 2, 8>(Z + qrow * ZW + ZC_QA + h * 128, KA + krow * 256 + kvh * 128, nullptr, VA + krow * 256 + kvh * 128, O + qrow * DM + h * 128, KEYS_S, F.ldsg);
    }
#endif
#if EN_ATT_MLA
    for (int L = F.bid; L < 512; L += F.G) {
        const int x = L & 7, s = L >> 3, b = x >> 1, h = (x & 1) * 4 + (s >> 4), qb = s & 15;
        const size_t qrow = (size_t)NP + (size_t)b * SEQ_S + qb * 256, krow = (size_t)NP + (size_t)b * KEYS_S;
        att::attn_unit<192, ZW, DM, DM, DM, ATT_MLA_SD, ATT_MLA_NQR>(Z + qrow * ZW + ZC_QB + h * 192, KVB + krow * DM + h * 256, KR + krow * 64, KVB + krow * DM + h * 256 + 128, O + qrow * DM + 1024 + h * 128, KEYS_S, F.ldsg);
    }
#endif
#if EN_ATT_GQA
    for (int L = F.bid; L < 128; L += F.G) {
        const int b = L >> 3, h = L & 7, kvh = h >> 2; const size_t row = (size_t)b * SEQ_P;
        att::attn_unit<128, ZW, 256, 256, DM, 2, 8>(Z + row * ZW + ZC_QA + h * 128, KA + row * 256 + kvh * 128, nullptr, VA + row * 256 + kvh * 128, O + row * DM + h * 128, SEQ_P, F.ldsg);
    }
#endif
#if EN_ATT_MLA
    for (int L = F.bid; L < 128; L += F.G) {
        const int b = L >> 3, h = L & 7; const size_t row = (size_t)b * SEQ_P;
        att::attn_unit<192, ZW, DM, DM, DM, ATT_MLA_SD, ATT_MLA_NQR>(Z + row * ZW + ZC_QB + h * 192, KVB + row * DM + h * 256, KR + row * 64, KVB + row * DM + h * 256 + 128, O + row * DM + 1024 + h * 128, SEQ_P, F.ldsg);
    }
#endif
    __syncthreads();
}

__device__ __forceinline__ void spatial_phase(Frame& F, int j) {
    FRAME_REFRESH(F);
    const bf16* U = (const bf16*)(F.ws + WS_U); const bf16* V = (const bf16*)(F.ws + WS_V); bf16* MC = (bf16*)(F.ws + WS_MC); const float* SS = (const float*)(F.ws + WS_SS);
    const float* Ws = F.in[I_CWS] + (size_t)j * 8 * 128 * 128; const float* bs = F.in[I_CBS] + j * 8 * 128; const float* gn = F.in[I_CVN] + j * DM;
    constexpr int RSB = 272;
    LAS unsigned char* As = F.lds; LAS unsigned char* Vt = F.lds + 128 * RSB; LAS float* RS = (LAS float*)(F.lds + 384 * RSB); LAS float* BS = RS + 128;
    const int tid = F.tid, lane = F.lane, r32 = lane & 31, hi = lane >> 5, wr = F.wave >> 2, wc = F.wave & 3;
    for (int it = F.bid; it < 160 * 8; it += F.G) {
        const int n = it >> 3, g = it & 7, r0 = n * 128;
        __syncthreads();
        if (tid < 128) { const GAS f32x4* sp = (const GAS f32x4*)(SS + (size_t)(r0 + tid) * 32); float s = 0.f;
#pragma unroll
            for (int e = 0; e < 8; ++e) { const f32x4 a = sp[e]; s += (a.x + a.y) + (a.z + a.w); }
            RS[tid] = 1.0f / sqrtf(s * (1.0f / 2048.0f) + EPS); BS[tid] = bs[g * 128 + tid]; }
        v4u vr[8]; f32x4 wr4[8];
#pragma unroll
        for (int i = 0; i < 8; ++i) { const int idx = tid + NTHREADS * i, q = idx & 127, c8 = (idx >> 7) * 8; vr[i] = *(const GAS v4u*)(V + (size_t)(r0 + q) * DM + g * 256 + c8); }
#pragma unroll
        for (int i = 0; i < 8; ++i) { const int idx = tid + NTHREADS * i, p = idx >> 5, q4 = (idx & 31) * 4; wr4[i] = *(const GAS f32x4*)(Ws + (size_t)g * 16384 + p * 128 + q4); }
#pragma unroll
        for (int i = 0; i < 8; ++i) { const int idx = tid + NTHREADS * i, q = idx & 127, c8 = (idx >> 7) * 8; const v4u w = vr[i];
            LAS unsigned short* d = (LAS unsigned short*)(Vt + c8 * RSB + q * 2);
            d[0 * (RSB / 2)] = (unsigned short)(w.x & 0xffffu); d[1 * (RSB / 2)] = (unsigned short)(w.x >> 16); d[2 * (RSB / 2)] = (unsigned short)(w.y & 0xffffu); d[3 * (RSB / 2)] = (unsigned short)(w.y >> 16);
            d[4 * (RSB / 2)] = (unsigned short)(w.z & 0xffffu); d[5 * (RSB / 2)] = (unsigned short)(w.z >> 16); d[6 * (RSB / 2)] = (unsigned short)(w.w & 0xffffu); d[7 * (RSB / 2)] = (unsigned short)(w.w >> 16); }
        __syncthreads();
#pragma unroll
        for (int i = 0; i < 8; ++i) { const int idx = tid + NTHREADS * i, p = idx >> 5, q4 = (idx & 31) * 4;
            const f32x4 w = wr4[i]; const f32x4 rs = *(LAS f32x4*)(RS + q4);
            v2u o; o.x = pk2(w.x * rs.x, w.y * rs.y); o.y = pk2(w.z * rs.z, w.w * rs.w); *(LAS v2u*)(As + p * RSB + q4 * 2) = o; }
        unsigned short ur[2][2][16];
#pragma unroll
        for (int b = 0; b < 2; ++b)
#pragma unroll
            for (int a = 0; a < 2; ++a) { const bf16* up = U + (size_t)(r0 + 64 * wr + 32 * a + 4 * hi) * DM + g * 256 + 64 * wc + 32 * b + r32;
#pragma unroll
                for (int r = 0; r < 16; ++r) ur[a][b][r] = up[((r & 3) + 8 * (r >> 2)) * DM]; }
        __syncthreads();
        f32x16 acc[2][2];
#pragma unroll
        for (int a = 0; a < 2; ++a)
#pragma unroll
            for (int b = 0; b < 2; ++b) acc[a][b] = (f32x16){};
#pragma unroll
        for (int ks = 0; ks < 8; ++ks) { bf16x8 af[2], bfr[2];
#pragma unroll
            for (int a = 0; a < 2; ++a) af[a] = *(LAS bf16x8*)(As + (64 * wr + 32 * a + r32) * RSB + (16 * ks + 8 * hi) * 2);
#pragma unroll
            for (int b = 0; b < 2; ++b) bfr[b] = *(LAS bf16x8*)(Vt + (64 * wc + 32 * b + r32) * RSB + (16 * ks + 8 * hi) * 2);
#pragma unroll
            for (int a = 0; a < 2; ++a)
#pragma unroll
                for (int b = 0; b < 2; ++b) acc[a][b] = __builtin_amdgcn_mfma_f32_32x32x16_bf16(af[a], bfr[b], acc[a][b], 0, 0, 0); }
#pragma unroll
        for (int b = 0; b < 2; ++b) { const int gc = g * 256 + 64 * wc + 32 * b + r32; const float gnc = gn[gc];
#pragma unroll
            for (int a = 0; a < 2; ++a) { bf16* mp = MC + (size_t)(r0 + 64 * wr + 32 * a + 4 * hi) * DM + gc;
#pragma unroll
                for (int r = 0; r < 16; ++r) { const int pr = (r & 3) + 8 * (r >> 2); const float u = __uint_as_float(((unsigned)ur[a][b][r]) << 16);
                    const unsigned w = pk2(u * (gnc * acc[a][b][r] + BS[64 * wr + 32 * a + pr + 4 * hi]), 0.f); mp[pr * DM] = (bf16)(w & 0xffffu); } } }
    }
    __syncthreads();
}

#ifndef EN_DEFAULT
#define EN_DEFAULT 1
#endif
#ifndef EN_P0
#define EN_P0 EN_DEFAULT
#endif
#ifndef EN_MOD
#define EN_MOD EN_DEFAULT
#endif
#ifndef EN_G1
#define EN_G1 EN_DEFAULT
#endif
#ifndef EN_POST
#define EN_POST EN_DEFAULT
#endif
#ifndef EN_KVUP
#define EN_KVUP EN_DEFAULT
#endif
#ifndef EN_ATT
#define EN_ATT EN_DEFAULT
#endif
#ifndef EN_G4
#define EN_G4 EN_DEFAULT
#endif
#ifndef EN_SPAT
#define EN_SPAT EN_DEFAULT
#endif
#ifndef EN_OUT
#define EN_OUT EN_DEFAULT
#endif
#ifndef EN_FUP
#define EN_FUP EN_DEFAULT
#endif
#ifndef EN_FDN
#define EN_FDN EN_DEFAULT
#endif
#ifndef EN_FIN
#define EN_FIN EN_DEFAULT
#endif
#ifndef REP_POST
#define REP_POST 1
#endif
#ifndef REP_BAR
#define REP_BAR 1
#endif
#ifndef REP_P0
#define REP_P0 1
#endif
#ifndef REP_MOD
#define REP_MOD 1
#endif
#ifndef REP_G1
#define REP_G1 1
#endif
#ifndef REP_KVUP
#define REP_KVUP 1
#endif
#ifndef REP_ATT
#define REP_ATT 1
#endif
#ifndef REP_G4
#define REP_G4 1
#endif
#ifndef REP_SPAT
#define REP_SPAT 1
#endif
#ifndef REP_FUP
#define REP_FUP 1
#endif
#ifndef REP_OUT
#define REP_OUT 1
#endif
#ifndef REP_FDN
#define REP_FDN 1
#endif
constexpr int NPHASE = 38;
__global__ void __launch_bounds__(NTHREADS, 2) fwd(Args args) {
    extern __shared__ __attribute__((aligned(16))) unsigned char lds[];
    Frame F;
    F.lds = (LAS unsigned char*)lds; F.ldsg = (char*)lds;
    F.in.ka = (KArgsPtr)__builtin_amdgcn_kernarg_segment_ptr();
    PHASE_BEGIN(F);
    const int lo = args.ph_lo, hi = args.ph_hi; const bool multi = (hi - lo) > 1;
    if (F.tid < 4) ((LAS unsigned*)(F.lds + MISC_OFF))[F.tid] = 0u;
    __syncthreads();
    if (multi) (void)xcd_barrier_post((unsigned*)(F.ws + WS_CTL) + CW_BAR, (volatile LAS unsigned*)(F.lds + MISC_OFF));
#define IN(k) (lo <= (k) && (k) < hi)
#define SEAM(k) do { if (multi && (k) + 1 < hi) { XcdBarrier b_; b_.bar = (unsigned*)(F.ws + WS_CTL) + CW_BAR; b_.x = xb_xcc_id(); b_.st = (volatile LAS unsigned*)(F.lds + MISC_OFF); for (int rb_ = 0; rb_ < REP_BAR; ++rb_) xcd_barrier(b_); } } while (0)

#define X (F.out)
#define H ((bf16*)(F.ws + WS_H))
#define LAYER_VARS() PHASE_BEGIN(F); int L = L_; asm volatile("" : "+s"(L)); const int j = L >> 1; const bool attn = (L & 1) == 0; const float* modl = (const float*)(F.ws + WS_MOD) + (size_t)L * 5 * 12288; (void)j; (void)attn; (void)modl

    #if EN_P0
    if (IN(0)) { PHASE_BEGIN(F); for (int rep_ = 0; rep_ < REP_P0; ++rep_) { p0_prologue(F); __syncthreads(); } SEAM(0); }
#endif

    for (int L_ = 0; L_ < NLAYER; ++L_) {
        const int pb = 1 + 9 * L_; const bool attn_ = (L_ & 1) == 0;
#if EN_MOD
        if (L_ == 0 && IN(pb + 0)) { LAYER_VARS();
            mod0_phase(F, F.in[I_XP], F.in[I_XS], F.in[I_NMIX], modl);
            const int gw = F.bid * NWAVES + F.wave, NGW = F.G * NWAVES;
            bias_rows(F, (const bf16*)(F.ws + WS_WIN), ZW, modl, (float*)(F.ws + WS_BIAS1), 4096, gw, NGW);
            bias_rows(F, (const bf16*)(F.ws + WS_FGU), 2 * FF, modl + 3 * DM, (float*)(F.ws + WS_BIAS2), 2 * FF, gw, NGW);
            SEAM(pb + 0);
        }
#endif
        if (attn_) {
#if EN_G1
            if (IN(pb + 1)) { LAYER_VARS();
                pg8::Gemm g{H, (const bf16*)(F.ws + WS_WIN) + (size_t)j * ZW * DM, MT, ZW, DM}; pg8::StaticOrder S; S.init(MT, ZW, F.G, F.bid);
                pg8::EpiBf16Plain E{(bf16*)(F.ws + WS_Z), ZW, (const float*)(F.ws + WS_SSX), (const float*)(F.ws + WS_BIAS1) + (size_t)L * 5 * 4096, 4096, -1, (PG8_LAS const float*)(F.lds + BIAS_LDS_OFF), 0};
                bias_to_lds(F, S, E.bias, 4096);
                for (int rep_ = 0; rep_ < REP_G1; ++rep_) pg8::gemm_phase<pg8::EpiBf16Plain, pg8::StaticOrder, true, true>(F.lds, g, S, E);
                SEAM(pb + 1);
            }
#endif
#if EN_POST
            if (IN(pb + 2)) { LAYER_VARS(); post_phase(F, j);
#if REP_POST > 1
              for (int rep_ = 1; rep_ < REP_POST; ++rep_) post_phase(F, j, true);
#endif
              SEAM(pb + 2); }
#endif
#if EN_KVUP
            if (IN(pb + 3)) { LAYER_VARS();
                pg8::Gemm g{(const bf16*)(F.ws + WS_CKV), (const bf16*)(F.ws + WS_WKV) + (size_t)j * 2048 * 512, MK, 2048, 512}; pg8::StaticOrder S; S.init(MK, 2048, F.G, F.bid);
                pg8::EpiBf16Plain E{(bf16*)(F.ws + WS_KVB), DM, nullptr, nullptr, 0, -1, nullptr, 0};
                for (int rep_ = 0; rep_ < REP_KVUP; ++rep_) pg8::gemm_phase<pg8::EpiBf16Plain, pg8::StaticOrder, true, true>(F.lds, g, S, E);
                SEAM(pb + 3);
            }
#endif
#if EN_ATT
            if (IN(pb + 4)) { LAYER_VARS(); for (int rep_ = 0; rep_ < REP_ATT; ++rep_) attn_phase(F); SEAM(pb + 4); }
#endif
        } else {
#if EN_G4
            if (IN(pb + 1)) { LAYER_VARS();
                pg8::Gemm g{H, (const bf16*)(F.ws + WS_CWIN) + (size_t)j * 4096 * DM, MT, 4096, DM}; pg8::StaticOrder S; S.init(MT, 4096, F.G, F.bid);
                pg8::EpiGeluUV E{(bf16*)(F.ws + WS_U), (bf16*)(F.ws + WS_V), (float*)(F.ws + WS_SS), (const float*)(F.ws + WS_SSX), (const float*)(F.ws + WS_BIAS1) + (size_t)L * 5 * 4096, 4096, -1, (PG8_LAS const float*)(F.lds + BIAS_LDS_OFF), 0};
                bias_to_lds(F, S, E.bias, 4096);
                for (int rep_ = 0; rep_ < REP_G4; ++rep_) pg8::gemm_phase<pg8::EpiGeluUV, pg8::StaticOrder, true, true>(F.lds, g, S, E);
                SEAM(pb + 1);
            }
#endif
#if EN_SPAT
            if (IN(pb + 2)) { LAYER_VARS(); for (int rep_ = 0; rep_ < REP_SPAT; ++rep_) spatial_phase(F, j); SEAM(pb + 2); }
#endif
        }
#if EN_OUT
        if (IN(pb + 5)) { LAYER_VARS();
            const bf16* A = attn ? (const bf16*)(F.ws + WS_O) : (const bf16*)(F.ws + WS_MC);
            const bf16* Bt = (attn ? (const bf16*)(F.ws + WS_WOUT) : (const bf16*)(F.ws + WS_CWOUT)) + (size_t)j * DM * DM;
            pg8::Gemm g{A, Bt, MT, DM, DM}; pg8::StaticOrder S; S.init(MT, DM, F.G, F.bid);
            pg8::EpiRes E{L == 0 ? F.in[I_XP] : X, L == 0 ? F.in[I_XS] : X + (size_t)NP * DM, X, modl + 2 * DM, H, F.in[I_NFFN] + L * DM, modl + 4 * DM, (float*)(F.ws + WS_SSX)};
            pg8::gemm_phase<pg8::EpiRes, pg8::StaticOrder, true, true>(F.lds, g, S, E);
#if 1
            { int widx, nwg; tail_slot(F, 640 - 2 * F.G, widx, nwg); if (widx >= 0) {
                if (L > 0) bias_rows(F, (const bf16*)(F.ws + WS_FGU) + (size_t)L * 2 * FF * DM, 2 * FF, modl + 3 * DM, (float*)(F.ws + WS_BIAS2) + (size_t)L * 5 * 2 * FF, 2 * FF, widx * NWAVES + F.wave, nwg * NWAVES);
                if (L + 1 < NLAYER) { ada_layer(F, L + 1, 0, 128, widx, nwg); __syncthreads(); conv_items(F, L + 1, 0, widx * NWAVES + F.wave, nwg * NWAVES); } } }
#endif
#if REP_OUT > 1
            { pg8::EpiBf16Plain E2{(bf16*)(F.ws + WS_PROBE), DM, nullptr, nullptr, 0, -1, nullptr, 0}; pg8::gemm_phase<pg8::EpiBf16Plain, pg8::StaticOrder, true, true>(F.lds, g, S, E2); }
#endif
            SEAM(pb + 5);
        }
#endif
#if EN_FUP
        if (IN(pb + 7)) { LAYER_VARS();
            pg8::Gemm g{H, (const bf16*)(F.ws + WS_FGU) + (size_t)L * 2 * FF * DM, MT, 2 * FF, DM}; pg8::StaticOrder S; S.init(MT, 2 * FF, F.G, F.bid);
            pg8::EpiSwiGLU E{(bf16*)(F.ws + WS_HH), FF, (const float*)(F.ws + WS_SSX), (const float*)(F.ws + WS_BIAS2) + (size_t)L * 5 * 2 * FF, 2 * FF, -1, (PG8_LAS const float*)(F.lds + BIAS_LDS_OFF), 0};
            bias_to_lds(F, S, E.bias, 2 * FF);
            for (int rep_ = 0; rep_ < REP_FUP; ++rep_) pg8::gemm_phase<pg8::EpiSwiGLU, pg8::StaticOrder, true, true>(F.lds, g, S, E);
            SEAM(pb + 7);
        }
#endif
#if EN_FDN
        if (IN(pb + 8)) { LAYER_VARS();
            pg8::Gemm g{(const bf16*)(F.ws + WS_HH), (const bf16*)(F.ws + WS_FD) + (size_t)L * DM * FF, MT, DM, FF}; pg8::StaticOrder S; S.init(MT, DM, F.G, F.bid);
            const bool more = L + 1 < NLAYER;
            pg8::EpiRes E{X, X + (size_t)NP * DM, X, modl + 5 * DM, more ? H : nullptr, F.in[I_NMIX] + (more ? L + 1 : 0) * DM, modl + 5 * 12288 + DM, (float*)(F.ws + WS_SSX)};
            pg8::gemm_phase<pg8::EpiRes, pg8::StaticOrder, true, true>(F.lds, g, S, E);
#if TAIL_CONV
            if (L + 1 < NLAYER) { int widx, nwg; tail_slot(F, 640 - 2 * F.G, widx, nwg); if (widx >= 0) { ada_layer(F, L + 1, 128, 384, widx, nwg); __syncthreads(); conv_items(F, L + 1, 1, widx * NWAVES + F.wave, nwg * NWAVES);
                const int j1 = (L + 1) >> 1; const bool attn1 = ((L + 1) & 1) == 0;
                bias_rows(F, attn1 ? (const bf16*)(F.ws + WS_WIN) + (size_t)j1 * ZW * DM : (const bf16*)(F.ws + WS_CWIN) + (size_t)j1 * 4096 * DM, attn1 ? ZW : 4096, modl + 5 * 12288, (float*)(F.ws + WS_BIAS1) + (size_t)(L + 1) * 5 * 4096, 4096, widx * NWAVES + F.wave, nwg * NWAVES); } }
#endif
#if REP_FDN > 1
            { pg8::EpiBf16Plain E2{(bf16*)(F.ws + WS_PROBE), DM, nullptr, nullptr, 0, -1, nullptr, 0}; pg8::gemm_phase<pg8::EpiBf16Plain, pg8::StaticOrder, true, true>(F.lds, g, S, E2); }
#endif
            SEAM(pb + 8);
        }
#endif
    }
#if EN_FIN
    if (IN(37)) { PHASE_BEGIN(F); final_phase(F); }
#endif
#undef IN
#undef SEAM
#undef X
#undef H
}

#ifndef MK_ONE_LAUNCH
#define MK_ONE_LAUNCH 0
#endif
extern "C" void kernel_launch(void* const* d_in, const int* in_sizes, int n_in, void* d_out, int out_size, void* d_ws, size_t ws_size, hipStream_t stream) {
    static int grid = 0;
    if (grid == 0) {
        if (n_in != 27 || out_size != 50855936 || ws_size < WS_END) { fprintf(stderr, "kernel_launch: built for 27 inputs, 50855936 outputs, >= %zu bytes of workspace; got n_in %d, out %d, ws %zu\n", (size_t)WS_END, n_in, out_size, ws_size); grid = -1; return; }
        int dev = 0, cus = 0, per_cu = 0;
        if (hipGetDevice(&dev) != hipSuccess || hipDeviceGetAttribute(&cus, hipDeviceAttributeMultiprocessorCount, dev) != hipSuccess) { fprintf(stderr, "kernel_launch: device query failed\n"); grid = -1; return; }
        if (hipFuncSetAttribute((const void*)fwd, hipFuncAttributeMaxDynamicSharedMemorySize, LDS_BYTES) != hipSuccess) { fprintf(stderr, "kernel_launch: hipFuncSetAttribute failed\n"); grid = -1; return; }
        if (hipOccupancyMaxActiveBlocksPerMultiprocessor(&per_cu, (const void*)fwd, NTHREADS, LDS_BYTES) != hipSuccess || per_cu < 1)
            fprintf(stderr, "kernel_launch: note: occupancy query reports %d workgroups per CU\n", per_cu);
        (void)hipGetLastError();
        grid = cus;
    }
    if (grid < 0) return;
    if (hipMemsetAsync((char*)d_ws + WS_CTL, 0, CTL_ZERO_BYTES, stream) != hipSuccess) { fprintf(stderr, "kernel_launch: memset failed\n"); return; }
    Args a{};
    for (int i = 0; i < 27; ++i) a.in[i] = (const GAS float*)d_in[i];
    a.out_f = (GAS float*)d_out; a.ws_b = (GAS unsigned char*)d_ws;
#if MK_ONE_LAUNCH
    a.ph_lo = 0; a.ph_hi = NPHASE;
    hipLaunchKernelGGL(fwd, dim3(grid), dim3(NTHREADS), LDS_BYTES, stream, a);
#else
    for (int ph = 0; ph < NPHASE; ++ph) {
        if (ph >= 1 && ph < 37) { const int L = (ph - 1) / 9, s = (ph - 1) % 9; if (((L & 1) && (s == 3 || s == 4)) || s == 6 || (s == 0 && L > 0)) continue; }
        a.ph_lo = ph; a.ph_hi = ph + 1;
        hipLaunchKernelGGL(fwd, dim3(grid), dim3(NTHREADS), LDS_BYTES, stream, a);
    }
#endif
    const hipError_t le = hipPeekAtLastError();
    if (le != hipSuccess) fprintf(stderr, "kernel_launch: launch failed: %s\n", hipGetErrorName(le));
}
```

```cpp
#define MK_ONE_LAUNCH 1
#define P0_DEFER8 4
#define EARLY_FIN 0
#define G1_DEFER2 1
#define DEFER_DOWN3 0
#define KV_ALIGN_EPI false
#define G1_ALIGN_EPI false
#include <hip/hip_runtime.h>
#include <cstdio>
#include <cstdint>
#ifndef PG8_WGM
#define PG8_WGM 4
#endif
namespace pg8 {
#define PG8_LAS __attribute__((address_space(3)))
typedef unsigned short bf16_t;
typedef short bf16x8 __attribute__((ext_vector_type(8)));
typedef float f32x4 __attribute__((ext_vector_type(4)));
typedef unsigned u32x4 __attribute__((ext_vector_type(4)));
constexpr int BM = 256, BK = 64, HALF = 128, HTB = HALF * BK * 2  , STAGE_BYTES = 8 * HTB, NXCD = 8, WGM = PG8_WGM;

__host__ __device__ __forceinline__ int lds_byte(int r, int c) { const int st = (r >> 4) * 2 + (c >> 5), rr = r & 15, cc = c & 31, ob = rr * 64 + cc * 2; return st * 1024 + (ob ^ (((ob >> 9) & 1) << 5)); }
__host__ __device__ __forceinline__ void stage_rc(int b, int& R, int& C) { const int st = b / 1024, sb = b % 1024, swz = sb ^ (((sb >> 9) & 1) << 5); R = (st >> 1) * 16 + swz / 64; C = (st & 1) * 32 + (swz % 64) / 2; }
__host__ __device__ __forceinline__ int perm32(int rho) { const int n = rho >> 4, i = rho & 15; return 8 * (i >> 2) + 4 * n + (i & 3); }

struct Unit { int pm, pn; };
struct Gemm { const bf16_t* A; const bf16_t* Bt; int M, N, K; };

struct StaticOrder {
    int nM, nN, nwg, G, c, wgm, rev;
    __host__ __device__ void init(int M, int N, int G_, int c_, int wgm_ = WGM, int rev_ = 0) { nM = M / BM; nN = N / BM; nwg = nM * nN; G = G_; c = c_; wgm = wgm_; rev = rev_; }
    __host__ __device__ bool next(int i, Unit& u) const {
        const int L = i * G + c; if (L >= nwg) return false;
        int wgid = L; { const int q = nwg / NXCD, r = nwg % NXCD, xcd = wgid % NXCD, off = wgid / NXCD; wgid = (xcd < r ? xcd * (q + 1) : r * (q + 1) + (xcd - r) * q) + off; }
        const int nig = wgm * nN, gid = wgid / nig, fm = gid * wgm, gsz = (nM - fm) < wgm ? (nM - fm) : wgm;
        u.pm = fm + ((wgid % nig) % gsz); u.pn = (wgid % nig) / gsz; if (rev) u.pm = nM - 1 - u.pm; return true;
    }
    __device__ __forceinline__ void a_ready(const Unit&) const {}
    __device__ __forceinline__ void done(const Unit&) const {}
};
struct CountedDone : StaticOrder {
    unsigned* arrive; mutable int nd;
    __device__ __forceinline__ void done(const Unit&) const {
        if (arrive && nd++ == 1) { asm volatile("s_waitcnt vmcnt(0)" ::: "memory"); __builtin_amdgcn_s_barrier();
            if (threadIdx.x < 64) { __builtin_amdgcn_fence(__ATOMIC_RELEASE, "agent"); if (threadIdx.x == 0) (void)__hip_atomic_fetch_add(arrive, 1u, __ATOMIC_RELAXED, __HIP_MEMORY_SCOPE_AGENT); } }
    }
};
__device__ __forceinline__ unsigned cvt_pk_bf16(float lo, float hi) { unsigned r; asm volatile("v_cvt_pk_bf16_f32 %0, %1, %2" : "=v"(r) : "v"(lo), "v"(hi)); return r; }
constexpr int ROWS_P = 4096;
__device__ __forceinline__ int cond_of_pm(int pm) { return pm < 16 ? 0 : 1 + ((pm - 16) >> 4); }

__device__ __forceinline__ float epi_add_x16_x32(float v) {
    v += __int_as_float(__builtin_amdgcn_ds_swizzle(__float_as_int(v), (16 << 10) | 0x1f));
    auto rr = __builtin_amdgcn_permlane32_swap(__float_as_uint(v), __float_as_uint(v), false, false); return __uint_as_float(rr[0]) + __uint_as_float(rr[1]);
}
#ifndef EPI_RSTD_PF_PLAIN
#define EPI_RSTD_PF_PLAIN 0
#endif
#ifndef EPI_RSTD_PF_SWIGLU
#define EPI_RSTD_PF_SWIGLU 0
#endif
#ifndef EPI_RSTD_PF_GELU
#define EPI_RSTD_PF_GELU 0
#endif
__device__ __forceinline__ void epi_row_rstd(const float* SSX, int row0, int fq, float (&rs)[2][4]) {
#pragma unroll
    for (int ai = 0; ai < 2; ++ai)
#pragma unroll
        for (int m = 0; m < 4; ++m) { const f32x4* p = (const f32x4*)(SSX + (size_t)(row0 + ai * HALF + m * 16) * 32 + 8 * fq); const f32x4 a = p[0], b = p[1];
            const float s = epi_add_x16_x32(((a[0] + a[1]) + (a[2] + a[3])) + ((b[0] + b[1]) + (b[2] + b[3])));
            rs[ai][m] = 1.0f / __builtin_sqrtf(s * (1.0f / 2048.0f) + 1e-6f); }
}

__device__ __forceinline__ void epi_rstd_issue(const float* SSX, int row0, int fq, f32x4 (&p)[16]) {
#pragma unroll
    for (int ai = 0; ai < 2; ++ai)
#pragma unroll
        for (int m = 0; m < 4; ++m) { const f32x4* q = (const f32x4*)(SSX + (size_t)(row0 + ai * HALF + m * 16) * 32 + 8 * fq); p[2 * (ai * 4 + m)] = q[0]; p[2 * (ai * 4 + m) + 1] = q[1]; }
}
__device__ __forceinline__ void epi_rstd_finish(const f32x4 (&p)[16], float (&rs)[2][4]) {
#pragma unroll
    for (int ai = 0; ai < 2; ++ai)
#pragma unroll
        for (int m = 0; m < 4; ++m) { const f32x4 a = p[2 * (ai * 4 + m)], b = p[2 * (ai * 4 + m) + 1];
            const float s = epi_add_x16_x32(((a[0] + a[1]) + (a[2] + a[3])) + ((b[0] + b[1]) + (b[2] + b[3])));
            rs[ai][m] = 1.0f / __builtin_sqrtf(s * (1.0f / 2048.0f) + 1e-6f); }
}

struct EpiBf16Plain {
    static constexpr bool PERM = true, AFTER_DRAIN = false;
    bf16_t* O; int ldc; const float* SSX; const float* bias; int ldb;
    mutable int pm_; PG8_LAS const float* lb; mutable int ui_;
    mutable float rs[2][4];
    static constexpr bool WANTS_NEXT = true;
    __device__ __forceinline__ void operator()(const f32x4 (&acc)[2][2][4][2], const Unit& u, int wr, int wc, int fr, int fq, int next_pm_ = -1) const {
        const int row0 = u.pm * BM + wr * 64 + fr, col0 = u.pn * BM + wc * 32 + 8 * fq;
        f32x4 bv[2][2];
        const bool pf = EPI_RSTD_PF_PLAIN && SSX && next_pm_ >= 0 && next_pm_ != u.pm; f32x4 pp[16];
        if (pf) epi_rstd_issue(SSX, next_pm_ * BM + wr * 64 + fr, fq, pp);
        if (SSX) { if (u.pm != pm_) { epi_row_rstd(SSX, row0, fq, rs); pm_ = u.pm; } PG8_LAS const float* bp = lb + ui_ * 256 + wc * 32 + 8 * fq; ++ui_;
#pragma unroll
            for (int bj = 0; bj < 2; ++bj)
#pragma unroll
                for (int n = 0; n < 2; ++n) bv[bj][n] = *(PG8_LAS const f32x4*)(bp + bj * HALF + 4 * n); }
#pragma unroll
        for (int ai = 0; ai < 2; ++ai)
#pragma unroll
            for (int m = 0; m < 4; ++m) { bf16_t* rowp = O + (size_t)(row0 + ai * HALF + m * 16) * ldc + col0;
#pragma unroll
                for (int bj = 0; bj < 2; ++bj) { f32x4 v0 = acc[ai][bj][m][0], v1 = acc[ai][bj][m][1];
                    if (SSX) { v0 = v0 * rs[ai][m] + bv[bj][0]; v1 = v1 * rs[ai][m] + bv[bj][1]; }
                    u32x4 w; w.x = cvt_pk_bf16(v0[0], v0[1]); w.y = cvt_pk_bf16(v0[2], v0[3]); w.z = cvt_pk_bf16(v1[0], v1[1]); w.w = cvt_pk_bf16(v1[2], v1[3]);
                    *(u32x4*)(rowp + bj * HALF) = w; } }
        if (pf) { epi_rstd_finish(pp, rs); pm_ = next_pm_; }
    }
};
#ifndef EPI_RES_DIAG
#define EPI_RES_DIAG 0
#endif
struct EpiRes {
    static constexpr bool PERM = true, AFTER_DRAIN = false, WANTS_NEXT = false;
    bf16_t* H; float* SSX;
    PG8_LAS const float* tab; mutable int ui_;
    __device__ __forceinline__ void operator()(const f32x4 (&acc)[2][2][4][2], const Unit& u, int wr, int wc, int fr, int fq) const {
        const int row0 = u.pm * BM + wr * 64 + fr, col0 = u.pn * BM + wc * 32 + 8 * fq;
        bf16_t* hp = H + (size_t)row0 * 2048 + col0;
        PG8_LAS const float* tp = tab + ui_ * 768 + wc * 32 + 8 * fq; ++ui_;
        u32x4 r[2][4][2];
#pragma unroll
        for (int ai = 0; ai < 2; ++ai)
#pragma unroll
            for (int m = 0; m < 4; ++m)
#pragma unroll
                for (int bj = 0; bj < 2; ++bj) r[ai][m][bj] = *(const u32x4*)(hp + (size_t)(ai * HALF + m * 16) * 2048 + bj * HALF);
#pragma unroll
        for (int ai = 0; ai < 2; ++ai) { float ss[4] = {0.f, 0.f, 0.f, 0.f};
#pragma unroll
            for (int bj = 0; bj < 2; ++bj) { f32x4 g[2], gs[2], gpi[2];
#pragma unroll
                for (int n = 0; n < 2; ++n) { g[n] = *(PG8_LAS const f32x4*)(tp + bj * HALF + n * 4); gs[n] = *(PG8_LAS const f32x4*)(tp + 256 + bj * HALF + n * 4); gpi[n] = *(PG8_LAS const f32x4*)(tp + 512 + bj * HALF + n * 4); }
#pragma unroll
                for (int m = 0; m < 4; ++m) { const size_t ro = (size_t)(ai * HALF + m * 16) * 2048; const u32x4 w0 = r[ai][m][bj]; u32x4 w;
                    { const f32x4 bs = (f32x4){__uint_as_float(w0.x << 16), __uint_as_float(w0.x & 0xffff0000u), __uint_as_float(w0.y << 16), __uint_as_float(w0.y & 0xffff0000u)} * gpi[0];
                      const f32x4 x = bs + g[0] * acc[ai][bj][m][0]; ss[m] += (x[0] * x[0] + x[1] * x[1]) + (x[2] * x[2] + x[3] * x[3]); const f32x4 a = x * gs[0];
                      w.x = cvt_pk_bf16(a[0], a[1]); w.y = cvt_pk_bf16(a[2], a[3]); }
                    { const f32x4 bs = (f32x4){__uint_as_float(w0.z << 16), __uint_as_float(w0.z & 0xffff0000u), __uint_as_float(w0.w << 16), __uint_as_float(w0.w & 0xffff0000u)} * gpi[1];
                      const f32x4 x = bs + g[1] * acc[ai][bj][m][1]; ss[m] += (x[0] * x[0] + x[1] * x[1]) + (x[2] * x[2] + x[3] * x[3]); const f32x4 a = x * gs[1];
                      w.z = cvt_pk_bf16(a[0], a[1]); w.w = cvt_pk_bf16(a[2], a[3]); }
                    *(u32x4*)(hp + ro + bj * HALF) = w; } }
#pragma unroll
            for (int m = 0; m < 4; ++m) { const float s1 = epi_add_x16_x32(ss[m]); if (fq == 0) SSX[(size_t)(row0 + ai * HALF + m * 16) * 32 + u.pn * 4 + wc] = s1; } }
    }
};
#ifndef NT_HH
#define NT_HH 0
#endif
#if NT_HH
#define EPI_HH_STORE(p, v) __builtin_nontemporal_store(v, p)
#else
#define EPI_HH_STORE(p, v) (*(p) = (v))
#endif
typedef float epi_f32x2 __attribute__((ext_vector_type(2)));
struct EpiSwiGLU {
    static constexpr bool PERM = true, AFTER_DRAIN = false;
    bf16_t* O; int ldc; const float* SSX; const float* bias; int ldb;
    mutable int pm_; PG8_LAS const float* lb; mutable int ui_; mutable float rs[2][4];
    static constexpr bool WANTS_NEXT = true;
    __device__ __forceinline__ void operator()(const f32x4 (&acc)[2][2][4][2], const Unit& u, int wr, int wc, int fr, int fq, int next_pm_ = -1) const {
        const int row0 = u.pm * BM + wr * 64 + fr, col0 = u.pn * HALF + wc * 32 + 8 * fq;
        const bool pf = EPI_RSTD_PF_SWIGLU && next_pm_ >= 0 && next_pm_ != u.pm; f32x4 pp[8];
        const float* nss = SSX + (size_t)(next_pm_ * BM + wr * 64 + fr) * 32 + 8 * fq;
        if (u.pm != pm_) { epi_row_rstd(SSX, row0, fq, rs); pm_ = u.pm; } f32x4 bv[2][2]; { PG8_LAS const float* bp = lb + ui_ * 256 + wc * 32 + 8 * fq; ++ui_;
#pragma unroll
            for (int bj = 0; bj < 2; ++bj)
#pragma unroll
                for (int n = 0; n < 2; ++n) bv[bj][n] = *(PG8_LAS const f32x4*)(bp + bj * HALF + 4 * n); }
#pragma unroll
        for (int ai = 0; ai < 2; ++ai) {
            if (pf) {
#pragma unroll
                for (int m = 0; m < 4; ++m) { const f32x4* q = (const f32x4*)(nss + (size_t)(ai * HALF + m * 16) * 32); pp[2 * m] = q[0]; pp[2 * m + 1] = q[1]; } }
#pragma unroll
            for (int m = 0; m < 4; ++m) { bf16_t* rowp = O + (size_t)(row0 + ai * HALF + m * 16) * ldc + col0;
                epi_f32x2 z[4]; const float rsm = rs[ai][m];
#pragma unroll
                for (int n = 0; n < 2; ++n)
#pragma unroll
                    for (int h = 0; h < 2; ++h) { const epi_f32x2 ag = {acc[ai][0][m][n][2 * h], acc[ai][0][m][n][2 * h + 1]}, au = {acc[ai][1][m][n][2 * h], acc[ai][1][m][n][2 * h + 1]};
                        const epi_f32x2 bg = {bv[0][n][2 * h], bv[0][n][2 * h + 1]}, bu = {bv[1][n][2 * h], bv[1][n][2 * h + 1]};
                        const epi_f32x2 gt = ag * rsm + bg, up = au * rsm + bu, q = gt * -1.4426950408889634f;
                        epi_f32x2 e; e.x = __builtin_amdgcn_exp2f(q.x); e.y = __builtin_amdgcn_exp2f(q.y);
                        const epi_f32x2 d = e + 1.0f; epi_f32x2 rc; rc.x = __builtin_amdgcn_rcpf(d.x); rc.y = __builtin_amdgcn_rcpf(d.y);
                        z[2 * n + h] = (gt * up) * rc; }
                u32x4 w; w.x = cvt_pk_bf16(z[0].x, z[0].y); w.y = cvt_pk_bf16(z[1].x, z[1].y); w.z = cvt_pk_bf16(z[2].x, z[2].y); w.w = cvt_pk_bf16(z[3].x, z[3].y);
                EPI_HH_STORE((u32x4*)rowp, w); }
            if (pf) {
#pragma unroll
                for (int m = 0; m < 4; ++m) { const f32x4 a = pp[2 * m], b = pp[2 * m + 1];
                    const float s1 = epi_add_x16_x32(((a[0] + a[1]) + (a[2] + a[3])) + ((b[0] + b[1]) + (b[2] + b[3])));
                    rs[ai][m] = 1.0f / __builtin_sqrtf(s1 * (1.0f / 2048.0f) + 1e-6f); } } }
        if (pf) pm_ = next_pm_;
    }
};
__device__ __forceinline__ float gelu_tanh(float x) {
    const float u = 0.7978845608028654f * (x + 0.044715f * x * x * x);
    const float e = __builtin_amdgcn_exp2f(u * -2.8853900817779268f);
    return x * __builtin_amdgcn_rcpf(1.0f + e);
}
__device__ __forceinline__ epi_f32x2 gelu_tanh2(epi_f32x2 x) {
    const epi_f32x2 t = (x * x) * (-0.10294324f) + (-2.3022082f), u = x * t;
    epi_f32x2 e; e.x = __builtin_amdgcn_exp2f(u.x); e.y = __builtin_amdgcn_exp2f(u.y);
    const epi_f32x2 d = e + 1.0f; epi_f32x2 r; r.x = __builtin_amdgcn_rcpf(d.x); r.y = __builtin_amdgcn_rcpf(d.y);
    return x * r;
}
struct EpiGeluUV {
    static constexpr bool PERM = true, AFTER_DRAIN = false;
    bf16_t* U; bf16_t* V; float* SS; const float* SSX; const float* bias; int ldb;
    mutable int pm_; PG8_LAS const float* lb; mutable int ui_; mutable float rs[2][4];
    static constexpr bool WANTS_NEXT = true;
    __device__ __forceinline__ void operator()(const f32x4 (&acc)[2][2][4][2], const Unit& u, int wr, int wc, int fr, int fq, int next_pm_ = -1) const {
        const bool isv = u.pn >= 8; const int pn = isv ? u.pn - 8 : u.pn;
        const int row0 = u.pm * BM + wr * 64 + fr, col0 = pn * BM + wc * 32 + 8 * fq;
        const bool pf = EPI_RSTD_PF_GELU && next_pm_ >= 0 && next_pm_ != u.pm; f32x4 pp[16];
        if (pf) epi_rstd_issue(SSX, next_pm_ * BM + wr * 64 + fr, fq, pp);
        if (u.pm != pm_) { epi_row_rstd(SSX, row0, fq, rs); pm_ = u.pm; } f32x4 bv[2][2]; { PG8_LAS const float* bp = lb + ui_ * 256 + wc * 32 + 8 * fq; ++ui_;
#pragma unroll
            for (int bj = 0; bj < 2; ++bj)
#pragma unroll
                for (int n = 0; n < 2; ++n) bv[bj][n] = *(PG8_LAS const f32x4*)(bp + bj * HALF + 4 * n); }
        bf16_t* O = isv ? V : U;
#pragma unroll
        for (int ai = 0; ai < 2; ++ai)
#pragma unroll
            for (int m = 0; m < 4; ++m) { const int row = row0 + ai * HALF + m * 16; bf16_t* rowp = O + (size_t)row * 2048 + col0; epi_f32x2 ss2 = {0.f, 0.f}; const float rsm = rs[ai][m];
#pragma unroll
                for (int bj = 0; bj < 2; ++bj) { epi_f32x2 z[4];
#pragma unroll
                    for (int n = 0; n < 2; ++n)
#pragma unroll
                        for (int h = 0; h < 2; ++h) { const epi_f32x2 a = {acc[ai][bj][m][n][2 * h], acc[ai][bj][m][n][2 * h + 1]}, b = {bv[bj][n][2 * h], bv[bj][n][2 * h + 1]};
                            z[2 * n + h] = gelu_tanh2(a * rsm + b); ss2 += z[2 * n + h] * z[2 * n + h]; }
                    u32x4 w; w.x = cvt_pk_bf16(z[0].x, z[0].y); w.y = cvt_pk_bf16(z[1].x, z[1].y); w.z = cvt_pk_bf16(z[2].x, z[2].y); w.w = cvt_pk_bf16(z[3].x, z[3].y);
                    *(u32x4*)(rowp + bj * HALF) = w; }
                float ss = ss2.x + ss2.y;
                if (isv) { ss += __int_as_float(__builtin_amdgcn_ds_swizzle(__float_as_int(ss), (16 << 10) | 0x1f)); { auto rr = __builtin_amdgcn_permlane32_swap(__float_as_uint(ss), __float_as_uint(ss), false, false); ss = __uint_as_float(rr[0]) + __uint_as_float(rr[1]); } if (fq == 0) SS[(size_t)row * 32 + pn * 4 + wc] = ss; } }
        if (pf) { epi_rstd_finish(pp, rs); pm_ = next_pm_; }
    }
};
template <class Epi, class Sched, bool ALIGN_EPI = false, bool SP2 = false>
__device__ __forceinline__ void gemm_phase(PG8_LAS unsigned char* lds, const Gemm g, const Sched& S, const Epi& E) {
    int tid_ = threadIdx.x; asm volatile("" : "+v"(tid_));
    const int tid = tid_, wid = __builtin_amdgcn_readfirstlane(tid >> 6), lane = tid & 63, wr = wid >> 2, wc = wid & 3, fr = lane & 15, fq = lane >> 4;
    const int K = g.K, nt = K / BK;
    unsigned voffA[2], voffB[2];
#pragma unroll
    for (int i = 0; i < 2; ++i) { int R, C; stage_rc(tid * 16 + i * 8192, R, C); const int Rb = Epi::PERM ? ((R & ~31) + perm32(R & 31)) : R;
        voffA[i] = (unsigned)(R * K + C) * 2u; voffB[i] = (unsigned)(Rb * K + C) * 2u; }
    const size_t kstep = (size_t)(BK * 2);
    const size_t hstep = (size_t)HALF * K * 2;
    const size_t tstep = 2 * hstep;
    const unsigned ldsw = (unsigned)wid * 1024u;
    const int aoff = lds_byte(wr * 64 + fr, fq * 8), boff = lds_byte(wc * 32 + fr, fq * 8);
#define PG8_SA(b, h) (((b) * 2 + (h)) * HTB)
#define PG8_SB(b, h) ((4 + (b) * 2 + (h)) * HTB)
#define PG8_STAGE(bufoff, gbase, voff) do { _Pragma("unroll") for (int _i = 0; _i < 2; ++_i) \
        __builtin_amdgcn_global_load_lds((const unsigned*)((const char*)(gbase) + (voff)[_i]), (PG8_LAS unsigned*)(lds + (bufoff) + ldsw + _i * 8192), 16, 0, 0); } while (0)
#define PG8_LDA(dst, b, h) do { _Pragma("unroll") for (int m = 0; m < 4; ++m) _Pragma("unroll") for (int k = 0; k < 2; ++k) dst[m][k] = *(const PG8_LAS bf16x8*)(lds + PG8_SA(b, h) + aoff + m * 2048 + k * 1024); } while (0)
#define PG8_LDB(dst, b, h) do { _Pragma("unroll") for (int n = 0; n < 2; ++n) _Pragma("unroll") for (int k = 0; k < 2; ++k) dst[n][k] = *(const PG8_LAS bf16x8*)(lds + PG8_SB(b, h) + boff + n * 2048 + k * 1024); } while (0)
#define PG8_MMA(ai, bj, At, Bt) do { __builtin_amdgcn_s_setprio(1); _Pragma("unroll") for (int m = 0; m < 4; ++m) _Pragma("unroll") for (int n = 0; n < 2; ++n) _Pragma("unroll") for (int k = 0; k < 2; ++k) \
        acc[ai][bj][m][n] = __builtin_amdgcn_mfma_f32_16x16x32_bf16(Bt[n][k], At[m][k], acc[ai][bj][m][n], 0, 0, 0); __builtin_amdgcn_s_setprio(0); } while (0)
#define PG8_WAIT_V(n) asm volatile("s_waitcnt vmcnt(" #n ")" ::: "memory")
#define PG8_WAIT_L(n) asm volatile("s_waitcnt lgkmcnt(" #n ")" ::: "memory")
#define PG8_BAR __builtin_amdgcn_s_barrier()
#define PG8_SCHED __builtin_amdgcn_sched_barrier(0)
    Unit cur, nxt; int ui = 0;
    if (!S.next(0, cur)) return;
    f32x4 acc[2][2][4][2];
#pragma unroll
    for (int a = 0; a < 2; ++a)
#pragma unroll
        for (int b = 0; b < 2; ++b)
#pragma unroll
            for (int m = 0; m < 4; ++m)
#pragma unroll
                for (int n = 0; n < 2; ++n) acc[a][b][m][n] = (f32x4){0.f, 0.f, 0.f, 0.f};
    bf16x8 At[4][2], B0[2][2], B1[2][2];
    const char* cA = (const char*)g.A + (size_t)cur.pm * tstep; const char* cB = (const char*)g.Bt + (size_t)cur.pn * tstep;
    S.a_ready(cur);
    if constexpr (SP2) {
        PG8_STAGE(PG8_SB(0, 0), cB, voffB); PG8_STAGE(PG8_SB(0, 1), cB + hstep, voffB); PG8_STAGE(PG8_SA(0, 0), cA, voffA); PG8_STAGE(PG8_SA(0, 1), cA + hstep, voffA);
        if (wr == 1) PG8_BAR;
        PG8_WAIT_V(2); PG8_BAR;
        PG8_STAGE(PG8_SB(1, 0), cB + kstep, voffB); PG8_STAGE(PG8_SA(1, 0), cA + kstep, voffA); PG8_STAGE(PG8_SB(1, 1), cB + hstep + kstep, voffB);
        PG8_WAIT_V(6); PG8_BAR;
    } else {
        PG8_STAGE(PG8_SB(0, 0), cB, voffB); PG8_STAGE(PG8_SA(0, 0), cA, voffA); PG8_STAGE(PG8_SB(0, 1), cB + hstep, voffB); PG8_STAGE(PG8_SA(0, 1), cA + hstep, voffA);
        if (wr == 1) PG8_BAR;
        PG8_WAIT_V(4); PG8_BAR;
        PG8_STAGE(PG8_SB(1, 0), cB + kstep, voffB); PG8_STAGE(PG8_SA(1, 0), cA + kstep, voffA); PG8_STAGE(PG8_SB(1, 1), cB + hstep + kstep, voffB);
        PG8_WAIT_V(6); PG8_BAR;
    }
    for (;;) {
        const bool has_next = S.next(ui + 1, nxt);
        const char* nA = has_next ? (const char*)g.A + (size_t)nxt.pm * tstep : cA; const char* nB = has_next ? (const char*)g.Bt + (size_t)nxt.pn * tstep : cB;
        for (int t = 0; t < nt; t += 2) {
            const bool last = (t == nt - 2);
            const char* a1 = cA + (size_t)(t + 1) * kstep;
            const char* a2 = last ? nA : cA + (size_t)(t + 2) * kstep; const char* b2 = last ? nB : cB + (size_t)(t + 2) * kstep;
            const char* a3 = a2 + kstep; const char* b3 = b2 + kstep;
            if (last && has_next) S.a_ready(nxt);
            if constexpr (SP2) {
            PG8_LDB(B0, 0, 0); PG8_LDB(B1, 0, 1); PG8_SCHED; PG8_LDA(At, 0, 0); PG8_STAGE(PG8_SA(1, 1), a1 + hstep, voffA);
            PG8_WAIT_V(8); PG8_WAIT_L(0); PG8_BAR; PG8_MMA(0, 0, At, B0); PG8_MMA(0, 1, At, B1); PG8_BAR; PG8_SCHED;
            PG8_LDA(At, 0, 1); PG8_STAGE(PG8_SB(0, 0), b2, voffB); PG8_STAGE(PG8_SB(0, 1), b2 + hstep, voffB); PG8_STAGE(PG8_SA(0, 0), a2, voffA);
            PG8_WAIT_V(8); PG8_WAIT_L(0); PG8_BAR; PG8_MMA(1, 0, At, B0); PG8_MMA(1, 1, At, B1); PG8_BAR; PG8_SCHED;
            PG8_LDB(B0, 1, 0); PG8_LDB(B1, 1, 1); PG8_SCHED; PG8_LDA(At, 1, 0); PG8_STAGE(PG8_SA(0, 1), a2 + hstep, voffA);
            PG8_WAIT_V(8); PG8_WAIT_L(0); PG8_BAR; PG8_MMA(0, 0, At, B0); PG8_MMA(0, 1, At, B1); PG8_BAR; PG8_SCHED;
            PG8_LDA(At, 1, 1); PG8_STAGE(PG8_SB(1, 0), b3, voffB); PG8_STAGE(PG8_SB(1, 1), b3 + hstep, voffB); PG8_STAGE(PG8_SA(1, 0), a3, voffA);
            PG8_WAIT_V(8); PG8_WAIT_L(0); PG8_BAR; PG8_MMA(1, 0, At, B0); PG8_MMA(1, 1, At, B1); PG8_BAR; PG8_SCHED;
            } else {
            PG8_LDB(B0, 0, 0); PG8_SCHED; PG8_LDA(At, 0, 0); PG8_STAGE(PG8_SA(1, 1), a1 + hstep, voffA);
            PG8_WAIT_L(8); PG8_BAR; PG8_WAIT_L(0); PG8_MMA(0, 0, At, B0); PG8_BAR; PG8_SCHED;
            PG8_LDB(B1, 0, 1); PG8_STAGE(PG8_SB(0, 0), b2, voffB);
            PG8_BAR; PG8_WAIT_L(0); PG8_MMA(0, 1, At, B1); PG8_BAR;
            PG8_LDA(At, 0, 1); PG8_STAGE(PG8_SA(0, 0), a2, voffA);
            PG8_BAR; PG8_WAIT_L(0); PG8_MMA(1, 0, At, B0); PG8_BAR; PG8_SCHED;
            PG8_STAGE(PG8_SB(0, 1), b2 + hstep, voffB);
            PG8_WAIT_V(6); PG8_BAR; PG8_MMA(1, 1, At, B1); PG8_BAR;
            PG8_LDB(B0, 1, 0); PG8_SCHED; PG8_LDA(At, 1, 0); PG8_STAGE(PG8_SA(0, 1), a2 + hstep, voffA);
            PG8_WAIT_L(8); PG8_BAR; PG8_WAIT_L(0); PG8_MMA(0, 0, At, B0); PG8_BAR; PG8_SCHED;
            PG8_LDB(B1, 1, 1); PG8_STAGE(PG8_SB(1, 0), b3, voffB);
            PG8_BAR; PG8_WAIT_L(0); PG8_MMA(0, 1, At, B1); PG8_BAR;
            PG8_LDA(At, 1, 1); PG8_STAGE(PG8_SA(1, 0), a3, voffA);
            PG8_BAR; PG8_WAIT_L(0); PG8_MMA(1, 0, At, B0); PG8_BAR; PG8_SCHED;
            PG8_STAGE(PG8_SB(1, 1), b3 + hstep, voffB);
            PG8_WAIT_V(6); PG8_BAR; PG8_MMA(1, 1, At, B1); PG8_BAR;
            }
        }
        if constexpr (ALIGN_EPI) { if (wr == 0) PG8_BAR; }
        if constexpr (!Epi::AFTER_DRAIN) { if constexpr (Epi::WANTS_NEXT) E(acc, cur, wr, wc, fr, fq, has_next ? nxt.pm : -1); else E(acc, cur, wr, wc, fr, fq); S.done(cur); }
        if (!has_next) break;
#pragma unroll
        for (int a = 0; a < 2; ++a)
#pragma unroll
            for (int b = 0; b < 2; ++b)
#pragma unroll
                for (int m = 0; m < 4; ++m)
#pragma unroll
                    for (int n = 0; n < 2; ++n) acc[a][b][m][n] = (f32x4){0.f, 0.f, 0.f, 0.f};
        cur = nxt; cA = nA; cB = nB; ++ui;
        if constexpr (ALIGN_EPI) { if (wr == 1) PG8_BAR; }
    }
    PG8_WAIT_V(0);
    if constexpr (!ALIGN_EPI) { if (wr == 0) PG8_BAR; }
    PG8_BAR;
    if constexpr (Epi::AFTER_DRAIN) { E.fused(acc, cur, wr, wc, fr, fq, lds, wid, lane); S.done(cur); }
#undef PG8_SA
#undef PG8_SB
#undef PG8_STAGE
#undef PG8_LDA
#undef PG8_LDB
#undef PG8_MMA
#undef PG8_WAIT_V
#undef PG8_WAIT_L
#undef PG8_BAR
#undef PG8_SCHED
}
}
namespace att {
typedef unsigned short bf16;
using bf16x8 = __attribute__((ext_vector_type(8))) short;
using s16x4  = __attribute__((ext_vector_type(4))) short;
using f32x16 = __attribute__((ext_vector_type(16))) float;
using u32x4  = __attribute__((ext_vector_type(4))) unsigned;
constexpr int NW = 8, QBLK = 32, KVBLK = 64;
constexpr float THR = 8.f;
#define ATT_SBAR() __builtin_amdgcn_sched_barrier(0)
template <int RS> __device__ __forceinline__ int kswz(int row, int colB) { return row * RS + (colB ^ ((row & 7) << 4)); }
__device__ __forceinline__ int crow(int r, int hi) { return (r & 3) + 8 * (r >> 2) + 4 * hi; }
__device__ __forceinline__ unsigned cvtpk(float lo, float hi) { unsigned r; asm volatile("v_cvt_pk_bf16_f32 %0, %1, %2" : "=v"(r) : "v"(lo), "v"(hi)); return r; }
__device__ __forceinline__ bf16x8 ld8(const bf16* p) { return *reinterpret_cast<const bf16x8*>(p); }

__device__ __forceinline__ void partialSM(f32x16& p0, f32x16& p1, float& m_reg, float& mn, float& alpha, const float C, const float TS) {
  float pmax = p0[0];
#pragma unroll
  for (int r = 1; r < 16; ++r) pmax = fmaxf(pmax, p0[r]);
#pragma unroll
  for (int r = 0; r < 16; ++r) pmax = fmaxf(pmax, p1[r]);
  { auto rr = __builtin_amdgcn_permlane32_swap(__float_as_uint(pmax), __float_as_uint(pmax), false, false);
    pmax = fmaxf(__uint_as_float(rr[0]), __uint_as_float(rr[1])); }
  if (__builtin_expect(__all(pmax - m_reg <= TS), 1)) { mn = m_reg; alpha = 1.f; }
  else { mn = fmaxf(m_reg, pmax); alpha = __builtin_amdgcn_exp2f((m_reg - mn) * C); m_reg = mn; }
  float mnC = -mn * C;
#pragma unroll
  for (int r = 0; r < 16; ++r) p0[r] = fmaf(p0[r], C, mnC);
#pragma unroll
  for (int r = 0; r < 16; ++r) p1[r] = fmaf(p1[r], C, mnC);
#pragma unroll
  for (int r = 0; r < 16; ++r) p0[r] = __builtin_amdgcn_exp2f(p0[r]);
}
__device__ __forceinline__ void finishSM(f32x16& p0, f32x16& p1, float alpha, float& l_reg, bf16x8& pa0, bf16x8& pa1, bf16x8& pa2, bf16x8& pa3) {
#pragma unroll
  for (int r = 0; r < 16; ++r) p1[r] = __builtin_amdgcn_exp2f(p1[r]);
  float ps = 0;
#pragma unroll
  for (int r = 0; r < 16; ++r) ps += p0[r];
#pragma unroll
  for (int r = 0; r < 16; ++r) ps += p1[r];
  { auto rr = __builtin_amdgcn_permlane32_swap(__float_as_uint(ps), __float_as_uint(ps), false, false);
    ps = __uint_as_float(rr[0]) + __uint_as_float(rr[1]); }
  l_reg = l_reg * alpha + ps;
#define ATT_PK4(P, BASE, OUT) do { unsigned a0 = cvtpk(P[BASE + 0], P[BASE + 1]), a1 = cvtpk(P[BASE + 2], P[BASE + 3]);   \
    unsigned b0 = cvtpk(P[BASE + 4], P[BASE + 5]), b1 = cvtpk(P[BASE + 6], P[BASE + 7]);                              \
    auto r0 = __builtin_amdgcn_permlane32_swap(a0, b0, false, false); auto r1 = __builtin_amdgcn_permlane32_swap(a1, b1, false, false); \
    u32x4 w = {r0[0], r1[0], r0[1], r1[1]}; OUT = *reinterpret_cast<bf16x8*>(&w); } while (0)
  ATT_PK4(p0, 0, pa0); ATT_PK4(p0, 8, pa1); ATT_PK4(p1, 0, pa2); ATT_PK4(p1, 8, pa3);
#undef ATT_PK4
}
#ifndef QKT_SB0
#define QKT_SB0 3
#endif
#ifndef QKT_SB1
#define QKT_SB1 7
#endif
template <int DK, int NQR> __device__ __forceinline__ void qkt(f32x16& p0, f32x16& p1, const char* Ks, const bf16x8* qr, const char* qrl, int r32, int hi) {
  p0 = f32x16{}; p1 = f32x16{};
#pragma unroll
  for (int d0 = 0; d0 < DK / 16; ++d0) { const int cb = (d0 * 16 + hi * 8) * 2;
    const bf16x8 qf = (d0 < NQR) ? qr[d0 < NQR ? d0 : 0] : *reinterpret_cast<const bf16x8*>(qrl + (d0 - NQR) * 1024);
    bf16x8 b0 = *reinterpret_cast<const bf16x8*>(Ks + kswz<DK * 2>(r32, cb));
    bf16x8 b1 = *reinterpret_cast<const bf16x8*>(Ks + kswz<DK * 2>(32 + r32, cb));
    p0 = __builtin_amdgcn_mfma_f32_32x32x16_bf16(b0, qf, p0, 0, 0, 0);
    p1 = __builtin_amdgcn_mfma_f32_32x32x16_bf16(b1, qf, p1, 0, 0, 0);
    if constexpr (DK == 192) { if (d0 == QKT_SB0 || d0 == QKT_SB1) ATT_SBAR(); } }
}
__device__ __forceinline__ int v_st(int k, int c) { const int kk = (k & ~0xC) | ((k & 4) << 1) | ((k & 8) >> 1); return ((kk >> 3) * 4 + (c >> 5)) * 512 + ((kk & 7) * 32 + (c & 31)) * 2; }
__device__ __forceinline__ int v_rd_base(int lane) { return ((lane & 3) << 3) | (((lane >> 2) & 3) << 6) | (((lane >> 4) & 1) << 5) | (((lane >> 5) & 1) << 8); }
constexpr int v_rd_off(int d0, int ks, int half) { return d0 * 512 + ks * 4096 + half * 2048; }
template <int OFF> __device__ __forceinline__ s16x4 tr_read(int vb) {
  s16x4 r; asm volatile("ds_read_b64_tr_b16 %0, %1 offset:%2" : "=&v"(r) : "v"(vb), "i"(OFF) : "memory"); return r;
}
template <int D0> __device__ __forceinline__ void pv_one(f32x16& od, int vb, bf16x8 pa0, bf16x8 pa1, bf16x8 pa2, bf16x8 pa3) {
  const s16x4 l0 = tr_read<v_rd_off(D0, 0, 0)>(vb), h0 = tr_read<v_rd_off(D0, 0, 1)>(vb), l1 = tr_read<v_rd_off(D0, 1, 0)>(vb), h1 = tr_read<v_rd_off(D0, 1, 1)>(vb);
  const s16x4 l2 = tr_read<v_rd_off(D0, 2, 0)>(vb), h2 = tr_read<v_rd_off(D0, 2, 1)>(vb), l3 = tr_read<v_rd_off(D0, 3, 0)>(vb), h3 = tr_read<v_rd_off(D0, 3, 1)>(vb);
  asm volatile("s_waitcnt lgkmcnt(0)" ::: "memory"); ATT_SBAR();
#define ATT_PK(L, H) (bf16x8){L[0], L[1], L[2], L[3], H[0], H[1], H[2], H[3]}
  od = __builtin_amdgcn_mfma_f32_32x32x16_bf16(pa0, ATT_PK(l0, h0), od, 0, 0, 0);
  od = __builtin_amdgcn_mfma_f32_32x32x16_bf16(pa1, ATT_PK(l1, h1), od, 0, 0, 0);
  od = __builtin_amdgcn_mfma_f32_32x32x16_bf16(pa2, ATT_PK(l2, h2), od, 0, 0, 0);
  od = __builtin_amdgcn_mfma_f32_32x32x16_bf16(pa3, ATT_PK(l3, h3), od, 0, 0, 0);
#undef ATT_PK
}
__device__ __forceinline__ void pv_d0(f32x16* o, int vb, bf16x8 pa0, bf16x8 pa1, bf16x8 pa2, bf16x8 pa3) {
  pv_one<0>(o[0], vb, pa0, pa1, pa2, pa3); pv_one<1>(o[1], vb, pa0, pa1, pa2, pa3); pv_one<2>(o[2], vb, pa0, pa1, pa2, pa3); pv_one<3>(o[3], vb, pa0, pa1, pa2, pa3);
}

template <int DK, int LDQ, int LDKN, int LDV, int LDO, int SDEPTH, int NQR, int QMODE>
__device__ __forceinline__ void attn_unit(const bf16* __restrict__ Qb, const bf16* __restrict__ Kn, const bf16* __restrict__ Kr, const bf16* __restrict__ Vh,
                                          bf16* __restrict__ Ob, int seq, char* lds, const float* __restrict__ qg, const float* __restrict__ T, int tok0) {
  constexpr int SHM_V = KVBLK * 128 * 2, SHM_K = KVBLK * DK * 2, KRS = DK * 2;
  constexpr float SCALE = (DK == 128) ? 0.088388347648318440f : 0.072168783648703220f;
  constexpr float C = SCALE * 1.4426950408889634f, TS = THR / SCALE;
  int tid_ = threadIdx.x; asm volatile("" : "+v"(tid_));
  const int tid = tid_, wid = tid >> 6, lane = tid & 63, r32 = lane & 31, hi = lane >> 5;
  char* V_lds = lds; char* K_lds = lds + 2 * SHM_V;
  float* ws = (float*)(lds + 2 * SHM_V + 2 * SHM_K) + wid * 64; float* li_l = ws; float* al_l = ws + 32;
  float m_reg = -1e30f, l_reg = 0; f32x16 o[4] = {}; bf16x8 qr[NQR]; constexpr int NQL = DK / 16 - NQR;
  char* qrl = lds + 2 * SHM_V + 2 * SHM_K + 2048 + (wid * NQL * 64 + lane) * 16;
  __syncthreads();
  const bf16* Qw = Qb + (long)(wid * QBLK + r32) * LDQ + hi * 8;
  { bf16x8 qraw[DK / 16];
#pragma unroll
    for (int d0 = 0; d0 < DK / 16; ++d0) qraw[d0] = ld8(Qw + d0 * 16);
#define ATT_UNPK(vv_, oo_) do { const u32x4 w_ = *reinterpret_cast<const u32x4*>(&(vv_)); oo_[0] = __uint_as_float(w_[0] << 16); oo_[1] = __uint_as_float(w_[0] & 0xffff0000u); oo_[2] = __uint_as_float(w_[1] << 16); oo_[3] = __uint_as_float(w_[1] & 0xffff0000u); \
      oo_[4] = __uint_as_float(w_[2] << 16); oo_[5] = __uint_as_float(w_[2] & 0xffff0000u); oo_[6] = __uint_as_float(w_[3] << 16); oo_[7] = __uint_as_float(w_[3] & 0xffff0000u); } while (0)
#define ATT_PK(ii_, vv_) do { u32x4 w_ = {cvtpk(ii_[0], ii_[1]), cvtpk(ii_[2], ii_[3]), cvtpk(ii_[4], ii_[5]), cvtpk(ii_[6], ii_[7])}; vv_ = *reinterpret_cast<bf16x8*>(&w_); } while (0)
    const int tok = tok0 + wid * QBLK + r32, prow = tok >> 6, pcol = tok & 63;
    if constexpr (QMODE == 1 || QMODE == 2) {
      float x[8][8]; float ss = 0.f;
#pragma unroll
      for (int d0 = 0; d0 < 8; ++d0) { ATT_UNPK(qraw[d0], x[d0]);
#pragma unroll
        for (int j = 0; j < 8; ++j) ss += x[d0][j] * x[d0][j]; }
      { auto rr = __builtin_amdgcn_permlane32_swap(__float_as_uint(ss), __float_as_uint(ss), false, false); ss = __uint_as_float(rr[0]) + __uint_as_float(rr[1]); }
      const float rstd = 1.0f / __builtin_sqrtf(ss * (1.0f / 128.0f) + 1e-6f);
#pragma unroll
      for (int d0 = 0; d0 < 8; ++d0) { const float* gp = qg + 16 * d0 + 8 * hi;
#pragma unroll
        for (int j = 0; j < 8; ++j) x[d0][j] = x[d0][j] * rstd * gp[j]; }
      if constexpr (QMODE == 2) {
#pragma unroll
        for (int ax = 0; ax < 2; ++ax) { const int pos = ax ? pcol : prow;
#pragma unroll
          for (int b = 0; b < 2; ++b) { const float* tp = T + ((long)pos * 32 + 16 * b + 8 * hi) * 2;
#pragma unroll
            for (int j = 0; j < 8; ++j) { const float co = tp[2 * j], si = tp[2 * j + 1], x1 = x[4 * ax + b][j], x2 = x[4 * ax + 2 + b][j];
              x[4 * ax + b][j] = x1 * co - x2 * si; x[4 * ax + 2 + b][j] = x1 * si + x2 * co; } } } }
#pragma unroll
      for (int d0 = 0; d0 < 8; ++d0) ATT_PK(x[d0], qraw[d0]);
    }
    if constexpr (QMODE == 3) {
#pragma unroll
      for (int ax = 0; ax < 2; ++ax) { const int pos = ax ? pcol : prow; const float* tp = T + ((long)pos * 16 + 8 * hi) * 2; float x1[8], x2[8];
        ATT_UNPK(qraw[8 + 2 * ax], x1); ATT_UNPK(qraw[9 + 2 * ax], x2);
#pragma unroll
        for (int j = 0; j < 8; ++j) { const float co = tp[2 * j], si = tp[2 * j + 1], a1 = x1[j], a2 = x2[j]; x1[j] = a1 * co - a2 * si; x2[j] = a1 * si + a2 * co; }
        ATT_PK(x1, qraw[8 + 2 * ax]); ATT_PK(x2, qraw[9 + 2 * ax]); } }
#undef ATT_UNPK
#undef ATT_PK
#pragma unroll
    for (int d0 = 0; d0 < NQR; ++d0) qr[d0] = qraw[d0];
    if constexpr (NQL > 0) {
#pragma unroll
      for (int f = 0; f < NQL; ++f) *reinterpret_cast<bf16x8*>(qrl + f * 1024) = qraw[NQR + f]; } }
  const int sr = tid >> 4, sc = (tid & 15) * 8, vst0 = v_st(sr, sc), vst1 = v_st(32 + sr, sc);
  const int rr = tid >> 3, rc = (tid & 7) * 8;
  const int vb0 = (int)(uintptr_t)V_lds + v_rd_base(lane);
  struct { bf16x8 vs0, vs1, ks0, ks1, kr; } sr_[SDEPTH];
#define ATT_SLOAD(i, k0) do { sr_[i].vs0 = ld8(&Vh[(long)((k0) + sr) * LDV + sc]); sr_[i].vs1 = ld8(&Vh[(long)((k0) + 32 + sr) * LDV + sc]); \
    sr_[i].ks0 = ld8(&Kn[(long)((k0) + sr) * LDKN + sc]); sr_[i].ks1 = ld8(&Kn[(long)((k0) + 32 + sr) * LDKN + sc]); \
    if constexpr (DK == 192) sr_[i].kr = ld8(&Kr[(long)((k0) + rr) * 64 + rc]); } while (0)
#define ATT_SWRITE(b, i) do { *(bf16x8*)(V_lds + (b) * SHM_V + vst0) = sr_[i].vs0; *(bf16x8*)(V_lds + (b) * SHM_V + vst1) = sr_[i].vs1; const int kc = sc * 2; \
    *(bf16x8*)(K_lds + (b) * SHM_K + kswz<KRS>(sr, kc)) = sr_[i].ks0; *(bf16x8*)(K_lds + (b) * SHM_K + kswz<KRS>(32 + sr, kc)) = sr_[i].ks1; \
    if constexpr (DK == 192) *(bf16x8*)(K_lds + (b) * SHM_K + kswz<KRS>(rr, 256 + rc * 2)) = sr_[i].kr; } while (0)
#define ATT_SWAIT() do { if constexpr (SDEPTH == 1) asm volatile("s_waitcnt vmcnt(0)" ::: "memory"); else if constexpr (DK == 192) asm volatile("s_waitcnt vmcnt(5)" ::: "memory"); else asm volatile("s_waitcnt vmcnt(4)" ::: "memory"); } while (0)
#define ATT_RESC(a) do { if (__any((a) < 1.f)) { if (hi == 0) al_l[r32] = (a); asm volatile("s_waitcnt lgkmcnt(0)" ::: "memory"); \
    _Pragma("unroll") for (int d = 0; d < 4; ++d) _Pragma("unroll") for (int r = 0; r < 16; ++r) o[d][r] *= al_l[crow(r, hi)]; } } while (0)
  f32x16 pA0, pA1, pB0, pB1; float mnA, mnB, alA, alB; bf16x8 pa0, pa1, pa2, pa3; const int NT = seq / KVBLK;
  constexpr int SE = 0, SO = SDEPTH - 1;
  ATT_SLOAD(SE, 0); asm volatile("s_waitcnt vmcnt(0)" ::: "memory"); ATT_SWRITE(0, SE); __syncthreads();
  qkt<DK, NQR>(pA0, pA1, K_lds, qr, qrl, r32, hi); partialSM(pA0, pA1, m_reg, mnA, alA, C, TS);
  ATT_SLOAD(SO, KVBLK); if constexpr (SDEPTH == 2) { if (2 < NT) ATT_SLOAD(SE, 2 * KVBLK); }
  if (2 < NT) ATT_SWAIT(); else asm volatile("s_waitcnt vmcnt(0)" ::: "memory");
  ATT_SWRITE(1, SO); __syncthreads();
  for (int j = 1; j + 1 < NT; j += 2) {
    ATT_SBAR(); qkt<DK, NQR>(pB0, pB1, K_lds + SHM_K, qr, qrl, r32, hi);
    finishSM(pA0, pA1, alA, l_reg, pa0, pa1, pa2, pa3); ATT_SBAR();
    ATT_SLOAD(SO, (j + SDEPTH) * KVBLK); ATT_SBAR();
    pv_d0(o, vb0, pa0, pa1, pa2, pa3); partialSM(pB0, pB1, m_reg, mnB, alB, C, TS);
    __syncthreads(); ATT_SWAIT(); ATT_SWRITE(0, SE);
    ATT_RESC(alB); __syncthreads();
    ATT_SBAR(); qkt<DK, NQR>(pA0, pA1, K_lds, qr, qrl, r32, hi);
    finishSM(pB0, pB1, alB, l_reg, pa0, pa1, pa2, pa3); ATT_SBAR();
    if (SDEPTH == 1 || j + 3 < NT) ATT_SLOAD(SE, (j + 1 + SDEPTH) * KVBLK); ATT_SBAR();
    pv_d0(o, vb0 + SHM_V, pa0, pa1, pa2, pa3); partialSM(pA0, pA1, m_reg, mnA, alA, C, TS);
    __syncthreads(); if (SDEPTH == 1 || j + 3 < NT) ATT_SWAIT(); else asm volatile("s_waitcnt vmcnt(0)" ::: "memory");
    ATT_SWRITE(1, SO);
    ATT_RESC(alA); __syncthreads();
  }
  ATT_SBAR(); qkt<DK, NQR>(pB0, pB1, K_lds + SHM_K, qr, qrl, r32, hi);
  finishSM(pA0, pA1, alA, l_reg, pa0, pa1, pa2, pa3); ATT_SBAR();
  pv_d0(o, vb0, pa0, pa1, pa2, pa3); partialSM(pB0, pB1, m_reg, mnB, alB, C, TS);
  __syncthreads(); ATT_RESC(alB);
  finishSM(pB0, pB1, alB, l_reg, pa0, pa1, pa2, pa3); ATT_SBAR();
  pv_d0(o, vb0 + SHM_V, pa0, pa1, pa2, pa3);
  if (hi == 0) li_l[r32] = l_reg; asm volatile("s_waitcnt lgkmcnt(0)" ::: "memory");
  float rli[16];
#pragma unroll
  for (int r = 0; r < 16; ++r) rli[r] = __builtin_amdgcn_rcpf(li_l[crow(r, hi)]);
  bf16* Ow = Ob + (long)(wid * QBLK) * LDO;
#pragma unroll
  for (int r = 0; r < 16; ++r) { const int orow = crow(r, hi);
#pragma unroll
    for (int d0 = 0; d0 < 4; d0 += 1) { const unsigned w = cvtpk(o[d0][r] * rli[r], 0.f); Ow[(long)orow * LDO + d0 * 32 + r32] = (bf16)(w & 0xffffu); } }
#undef ATT_SLOAD
#undef ATT_SWRITE
#undef ATT_SWAIT
#undef ATT_RESC
}
template <int DK, int LDQ, int LDKN, int LDV, int LDO, int NQR>
__device__ __forceinline__ void attn_unit_dma(const bf16* __restrict__ Qb, const bf16* __restrict__ Kn, const bf16* __restrict__ Kr, const bf16* __restrict__ Vh,
                                              bf16* __restrict__ Ob, int seq, char* lds, __attribute__((address_space(3))) unsigned char* ldsl) {
  constexpr int SHM_V = KVBLK * 128 * 2, SHM_K = KVBLK * DK * 2, KRS = DK * 2, STG = SHM_K + SHM_V, NKI = SHM_K / 8192;
  constexpr float SCALE = (DK == 128) ? 0.088388347648318440f : 0.072168783648703220f;
  constexpr float C = SCALE * 1.4426950408889634f, TS = THR / SCALE;
  int tid_ = threadIdx.x; asm volatile("" : "+v"(tid_));
  const int tid = tid_, wid = __builtin_amdgcn_readfirstlane(tid >> 6), lane = tid & 63, r32 = lane & 31, hi = lane >> 5;
  float* ws = (float*)(lds + 3 * STG) + wid * 64; float* li_l = ws; float* al_l = ws + 32;
  float m_reg = -1e30f, l_reg = 0; f32x16 o[4] = {}; bf16x8 qr[NQR]; constexpr int NQL = DK / 16 - NQR;
  char* qrl = lds + 3 * STG + 2048 + (wid * NQL * 64 + lane) * 16;
#define ATT_BAR() do { asm volatile("" ::: "memory"); __builtin_amdgcn_s_barrier(); asm volatile("" ::: "memory"); } while (0)
#define ATT_WAITV_B() do { if constexpr (NKI == 2) asm volatile("s_waitcnt vmcnt(4)" ::: "memory"); else asm volatile("s_waitcnt vmcnt(5)" ::: "memory"); } while (0)
#define ATT_WAITV_2B() do { if constexpr (NKI == 2) asm volatile("s_waitcnt vmcnt(8)" ::: "memory"); else asm volatile("s_waitcnt vmcnt(10)" ::: "memory"); } while (0)
  asm volatile("s_waitcnt vmcnt(0) lgkmcnt(0)" ::: "memory"); ATT_BAR();
  const bf16* Qw = Qb + (long)(wid * QBLK + r32) * LDQ + hi * 8;
#pragma unroll
  for (int d0 = 0; d0 < NQR; ++d0) qr[d0] = ld8(Qw + d0 * 16);
  if constexpr (NQL > 0) {
#pragma unroll
    for (int f = 0; f < NQL; ++f) *reinterpret_cast<bf16x8*>(qrl + f * 1024) = ld8(Qw + (NQR + f) * 16); }
  const char* ksrc[NKI]; int kinc[NKI]; const char* vsrc[2];
#pragma unroll
  for (int i = 0; i < NKI; ++i) { const int p = (i * 8 + wid) * 1024 + lane * 16, row = p / KRS, cb = (p % KRS) ^ ((row & 7) << 4);
    if (DK == 128 || cb < 256) { ksrc[i] = (const char*)Kn + ((long)row * LDKN) * 2 + cb; kinc[i] = KVBLK * LDKN * 2; }
    else { ksrc[i] = (const char*)Kr + row * 128 + (cb - 256); kinc[i] = KVBLK * 128; } }
#pragma unroll
  for (int i = 0; i < 2; ++i) { const int p = (i * 8 + wid) * 1024 + lane * 16, sub = p >> 9, q = p & 511, kk = ((sub >> 2) << 3) | (q >> 6), col = (sub & 3) * 32 + ((q & 63) >> 1);
    const int key = (kk & ~0xC) | ((kk & 4) << 1) | ((kk & 8) >> 1); vsrc[i] = (const char*)Vh + ((long)key * LDV + col) * 2; }
  constexpr int vinc = KVBLK * LDV * 2;
#define ATT_ISSUE(t, s) do { const int t_ = (t); const unsigned so_ = (unsigned)(s) * STG; \
    _Pragma("unroll") for (int i_ = 0; i_ < NKI; ++i_) __builtin_amdgcn_global_load_lds((const unsigned*)(ksrc[i_] + (long)t_ * kinc[i_]), (__attribute__((address_space(3))) unsigned*)(ldsl + so_ + (i_ * 8 + wid) * 1024), 16, 0, 0); \
    _Pragma("unroll") for (int i_ = 0; i_ < 2; ++i_) __builtin_amdgcn_global_load_lds((const unsigned*)(vsrc[i_] + (long)t_ * vinc), (__attribute__((address_space(3))) unsigned*)(ldsl + so_ + SHM_K + (i_ * 8 + wid) * 1024), 16, 0, 0); } while (0)
#define ATT_RESC2(a) do { if (__any((a) < 1.f)) { if (hi == 0) al_l[r32] = (a); asm volatile("s_waitcnt lgkmcnt(0)" ::: "memory"); \
    _Pragma("unroll") for (int d = 0; d < 4; ++d) _Pragma("unroll") for (int r = 0; r < 16; ++r) o[d][r] *= al_l[crow(r, hi)]; } } while (0)
  f32x16 pA0, pA1, pB0, pB1; float mnA, mnB, alA, alB; bf16x8 pa0, pa1, pa2, pa3; const int NT = seq / KVBLK;
  const int vbase = (int)(uintptr_t)lds + SHM_K + v_rd_base(lane);
  asm volatile("s_waitcnt vmcnt(0)" ::: "memory");
  ATT_ISSUE(0, 0); ATT_ISSUE(1, 1); ATT_ISSUE(2, 2);
  ATT_WAITV_2B(); ATT_BAR();
  qkt<DK, NQR>(pA0, pA1, lds, qr, qrl, r32, hi); partialSM(pA0, pA1, m_reg, mnA, alA, C, TS);
  ATT_WAITV_B(); ATT_BAR();
  int s = 1, sp = 0;
  for (int j = 1; j + 1 < NT; j += 2) {
    const int sn = 3 - s - sp;
    ATT_SBAR(); qkt<DK, NQR>(pB0, pB1, lds + s * STG, qr, qrl, r32, hi);
    finishSM(pA0, pA1, alA, l_reg, pa0, pa1, pa2, pa3); ATT_SBAR();
    pv_d0(o, vbase + sp * STG, pa0, pa1, pa2, pa3); partialSM(pB0, pB1, m_reg, mnB, alB, C, TS);
    asm volatile("s_waitcnt lgkmcnt(0)" ::: "memory"); ATT_BAR();
    const bool i2 = j + 2 < NT; if (i2) ATT_ISSUE(j + 2, sp);
    ATT_RESC2(alB);
    if (i2) ATT_WAITV_B(); else asm volatile("s_waitcnt vmcnt(0)" ::: "memory");
    ATT_BAR();
    ATT_SBAR(); qkt<DK, NQR>(pA0, pA1, lds + sn * STG, qr, qrl, r32, hi);
    finishSM(pB0, pB1, alB, l_reg, pa0, pa1, pa2, pa3); ATT_SBAR();
    pv_d0(o, vbase + s * STG, pa0, pa1, pa2, pa3); partialSM(pA0, pA1, m_reg, mnA, alA, C, TS);
    asm volatile("s_waitcnt lgkmcnt(0)" ::: "memory"); ATT_BAR();
    const bool i3 = j + 3 < NT; if (i3) ATT_ISSUE(j + 3, s);
    ATT_RESC2(alA);
    if (i3) ATT_WAITV_B(); else asm volatile("s_waitcnt vmcnt(0)" ::: "memory");
    ATT_BAR();
    const int s2 = sp; sp = sn; s = s2;
  }
  ATT_SBAR(); qkt<DK, NQR>(pB0, pB1, lds + s * STG, qr, qrl, r32, hi);
  finishSM(pA0, pA1, alA, l_reg, pa0, pa1, pa2, pa3); ATT_SBAR();
  pv_d0(o, vbase + sp * STG, pa0, pa1, pa2, pa3); partialSM(pB0, pB1, m_reg, mnB, alB, C, TS);
  ATT_RESC2(alB);
  finishSM(pB0, pB1, alB, l_reg, pa0, pa1, pa2, pa3); ATT_SBAR();
  pv_d0(o, vbase + s * STG, pa0, pa1, pa2, pa3);
  if (hi == 0) li_l[r32] = l_reg; asm volatile("s_waitcnt lgkmcnt(0)" ::: "memory");
  float rli[16];
#pragma unroll
  for (int r = 0; r < 16; ++r) rli[r] = __builtin_amdgcn_rcpf(li_l[crow(r, hi)]);
  bf16* Ow = Ob + (long)(wid * QBLK) * LDO;
#pragma unroll
  for (int r = 0; r < 16; ++r) { const int orow = crow(r, hi);
#pragma unroll
    for (int d0 = 0; d0 < 4; d0 += 1) { const unsigned w = cvtpk(o[d0][r] * rli[r], 0.f); Ow[(long)orow * LDO + d0 * 32 + r32] = (bf16)(w & 0xffffu); } }
#undef ATT_BAR
#undef ATT_WAITV_B
#undef ATT_WAITV_2B
#undef ATT_ISSUE
#undef ATT_RESC2
}

using f32x4a = __attribute__((ext_vector_type(4))) float;
__device__ __forceinline__ float max_x16(float v) { auto rr = __builtin_amdgcn_permlane16_swap(__float_as_uint(v), __float_as_uint(v), false, false); return fmaxf(__uint_as_float(rr[0]), __uint_as_float(rr[1])); }
__device__ __forceinline__ float max_x32(float v) { auto rr = __builtin_amdgcn_permlane32_swap(__float_as_uint(v), __float_as_uint(v), false, false); return fmaxf(__uint_as_float(rr[0]), __uint_as_float(rr[1])); }
__device__ __forceinline__ float add_x16(float v) { auto rr = __builtin_amdgcn_permlane16_swap(__float_as_uint(v), __float_as_uint(v), false, false); return __uint_as_float(rr[0]) + __uint_as_float(rr[1]); }
__device__ __forceinline__ float add_x32(float v) { auto rr = __builtin_amdgcn_permlane32_swap(__float_as_uint(v), __float_as_uint(v), false, false); return __uint_as_float(rr[0]) + __uint_as_float(rr[1]); }
__device__ __forceinline__ int k16_st(int r, int c) { return r * 256 + ((c ^ (r & 15)) << 4); }
__device__ __forceinline__ int kr16_st(int r, int c) { return 16384 + (r >> 1) * 256 + ((((r & 1) << 3) | (c ^ ((r >> 1) & 7))) << 4); }
__device__ __forceinline__ int v16_st(int k, int c) { const int row = (k & 0x23) | (((k >> 2) & 3) << 3) | (((k >> 4) & 1) << 2); return 256 * row + 16 * (c ^ (((row & 3) << 2) | ((row >> 2) & 3))); }

__device__ __forceinline__ void partialSM16(f32x4a (&p)[2][4], float (&m_reg)[2], float (&alpha)[2], const float C, const float TS) {
  float pmax[2];
#pragma unroll
  for (int qb = 0; qb < 2; ++qb) { float v = p[qb][0][0];
#pragma unroll
    for (int kb = 0; kb < 4; ++kb)
#pragma unroll
      for (int r = 0; r < 4; ++r) v = fmaxf(v, p[qb][kb][r]);
    v = max_x16(v); pmax[qb] = max_x32(v); }
  float mn[2];
  if (__builtin_expect(__all((pmax[0] - m_reg[0] <= TS) && (pmax[1] - m_reg[1] <= TS)), 1)) { mn[0] = m_reg[0]; mn[1] = m_reg[1]; alpha[0] = 1.f; alpha[1] = 1.f; }
  else {
#pragma unroll
    for (int qb = 0; qb < 2; ++qb) { mn[qb] = fmaxf(m_reg[qb], pmax[qb]); alpha[qb] = __builtin_amdgcn_exp2f((m_reg[qb] - mn[qb]) * C); m_reg[qb] = mn[qb]; } }
#pragma unroll
  for (int qb = 0; qb < 2; ++qb) { const float mnC = -mn[qb] * C;
#pragma unroll
    for (int kb = 0; kb < 4; ++kb)
#pragma unroll
      for (int r = 0; r < 4; ++r) p[qb][kb][r] = fmaf(p[qb][kb][r], C, mnC); }
#pragma unroll
  for (int qb = 0; qb < 2; ++qb)
#pragma unroll
    for (int kb = 0; kb < 2; ++kb)
#pragma unroll
      for (int r = 0; r < 4; ++r) p[qb][kb][r] = __builtin_amdgcn_exp2f(p[qb][kb][r]);
}
__device__ __forceinline__ void finishSM16(f32x4a (&p)[2][4], const float (&alpha)[2], float (&l_reg)[2], bf16x8 (&pa)[2][2]) {
#pragma unroll
  for (int qb = 0; qb < 2; ++qb)
#pragma unroll
    for (int kb = 2; kb < 4; ++kb)
#pragma unroll
      for (int r = 0; r < 4; ++r) p[qb][kb][r] = __builtin_amdgcn_exp2f(p[qb][kb][r]);
#pragma unroll
  for (int qb = 0; qb < 2; ++qb) { float ps = 0.f;
#pragma unroll
    for (int kb = 0; kb < 4; ++kb) ps += (p[qb][kb][0] + p[qb][kb][1]) + (p[qb][kb][2] + p[qb][kb][3]);
    ps = add_x16(ps); ps = add_x32(ps); l_reg[qb] = l_reg[qb] * alpha[qb] + ps;
#pragma unroll
    for (int ks = 0; ks < 2; ++ks) { u32x4 w = {cvtpk(p[qb][2 * ks][0], p[qb][2 * ks][1]), cvtpk(p[qb][2 * ks][2], p[qb][2 * ks][3]), cvtpk(p[qb][2 * ks + 1][0], p[qb][2 * ks + 1][1]), cvtpk(p[qb][2 * ks + 1][2], p[qb][2 * ks + 1][3])};
      pa[qb][ks] = *reinterpret_cast<bf16x8*>(&w); } }
}
template <int DK, int NQR> __device__ __forceinline__ void qkt16(f32x4a (&p)[2][4], const char* Ks, const bf16x8* qr, const char* qrl, int kbn, int kbr) {
#pragma unroll
  for (int qb = 0; qb < 2; ++qb)
#pragma unroll
    for (int kb = 0; kb < 4; ++kb) p[qb][kb] = (f32x4a){0.f, 0.f, 0.f, 0.f};
#pragma unroll
  for (int s = 0; s < DK / 32; ++s) {
    const bf16x8 q0 = (2 * s < NQR) ? qr[2 * s < NQR ? 2 * s : 0] : *reinterpret_cast<const bf16x8*>(qrl + (2 * s - NQR) * 1024);
    const bf16x8 q1 = (2 * s + 1 < NQR) ? qr[2 * s + 1 < NQR ? 2 * s + 1 : 0] : *reinterpret_cast<const bf16x8*>(qrl + (2 * s + 1 - NQR) * 1024);
    const int ka = (s < 4) ? (kbn ^ (s << 6)) : (kbr ^ ((s - 4) << 6));
#pragma unroll
    for (int kb = 0; kb < 4; ++kb) { const bf16x8 kf = *reinterpret_cast<const bf16x8*>(Ks + ka + kb * ((s < 4) ? 4096 : 2048));
      p[0][kb] = __builtin_amdgcn_mfma_f32_16x16x32_bf16(kf, q0, p[0][kb], 0, 0, 0);
      p[1][kb] = __builtin_amdgcn_mfma_f32_16x16x32_bf16(kf, q1, p[1][kb], 0, 0, 0); }
    if constexpr (DK == 192) { if (s == 1 || s == 3) ATT_SBAR(); } }
}
template <int DB> __device__ __forceinline__ void pv16_one(f32x4a& o0, f32x4a& o1, int vb, const bf16x8 (&pa)[2][2]) {
  const int a0 = vb ^ (32 * DB), a1 = vb ^ (32 * DB + 16);
  const s16x4 b00 = tr_read<0>(a0), b01 = tr_read<1024>(a1), b10 = tr_read<8192>(a0), b11 = tr_read<9216>(a1);
  asm volatile("s_waitcnt lgkmcnt(0)" ::: "memory"); ATT_SBAR();
  const bf16x8 B0 = (bf16x8){b00[0], b00[1], b00[2], b00[3], b01[0], b01[1], b01[2], b01[3]}, B1 = (bf16x8){b10[0], b10[1], b10[2], b10[3], b11[0], b11[1], b11[2], b11[3]};
  o0 = __builtin_amdgcn_mfma_f32_16x16x32_bf16(pa[0][0], B0, o0, 0, 0, 0);
  o1 = __builtin_amdgcn_mfma_f32_16x16x32_bf16(pa[1][0], B0, o1, 0, 0, 0);
  o0 = __builtin_amdgcn_mfma_f32_16x16x32_bf16(pa[0][1], B1, o0, 0, 0, 0);
  o1 = __builtin_amdgcn_mfma_f32_16x16x32_bf16(pa[1][1], B1, o1, 0, 0, 0);
}
__device__ __forceinline__ void pv16(f32x4a (&o)[2][8], int vb, const bf16x8 (&pa)[2][2]) {
  pv16_one<0>(o[0][0], o[1][0], vb, pa); pv16_one<1>(o[0][1], o[1][1], vb, pa); pv16_one<2>(o[0][2], o[1][2], vb, pa); pv16_one<3>(o[0][3], o[1][3], vb, pa);
  pv16_one<4>(o[0][4], o[1][4], vb, pa); pv16_one<5>(o[0][5], o[1][5], vb, pa); pv16_one<6>(o[0][6], o[1][6], vb, pa); pv16_one<7>(o[0][7], o[1][7], vb, pa);
}

template <int DK, int LDQ, int LDKN, int LDV, int LDO, int SDEPTH, int NQR, int QMODE>
__device__ __forceinline__ void attn_unit16(const bf16* __restrict__ Qb, const bf16* __restrict__ Kn, const bf16* __restrict__ Kr, const bf16* __restrict__ Vh,
                                            bf16* __restrict__ Ob, int seq, char* lds, const float* __restrict__ qg, const float* __restrict__ T, int tok0) {
  constexpr int SHM_V = KVBLK * 128 * 2, SHM_K = KVBLK * DK * 2, NF = DK / 16;
  constexpr float SCALE = (DK == 128) ? 0.088388347648318440f : 0.072168783648703220f;
  constexpr float C = SCALE * 1.4426950408889634f, TS = THR / SCALE;
  int tid_ = threadIdx.x; asm volatile("" : "+v"(tid_));
  const int tid = tid_, wid = tid >> 6, lane = tid & 63, li = lane & 15, lg = lane >> 4;
  char* V_lds = lds; char* K_lds = lds + 2 * SHM_V;
  float* ws = (float*)(lds + 2 * SHM_V + 2 * SHM_K) + wid * 64; float* li_l = ws; float* al_l = ws + 32;
  float m_reg[2] = {-1e30f, -1e30f}, l_reg[2] = {0.f, 0.f}; f32x4a o[2][8]; bf16x8 qr[NQR]; constexpr int NQL = NF - NQR;
#pragma unroll
  for (int qb = 0; qb < 2; ++qb)
#pragma unroll
    for (int db = 0; db < 8; ++db) o[qb][db] = (f32x4a){0.f, 0.f, 0.f, 0.f};
  char* qrl = lds + 2 * SHM_V + 2 * SHM_K + 2048 + (wid * NQL * 64 + lane) * 16;
  __syncthreads();
  const bf16* Qw = Qb + (long)(wid * QBLK + li) * LDQ + lg * 8;
  { bf16x8 qraw[NF];
#pragma unroll
    for (int s = 0; s < DK / 32; ++s)
#pragma unroll
      for (int qb = 0; qb < 2; ++qb) qraw[2 * s + qb] = ld8(Qw + (long)(16 * qb) * LDQ + 32 * s);
#define ATT_UNPK(vv_, oo_) do { const u32x4 w_ = *reinterpret_cast<const u32x4*>(&(vv_)); oo_[0] = __uint_as_float(w_[0] << 16); oo_[1] = __uint_as_float(w_[0] & 0xffff0000u); oo_[2] = __uint_as_float(w_[1] << 16); oo_[3] = __uint_as_float(w_[1] & 0xffff0000u); \
      oo_[4] = __uint_as_float(w_[2] << 16); oo_[5] = __uint_as_float(w_[2] & 0xffff0000u); oo_[6] = __uint_as_float(w_[3] << 16); oo_[7] = __uint_as_float(w_[3] & 0xffff0000u); } while (0)
#define ATT_PK(ii_, vv_) do { u32x4 w_ = {cvtpk(ii_[0], ii_[1]), cvtpk(ii_[2], ii_[3]), cvtpk(ii_[4], ii_[5]), cvtpk(ii_[6], ii_[7])}; vv_ = *reinterpret_cast<bf16x8*>(&w_); } while (0)
    if constexpr (QMODE == 1 || QMODE == 2) {
#pragma unroll
      for (int qb = 0; qb < 2; ++qb) {
        float x[4][8]; float ss = 0.f;
#pragma unroll
        for (int s = 0; s < 4; ++s) { ATT_UNPK(qraw[2 * s + qb], x[s]);
#pragma unroll
          for (int j = 0; j < 8; ++j) ss += x[s][j] * x[s][j]; }
        ss = add_x16(ss); ss = add_x32(ss);
        const float rstd = 1.0f / __builtin_sqrtf(ss * (1.0f / 128.0f) + 1e-6f);
#pragma unroll
        for (int s = 0; s < 4; ++s) { const float* gp = qg + 32 * s + 8 * lg;
#pragma unroll
          for (int j = 0; j < 8; ++j) x[s][j] = x[s][j] * rstd * gp[j]; }
        if constexpr (QMODE == 2) {
          const int tok = tok0 + wid * QBLK + 16 * qb + li, prow = tok >> 6, pcol = tok & 63;
#pragma unroll
          for (int ax = 0; ax < 2; ++ax) { const int pos = ax ? pcol : prow; const float* tp = T + ((long)pos * 32 + 8 * lg) * 2;
#pragma unroll
            for (int j = 0; j < 8; ++j) { const float co = tp[2 * j], si = tp[2 * j + 1], x1 = x[2 * ax][j], x2 = x[2 * ax + 1][j];
              x[2 * ax][j] = x1 * co - x2 * si; x[2 * ax + 1][j] = x1 * si + x2 * co; } } }
#pragma unroll
        for (int s = 0; s < 4; ++s) ATT_PK(x[s], qraw[2 * s + qb]);
      }
    }
    if constexpr (QMODE == 3) {
#pragma unroll
      for (int qb = 0; qb < 2; ++qb) { const int tok = tok0 + wid * QBLK + 16 * qb + li, prow = tok >> 6, pcol = tok & 63;
#pragma unroll
        for (int ax = 0; ax < 2; ++ax) { const int pos = ax ? pcol : prow; const float* tp = T + ((long)pos * 16 + 8 * (lg & 1)) * 2;
          const u32x4 w = *reinterpret_cast<const u32x4*>(&qraw[2 * (4 + ax) + qb]); u32x4 wo;
#pragma unroll
          for (int k = 0; k < 4; ++k) { auto rr = __builtin_amdgcn_permlane32_swap(w[k], w[k], false, false);
            const float a1 = __uint_as_float(rr[0] << 16), b1 = __uint_as_float(rr[0] & 0xffff0000u), a2 = __uint_as_float(rr[1] << 16), b2 = __uint_as_float(rr[1] & 0xffff0000u);
            const float co0 = tp[4 * k], si0 = tp[4 * k + 1], co1 = tp[4 * k + 2], si1 = tp[4 * k + 3];
            const float r0 = (lg < 2) ? a1 * co0 - a2 * si0 : a1 * si0 + a2 * co0, r1 = (lg < 2) ? b1 * co1 - b2 * si1 : b1 * si1 + b2 * co1;
            wo[k] = cvtpk(r0, r1); }
          qraw[2 * (4 + ax) + qb] = *reinterpret_cast<bf16x8*>(&wo); } } }
#undef ATT_UNPK
#undef ATT_PK
#pragma unroll
    for (int f = 0; f < NQR; ++f) qr[f] = qraw[f];
    if constexpr (NQL > 0) {
#pragma unroll
      for (int f = 0; f < NQL; ++f) *reinterpret_cast<bf16x8*>(qrl + f * 1024) = qraw[NQR + f]; } }
  const int sr = tid >> 4, sc = (tid & 15) * 8, vst0 = v16_st(sr, tid & 15), vst1 = vst0 + 8192, kst0 = k16_st(sr, tid & 15), kst1 = kst0 + 8192;
  const int rr = tid >> 3, rc = (tid & 7) * 8, krst = kr16_st(rr, tid & 7);
  const int vb0 = (int)(uintptr_t)V_lds + 256 * (8 * lg + (li >> 2)) + 8 * (lane & 1) + 16 * ((((li >> 2) << 2) | ((lg & 1) << 1)) | ((lane >> 1) & 1));
  const int kbn = li * 256 + (((li & 12) | ((lg ^ li) & 3)) << 4), kbr = 16384 + (li >> 1) * 256 + ((((li & 1) << 3) | ((lg ^ (li >> 1)) & 7)) << 4);
  struct { bf16x8 vs0, vs1, ks0, ks1, kr; } sr_[SDEPTH];
#define ATT_SLOAD(i, k0) do { sr_[i].vs0 = ld8(&Vh[(long)((k0) + sr) * LDV + sc]); sr_[i].vs1 = ld8(&Vh[(long)((k0) + 32 + sr) * LDV + sc]); \
    sr_[i].ks0 = ld8(&Kn[(long)((k0) + sr) * LDKN + sc]); sr_[i].ks1 = ld8(&Kn[(long)((k0) + 32 + sr) * LDKN + sc]); \
    if constexpr (DK == 192) sr_[i].kr = ld8(&Kr[(long)((k0) + rr) * 64 + rc]); } while (0)
#define ATT_SWRITE(b, i) do { *(bf16x8*)(V_lds + (b) * SHM_V + vst0) = sr_[i].vs0; *(bf16x8*)(V_lds + (b) * SHM_V + vst1) = sr_[i].vs1; \
    *(bf16x8*)(K_lds + (b) * SHM_K + kst0) = sr_[i].ks0; *(bf16x8*)(K_lds + (b) * SHM_K + kst1) = sr_[i].ks1; \
    if constexpr (DK == 192) *(bf16x8*)(K_lds + (b) * SHM_K + krst) = sr_[i].kr; } while (0)
#define ATT_SWAIT() do { if constexpr (SDEPTH == 1) asm volatile("s_waitcnt vmcnt(0)" ::: "memory"); else if constexpr (DK == 192) asm volatile("s_waitcnt vmcnt(5)" ::: "memory"); else asm volatile("s_waitcnt vmcnt(4)" ::: "memory"); } while (0)
#define ATT_RESC(a) do { if (__any(((a)[0] < 1.f) || ((a)[1] < 1.f))) { if (lg == 0) { al_l[li] = (a)[0]; al_l[16 + li] = (a)[1]; } asm volatile("s_waitcnt lgkmcnt(0)" ::: "memory"); \
    const f32x4a a0_ = *reinterpret_cast<const f32x4a*>(al_l + 4 * lg), a1_ = *reinterpret_cast<const f32x4a*>(al_l + 16 + 4 * lg); \
    _Pragma("unroll") for (int d = 0; d < 8; ++d) { o[0][d] *= a0_; o[1][d] *= a1_; } } } while (0)
  f32x4a pA[2][4], pB[2][4]; float alA[2], alB[2]; bf16x8 pa[2][2]; const int NT = seq / KVBLK;
  constexpr int SE = 0, SO = SDEPTH - 1;
  ATT_SLOAD(SE, 0); asm volatile("s_waitcnt vmcnt(0)" ::: "memory"); ATT_SWRITE(0, SE); __syncthreads();
  qkt16<DK, NQR>(pA, K_lds, qr, qrl, kbn, kbr); partialSM16(pA, m_reg, alA, C, TS);
  ATT_SLOAD(SO, KVBLK); if constexpr (SDEPTH == 2) { if (2 < NT) ATT_SLOAD(SE, 2 * KVBLK); }
  if (2 < NT) ATT_SWAIT(); else asm volatile("s_waitcnt vmcnt(0)" ::: "memory");
  ATT_SWRITE(1, SO); __syncthreads();
  for (int j = 1; j + 1 < NT; j += 2) {
    ATT_SBAR(); qkt16<DK, NQR>(pB, K_lds + SHM_K, qr, qrl, kbn, kbr);
    finishSM16(pA, alA, l_reg, pa); ATT_SBAR();
    ATT_SLOAD(SO, (j + SDEPTH) * KVBLK); ATT_SBAR();
    pv16(o, vb0, pa); partialSM16(pB, m_reg, alB, C, TS);
    __syncthreads(); ATT_SWAIT(); ATT_SWRITE(0, SE);
    ATT_RESC(alB); __syncthreads();
    ATT_SBAR(); qkt16<DK, NQR>(pA, K_lds, qr, qrl, kbn, kbr);
    finishSM16(pB, alB, l_reg, pa); ATT_SBAR();
    if (SDEPTH == 1 || j + 3 < NT) ATT_SLOAD(SE, (j + 1 + SDEPTH) * KVBLK); ATT_SBAR();
    pv16(o, vb0 + SHM_V, pa); partialSM16(pA, m_reg, alA, C, TS);
    __syncthreads(); if (SDEPTH == 1 || j + 3 < NT) ATT_SWAIT(); else asm volatile("s_waitcnt vmcnt(0)" ::: "memory");
    ATT_SWRITE(1, SO);
    ATT_RESC(alA); __syncthreads();
  }
  ATT_SBAR(); qkt16<DK, NQR>(pB, K_lds + SHM_K, qr, qrl, kbn, kbr);
  finishSM16(pA, alA, l_reg, pa); ATT_SBAR();
  pv16(o, vb0, pa); partialSM16(pB, m_reg, alB, C, TS);
  __syncthreads(); ATT_RESC(alB);
  finishSM16(pB, alB, l_reg, pa); ATT_SBAR();
  pv16(o, vb0 + SHM_V, pa);
  if (lg == 0) { li_l[li] = l_reg[0]; li_l[16 + li] = l_reg[1]; } asm volatile("s_waitcnt lgkmcnt(0)" ::: "memory");
  f32x4a rl[2] = {*reinterpret_cast<const f32x4a*>(li_l + 4 * lg), *reinterpret_cast<const f32x4a*>(li_l + 16 + 4 * lg)};
#pragma unroll
  for (int qb = 0; qb < 2; ++qb)
#pragma unroll
    for (int r = 0; r < 4; ++r) rl[qb][r] = __builtin_amdgcn_rcpf(rl[qb][r]);
  bf16* Ow = Ob + (long)(wid * QBLK + 4 * lg) * LDO + li;
#pragma unroll
  for (int qb = 0; qb < 2; ++qb)
#pragma unroll
    for (int r = 0; r < 4; ++r)
#pragma unroll
      for (int db = 0; db < 8; ++db) { const unsigned w = cvtpk(o[qb][db][r] * rl[qb][r], 0.f); Ow[(long)(16 * qb + r) * LDO + 16 * db] = (bf16)(w & 0xffffu); }
#undef ATT_SLOAD
#undef ATT_SWRITE
#undef ATT_SWAIT
#undef ATT_RESC
}
}
constexpr int DM = 2048, NP = 4096  , NS = 16384  , MT = NP + NS  ;
constexpr int SEQ_P = 256, SEQ_S = 4096, PAST = 512, KEYS_S = SEQ_S + PAST  , MK = NP + 4 * KEYS_S  ;
constexpr int ZW = 3840  , AIN = 3648, FF = 5632, NLAYER = 4;
constexpr int ZC_QA = 0, ZC_KA = 1024, ZC_VA = 1280, ZC_QB = 1536, ZC_CKV = 3072, ZC_KR = 3584;
constexpr float EPS = 1e-6f;
constexpr size_t OUT_SK = (size_t)MT * DM, OUT_SV = OUT_SK + 2097152, OUT_SCKV = OUT_SV + 2097152, OUT_SKR = OUT_SCKV + 4194304;

constexpr size_t MiB = 1u << 20;
constexpr size_t WS_CTL = 0, CTL_ZERO_BYTES = 64 * 1024;
constexpr size_t WS_TAB = 1 * MiB;
constexpr size_t WS_MOD = 2 * MiB;
constexpr size_t WS_SS = 3 * MiB;
constexpr size_t WS_WIN = 6 * MiB;
constexpr size_t WS_WKV = 36 * MiB;
constexpr size_t WS_WOUT = 40 * MiB;
constexpr size_t WS_CWIN = 56 * MiB;
constexpr size_t WS_CWOUT = 88 * MiB;
constexpr size_t WS_FGU = 104 * MiB;
constexpr size_t WS_FD = 280 * MiB;
constexpr size_t WS_H = 368 * MiB;
constexpr size_t WS_ACT = 448 * MiB;
constexpr size_t WS_Z = WS_ACT;
constexpr size_t WS_KA = WS_Z + 150 * MiB;
constexpr size_t WS_VA = WS_KA + 11 * MiB;
constexpr size_t WS_CKV = WS_VA + 11 * MiB;
constexpr size_t WS_KR = WS_CKV + 22 * MiB;
constexpr size_t WS_KVB = WS_KR + 3 * MiB;
constexpr size_t WS_O = WS_KVB + 88 * MiB;
constexpr size_t WS_ACT_END = WS_O + 80 * MiB;
constexpr size_t WS_U = WS_ACT, WS_V = WS_ACT + 80 * MiB, WS_MC = WS_ACT + 160 * MiB;
constexpr size_t WS_HH = WS_ACT;
constexpr size_t WS_SSX = WS_ACT_END;
constexpr size_t WS_BIAS1 = WS_ACT_END + 3 * MiB;
constexpr size_t WS_BIAS2 = WS_ACT_END + 4 * MiB;
constexpr size_t WS_XB = WS_ACT_END + 8 * MiB;
constexpr size_t WS_PROBE = WS_ACT_END + 88 * MiB;
constexpr size_t WS_END = WS_ACT_END + 96 * MiB;
constexpr int CW_BAR = 1024;

constexpr int RING_BYTES = 131072;
#ifndef LDS_KB
#define LDS_KB 144
#endif
constexpr int LDS_BYTES = LDS_KB * 1024;
constexpr int MISC_OFF = LDS_BYTES - 64;
constexpr int NWAVES = 8, NTHREADS = 512;

#define GAS __attribute__((address_space(1)))
#define LAS __attribute__((address_space(3)))
typedef unsigned short bf16;
typedef unsigned v4u __attribute__((ext_vector_type(4)));
typedef unsigned v2u __attribute__((ext_vector_type(2)));
typedef float f32x4 __attribute__((ext_vector_type(4)));
typedef short bf16x8 __attribute__((ext_vector_type(8)));
typedef float f32x16 __attribute__((ext_vector_type(16)));
#define LDS_WAIT() asm volatile("s_waitcnt lgkmcnt(0)" ::: "memory")
#define VM_WAIT() asm volatile("s_waitcnt vmcnt(0)" ::: "memory")
__device__ __forceinline__ unsigned pk2(float lo, float hi) { unsigned r; asm volatile("v_cvt_pk_bf16_f32 %0, %1, %2" : "=v"(r) : "v"(lo), "v"(hi)); return r; }
__device__ __forceinline__ float bf_lo(unsigned w) { return __uint_as_float(w << 16); }
__device__ __forceinline__ float bf_hi(unsigned w) { return __uint_as_float(w & 0xffff0000u); }
#define SWZ_XOR(v, m) __int_as_float(__builtin_amdgcn_ds_swizzle(__float_as_int(v), ((m) << 10) | 0x1f))
__device__ __forceinline__ float add_xor32(float v) { auto rr = __builtin_amdgcn_permlane32_swap(__float_as_uint(v), __float_as_uint(v), false, false); return __uint_as_float(rr[0]) + __uint_as_float(rr[1]); }
__device__ __forceinline__ float wave_sum(float v) {
    v += SWZ_XOR(v, 1); v += SWZ_XOR(v, 2); v += SWZ_XOR(v, 4); v += SWZ_XOR(v, 8); v += SWZ_XOR(v, 16);
    return add_xor32(v);
}

#define XB_TMO      128
#define XB_XCNT(j)  (256  + 64 * (j))
#define XB_XSUB(j)  (1280 + 64 * (j))
#define XB_XGEN(j)  (2304 + 64 * (j))
#define XB_TOP      3328
#define XB_TOPGEN   3392
#define XCD_BAR_WORDS 3456
#define XB_SPIN_CAP (1u << 18)
#define LAS __attribute__((address_space(3)))

__device__ __forceinline__ unsigned xb_ld(unsigned* p)              { return __hip_atomic_load(p, __ATOMIC_RELAXED, __HIP_MEMORY_SCOPE_AGENT); }
__device__ __forceinline__ unsigned xb_add(unsigned* p, unsigned v) { return __hip_atomic_fetch_add(p, v, __ATOMIC_RELAXED, __HIP_MEMORY_SCOPE_AGENT); }
__device__ __forceinline__ unsigned xb_xcc_id() { return (unsigned)__builtin_amdgcn_s_getreg((3 << 11) | 20) & 0xFu; }
#define XB_SPIN(cond, bar) do { unsigned _sp = 0; while (cond) { __builtin_amdgcn_s_sleep(1); \
    if ((++_sp & 255u) == 0u) { if (xb_ld(&(bar)[XB_TMO])) break; if (_sp > XB_SPIN_CAP) { atomicAdd(&(bar)[XB_TMO], 1u); break; } } } } while (0)

struct XcdBarrier {
    unsigned* bar; unsigned x;
    volatile LAS unsigned* st;
};

__device__ __forceinline__ XcdBarrier xcd_barrier_post(unsigned* bar, volatile LAS unsigned* st) {
    XcdBarrier b; b.bar = bar; b.x = xb_xcc_id(); b.st = st;
    if (threadIdx.x == 0) (void)xb_add(&bar[XB_XCNT(b.x)], 1u);
    return b;
}
__device__ __forceinline__ void xcd_barrier_complete(unsigned* bar, unsigned x, unsigned& nloc, unsigned& nx) {
    const unsigned G = gridDim.x * gridDim.y * gridDim.z;
    unsigned sum, cnt, mine, sp = 0u;
    for (;;) {
        sum = 0u; cnt = 0u; mine = 0u;
#pragma unroll
        for (unsigned j = 0; j < 16; ++j) { const unsigned c = xb_ld(&bar[XB_XCNT(j)]); sum += c; cnt += (c > 0u) ? 1u : 0u; mine = (j == x) ? c : mine; }
        if (sum == G) break;
        __builtin_amdgcn_s_sleep(1);
        if ((++sp & 255u) == 0u) { if (xb_ld(&bar[XB_TMO])) break; if (sp > XB_SPIN_CAP) { atomicAdd(&bar[XB_TMO], 1u); break; } }
    }
    nloc = mine > 0u ? mine : 1u; nx = cnt > 0u ? cnt : 1u;
}

__device__ __forceinline__ void xcd_barrier(const XcdBarrier& b) {
    asm volatile("s_waitcnt vmcnt(0)" ::: "memory");
    __syncthreads();
    if (threadIdx.x == 0) {
        unsigned* bar = b.bar;
        __builtin_amdgcn_s_waitcnt(0);
        unsigned nloc = b.st[0], nx = b.st[1];
        if (nloc == 0u) { xcd_barrier_complete(bar, b.x, nloc, nx); b.st[0] = nloc; b.st[1] = nx; }
        const unsigned old = xb_add(&bar[XB_XSUB(b.x)], 1u);
        const unsigned gen = old / nloc;
        if (old + 1u == (gen + 1u) * nloc) {
            __builtin_amdgcn_fence(__ATOMIC_RELEASE, "agent");
            asm volatile("s_waitcnt vmcnt(0)" ::: "memory");
            const unsigned og = xb_add(&bar[XB_TOP], 1u);
            const unsigned tg = og / nx;
            if (og + 1u == (tg + 1u) * nx) xb_add(&bar[XB_TOPGEN], 1u);
            else XB_SPIN(xb_ld(&bar[XB_TOPGEN]) == tg, bar);
            __builtin_amdgcn_fence(__ATOMIC_ACQUIRE, "agent");
            xb_add(&bar[XB_XGEN(b.x)], 1u);
            asm volatile("s_waitcnt vmcnt(0)" ::: "memory");
        } else {
            XB_SPIN(xb_ld(&bar[XB_XGEN(b.x)]) == gen, bar);
            __builtin_amdgcn_fence(__ATOMIC_ACQUIRE, "agent");
            asm volatile("s_waitcnt vmcnt(0)" ::: "memory");
        }
    }
    __syncthreads();
}

struct Args { const GAS float* in[27]; GAS float* out_f; GAS unsigned char* ws_b; int ph_lo, ph_hi; };
typedef __attribute__((address_space(4))) const Args* KArgsPtr;
struct InProxy { KArgsPtr ka; __device__ __forceinline__ const float* operator[](int i) const { return (const float*)ka->in[i]; } };
struct Frame {
    LAS unsigned char* lds;
    char* ldsg;
    int tid, lane, wave, bid, G;
    InProxy in;
    float* out; unsigned char* ws;
};
#define PHASE_BEGIN(F) do { GAS unsigned char* w_ = (F).in.ka->ws_b; GAS float* o_ = (F).in.ka->out_f; int g_ = (int)gridDim.x, b_ = (int)blockIdx.x, t_ = (int)threadIdx.x; \
    asm volatile("" : "+s"(w_), "+s"(o_), "+s"(g_), "+s"(b_), "+v"(t_)); (F).ws = (unsigned char*)w_; (F).out = (float*)o_; (F).G = g_; (F).bid = b_; (F).tid = t_; (F).lane = t_ & 63; (F).wave = __builtin_amdgcn_readfirstlane(t_ >> 6); } while (0)
#define FRAME_REFRESH(F) do { } while (0)
#ifndef PROBE_T
#define PROBE_T 0
#endif
#define PROBE_STAMP(F, k) do { if (PROBE_T && blockIdx.x == 0 && threadIdx.x == 0) { ((unsigned long long*)((F).ws + WS_PROBE))[(k)] = __builtin_amdgcn_s_memrealtime(); ((unsigned long long*)((F).ws + WS_PROBE))[64 + (k)] = __builtin_amdgcn_s_memtime(); } } while (0)
enum { I_XP = 0, I_XS, I_C, I_CK, I_CV, I_CCKV, I_CKR, I_CCTX, I_ADAW, I_ADAB, I_NMIX, I_NFFN, I_FG, I_FU, I_FD, I_AWIN, I_AQN, I_AKN, I_AKVN, I_AWKV, I_AWOUT, I_CWIN, I_CVN, I_CWS, I_CBS, I_CWOUT, I_FNORM };

#ifndef NT_WEIGHTS
#define NT_WEIGHTS 1
#endif
#if NT_WEIGHTS
#define NT_LOAD4(p) __builtin_nontemporal_load(p)
#else
#define NT_LOAD4(p) (*(p))
#endif
struct ConvItem { const float* W; bf16* WT; int K, N, k0, n0, drow0; };
__device__ __forceinline__ void conv_issue(const ConvItem& c, f32x4 (&v)[16], int lane) {
    const int kr = lane >> 4, n4 = (lane & 15) * 4;
#pragma unroll
    for (int i = 0; i < 16; ++i) v[i] = NT_LOAD4((const GAS f32x4*)(c.W + (size_t)(c.k0 + 4 * i + kr) * c.N + c.n0 + n4));
}
__device__ __forceinline__ void conv_finish(const ConvItem& c, const f32x4 (&v)[16], LAS float* scr, int lane) {
    const int kr = lane >> 4, n4 = (lane & 15) * 4;
#pragma unroll
    for (int i = 0; i < 16; ++i) { LAS float* d = scr + (4 * i + kr) * 65 + n4; d[0] = v[i].x; d[1] = v[i].y; d[2] = v[i].z; d[3] = v[i].w; }
    LDS_WAIT(); asm volatile("" ::: "memory");
    const int cc = lane & 7;
#pragma unroll
    for (int j = 0; j < 8; ++j) { const int n = (lane >> 3) + 8 * j; const LAS float* s = scr + (8 * cc) * 65 + n;
        v4u o; o.x = pk2(s[0 * 65], s[1 * 65]); o.y = pk2(s[2 * 65], s[3 * 65]); o.z = pk2(s[4 * 65], s[5 * 65]); o.w = pk2(s[6 * 65], s[7 * 65]);
        *(GAS v4u*)(c.WT + (size_t)(c.drow0 + n) * c.K + c.k0 + 8 * cc) = o; }
    LDS_WAIT(); asm volatile("" ::: "memory");
}
__device__ __forceinline__ void rope_entry(int pos, int i, double r, float& co, float& si) {
    double inv = 1.0; for (int k = 0; k < i; ++k) inv *= r;
    const double ang = (double)pos * inv;
    const double n = __builtin_rint(ang * 0.63661977236758134308);
    const double x = (ang - n * 1.57079632679489655800) - n * 6.12323399573676603587e-17;
    const double x2 = x * x;
    const double s = x * (1.0 + x2 * (-1.0 / 6 + x2 * (1.0 / 120 + x2 * (-1.0 / 5040 + x2 * (1.0 / 362880 + x2 * (-1.0 / 39916800 + x2 * (1.0 / 6227020800.0 + x2 * (-1.0 / 1307674368000.0))))))));
    const double c = 1.0 + x2 * (-0.5 + x2 * (1.0 / 24 + x2 * (-1.0 / 720 + x2 * (1.0 / 40320 + x2 * (-1.0 / 3628800 + x2 * (1.0 / 479001600 + x2 * (-1.0 / 87178291200.0 + x2 * (1.0 / 20922789888000.0))))))));
    const int q = ((int)n) & 3;
    const double cc = (q == 0) ? c : (q == 1) ? -s : (q == 2) ? -c : s;
    const double ss = (q == 0) ? s : (q == 1) ? c : (q == 2) ? -s : -c;
    co = (float)cc; si = (float)ss;
}
__device__ __forceinline__ void ada_layer(Frame& F, int layer, int it_lo, int it_hi, int widx, int nwg) {
    LAS float* SC = (LAS float*)F.lds;
    LAS float* RED = (LAS float*)(F.lds + 40960);
    __syncthreads();
    for (int idx = F.tid; idx < 5 * DM; idx += NTHREADS) { const int cd = idx >> 11, k = idx & 2047; const float v = cd == 0 ? F.in[I_CCTX][k] : F.in[I_C][(cd - 1) * DM + k];
        SC[idx] = v / (1.0f + __expf(-v)); }
    __syncthreads();
    float* MOD = (float*)(F.ws + WS_MOD);
    for (int it = it_lo + widx; it < it_hi; it += nwg) {
        const int c0 = it * 32, cg = F.lane & 7, rsub = F.lane >> 3;
        const float* W = F.in[I_ADAW] + (size_t)layer * DM * 12288 + c0 + 4 * cg;
        f32x4 acc[5];
#pragma unroll
        for (int cd = 0; cd < 5; ++cd) acc[cd] = (f32x4){0.f, 0.f, 0.f, 0.f};
        f32x4 w[32];
#pragma unroll
        for (int i = 0; i < 32; ++i) w[i] = NT_LOAD4((const GAS f32x4*)(W + (size_t)(256 * F.wave + 8 * i + rsub) * 12288));
#pragma unroll
        for (int i = 0; i < 32; ++i) { const int k = 256 * F.wave + 8 * i + rsub;
#pragma unroll
            for (int cd = 0; cd < 5; ++cd) acc[cd] += SC[cd * DM + k] * w[i]; }
#pragma unroll
        for (int cd = 0; cd < 5; ++cd)
#pragma unroll
            for (int e = 0; e < 4; ++e) { float v = acc[cd][e]; v += SWZ_XOR(v, 8); v += SWZ_XOR(v, 16); v = add_xor32(v); acc[cd][e] = v; }
        if (rsub == 0) {
#pragma unroll
            for (int cd = 0; cd < 5; ++cd) *(LAS f32x4*)(RED + (F.wave * 5 + cd) * 32 + 4 * cg) = acc[cd]; }
        __syncthreads();
        if (F.tid < 160) { const int cd = F.tid >> 5, col = F.tid & 31; float s = 0.f;
#pragma unroll
            for (int w = 0; w < 8; ++w) s += RED[(w * 5 + cd) * 32 + col];
            MOD[((size_t)layer * 5 + cd) * 12288 + c0 + col] = s + F.in[I_ADAB][layer * 12288 + c0 + col]; }
        __syncthreads();
    }
}
__device__ __forceinline__ ConvItem conv_decode(Frame& F, int L, int part, int it) {
    constexpr int I_WIN = 32 * 57, I_WKV = 8 * 32, I_WOUT = 32 * 32, I_CWI = 32 * 64, I_FGU = 32 * 88;
    const int j = L >> 1; const bool attn = (L & 1) == 0;
    const float* W; bf16* WT; int K, N, r, gu = -1;
    if (part) { const int m = it / I_FGU; r = it % I_FGU;
        if (m < 2) { gu = m; K = DM; N = FF; W = (gu ? F.in[I_FU] : F.in[I_FG]) + (size_t)L * DM * FF; WT = (bf16*)(F.ws + WS_FGU) + (size_t)L * 2 * FF * DM; }
        else { K = FF; N = DM; W = F.in[I_FD] + (size_t)L * FF * DM; WT = (bf16*)(F.ws + WS_FD) + (size_t)L * DM * FF; } }
    else if (attn) {
        if (it < I_WIN) { r = it; K = DM; N = AIN; W = F.in[I_AWIN] + (size_t)j * DM * AIN; WT = (bf16*)(F.ws + WS_WIN) + (size_t)j * ZW * DM; }
        else if (it < I_WIN + I_WKV) { r = it - I_WIN; K = 512; N = 2048; W = F.in[I_AWKV] + (size_t)j * 512 * 2048; WT = (bf16*)(F.ws + WS_WKV) + (size_t)j * 2048 * 512; }
        else { r = it - I_WIN - I_WKV; K = DM; N = DM; W = F.in[I_AWOUT] + (size_t)j * DM * DM; WT = (bf16*)(F.ws + WS_WOUT) + (size_t)j * DM * DM; } }
    else {
        if (it < I_CWI) { r = it; K = DM; N = 4096; W = F.in[I_CWIN] + (size_t)j * DM * 4096; WT = (bf16*)(F.ws + WS_CWIN) + (size_t)j * 4096 * DM; }
        else { r = it - I_CWI; K = DM; N = DM; W = F.in[I_CWOUT] + (size_t)j * DM * DM; WT = (bf16*)(F.ws + WS_CWOUT) + (size_t)j * DM * DM; } }
    const int nblk = N / 64, kb = r / nblk, nb = r % nblk, n0 = 64 * nb;
    const int drow0 = (gu < 0) ? n0 : ((n0 >> 7) * 256 + gu * 128 + (n0 & 127));
    return ConvItem{W, WT, K, N, 64 * kb, n0, drow0};
}
__device__ __forceinline__ void conv_items(Frame& F, int L, int part, int widx, int nw, int it_lo = 0, int it_hi = 0x7fffffff) {
    LAS float* scr = (LAS float*)(F.lds + F.wave * 16640);
    constexpr int I_WIN = 32 * 57, I_WKV = 8 * 32, I_WOUT = 32 * 32, I_CWI = 32 * 64, I_FGU = 32 * 88;
    const bool attn = (L & 1) == 0;
    const int count_ = part ? 3 * I_FGU : (attn ? I_WIN + I_WKV + I_WOUT : I_CWI + I_WOUT), count = count_ < it_hi ? count_ : it_hi;
    f32x4 va[16], vb[16]; ConvItem ca, cb;
    int it = it_lo + widx;
    if (it < count) { ca = conv_decode(F, L, part, it); conv_issue(ca, va, F.lane); }
    while (it < count) {
        const int itb = it + nw; const bool hb = itb < count;
        if (hb) { cb = conv_decode(F, L, part, itb); conv_issue(cb, vb, F.lane); }
        conv_finish(ca, va, scr, F.lane);
        it = itb + nw;
        if (it < count) { ca = conv_decode(F, L, part, it); conv_issue(ca, va, F.lane); }
        if (hb) conv_finish(cb, vb, scr, F.lane);
    }
}
__device__ __forceinline__ void tail_slot(Frame& F, int first_idle, int& widx, int& nwg) {
    const int fi = (first_idle > 0 && first_idle < F.G) ? first_idle : 0; widx = F.bid - fi; nwg = F.G - fi;
}
#ifndef P0_DEFER8
#define P0_DEFER8 0
#endif
constexpr int P0_FFN_ITEMS = (3 * 32 * 88) * (8 - P0_DEFER8) / 8;
#ifndef SPAT_MRU
#define SPAT_MRU 0
#endif
#ifndef TAIL_CONV
#define TAIL_CONV 1
#endif
__device__ __forceinline__ void p0_prologue(Frame& F) {
    FRAME_REFRESH(F);
    for (int layer = 0; layer < (TAIL_CONV ? 1 : NLAYER); ++layer) ada_layer(F, layer, 0, 384, F.bid, F.G);
    if (F.bid == F.G - 1) {
        float* T128 = (float*)(F.ws + WS_TAB); float* T64 = (float*)(F.ws + WS_TAB + 16384);
        for (int e = F.tid; e < 64 * 32 + 64 * 16; e += NTHREADS) {
            float co, si;
            if (e < 2048) { rope_entry(e >> 5, e & 31, 0.74989420933245582730, co, si); T128[2 * e] = co; T128[2 * e + 1] = si; }
            else { const int f = e - 2048; rope_entry(f >> 4, f & 15, 0.56234132519034908039, co, si); T64[2 * f] = co; T64[2 * f + 1] = si; }
        }
    }
    { const size_t n16 = (size_t)(ZW - AIN) * DM * 2 / 16;
      for (size_t i = (size_t)F.bid * NTHREADS + F.tid; i < 2 * n16; i += (size_t)F.G * NTHREADS) { const size_t l = i / n16, r = i % n16;
          *(GAS v4u*)(F.ws + WS_WIN + l * ((size_t)ZW * DM * 2) + (size_t)AIN * DM * 2 + r * 16) = (v4u){0u, 0u, 0u, 0u}; } }
    __syncthreads();
    const int gw = F.bid * NWAVES + F.wave, NGW = F.G * NWAVES;
    for (int L = 0; L < (TAIL_CONV ? 1 : NLAYER); ++L) { conv_items(F, L, 0, gw, NGW); conv_items(F, L, 1, gw, NGW, 0, (L == 0 && TAIL_CONV) ? P0_FFN_ITEMS : 0x7fffffff); }
}

__device__ __forceinline__ void unpack8(const v4u w, float (&x)[8]) { x[0] = bf_lo(w.x); x[1] = bf_hi(w.x); x[2] = bf_lo(w.y); x[3] = bf_hi(w.y); x[4] = bf_lo(w.z); x[5] = bf_hi(w.z); x[6] = bf_lo(w.w); x[7] = bf_hi(w.w); }
__device__ __forceinline__ void mod0_phase(Frame& F, const float* x_lo, const float* x_hi, const float* gain, const float* modl  ) {
    bf16* H = (bf16*)(F.ws + WS_H); float* SSX = (float*)(F.ws + WS_SSX);
    const int gw = F.bid * NWAVES + F.wave, NGW = F.G * NWAVES;
    LAS float* GS = (LAS float*)F.lds;
    __syncthreads();
    for (int i = F.tid; i < 5 * DM / 4; i += NTHREADS) { const int cd = i >> 9, c4 = i & 511; const f32x4 g = ((const GAS f32x4*)gain)[c4], a = ((const GAS f32x4*)(modl + (size_t)cd * 12288 + DM))[c4];
        ((LAS f32x4*)GS)[i] = g * (1.0f + a); }
    __syncthreads();
#define MOD0_ROW(m_) (((m_) < NP) ? x_lo + (size_t)(m_) * DM : x_hi + (size_t)((m_) - NP) * DM)
    f32x4 v[8]; int m = gw;
    if (m < MT) { const float* xr = MOD0_ROW(m);
#pragma unroll
        for (int j = 0; j < 8; ++j) v[j] = ((const GAS f32x4*)xr)[F.lane + 64 * j]; }
    for (; m < MT; m += NGW) {
        const int mn = m + NGW; f32x4 vn[8];
        if (mn < MT) { const float* xn = MOD0_ROW(mn);
#pragma unroll
            for (int j = 0; j < 8; ++j) vn[j] = ((const GAS f32x4*)xn)[F.lane + 64 * j]; }
        const int cd = (m < NP) ? 0 : 1 + ((m - NP) >> 12);
        float s = 0.f;
#pragma unroll
        for (int j = 0; j < 8; ++j) s += (v[j].x * v[j].x + v[j].y * v[j].y) + (v[j].z * v[j].z + v[j].w * v[j].w);
        s = wave_sum(s);
        if (F.lane < 32) SSX[(size_t)m * 32 + F.lane] = F.lane == 0 ? s : 0.f;
        GAS v2u* o8 = (GAS v2u*)(H + (size_t)m * DM) + F.lane;
#pragma unroll
        for (int j = 0; j < 8; ++j) { const f32x4 y = v[j] * ((LAS f32x4*)GS)[cd * 512 + F.lane + 64 * j];
            v2u w; w.x = pk2(y.x, y.y); w.y = pk2(y.z, y.w); o8[64 * j] = w; }
#pragma unroll
        for (int j = 0; j < 8; ++j) v[j] = vn[j];
    }
#undef MOD0_ROW
}
__device__ __forceinline__ void bias_rows(Frame& F, const bf16* Bt, int nrows, const float* sh  , float* out, int ldb, int widx, int nw) {
    LAS float* SH = (LAS float*)F.lds;
    __syncthreads();
    for (int idx = F.tid; idx < 5 * DM; idx += NTHREADS) SH[idx] = sh[(size_t)(idx >> 11) * 12288 + (idx & 2047)];
    __syncthreads();
    v4u wn[4];
    if (widx < nrows) { const GAS v4u* bp = (const GAS v4u*)(Bt + (size_t)widx * DM) + F.lane;
#pragma unroll
        for (int i = 0; i < 4; ++i) wn[i] = bp[64 * i]; }
    for (int n = widx; n < nrows; n += nw) {
        v4u w[4];
#pragma unroll
        for (int i = 0; i < 4; ++i) w[i] = wn[i];
        if (n + nw < nrows) { const GAS v4u* bp = (const GAS v4u*)(Bt + (size_t)(n + nw) * DM) + F.lane;
#pragma unroll
            for (int i = 0; i < 4; ++i) wn[i] = bp[64 * i]; }
        float acc[5] = {0.f, 0.f, 0.f, 0.f, 0.f};
#pragma unroll
        for (int i = 0; i < 4; ++i) { float x[8]; unpack8(w[i], x);
#pragma unroll
            for (int cd = 0; cd < 5; ++cd) { const LAS f32x4* sp = (const LAS f32x4*)(SH + cd * DM + 8 * F.lane + 512 * i); const f32x4 a = sp[0], b = sp[1];
                acc[cd] += (x[0] * a.x + x[1] * a.y) + (x[2] * a.z + x[3] * a.w) + (x[4] * b.x + x[5] * b.y) + (x[6] * b.z + x[7] * b.w); } }
#pragma unroll
        for (int cd = 0; cd < 5; ++cd) { const float s = wave_sum(acc[cd]); if (F.lane == 0) out[(size_t)cd * ldb + n] = s; }
    }
    __syncthreads();
}
__device__ __forceinline__ void final_row(Frame& F, int m) {
    const bf16* HB = (const bf16*)(F.ws + WS_H); const float* SSX = (const float*)(F.ws + WS_SSX);
    const GAS v4u* xr = (const GAS v4u*)(HB + (size_t)m * DM); GAS f32x4* yr = (GAS f32x4*)(F.out + (size_t)m * DM);
    v4u w[4];
#pragma unroll
    for (int j = 0; j < 4; ++j) w[j] = xr[F.lane + 64 * j];
    float s = SSX[(size_t)m * 32 + (F.lane & 31)]; s += SWZ_XOR(s, 1); s += SWZ_XOR(s, 2); s += SWZ_XOR(s, 4); s += SWZ_XOR(s, 8); s += SWZ_XOR(s, 16);
    const float rstd = 1.0f / sqrtf(s * (1.0f / DM) + EPS);
#pragma unroll
    for (int j = 0; j < 4; ++j) { float v[8]; unpack8(w[j], v);
        yr[2 * (F.lane + 64 * j)] = (f32x4){v[0], v[1], v[2], v[3]} * rstd; yr[2 * (F.lane + 64 * j) + 1] = (f32x4){v[4], v[5], v[6], v[7]} * rstd; }
}
__device__ __forceinline__ void final_phase(Frame& F) {
    FRAME_REFRESH(F);
    const int gw = F.bid * NWAVES + F.wave, NGW = F.G * NWAVES;
    for (int m = gw; m < MT; m += NGW) final_row(F, m);
}

__device__ __forceinline__ void head_norm_rope16(float (&x)[16], int s, const float* gain128, bool rope, int prow, int pcol, const float* T128) {
    float ss = 0.f;
#pragma unroll
    for (int e = 0; e < 16; ++e) ss += x[e] * x[e];
    ss += SWZ_XOR(ss, 1); ss += SWZ_XOR(ss, 2); ss += SWZ_XOR(ss, 4);
    const float rstd = 1.0f / sqrtf(ss * (1.0f / 128.0f) + EPS);
#pragma unroll
    for (int e = 0; e < 16; ++e) x[e] = x[e] * rstd * gain128[16 * s + e];
    if (rope) {
        const int pos = (s >> 2) ? pcol : prow; const bool second = (s >> 1) & 1; const float* t = T128 + ((size_t)pos * 32 + 16 * (s & 1)) * 2;
#pragma unroll
        for (int e = 0; e < 16; ++e) { const float xp = SWZ_XOR(x[e], 2); const float co = t[2 * e], si = t[2 * e + 1];
            x[e] = x[e] * co + (second ? xp * si : -xp * si); }
    }
}
__device__ __forceinline__ void rope8(float (&x)[8], int s, int prow, int pcol, const float* T64) {
    const int pos = (s >> 2) ? pcol : prow; const bool second = (s >> 1) & 1; const float* t = T64 + ((size_t)pos * 16 + 8 * (s & 1)) * 2;
#pragma unroll
    for (int e = 0; e < 8; ++e) { const float xp = SWZ_XOR(x[e], 2); const float co = t[2 * e], si = t[2 * e + 1];
        x[e] = x[e] * co + (second ? xp * si : -xp * si); }
}
__device__ __forceinline__ v4u pack8(const float* x) { v4u w; w.x = pk2(x[0], x[1]); w.y = pk2(x[2], x[3]); w.z = pk2(x[4], x[5]); w.w = pk2(x[6], x[7]); return w; }
__device__ __forceinline__ void post_phase(Frame& F, int j, bool dry = false) {
    FRAME_REFRESH(F);
    bf16* Z = (bf16*)(F.ws + WS_Z); bf16* KA = (bf16*)(F.ws + WS_KA); bf16* VA = (bf16*)(F.ws + WS_VA); bf16* CKV = (bf16*)(F.ws + WS_CKV); bf16* KR = (bf16*)(F.ws + WS_KR);
    const float* T128 = (const float*)(F.ws + WS_TAB); const float* T64 = (const float*)(F.ws + WS_TAB + 16384);
    const float* qn = F.in[I_AQN] + j * 128; const float* kn = F.in[I_AKN] + j * 128; const float* kvn = F.in[I_AKVN] + j * 512;
    const int gw = F.bid * NWAVES + F.wave, NGW = F.G * NWAVES, lane = F.lane, s = lane & 7;
    for (int m = MT + gw; m < MT + 4 * PAST; m += NGW) {
            const int ci = m - MT, b = ci >> 9, p = ci & 511; const size_t krow = (size_t)NP + (size_t)b * KEYS_S + SEQ_S + p; const size_t src = ((size_t)(b * 2 + j) * PAST + p);
            { const f32x4 a = ((const GAS f32x4*)(F.in[I_CK] + src * 256))[lane]; v2u w; w.x = pk2(a.x, a.y); w.y = pk2(a.z, a.w); ((GAS v2u*)(KA + krow * 256))[lane] = w; }
            { const f32x4 a = ((const GAS f32x4*)(F.in[I_CV] + src * 256))[lane]; v2u w; w.x = pk2(a.x, a.y); w.y = pk2(a.z, a.w); ((GAS v2u*)(VA + krow * 256))[lane] = w; }
            { const f32x4 a = ((const GAS f32x4*)(F.in[I_CCKV] + src * 512))[2 * lane], c = ((const GAS f32x4*)(F.in[I_CCKV] + src * 512))[2 * lane + 1];
              v4u w; w.x = pk2(a.x, a.y); w.y = pk2(a.z, a.w); w.z = pk2(c.x, c.y); w.w = pk2(c.z, c.w); ((GAS v4u*)(CKV + krow * 512))[lane] = w; }
            if (lane < 16) { const f32x4 a = ((const GAS f32x4*)(F.in[I_CKR] + src * 64))[lane]; v2u w; w.x = pk2(a.x, a.y); w.y = pk2(a.z, a.w); ((GAS v2u*)(KR + krow * 64))[lane] = w; }
    }
    v4u nk0, nk1, nvv, ncw, nrw;
#define POST_LOAD(mm) do { const bf16* z_ = Z + (size_t)(mm) * ZW; \
        nk0 = ((const GAS v4u*)(z_ + ZC_KA))[2 * (lane & 15)]; nk1 = ((const GAS v4u*)(z_ + ZC_KA))[2 * (lane & 15) + 1]; \
        nvv = ((const GAS v4u*)(z_ + ZC_VA))[lane & 31]; \
        ncw = ((const GAS v4u*)(z_ + ZC_CKV))[lane]; nrw = ((const GAS v4u*)(z_ + ZC_KR))[s]; } while (0)
    if (gw < MT) POST_LOAD(gw);
    for (int m = gw; m < MT; m += NGW) {
        const bool lat = m >= NP; const int t = (m - NP) & 4095, prow = t >> 6, pcol = t & 63;
        const size_t krow = lat ? (size_t)NP + (size_t)((m - NP) >> 12) * KEYS_S + t : (size_t)m;
        bf16* zr = Z + (size_t)m * ZW;
        const v4u k0 = nk0, k1 = nk1, vv = nvv, cw = ncw, rw = nrw;
        if (m + NGW < MT) POST_LOAD(m + NGW);
        { float x[16]; float xa[8], xb[8]; unpack8(k0, xa); unpack8(k1, xb);
#pragma unroll
          for (int e = 0; e < 8; ++e) { x[e] = xa[e]; x[8 + e] = xb[e]; }
          head_norm_rope16(x, s, kn, false, 0, 0, T128);
          if (!lat && lane < 16) { float* so = F.out + OUT_SK + ((size_t)((m >> 8) * 2 + j) * SEQ_P + (m & 255)) * 256 + 16 * lane;
#pragma unroll
              for (int e = 0; e < 4; ++e) ((GAS f32x4*)so)[e] = (f32x4){x[4 * e], x[4 * e + 1], x[4 * e + 2], x[4 * e + 3]}; }
          if (lat) { const int pos = (s >> 2) ? pcol : prow; const bool second = (s >> 1) & 1; const float* tt = T128 + ((size_t)pos * 32 + 16 * (s & 1)) * 2;
#pragma unroll
              for (int e = 0; e < 16; ++e) { const float xp = SWZ_XOR(x[e], 2); x[e] = x[e] * tt[2 * e] + (second ? xp * tt[2 * e + 1] : -xp * tt[2 * e + 1]); } }
          if (lane < 16) { ((GAS v4u*)(KA + krow * 256))[2 * lane] = pack8(x); ((GAS v4u*)(KA + krow * 256))[2 * lane + 1] = pack8(x + 8); } }
        if (lane < 32) { ((GAS v4u*)(VA + krow * 256))[lane] = vv;
            if (!lat) { float x[8]; unpack8(vv, x); float* so = F.out + OUT_SV + ((size_t)((m >> 8) * 2 + j) * SEQ_P + (m & 255)) * 256 + 8 * lane;
                ((GAS f32x4*)so)[0] = (f32x4){x[0], x[1], x[2], x[3]}; ((GAS f32x4*)so)[1] = (f32x4){x[4], x[5], x[6], x[7]}; } }
        { float x[8]; unpack8(cw, x); float ss = 0.f;
#pragma unroll
          for (int e = 0; e < 8; ++e) ss += x[e] * x[e];
          const float rstd = 1.0f / sqrtf(wave_sum(ss) * (1.0f / 512.0f) + EPS);
#pragma unroll
          for (int e = 0; e < 8; ++e) x[e] = x[e] * rstd * kvn[8 * lane + e];
          ((GAS v4u*)(CKV + krow * 512))[lane] = pack8(x);
          if (!lat) { float* so = F.out + OUT_SCKV + ((size_t)((m >> 8) * 2 + j) * SEQ_P + (m & 255)) * 512 + 8 * lane;
              ((GAS f32x4*)so)[0] = (f32x4){x[0], x[1], x[2], x[3]}; ((GAS f32x4*)so)[1] = (f32x4){x[4], x[5], x[6], x[7]}; } }
        { float x[8]; unpack8(rw, x);
          if (!lat && lane < 8) { float* so = F.out + OUT_SKR + ((size_t)((m >> 8) * 2 + j) * SEQ_P + (m & 255)) * 64 + 8 * lane;
              ((GAS f32x4*)so)[0] = (f32x4){x[0], x[1], x[2], x[3]}; ((GAS f32x4*)so)[1] = (f32x4){x[4], x[5], x[6], x[7]}; }
          if (lat) rope8(x, s, prow, pcol, T64);
          if (lane < 8) ((GAS v4u*)(KR + krow * 64))[lane] = pack8(x); }
    }
}

#ifndef ATT_DMA
#define ATT_DMA 0
#endif
#ifndef ATT_MLA_SD
#define ATT_MLA_SD 1
#endif
#ifndef ATT_MLA_NQR
#define ATT_MLA_NQR 6
#endif
#ifndef EN_ATT_GQA
#define EN_ATT_GQA 1
#endif
#ifndef EN_ATT_MLA
#define EN_ATT_MLA 1
#endif
#undef POST_LOAD
constexpr int BIAS_LDS_OFF = RING_BYTES, BIAS_LDS_UNITS = 14;
static_assert(BIAS_LDS_OFF + BIAS_LDS_UNITS * 1024 <= MISC_OFF, "bias table vs the LDS map");
__device__ __forceinline__ void bias_to_lds(Frame& F, const pg8::StaticOrder& S, const float* bias, int ldb) {
    LAS float* tb = (LAS float*)(F.lds + BIAS_LDS_OFF);
    __syncthreads();
    const int half = F.tid >> 8, t = F.tid & 255; pg8::Unit u;
#pragma unroll
    for (int i0 = 0; i0 < BIAS_LDS_UNITS; i0 += 2) { const int i = i0 + half; if (S.next(i, u)) tb[i * 256 + t] = bias[(size_t)pg8::cond_of_pm(u.pm) * ldb + u.pn * 256 + t]; }
    __syncthreads();
}
constexpr int RES_LDS_UNITS = 4;
static_assert(BIAS_LDS_OFF + RES_LDS_UNITS * 3072 <= MISC_OFF, "residual tables vs the LDS map");
__device__ __forceinline__ void res_tables_to_lds(Frame& F, const pg8::StaticOrder& S, const float* gate, const float* gnorm, const float* scale, const float* pnorm, const float* pscale) {
    LAS float* tb = (LAS float*)(F.lds + BIAS_LDS_OFF);
    __syncthreads();
    const int half = F.tid >> 8, t = F.tid & 255; pg8::Unit u;
#pragma unroll
    for (int i0 = 0; i0 < RES_LDS_UNITS; i0 += 2) { const int i = i0 + half;
        if (S.next(i, u)) { const int cd = pg8::cond_of_pm(u.pm), col = u.pn * 256 + t;
            tb[i * 768 + t] = gate[(size_t)cd * 12288 + col];
            tb[i * 768 + 256 + t] = gnorm[col] * (scale ? 1.0f + scale[(size_t)cd * 12288 + col] : 1.0f);
            const float tp = pnorm[col] * (1.0f + pscale[(size_t)cd * 12288 + col]); tb[i * 768 + 512 + t] = tp != 0.f ? 1.0f / tp : 0.f; } }
    __syncthreads();
}
static_assert(2 * 16384 + 2 * 64 * 192 * 2 + 2048 + 8 * (12 - ATT_MLA_NQR) * 1024 <= MISC_OFF, "attention LDS use vs the LDS map");
static_assert(384 * 272 + 1024 <= MISC_OFF && 8 * 16640 <= MISC_OFF, "phase scratch vs the LDS map");
#if ATT_DMA
#ifndef ATT_DMA_NQR
#define ATT_DMA_NQR 10
#endif
#error the LDS-DMA attention variant does not carry the fused Q-side norm/rope
#define ATT_GQA_UNIT(QM) att::attn_unit_dma<128, ZW, 256, 256, DM, 8>
#define ATT_MLA_UNIT(QM) att::attn_unit_dma<192, ZW, DM, DM, DM, ATT_DMA_NQR>
#define ATT_LDSL , F.lds
static_assert(3 * (64 * 192 * 2 + 16384) + 2048 + 8 * (12 - ATT_DMA_NQR) * 1024 <= MISC_OFF, "attention ring vs the LDS map");
#else
#ifndef ATT16
#define ATT16 0
#endif
#ifndef ATT16_GSD
#define ATT16_GSD 2
#endif
#ifndef ATT16_GNQR
#define ATT16_GNQR 8
#endif
#if ATT16 & 1
#define ATT_GQA_UNIT(QM) att::attn_unit16<128, ZW, 256, 256, DM, ATT16_GSD, ATT16_GNQR, QM>
#else
#define ATT_GQA_UNIT(QM) att::attn_unit<128, ZW, 256, 256, DM, 2, 8, QM>
#endif
#if ATT16 & 2
#define ATT_MLA_UNIT(QM) att::attn_unit16<192, ZW, DM, DM, DM, ATT_MLA_SD, ATT_MLA_NQR, QM>
#else
#define ATT_MLA_UNIT(QM) att::attn_unit<192, ZW, DM, DM, DM, ATT_MLA_SD, ATT_MLA_NQR, QM>
#endif
#define ATT_LDSL
#endif
__device__ __forceinline__ void attn_phase(Frame& F, int j) {
    const float* qn = F.in[I_AQN] + j * 128; const float* T128 = (const float*)(F.ws + WS_TAB); const float* T64 = (const float*)(F.ws + WS_TAB + 16384);
    const bf16* Z = (const bf16*)(F.ws + WS_Z); const bf16* KA = (const bf16*)(F.ws + WS_KA); const bf16* VA = (const bf16*)(F.ws + WS_VA);
    const bf16* KR = (const bf16*)(F.ws + WS_KR); const bf16* KVB = (const bf16*)(F.ws + WS_KVB); bf16* O = (bf16*)(F.ws + WS_O);
#if EN_ATT_GQA
    for (int L = F.bid; L < 512; L += F.G) {
        const int x = L & 7, s = L >> 3, b = x >> 1, kvh = x & 1, h = kvh * 4 + (s >> 4), qb = s & 15;
        const size_t qrow = (size_t)NP + (size_t)b * SEQ_S + qb * 256, krow = (size_t)NP + (size_t)b * KEYS_S;
        ATT_GQA_UNIT(2)(Z + qrow * ZW + ZC_QA + h * 128, KA + krow * 256 + kvh * 128, nullptr, VA + krow * 256 + kvh * 128, O + qrow * DM + h * 128, KEYS_S, F.ldsg ATT_LDSL, qn, T128, qb * 256);
    }
#endif
#if EN_ATT_MLA
    for (int L = F.bid; L < 512; L += F.G) {
        const int x = L & 7, s = L >> 3, b = x >> 1, h = (x & 1) * 4 + (s >> 4), qb = s & 15;
        const size_t qrow = (size_t)NP + (size_t)b * SEQ_S + qb * 256, krow = (size_t)NP + (size_t)b * KEYS_S;
        ATT_MLA_UNIT(3)(Z + qrow * ZW + ZC_QB + h * 192, KVB + krow * DM + h * 256, KR + krow * 64, KVB + krow * DM + h * 256 + 128, O + qrow * DM + 1024 + h * 128, KEYS_S, F.ldsg ATT_LDSL, nullptr, T64, qb * 256);
    }
#endif
#if EN_ATT_GQA
    for (int L = F.bid; L < 128; L += F.G) {
        const int b = L >> 3, h = L & 7, kvh = h >> 2; const size_t row = (size_t)b * SEQ_P;
        ATT_GQA_UNIT(1)(Z + row * ZW + ZC_QA + h * 128, KA + row * 256 + kvh * 128, nullptr, VA + row * 256 + kvh * 128, O + row * DM + h * 128, SEQ_P, F.ldsg ATT_LDSL, qn, nullptr, 0);
    }
#endif
#if EN_ATT_MLA
    for (int L2 = F.bid; L2 < 256; L2 += F.G) { if (L2 < 128 && F.G > 128) continue; const int L = L2 & 127;
        const int b = L >> 3, h = L & 7; const size_t row = (size_t)b * SEQ_P;
        ATT_MLA_UNIT(0)(Z + row * ZW + ZC_QB + h * 192, KVB + row * DM + h * 256, KR + row * 64, KVB + row * DM + h * 256 + 128, O + row * DM + 1024 + h * 128, SEQ_P, F.ldsg ATT_LDSL, nullptr, nullptr, 0);
    }
#endif
    __syncthreads();
}

__device__ __forceinline__ void spatial_phase(Frame& F, int j) {
    FRAME_REFRESH(F);
    const bf16* U = (const bf16*)(F.ws + WS_U); const bf16* V = (const bf16*)(F.ws + WS_V); bf16* MC = (bf16*)(F.ws + WS_MC); const float* SS = (const float*)(F.ws + WS_SS);
    const float* Ws = F.in[I_CWS] + (size_t)j * 8 * 128 * 128; const float* bs = F.in[I_CBS] + j * 8 * 128; const float* gn = F.in[I_CVN] + j * DM;
    constexpr int RSB = 272, UTB = 528;
    LAS unsigned char* As = F.lds; LAS unsigned char* Vt = F.lds + 128 * RSB; LAS float* RS = (LAS float*)(F.lds + 384 * RSB); LAS float* BS = RS + 128; LAS unsigned char* UT = Vt;
    static_assert(128 * UTB <= 256 * RSB, "UT overlays Vt");
    const int tid0 = F.tid, wr = F.wave >> 2, wc = F.wave & 3;
    v4u vr[8], ur[8]; f32x4 ssa, ssb; int g_built = -1;
#define SPAT_ITEM(it_, n_, g_) const int g_ = (it_) & 7; int n_ = (it_) >> 3; \
        if (SPAT_MRU && F.G == 256) { const int r_ = (it_) >> 8, q_ = ((it_) >> 3) & 31, off_ = r_ == 0 ? 16 : r_ == 1 ? 4 : r_ == 2 ? 12 : r_ == 3 ? 8 : 0; n_ = 2 * (20 * (q_ >> 3) + off_ + ((q_ >> 1) & 3)) + (q_ & 1); }
#define SPAT_LOADS(it_) do { SPAT_ITEM(it_, nn_, gg_); const int rr0_ = nn_ * 128; int tid = tid0; asm volatile("" : "+v"(tid)); \
        { const GAS f32x4* sp = (const GAS f32x4*)(SS + (size_t)rr0_ * 32) + 2 * tid; ssa = sp[0]; ssb = sp[1]; }     \
        _Pragma("unroll") for (int i = 0; i < 8; ++i) { const int idx = tid + NTHREADS * i, q = idx >> 5, c8 = (idx & 31) * 8; vr[i] = *(const GAS v4u*)(V + (size_t)(rr0_ + q) * DM + gg_ * 256 + c8); } } while (0)
    if (F.bid < 160 * 8) SPAT_LOADS(F.bid);
    for (int it = F.bid; it < 160 * 8; it += F.G) {
        SPAT_ITEM(it, n, g); const int r0 = n * 128;
        int tid = tid0; asm volatile("" : "+v"(tid)); const int lane = tid & 63, r32 = lane & 31, hi = lane >> 5;
        __syncthreads();
        { float s = ((ssa.x + ssa.y) + (ssa.z + ssa.w)) + ((ssb.x + ssb.y) + (ssb.z + ssb.w)); s += SWZ_XOR(s, 1); s += SWZ_XOR(s, 2);
          if ((tid & 3) == 0) RS[tid >> 2] = 1.0f / sqrtf(s * (1.0f / 2048.0f) + EPS); }
        if (g != g_built) { g_built = g;
            if (tid < 128) BS[tid] = bs[g * 128 + tid];
#pragma unroll
            for (int i = 0; i < 8; ++i) { const int idx = tid + NTHREADS * i, p = idx >> 5, q4 = (idx & 31) * 4; const f32x4 w = *(const GAS f32x4*)(Ws + (size_t)g * 16384 + p * 128 + q4);
                v2u o; o.x = pk2(w.x, w.y); o.y = pk2(w.z, w.w); *(LAS v2u*)(As + p * RSB + q4 * 2) = o; } }
#pragma unroll
        for (int i = 0; i < 8; ++i) { const int idx = tid + NTHREADS * i, p = idx >> 5, c8 = (idx & 31) * 8; ur[i] = *(const GAS v4u*)(U + (size_t)(r0 + p) * DM + g * 256 + c8); }
        __syncthreads();
#pragma unroll
        for (int i = 0; i < 8; ++i) { const int idx = tid + NTHREADS * i, q = idx >> 5, cb = idx & 31; const v4u w = vr[i]; const float rs = RS[q];
            const unsigned w0 = pk2(bf_lo(w.x) * rs, bf_hi(w.x) * rs), w1 = pk2(bf_lo(w.y) * rs, bf_hi(w.y) * rs), w2 = pk2(bf_lo(w.z) * rs, bf_hi(w.z) * rs), w3 = pk2(bf_lo(w.w) * rs, bf_hi(w.w) * rs);
            LAS unsigned short* d = (LAS unsigned short*)(Vt + (cb * 8) * RSB + ((((q >> 3) ^ (cb & 15)) << 4) | ((q & 7) * 2)));
            d[0 * (RSB / 2)] = (unsigned short)(w0 & 0xffffu); d[1 * (RSB / 2)] = (unsigned short)(w0 >> 16); d[2 * (RSB / 2)] = (unsigned short)(w1 & 0xffffu); d[3 * (RSB / 2)] = (unsigned short)(w1 >> 16);
            d[4 * (RSB / 2)] = (unsigned short)(w2 & 0xffffu); d[5 * (RSB / 2)] = (unsigned short)(w2 >> 16); d[6 * (RSB / 2)] = (unsigned short)(w3 & 0xffffu); d[7 * (RSB / 2)] = (unsigned short)(w3 >> 16); }
        __syncthreads();
        f32x16 acc[2][2];
#pragma unroll
        for (int a = 0; a < 2; ++a)
#pragma unroll
            for (int b = 0; b < 2; ++b) acc[a][b] = (f32x16){};
#pragma unroll
        for (int ks = 0; ks < 8; ++ks) { bf16x8 af[2], bfr[2];
#pragma unroll
            for (int a = 0; a < 2; ++a) af[a] = *(LAS bf16x8*)(As + (64 * wr + 32 * a + r32) * RSB + (16 * ks + 8 * hi) * 2);
#pragma unroll
            for (int b = 0; b < 2; ++b) { const int c = 64 * wc + 32 * b + r32; bfr[b] = *(LAS bf16x8*)(Vt + c * RSB + (((2 * ks + hi) ^ ((c >> 3) & 15)) << 4)); }
#pragma unroll
            for (int a = 0; a < 2; ++a)
#pragma unroll
                for (int b = 0; b < 2; ++b) acc[a][b] = __builtin_amdgcn_mfma_f32_32x32x16_bf16(af[a], bfr[b], acc[a][b], 0, 0, 0); }
        __syncthreads();
#pragma unroll
        for (int i = 0; i < 8; ++i) { const int idx = tid + NTHREADS * i, p = idx >> 5, c8 = (idx & 31) * 8; *(LAS v4u*)(UT + p * UTB + c8 * 2) = ur[i]; }
        __syncthreads();
        if (it + F.G < 160 * 8) SPAT_LOADS(it + F.G);
#pragma unroll
        for (int b = 0; b < 2; ++b) { const int cl = 64 * wc + 32 * b + r32; const float gnc = gn[g * 256 + cl];
#pragma unroll
            for (int a = 0; a < 2; ++a)
#pragma unroll
                for (int r = 0; r < 16; ++r) { const int p = 64 * wr + 32 * a + (r & 3) + 8 * (r >> 2) + 4 * hi; LAS unsigned short* e = (LAS unsigned short*)(UT + p * UTB + cl * 2);
                    const float u = __uint_as_float(((unsigned)*e) << 16);
                    const unsigned w = pk2(u * (gnc * acc[a][b][r] + BS[p]), 0.f); *e = (unsigned short)(w & 0xffffu); } }
        __syncthreads();
#pragma unroll
        for (int i = 0; i < 8; ++i) { const int idx = tid + NTHREADS * i, p = idx >> 5, c8 = (idx & 31) * 8; *(GAS v4u*)(MC + (size_t)(r0 + p) * DM + g * 256 + c8) = *(LAS v4u*)(UT + p * UTB + c8 * 2); }
    }
#undef SPAT_ITEM
#undef SPAT_LOADS
}

#ifndef EN_DEFAULT
#define EN_DEFAULT 1
#endif
#ifndef EN_P0
#define EN_P0 EN_DEFAULT
#endif
#ifndef EN_MOD
#define EN_MOD EN_DEFAULT
#endif
#ifndef EN_G1
#define EN_G1 EN_DEFAULT
#endif
#ifndef EN_POST
#define EN_POST EN_DEFAULT
#endif
#ifndef EN_KVUP
#define EN_KVUP EN_DEFAULT
#endif
#ifndef EN_ATT
#define EN_ATT EN_DEFAULT
#endif
#ifndef EN_G4
#define EN_G4 EN_DEFAULT
#endif
#ifndef EN_SPAT
#define EN_SPAT EN_DEFAULT
#endif
#ifndef EN_OUT
#define EN_OUT EN_DEFAULT
#endif
#ifndef EN_FUP
#define EN_FUP EN_DEFAULT
#endif
#ifndef EN_FDN
#define EN_FDN EN_DEFAULT
#endif
#ifndef EN_FIN
#define EN_FIN EN_DEFAULT
#endif
#ifndef REP_POST
#define REP_POST 1
#endif
#ifndef REP_BAR
#define REP_BAR 1
#endif
#ifndef REP_P0
#define REP_P0 1
#endif
#ifndef REP_MOD
#define REP_MOD 1
#endif
#ifndef REP_G1
#define REP_G1 1
#endif
#ifndef REP_KVUP
#define REP_KVUP 1
#endif
#ifndef REP_ATT
#define REP_ATT 1
#endif
#ifndef REP_G4
#define REP_G4 1
#endif
#ifndef REP_SPAT
#define REP_SPAT 1
#endif
#ifndef REP_FUP
#define REP_FUP 1
#endif
#ifndef REP_OUT
#define REP_OUT 1
#endif
#ifndef REP_FDN
#define REP_FDN 1
#endif
#ifndef WGM_G1
#define WGM_G1 PG8_WGM
#endif
#ifndef WGM_KV
#define WGM_KV PG8_WGM
#endif
#ifndef WGM_G4
#define WGM_G4 PG8_WGM
#endif
#ifndef WGM_FUP
#define WGM_FUP PG8_WGM
#endif
#ifndef WGM_RES
#define WGM_RES PG8_WGM
#endif
#ifndef STAGGER_TICKS
#define STAGGER_TICKS 0
#endif
#define STAGGER(F) do { if (STAGGER_TICKS > 0) { const unsigned long long t0_ = __builtin_amdgcn_s_memrealtime(), d_ = (unsigned long long)(((F).bid >> 3) & 3) * STAGGER_TICKS; \
    while (__builtin_amdgcn_s_memrealtime() - t0_ < d_) __builtin_amdgcn_s_sleep(4); } } while (0)
#ifndef FDN_REV
#define FDN_REV 1
#endif
#ifndef G1_DEFER2
#define G1_DEFER2 1
#endif
#ifndef DEFER_DOWN3
#define DEFER_DOWN3 1
#endif
#ifndef DEFER2_8
#define DEFER2_8 P0_DEFER8
#endif
constexpr int P2_FFN_ITEMS = (3 * 32 * 88) * (8 - DEFER2_8) / 8;
#ifndef FDN_ALL_ITEMS
#define FDN_ALL_ITEMS 0
#endif
#ifndef FUP_ALIGN_EPI
#define FUP_ALIGN_EPI true
#endif
#ifndef G1_ALIGN_EPI
#define G1_ALIGN_EPI true
#endif
#ifndef G4_ALIGN_EPI
#define G4_ALIGN_EPI true
#endif
#ifndef KV_ALIGN_EPI
#define KV_ALIGN_EPI true
#endif
#ifndef ADA_FUP_ITEMS
#define ADA_FUP_ITEMS 128
#endif
#ifndef ADA_IN_FUP
#define ADA_IN_FUP 1
#endif
#ifndef EARLY_FIN
#define EARLY_FIN 1
#endif
constexpr int CW_RDY = 6144;
static_assert(CW_RDY >= CW_BAR + XCD_BAR_WORDS && (CW_RDY + 64 * 80) * 4 <= (int)CTL_ZERO_BYTES, "arrival counters vs the control block");
__device__ __forceinline__ void fdn_panel_lists(Frame& F, LAS unsigned* lst) {
    LAS unsigned* msk = lst + 60;
    __syncthreads();
    if (F.tid < 3) msk[F.tid] = 0u;
    __syncthreads();
    if (F.tid < F.G) { pg8::StaticOrder S; S.init(MT, DM, F.G, F.tid, WGM_RES, FDN_REV); pg8::Unit u; if (S.next(2, u)) (void)__hip_atomic_fetch_or(&msk[u.pm >> 5], 1u << (u.pm & 31), __ATOMIC_RELAXED, __HIP_MEMORY_SCOPE_WORKGROUP); }
    __syncthreads();
    if (F.tid == 0) { unsigned ne = 0, nl = 0; LAS unsigned char* eb = (LAS unsigned char*)lst + 16; LAS unsigned char* lb = (LAS unsigned char*)lst + 112;
        for (int pm = 0; pm < MT / 256; ++pm) { if ((msk[pm >> 5] >> (pm & 31)) & 1u) lb[nl++] = (unsigned char)pm; else eb[ne++] = (unsigned char)pm; }
        lst[0] = ne; lst[1] = nl; }
    __syncthreads();
}
#define EARLY_FIN_ON(F) (EARLY_FIN && (F).G == 256)
__device__ __forceinline__ void early_final(Frame& F, int widx) {
    LAS unsigned* lst = (LAS unsigned*)F.lds;
    fdn_panel_lists(F, lst);
    const int ne = (int)lst[0];
    if (widx < 2 * ne && widx < 128) {
        const int pm = ((LAS unsigned char*)lst)[16 + (widx >> 1)];
        if (F.tid < 64) { unsigned* arr = (unsigned*)(F.ws + WS_CTL) + CW_RDY; unsigned sp = 0;
            while ((unsigned)__builtin_amdgcn_readfirstlane(__hip_atomic_load(arr, __ATOMIC_RELAXED, __HIP_MEMORY_SCOPE_AGENT)) < (unsigned)F.G) { __builtin_amdgcn_s_sleep(4); if (++sp > (1u << 20)) break; }
            __builtin_amdgcn_fence(__ATOMIC_ACQUIRE, "agent"); asm volatile("s_waitcnt vmcnt(0)" ::: "memory"); }
        __syncthreads();
        for (int r = F.wave; r < 128; r += NWAVES) final_row(F, pm * 256 + (widx & 1) * 128 + r);
    }
}
__device__ __forceinline__ void final_phase_rest(Frame& F) {
    LAS unsigned* lst = (LAS unsigned*)F.lds;
    fdn_panel_lists(F, lst);
    const int ne = (int)lst[0], nl = (int)lst[1], nx = ne > 64 ? ne - 64 : 0, rows = (nl + nx) * 256;
    const int gw = F.bid * NWAVES + F.wave, NGW = F.G * NWAVES;
    for (int idx = gw; idx < rows; idx += NGW) { const int pi = idx >> 8; const int pm = pi < nl ? ((LAS unsigned char*)lst)[112 + pi] : ((LAS unsigned char*)lst)[16 + 64 + (pi - nl)];
        final_row(F, pm * 256 + (idx & 255)); }
}
constexpr int NPHASE = 38;
__global__ void __launch_bounds__(NTHREADS, 2) fwd(Args args) {
    extern __shared__ __attribute__((aligned(1024))) unsigned char lds[];
    Frame F;
    F.lds = (LAS unsigned char*)lds; F.ldsg = (char*)lds;
    F.in.ka = (KArgsPtr)__builtin_amdgcn_kernarg_segment_ptr();
    PHASE_BEGIN(F);
    const int lo = args.ph_lo, hi = args.ph_hi; const bool multi = (hi - lo) > 1;
    if (F.tid < 4) ((LAS unsigned*)(F.lds + MISC_OFF))[F.tid] = 0u;
    __syncthreads();
    if (multi) (void)xcd_barrier_post((unsigned*)(F.ws + WS_CTL) + CW_BAR, (volatile LAS unsigned*)(F.lds + MISC_OFF));
#define IN(k) (lo <= (k) && (k) < hi)
#ifndef CODE_WARM
#define CODE_WARM 0
#endif
#if CODE_WARM
    if (lo == 0) { const char* pc = (const char*)(__builtin_amdgcn_s_getpc() & ~0xFFull); unsigned acc = 0;
#pragma unroll 8
        for (int i = F.tid; i < 14848; i += NTHREADS) { const v4u w = *(const GAS v4u*)(pc + (size_t)i * 16); acc ^= (w.x ^ w.y) ^ (w.z ^ w.w); }
        if (acc == 0x9e3779b9u && F.tid == 12345) ((GAS unsigned*)(F.ws + WS_PROBE))[0] = acc; }
#endif
#define SEAM(k) do { if (multi && (k) + 1 < hi) { XcdBarrier b_; b_.bar = (unsigned*)(F.ws + WS_CTL) + CW_BAR; b_.x = xb_xcc_id(); b_.st = (volatile LAS unsigned*)(F.lds + MISC_OFF); for (int rb_ = 0; rb_ < REP_BAR; ++rb_) xcd_barrier(b_); } } while (0)

#define X (F.out)
#define H ((bf16*)(F.ws + WS_H))
#define LAYER_VARS() PHASE_BEGIN(F); int L = L_; asm volatile("" : "+s"(L)); const int j = L >> 1; const bool attn = (L & 1) == 0; const float* modl = (const float*)(F.ws + WS_MOD) + (size_t)L * 5 * 12288; (void)j; (void)attn; (void)modl

    #if EN_P0
    if (IN(0)) { PHASE_BEGIN(F); PROBE_STAMP(F, 0); for (int rep_ = 0; rep_ < REP_P0; ++rep_) { p0_prologue(F); __syncthreads(); } SEAM(0); }
#endif

    for (int L_ = 0; L_ < NLAYER; ++L_) {
        const int pb = 1 + 9 * L_; const bool attn_ = (L_ & 1) == 0;
#if EN_MOD
        if (L_ == 0 && IN(pb + 0)) { LAYER_VARS(); PROBE_STAMP(F, pb + 0);
            mod0_phase(F, F.in[I_XP], F.in[I_XS], F.in[I_NMIX], modl);
            const int gw = F.bid * NWAVES + F.wave, NGW = F.G * NWAVES;
            bias_rows(F, (const bf16*)(F.ws + WS_WIN), ZW, modl, (float*)(F.ws + WS_BIAS1), 4096, gw, NGW);
            if (P0_DEFER8 == 0) bias_rows(F, (const bf16*)(F.ws + WS_FGU), 2 * FF, modl + 3 * DM, (float*)(F.ws + WS_BIAS2), 2 * FF, gw, NGW);
            SEAM(pb + 0);
        }
#endif
        if (attn_) {
#if EN_G1
            if (IN(pb + 1)) { LAYER_VARS(); PROBE_STAMP(F, pb + 1);
                pg8::Gemm g{H, (const bf16*)(F.ws + WS_WIN) + (size_t)j * ZW * DM, MT, ZW, DM}; pg8::StaticOrder S; S.init(MT, ZW, F.G, F.bid, WGM_G1);
                pg8::EpiBf16Plain E{(bf16*)(F.ws + WS_Z), ZW, (const float*)(F.ws + WS_SSX), (const float*)(F.ws + WS_BIAS1) + (size_t)L * 5 * 4096, 4096, -1, (PG8_LAS const float*)(F.lds + BIAS_LDS_OFF), 0};
                if (P0_DEFER8 > 0 && (L == 0 || G1_DEFER2)) { int widx, nwg; tail_slot(F, 1200 - 4 * F.G, widx, nwg);
                    if (widx >= 0) conv_items(F, L, 1, widx * NWAVES + F.wave, nwg * NWAVES, L == 0 ? P0_FFN_ITEMS : P2_FFN_ITEMS); __syncthreads(); }
                bias_to_lds(F, S, E.bias, 4096);
                for (int rep_ = 0; rep_ < REP_G1; ++rep_) pg8::gemm_phase<pg8::EpiBf16Plain, pg8::StaticOrder, G1_ALIGN_EPI, true>(F.lds, g, S, E);
                SEAM(pb + 1);
            }
#endif
#if EN_POST
            if (IN(pb + 2)) { LAYER_VARS(); PROBE_STAMP(F, pb + 2); post_phase(F, j);
#if REP_POST > 1
              for (int rep_ = 1; rep_ < REP_POST; ++rep_) post_phase(F, j, true);
#endif
              SEAM(pb + 2); }
#endif
#if EN_KVUP
            if (IN(pb + 3)) { LAYER_VARS(); PROBE_STAMP(F, pb + 3);
                pg8::Gemm g{(const bf16*)(F.ws + WS_CKV), (const bf16*)(F.ws + WS_WKV) + (size_t)j * 2048 * 512, MK, 2048, 512}; pg8::StaticOrder S; S.init(MK, 2048, F.G, F.bid, WGM_KV);
                pg8::EpiBf16Plain E{(bf16*)(F.ws + WS_KVB), DM, nullptr, nullptr, 0, -1, nullptr, 0};
                for (int rep_ = 0; rep_ < REP_KVUP; ++rep_) pg8::gemm_phase<pg8::EpiBf16Plain, pg8::StaticOrder, KV_ALIGN_EPI, true>(F.lds, g, S, E);
                SEAM(pb + 3);
            }
#endif
#if EN_ATT
            if (IN(pb + 4)) { LAYER_VARS(); PROBE_STAMP(F, pb + 4); for (int rep_ = 0; rep_ < REP_ATT; ++rep_) attn_phase(F, j); SEAM(pb + 4); }
#endif
        } else {
#if EN_G4
            if (IN(pb + 1)) { LAYER_VARS(); PROBE_STAMP(F, pb + 1);
                pg8::Gemm g{H, (const bf16*)(F.ws + WS_CWIN) + (size_t)j * 4096 * DM, MT, 4096, DM}; pg8::StaticOrder S; S.init(MT, 4096, F.G, F.bid, WGM_G4);
                pg8::EpiGeluUV E{(bf16*)(F.ws + WS_U), (bf16*)(F.ws + WS_V), (float*)(F.ws + WS_SS), (const float*)(F.ws + WS_SSX), (const float*)(F.ws + WS_BIAS1) + (size_t)L * 5 * 4096, 4096, -1, (PG8_LAS const float*)(F.lds + BIAS_LDS_OFF), 0};
                bias_to_lds(F, S, E.bias, 4096);
                for (int rep_ = 0; rep_ < REP_G4; ++rep_) pg8::gemm_phase<pg8::EpiGeluUV, pg8::StaticOrder, G4_ALIGN_EPI, true>(F.lds, g, S, E);
                SEAM(pb + 1);
            }
#endif
#if EN_SPAT
            if (IN(pb + 2)) { LAYER_VARS(); PROBE_STAMP(F, pb + 2); for (int rep_ = 0; rep_ < REP_SPAT; ++rep_) spatial_phase(F, j); SEAM(pb + 2); }
#endif
        }
#if EN_OUT
        if (IN(pb + 5)) { LAYER_VARS(); PROBE_STAMP(F, pb + 5);
            const bf16* A = attn ? (const bf16*)(F.ws + WS_O) : (const bf16*)(F.ws + WS_MC);
            const bf16* Bt = (attn ? (const bf16*)(F.ws + WS_WOUT) : (const bf16*)(F.ws + WS_CWOUT)) + (size_t)j * DM * DM;
            pg8::Gemm g{A, Bt, MT, DM, DM}; pg8::StaticOrder S; S.init(MT, DM, F.G, F.bid, WGM_RES);
            pg8::EpiRes E{H, (float*)(F.ws + WS_SSX), (PG8_LAS const float*)(F.lds + BIAS_LDS_OFF), 0};
#if 1
            { int widx, nwg; tail_slot(F, 640 - 2 * F.G, widx, nwg); if (widx >= 0) {
                if (L > 0 || P0_DEFER8 > 0) bias_rows(F, (const bf16*)(F.ws + WS_FGU) + (size_t)L * 2 * FF * DM, 2 * FF, modl + 3 * DM, (float*)(F.ws + WS_BIAS2) + (size_t)L * 5 * 2 * FF, 2 * FF, widx * NWAVES + F.wave, nwg * NWAVES);
                if (L + 1 < NLAYER) { if (!ADA_IN_FUP) ada_layer(F, L + 1, 0, 128, widx, nwg); __syncthreads(); conv_items(F, L + 1, 0, widx * NWAVES + F.wave, nwg * NWAVES); }
                else if (DEFER_DOWN3) { __syncthreads(); conv_items(F, L, 1, widx * NWAVES + F.wave, nwg * NWAVES, 2 * 32 * 88); } } }
            __syncthreads();
#endif
            res_tables_to_lds(F, S, modl + 2 * DM, F.in[I_NFFN] + L * DM, modl + 4 * DM, F.in[I_NMIX] + L * DM, modl + 1 * DM);
            STAGGER(F);
            pg8::gemm_phase<pg8::EpiRes, pg8::StaticOrder, true, true>(F.lds, g, S, E);
#if REP_OUT > 1
            { pg8::EpiBf16Plain E2{(bf16*)(F.ws + WS_PROBE), DM, nullptr, nullptr, 0, -1, nullptr, 0}; pg8::gemm_phase<pg8::EpiBf16Plain, pg8::StaticOrder, true, true>(F.lds, g, S, E2); }
#endif
            SEAM(pb + 5);
        }
#endif
#if EN_FUP
        if (IN(pb + 7)) { LAYER_VARS(); PROBE_STAMP(F, pb + 7);
            pg8::Gemm g{H, (const bf16*)(F.ws + WS_FGU) + (size_t)L * 2 * FF * DM, MT, 2 * FF, DM}; pg8::StaticOrder S; S.init(MT, 2 * FF, F.G, F.bid, WGM_FUP);
            pg8::EpiSwiGLU E{(bf16*)(F.ws + WS_HH), FF, (const float*)(F.ws + WS_SSX), (const float*)(F.ws + WS_BIAS2) + (size_t)L * 5 * 2 * FF, 2 * FF, -1, (PG8_LAS const float*)(F.lds + BIAS_LDS_OFF), 0};
            if (ADA_IN_FUP && TAIL_CONV && L + 1 < NLAYER) { int widx, nwg; tail_slot(F, 3520 - 13 * F.G, widx, nwg);
                if (widx >= 0) ada_layer(F, L + 1, 0, ADA_FUP_ITEMS, widx, nwg); __syncthreads(); }
            bias_to_lds(F, S, E.bias, 2 * FF);
            for (int rep_ = 0; rep_ < REP_FUP; ++rep_) pg8::gemm_phase<pg8::EpiSwiGLU, pg8::StaticOrder, FUP_ALIGN_EPI, true>(F.lds, g, S, E);
            SEAM(pb + 7);
        }
#endif
#if EN_FDN
        if (IN(pb + 8)) { LAYER_VARS(); PROBE_STAMP(F, pb + 8);
            pg8::Gemm g{(const bf16*)(F.ws + WS_HH), (const bf16*)(F.ws + WS_FD) + (size_t)L * DM * FF, MT, DM, FF}; pg8::CountedDone S; S.init(MT, DM, F.G, F.bid, WGM_RES, FDN_REV);
            const bool more = L + 1 < NLAYER;
            S.arrive = (!more && EARLY_FIN_ON(F)) ? (unsigned*)(F.ws + WS_CTL) + CW_RDY : nullptr; S.nd = 0;
            pg8::EpiRes E{H, (float*)(F.ws + WS_SSX), (PG8_LAS const float*)(F.lds + BIAS_LDS_OFF), 0};
#if TAIL_CONV
            if (L + 1 < NLAYER) { int widx, nwg; tail_slot(F, 640 - 2 * F.G, widx, nwg);
              if (FDN_ALL_ITEMS > 0 && widx != F.bid) conv_items(F, L + 1, 1, F.bid * NWAVES + F.wave, F.G * NWAVES, 0, FDN_ALL_ITEMS);
              if (widx >= 0) { ada_layer(F, L + 1, (ADA_IN_FUP ? ADA_FUP_ITEMS : 128), 384, widx, nwg); __syncthreads(); conv_items(F, L + 1, 1, widx * NWAVES + F.wave, nwg * NWAVES, (FDN_ALL_ITEMS > 0 && widx != F.bid) ? FDN_ALL_ITEMS : 0, (G1_DEFER2 && P0_DEFER8 > 0 && L + 1 == 2) ? P2_FFN_ITEMS : (DEFER_DOWN3 && L + 1 == 3) ? 2 * 32 * 88 : 0x7fffffff);
                const int j1 = (L + 1) >> 1; const bool attn1 = ((L + 1) & 1) == 0;
                bias_rows(F, attn1 ? (const bf16*)(F.ws + WS_WIN) + (size_t)j1 * ZW * DM : (const bf16*)(F.ws + WS_CWIN) + (size_t)j1 * 4096 * DM, attn1 ? ZW : 4096, modl + 5 * 12288, (float*)(F.ws + WS_BIAS1) + (size_t)(L + 1) * 5 * 4096, 4096, widx * NWAVES + F.wave, nwg * NWAVES); } }
            __syncthreads();
#endif
            res_tables_to_lds(F, S, modl + 5 * DM, more ? F.in[I_NMIX] + (L + 1) * DM : F.in[I_FNORM], more ? modl + 5 * 12288 + DM : nullptr, F.in[I_NFFN] + L * DM, modl + 4 * DM);
            STAGGER(F);
            pg8::gemm_phase<pg8::EpiRes, pg8::CountedDone, true, true>(F.lds, g, S, E);
            if (!more && EARLY_FIN_ON(F) && F.bid >= 128) early_final(F, F.bid - 128);
#if REP_FDN > 1
            { pg8::EpiBf16Plain E2{(bf16*)(F.ws + WS_PROBE), DM, nullptr, nullptr, 0, -1, nullptr, 0}; pg8::gemm_phase<pg8::EpiBf16Plain, pg8::StaticOrder, true, true>(F.lds, g, S, E2); }
#endif
            SEAM(pb + 8);
        }
#endif
    }
#if EN_FIN
    if (IN(37)) { PHASE_BEGIN(F); PROBE_STAMP(F, 37);
#ifdef IDLE_US
        { const unsigned long long t0_ = __builtin_amdgcn_s_memrealtime(); while (__builtin_amdgcn_s_memrealtime() - t0_ < (unsigned long long)(IDLE_US) * 100ull) __builtin_amdgcn_s_sleep(16); }
#endif
        if (EARLY_FIN_ON(F)) final_phase_rest(F); else final_phase(F); asm volatile("s_waitcnt vmcnt(0)" ::: "memory"); __syncthreads(); PROBE_STAMP(F, 38);
#if PROBE_T
#ifndef PROBE_SA
#define PROBE_SA 1e-4f
#endif
#ifndef PROBE_OA
#define PROBE_OA 0.0f
#endif
#ifndef PROBE_SB
#define PROBE_SB 1e-3f
#endif
        if (blockIdx.x == 0) {
            __syncthreads(); asm volatile("s_waitcnt vmcnt(0)" ::: "memory");
            const unsigned long long* ts = (const unsigned long long*)(F.ws + WS_PROBE);
            const float ta = (float)(long long)(__hip_atomic_load(ts + PROBE_A1, __ATOMIC_RELAXED, __HIP_MEMORY_SCOPE_AGENT) - __hip_atomic_load(ts + PROBE_A0, __ATOMIC_RELAXED, __HIP_MEMORY_SCOPE_AGENT)) * 0.01f - PROBE_OA;
            const float tb = (float)(long long)(__hip_atomic_load(ts + PROBE_B1, __ATOMIC_RELAXED, __HIP_MEMORY_SCOPE_AGENT) - __hip_atomic_load(ts + PROBE_B0, __ATOMIC_RELAXED, __HIP_MEMORY_SCOPE_AGENT)) * 0.01f;
            for (int i = F.tid; i < 524288; i += NTHREADS) F.out[OUT_SKR + i] *= (1.0f + ta * PROBE_SA);
            if (F.tid == 0) F.out[0] += tb * PROBE_SB;
        }
#endif
    }
#endif
#undef IN
#undef SEAM
#undef X
#undef H
}

#ifndef MK_ONE_LAUNCH
#define MK_ONE_LAUNCH 0
#endif
extern "C" void kernel_launch(void* const* d_in, const int* in_sizes, int n_in, void* d_out, int out_size, void* d_ws, size_t ws_size, hipStream_t stream) {
    static int grid = 0;
    if (grid == 0) {
        if (n_in != 27 || out_size != 50855936 || ws_size < WS_END) { fprintf(stderr, "kernel_launch: built for 27 inputs, 50855936 outputs, >= %zu bytes of workspace; got n_in %d, out %d, ws %zu\n", (size_t)WS_END, n_in, out_size, ws_size); grid = -1; return; }
        int dev = 0, cus = 0, per_cu = 0;
        if (hipGetDevice(&dev) != hipSuccess || hipDeviceGetAttribute(&cus, hipDeviceAttributeMultiprocessorCount, dev) != hipSuccess) { fprintf(stderr, "kernel_launch: device query failed\n"); grid = -1; return; }
        if (hipFuncSetAttribute((const void*)fwd, hipFuncAttributeMaxDynamicSharedMemorySize, LDS_BYTES) != hipSuccess) { fprintf(stderr, "kernel_launch: hipFuncSetAttribute failed\n"); grid = -1; return; }
        if (hipOccupancyMaxActiveBlocksPerMultiprocessor(&per_cu, (const void*)fwd, NTHREADS, LDS_BYTES) != hipSuccess || per_cu < 1)
            fprintf(stderr, "kernel_launch: note: occupancy query reports %d workgroups per CU\n", per_cu);
        (void)hipGetLastError();
        grid = cus;
    }
    if (grid < 0) return;
    if (hipMemsetAsync((char*)d_ws + WS_CTL, 0, CTL_ZERO_BYTES, stream) != hipSuccess) { fprintf(stderr, "kernel_launch: memset failed\n"); return; }
    Args a{};
    for (int i = 0; i < 27; ++i) a.in[i] = (const GAS float*)d_in[i];
    a.out_f = (GAS float*)d_out; a.ws_b = (GAS unsigned char*)d_ws;
#if MK_ONE_LAUNCH
    a.ph_lo = 0; a.ph_hi = NPHASE;
    hipLaunchKernelGGL(fwd, dim3(grid), dim3(NTHREADS), LDS_BYTES, stream, a);
#else
    for (int ph = 0; ph < NPHASE; ++ph) {
        if (ph >= 1 && ph < 37) { const int L = (ph - 1) / 9, s = (ph - 1) % 9; if (((L & 1) && (s == 3 || s == 4)) || s == 6 || (s == 0 && L > 0)) continue; }
        a.ph_lo = ph; a.ph_hi = ph + 1;
        hipLaunchKernelGGL(fwd, dim3(grid), dim3(NTHREADS), LDS_BYTES, stream, a);
    }
#endif
    const hipError_t le = hipPeekAtLastError();
    if (le != hipSuccess) fprintf(stderr, "kernel_launch: launch failed: %s\n", hipGetErrorName(le));
}
```

```cpp
#define MK_ONE_LAUNCH 1
#define P0_DEFER8 4
#define EARLY_FIN 0
#define G1_DEFER2 1
#define DEFER_DOWN3 0
#define KV_ALIGN_EPI false
#include <hip/hip_runtime.h>
#include <cstdio>
#include <cstdint>
#ifndef PG8_WGM
#define PG8_WGM 4
#endif
namespace pg8 {
#define PG8_LAS __attribute__((address_space(3)))
typedef unsigned short bf16_t;
typedef short bf16x8 __attribute__((ext_vector_type(8)));
typedef float f32x4 __attribute__((ext_vector_type(4)));
typedef unsigned u32x4 __attribute__((ext_vector_type(4)));
constexpr int BM = 256, BK = 64, HALF = 128, HTB = HALF * BK * 2  , STAGE_BYTES = 8 * HTB, NXCD = 8, WGM = PG8_WGM;

__host__ __device__ __forceinline__ int lds_byte(int r, int c) { const int st = (r >> 4) * 2 + (c >> 5), rr = r & 15, cc = c & 31, ob = rr * 64 + cc * 2; return st * 1024 + (ob ^ (((ob >> 9) & 1) << 5)); }
__host__ __device__ __forceinline__ void stage_rc(int b, int& R, int& C) { const int st = b / 1024, sb = b % 1024, swz = sb ^ (((sb >> 9) & 1) << 5); R = (st >> 1) * 16 + swz / 64; C = (st & 1) * 32 + (swz % 64) / 2; }
__host__ __device__ __forceinline__ int perm32(int rho) { const int n = rho >> 4, i = rho & 15; return 8 * (i >> 2) + 4 * n + (i & 3); }

struct Unit { int pm, pn; };
struct Gemm { const bf16_t* A; const bf16_t* Bt; int M, N, K; };

struct StaticOrder {
    int nM, nN, nwg, G, c, wgm, rev;
    __host__ __device__ void init(int M, int N, int G_, int c_, int wgm_ = WGM, int rev_ = 0) { nM = M / BM; nN = N / BM; nwg = nM * nN; G = G_; c = c_; wgm = wgm_; rev = rev_; }
    __host__ __device__ bool next(int i, Unit& u) const {
        const int L = i * G + c; if (L >= nwg) return false;
        int wgid = L; { const int q = nwg / NXCD, r = nwg % NXCD, xcd = wgid % NXCD, off = wgid / NXCD; wgid = (xcd < r ? xcd * (q + 1) : r * (q + 1) + (xcd - r) * q) + off; }
        const int nig = wgm * nN, gid = wgid / nig, fm = gid * wgm, gsz = (nM - fm) < wgm ? (nM - fm) : wgm;
        u.pm = fm + ((wgid % nig) % gsz); u.pn = (wgid % nig) / gsz; if (rev) u.pm = nM - 1 - u.pm; return true;
    }
    __device__ __forceinline__ void a_ready(const Unit&) const {}
    __device__ __forceinline__ void done(const Unit&) const {}
};
struct CountedDone : StaticOrder {
    unsigned* arrive; mutable int nd;
    __device__ __forceinline__ void done(const Unit&) const {
        if (arrive && nd++ == 1) { asm volatile("s_waitcnt vmcnt(0)" ::: "memory"); __builtin_amdgcn_s_barrier();
            if (threadIdx.x < 64) { __builtin_amdgcn_fence(__ATOMIC_RELEASE, "agent"); if (threadIdx.x == 0) (void)__hip_atomic_fetch_add(arrive, 1u, __ATOMIC_RELAXED, __HIP_MEMORY_SCOPE_AGENT); } }
    }
};
__device__ __forceinline__ unsigned cvt_pk_bf16(float lo, float hi) { unsigned r; asm volatile("v_cvt_pk_bf16_f32 %0, %1, %2" : "=v"(r) : "v"(lo), "v"(hi)); return r; }
constexpr int ROWS_P = 4096;
__device__ __forceinline__ int cond_of_pm(int pm) { return pm < 16 ? 0 : 1 + ((pm - 16) >> 4); }

__device__ __forceinline__ float epi_add_x16_x32(float v) {
    v += __int_as_float(__builtin_amdgcn_ds_swizzle(__float_as_int(v), (16 << 10) | 0x1f));
    auto rr = __builtin_amdgcn_permlane32_swap(__float_as_uint(v), __float_as_uint(v), false, false); return __uint_as_float(rr[0]) + __uint_as_float(rr[1]);
}
#ifndef EPI_RSTD_PF_PLAIN
#define EPI_RSTD_PF_PLAIN 0
#endif
#ifndef EPI_RSTD_PF_SWIGLU
#define EPI_RSTD_PF_SWIGLU 0
#endif
#ifndef EPI_RSTD_PF_GELU
#define EPI_RSTD_PF_GELU 0
#endif
__device__ __forceinline__ void epi_row_rstd(const float* SSX, int row0, int fq, float (&rs)[2][4]) {
#pragma unroll
    for (int ai = 0; ai < 2; ++ai)
#pragma unroll
        for (int m = 0; m < 4; ++m) { const f32x4* p = (const f32x4*)(SSX + (size_t)(row0 + ai * HALF + m * 16) * 32 + 8 * fq); const f32x4 a = p[0], b = p[1];
            const float s = epi_add_x16_x32(((a[0] + a[1]) + (a[2] + a[3])) + ((b[0] + b[1]) + (b[2] + b[3])));
            rs[ai][m] = 1.0f / __builtin_sqrtf(s * (1.0f / 2048.0f) + 1e-6f); }
}

__device__ __forceinline__ void epi_rstd_issue(const float* SSX, int row0, int fq, f32x4 (&p)[16]) {
#pragma unroll
    for (int ai = 0; ai < 2; ++ai)
#pragma unroll
        for (int m = 0; m < 4; ++m) { const f32x4* q = (const f32x4*)(SSX + (size_t)(row0 + ai * HALF + m * 16) * 32 + 8 * fq); p[2 * (ai * 4 + m)] = q[0]; p[2 * (ai * 4 + m) + 1] = q[1]; }
}
__device__ __forceinline__ void epi_rstd_finish(const f32x4 (&p)[16], float (&rs)[2][4]) {
#pragma unroll
    for (int ai = 0; ai < 2; ++ai)
#pragma unroll
        for (int m = 0; m < 4; ++m) { const f32x4 a = p[2 * (ai * 4 + m)], b = p[2 * (ai * 4 + m) + 1];
            const float s = epi_add_x16_x32(((a[0] + a[1]) + (a[2] + a[3])) + ((b[0] + b[1]) + (b[2] + b[3])));
            rs[ai][m] = 1.0f / __builtin_sqrtf(s * (1.0f / 2048.0f) + 1e-6f); }
}

struct EpiBf16Plain {
    static constexpr bool PERM = true, AFTER_DRAIN = false;
    bf16_t* O; int ldc; const float* SSX; const float* bias; int ldb;
    mutable int pm_; PG8_LAS const float* lb; mutable int ui_;
    mutable float rs[2][4];
    static constexpr bool WANTS_NEXT = true;
    __device__ __forceinline__ void operator()(const f32x4 (&acc)[2][2][4][2], const Unit& u, int wr, int wc, int fr, int fq, int next_pm_ = -1) const {
        const int row0 = u.pm * BM + wr * 64 + fr, col0 = u.pn * BM + wc * 32 + 8 * fq;
        f32x4 bv[2][2];
        const bool pf = EPI_RSTD_PF_PLAIN && SSX && next_pm_ >= 0 && next_pm_ != u.pm; f32x4 pp[16];
        if (pf) epi_rstd_issue(SSX, next_pm_ * BM + wr * 64 + fr, fq, pp);
        if (SSX) { if (u.pm != pm_) { epi_row_rstd(SSX, row0, fq, rs); pm_ = u.pm; } PG8_LAS const float* bp = lb + ui_ * 256 + wc * 32 + 8 * fq; ++ui_;
#pragma unroll
            for (int bj = 0; bj < 2; ++bj)
#pragma unroll
                for (int n = 0; n < 2; ++n) bv[bj][n] = *(PG8_LAS const f32x4*)(bp + bj * HALF + 4 * n); }
#pragma unroll
        for (int ai = 0; ai < 2; ++ai)
#pragma unroll
            for (int m = 0; m < 4; ++m) { bf16_t* rowp = O + (size_t)(row0 + ai * HALF + m * 16) * ldc + col0;
#pragma unroll
                for (int bj = 0; bj < 2; ++bj) { f32x4 v0 = acc[ai][bj][m][0], v1 = acc[ai][bj][m][1];
                    if (SSX) { v0 = v0 * rs[ai][m] + bv[bj][0]; v1 = v1 * rs[ai][m] + bv[bj][1]; }
                    u32x4 w; w.x = cvt_pk_bf16(v0[0], v0[1]); w.y = cvt_pk_bf16(v0[2], v0[3]); w.z = cvt_pk_bf16(v1[0], v1[1]); w.w = cvt_pk_bf16(v1[2], v1[3]);
                    *(u32x4*)(rowp + bj * HALF) = w; } }
        if (pf) { epi_rstd_finish(pp, rs); pm_ = next_pm_; }
    }
};
#ifndef EPI_RES_DIAG
#define EPI_RES_DIAG 0
#endif
struct EpiRes {
    static constexpr bool PERM = true, AFTER_DRAIN = false, WANTS_NEXT = false;
    bf16_t* H; float* SSX;
    PG8_LAS const float* tab; mutable int ui_;
    __device__ __forceinline__ void operator()(const f32x4 (&acc)[2][2][4][2], const Unit& u, int wr, int wc, int fr, int fq) const {
        const int row0 = u.pm * BM + wr * 64 + fr, col0 = u.pn * BM + wc * 32 + 8 * fq;
        bf16_t* hp = H + (size_t)row0 * 2048 + col0;
        PG8_LAS const float* tp = tab + ui_ * 768 + wc * 32 + 8 * fq; ++ui_;
        u32x4 r[2][4][2];
#pragma unroll
        for (int ai = 0; ai < 2; ++ai)
#pragma unroll
            for (int m = 0; m < 4; ++m)
#pragma unroll
                for (int bj = 0; bj < 2; ++bj) r[ai][m][bj] = *(const u32x4*)(hp + (size_t)(ai * HALF + m * 16) * 2048 + bj * HALF);
#pragma unroll
        for (int ai = 0; ai < 2; ++ai) { float ss[4] = {0.f, 0.f, 0.f, 0.f};
#pragma unroll
            for (int bj = 0; bj < 2; ++bj) { f32x4 g[2], gs[2], gpi[2];
#pragma unroll
                for (int n = 0; n < 2; ++n) { g[n] = *(PG8_LAS const f32x4*)(tp + bj * HALF + n * 4); gs[n] = *(PG8_LAS const f32x4*)(tp + 256 + bj * HALF + n * 4); gpi[n] = *(PG8_LAS const f32x4*)(tp + 512 + bj * HALF + n * 4); }
#pragma unroll
                for (int m = 0; m < 4; ++m) { const size_t ro = (size_t)(ai * HALF + m * 16) * 2048; const u32x4 w0 = r[ai][m][bj]; u32x4 w;
                    { const f32x4 bs = (f32x4){__uint_as_float(w0.x << 16), __uint_as_float(w0.x & 0xffff0000u), __uint_as_float(w0.y << 16), __uint_as_float(w0.y & 0xffff0000u)} * gpi[0];
                      const f32x4 x = bs + g[0] * acc[ai][bj][m][0]; ss[m] += (x[0] * x[0] + x[1] * x[1]) + (x[2] * x[2] + x[3] * x[3]); const f32x4 a = x * gs[0];
                      w.x = cvt_pk_bf16(a[0], a[1]); w.y = cvt_pk_bf16(a[2], a[3]); }
                    { const f32x4 bs = (f32x4){__uint_as_float(w0.z << 16), __uint_as_float(w0.z & 0xffff0000u), __uint_as_float(w0.w << 16), __uint_as_float(w0.w & 0xffff0000u)} * gpi[1];
                      const f32x4 x = bs + g[1] * acc[ai][bj][m][1]; ss[m] += (x[0] * x[0] + x[1] * x[1]) + (x[2] * x[2] + x[3] * x[3]); const f32x4 a = x * gs[1];
                      w.z = cvt_pk_bf16(a[0], a[1]); w.w = cvt_pk_bf16(a[2], a[3]); }
                    *(u32x4*)(hp + ro + bj * HALF) = w; } }
#pragma unroll
            for (int m = 0; m < 4; ++m) { const float s1 = epi_add_x16_x32(ss[m]); if (fq == 0) SSX[(size_t)(row0 + ai * HALF + m * 16) * 32 + u.pn * 4 + wc] = s1; } }
    }
};
#ifndef NT_HH
#define NT_HH 0
#endif
#if NT_HH
#define EPI_HH_STORE(p, v) __builtin_nontemporal_store(v, p)
#else
#define EPI_HH_STORE(p, v) (*(p) = (v))
#endif
typedef float epi_f32x2 __attribute__((ext_vector_type(2)));
struct EpiSwiGLU {
    static constexpr bool PERM = true, AFTER_DRAIN = false;
    bf16_t* O; int ldc; const float* SSX; const float* bias; int ldb;
    mutable int pm_; PG8_LAS const float* lb; mutable int ui_; mutable float rs[2][4];
    static constexpr bool WANTS_NEXT = true;
    __device__ __forceinline__ void operator()(const f32x4 (&acc)[2][2][4][2], const Unit& u, int wr, int wc, int fr, int fq, int next_pm_ = -1) const {
        const int row0 = u.pm * BM + wr * 64 + fr, col0 = u.pn * HALF + wc * 32 + 8 * fq;
        const bool pf = EPI_RSTD_PF_SWIGLU && next_pm_ >= 0 && next_pm_ != u.pm; f32x4 pp[8];
        const float* nss = SSX + (size_t)(next_pm_ * BM + wr * 64 + fr) * 32 + 8 * fq;
        if (u.pm != pm_) { epi_row_rstd(SSX, row0, fq, rs); pm_ = u.pm; } f32x4 bv[2][2]; { PG8_LAS const float* bp = lb + ui_ * 256 + wc * 32 + 8 * fq; ++ui_;
#pragma unroll
            for (int bj = 0; bj < 2; ++bj)
#pragma unroll
                for (int n = 0; n < 2; ++n) bv[bj][n] = *(PG8_LAS const f32x4*)(bp + bj * HALF + 4 * n); }
#pragma unroll
        for (int ai = 0; ai < 2; ++ai) {
            if (pf) {
#pragma unroll
                for (int m = 0; m < 4; ++m) { const f32x4* q = (const f32x4*)(nss + (size_t)(ai * HALF + m * 16) * 32); pp[2 * m] = q[0]; pp[2 * m + 1] = q[1]; } }
#pragma unroll
            for (int m = 0; m < 4; ++m) { bf16_t* rowp = O + (size_t)(row0 + ai * HALF + m * 16) * ldc + col0;
                epi_f32x2 z[4]; const float rsm = rs[ai][m];
#pragma unroll
                for (int n = 0; n < 2; ++n)
#pragma unroll
                    for (int h = 0; h < 2; ++h) { const epi_f32x2 ag = {acc[ai][0][m][n][2 * h], acc[ai][0][m][n][2 * h + 1]}, au = {acc[ai][1][m][n][2 * h], acc[ai][1][m][n][2 * h + 1]};
                        const epi_f32x2 bg = {bv[0][n][2 * h], bv[0][n][2 * h + 1]}, bu = {bv[1][n][2 * h], bv[1][n][2 * h + 1]};
                        const epi_f32x2 gt = ag * rsm + bg, up = au * rsm + bu, q = gt * -1.4426950408889634f;
                        epi_f32x2 e; e.x = __builtin_amdgcn_exp2f(q.x); e.y = __builtin_amdgcn_exp2f(q.y);
                        const epi_f32x2 d = e + 1.0f; epi_f32x2 rc; rc.x = __builtin_amdgcn_rcpf(d.x); rc.y = __builtin_amdgcn_rcpf(d.y);
                        z[2 * n + h] = (gt * up) * rc; }
                u32x4 w; w.x = cvt_pk_bf16(z[0].x, z[0].y); w.y = cvt_pk_bf16(z[1].x, z[1].y); w.z = cvt_pk_bf16(z[2].x, z[2].y); w.w = cvt_pk_bf16(z[3].x, z[3].y);
                EPI_HH_STORE((u32x4*)rowp, w); }
            if (pf) {
#pragma unroll
                for (int m = 0; m < 4; ++m) { const f32x4 a = pp[2 * m], b = pp[2 * m + 1];
                    const float s1 = epi_add_x16_x32(((a[0] + a[1]) + (a[2] + a[3])) + ((b[0] + b[1]) + (b[2] + b[3])));
                    rs[ai][m] = 1.0f / __builtin_sqrtf(s1 * (1.0f / 2048.0f) + 1e-6f); } } }
        if (pf) pm_ = next_pm_;
    }
};
__device__ __forceinline__ float gelu_tanh(float x) {
    const float u = 0.7978845608028654f * (x + 0.044715f * x * x * x);
    const float e = __builtin_amdgcn_exp2f(u * -2.8853900817779268f);
    return x * __builtin_amdgcn_rcpf(1.0f + e);
}
__device__ __forceinline__ epi_f32x2 gelu_tanh2(epi_f32x2 x) {
    const epi_f32x2 t = (x * x) * (-0.10294324f) + (-2.3022082f), u = x * t;
    epi_f32x2 e; e.x = __builtin_amdgcn_exp2f(u.x); e.y = __builtin_amdgcn_exp2f(u.y);
    const epi_f32x2 d = e + 1.0f; epi_f32x2 r; r.x = __builtin_amdgcn_rcpf(d.x); r.y = __builtin_amdgcn_rcpf(d.y);
    return x * r;
}
struct EpiGeluUV {
    static constexpr bool PERM = true, AFTER_DRAIN = false;
    bf16_t* U; bf16_t* V; float* SS; const float* SSX; const float* bias; int ldb;
    mutable int pm_; PG8_LAS const float* lb; mutable int ui_; mutable float rs[2][4];
    static constexpr bool WANTS_NEXT = true;
    __device__ __forceinline__ void operator()(const f32x4 (&acc)[2][2][4][2], const Unit& u, int wr, int wc, int fr, int fq, int next_pm_ = -1) const {
        const bool isv = u.pn >= 8; const int pn = isv ? u.pn - 8 : u.pn;
        const int row0 = u.pm * BM + wr * 64 + fr, col0 = pn * BM + wc * 32 + 8 * fq;
        const bool pf = EPI_RSTD_PF_GELU && next_pm_ >= 0 && next_pm_ != u.pm; f32x4 pp[16];
        if (pf) epi_rstd_issue(SSX, next_pm_ * BM + wr * 64 + fr, fq, pp);
        if (u.pm != pm_) { epi_row_rstd(SSX, row0, fq, rs); pm_ = u.pm; } f32x4 bv[2][2]; { PG8_LAS const float* bp = lb + ui_ * 256 + wc * 32 + 8 * fq; ++ui_;
#pragma unroll
            for (int bj = 0; bj < 2; ++bj)
#pragma unroll
                for (int n = 0; n < 2; ++n) bv[bj][n] = *(PG8_LAS const f32x4*)(bp + bj * HALF + 4 * n); }
        bf16_t* O = isv ? V : U;
#pragma unroll
        for (int ai = 0; ai < 2; ++ai)
#pragma unroll
            for (int m = 0; m < 4; ++m) { const int row = row0 + ai * HALF + m * 16; bf16_t* rowp = O + (size_t)row * 2048 + col0; epi_f32x2 ss2 = {0.f, 0.f}; const float rsm = rs[ai][m];
#pragma unroll
                for (int bj = 0; bj < 2; ++bj) { epi_f32x2 z[4];
#pragma unroll
                    for (int n = 0; n < 2; ++n)
#pragma unroll
                        for (int h = 0; h < 2; ++h) { const epi_f32x2 a = {acc[ai][bj][m][n][2 * h], acc[ai][bj][m][n][2 * h + 1]}, b = {bv[bj][n][2 * h], bv[bj][n][2 * h + 1]};
                            z[2 * n + h] = gelu_tanh2(a * rsm + b); ss2 += z[2 * n + h] * z[2 * n + h]; }
                    u32x4 w; w.x = cvt_pk_bf16(z[0].x, z[0].y); w.y = cvt_pk_bf16(z[1].x, z[1].y); w.z = cvt_pk_bf16(z[2].x, z[2].y); w.w = cvt_pk_bf16(z[3].x, z[3].y);
                    *(u32x4*)(rowp + bj * HALF) = w; }
                float ss = ss2.x + ss2.y;
                if (isv) { ss += __int_as_float(__builtin_amdgcn_ds_swizzle(__float_as_int(ss), (16 << 10) | 0x1f)); { auto rr = __builtin_amdgcn_permlane32_swap(__float_as_uint(ss), __float_as_uint(ss), false, false); ss = __uint_as_float(rr[0]) + __uint_as_float(rr[1]); } if (fq == 0) SS[(size_t)row * 32 + pn * 4 + wc] = ss; } }
        if (pf) { epi_rstd_finish(pp, rs); pm_ = next_pm_; }
    }
};
template <class Epi, class Sched, bool ALIGN_EPI = false, bool SP2 = false>
__device__ __forceinline__ void gemm_phase(PG8_LAS unsigned char* lds, const Gemm g, const Sched& S, const Epi& E) {
    int tid_ = threadIdx.x; asm volatile("" : "+v"(tid_));
    const int tid = tid_, wid = __builtin_amdgcn_readfirstlane(tid >> 6), lane = tid & 63, wr = wid >> 2, wc = wid & 3, fr = lane & 15, fq = lane >> 4;
    const int K = g.K, nt = K / BK;
    unsigned voffA[2], voffB[2];
#pragma unroll
    for (int i = 0; i < 2; ++i) { int R, C; stage_rc(tid * 16 + i * 8192, R, C); const int Rb = Epi::PERM ? ((R & ~31) + perm32(R & 31)) : R;
        voffA[i] = (unsigned)(R * K + C) * 2u; voffB[i] = (unsigned)(Rb * K + C) * 2u; }
    const size_t kstep = (size_t)(BK * 2);
    const size_t hstep = (size_t)HALF * K * 2;
    const size_t tstep = 2 * hstep;
    const unsigned ldsw = (unsigned)wid * 1024u;
    const int aoff = lds_byte(wr * 64 + fr, fq * 8), boff = lds_byte(wc * 32 + fr, fq * 8);
#define PG8_SA(b, h) (((b) * 2 + (h)) * HTB)
#define PG8_SB(b, h) ((4 + (b) * 2 + (h)) * HTB)
#define PG8_STAGE(bufoff, gbase, voff) do { _Pragma("unroll") for (int _i = 0; _i < 2; ++_i) \
        __builtin_amdgcn_global_load_lds((const unsigned*)((const char*)(gbase) + (voff)[_i]), (PG8_LAS unsigned*)(lds + (bufoff) + ldsw + _i * 8192), 16, 0, 0); } while (0)
#define PG8_LDA(dst, b, h) do { _Pragma("unroll") for (int m = 0; m < 4; ++m) _Pragma("unroll") for (int k = 0; k < 2; ++k) dst[m][k] = *(const PG8_LAS bf16x8*)(lds + PG8_SA(b, h) + aoff + m * 2048 + k * 1024); } while (0)
#define PG8_LDB(dst, b, h) do { _Pragma("unroll") for (int n = 0; n < 2; ++n) _Pragma("unroll") for (int k = 0; k < 2; ++k) dst[n][k] = *(const PG8_LAS bf16x8*)(lds + PG8_SB(b, h) + boff + n * 2048 + k * 1024); } while (0)
#define PG8_MMA(ai, bj, At, Bt) do { __builtin_amdgcn_s_setprio(1); _Pragma("unroll") for (int m = 0; m < 4; ++m) _Pragma("unroll") for (int n = 0; n < 2; ++n) _Pragma("unroll") for (int k = 0; k < 2; ++k) \
        acc[ai][bj][m][n] = __builtin_amdgcn_mfma_f32_16x16x32_bf16(Bt[n][k], At[m][k], acc[ai][bj][m][n], 0, 0, 0); __builtin_amdgcn_s_setprio(0); } while (0)
#define PG8_WAIT_V(n) asm volatile("s_waitcnt vmcnt(" #n ")" ::: "memory")
#define PG8_WAIT_L(n) asm volatile("s_waitcnt lgkmcnt(" #n ")" ::: "memory")
#define PG8_BAR __builtin_amdgcn_s_barrier()
#define PG8_SCHED __builtin_amdgcn_sched_barrier(0)
    Unit cur, nxt; int ui = 0;
    if (!S.next(0, cur)) return;
    f32x4 acc[2][2][4][2];
#pragma unroll
    for (int a = 0; a < 2; ++a)
#pragma unroll
        for (int b = 0; b < 2; ++b)
#pragma unroll
            for (int m = 0; m < 4; ++m)
#pragma unroll
                for (int n = 0; n < 2; ++n) acc[a][b][m][n] = (f32x4){0.f, 0.f, 0.f, 0.f};
    bf16x8 At[4][2], B0[2][2], B1[2][2];
    const char* cA = (const char*)g.A + (size_t)cur.pm * tstep; const char* cB = (const char*)g.Bt + (size_t)cur.pn * tstep;
    S.a_ready(cur);
    if constexpr (SP2) {
        PG8_STAGE(PG8_SB(0, 0), cB, voffB); PG8_STAGE(PG8_SB(0, 1), cB + hstep, voffB); PG8_STAGE(PG8_SA(0, 0), cA, voffA); PG8_STAGE(PG8_SA(0, 1), cA + hstep, voffA);
        if (wr == 1) PG8_BAR;
        PG8_WAIT_V(2); PG8_BAR;
        PG8_STAGE(PG8_SB(1, 0), cB + kstep, voffB); PG8_STAGE(PG8_SA(1, 0), cA + kstep, voffA); PG8_STAGE(PG8_SB(1, 1), cB + hstep + kstep, voffB);
        PG8_WAIT_V(6); PG8_BAR;
    } else {
        PG8_STAGE(PG8_SB(0, 0), cB, voffB); PG8_STAGE(PG8_SA(0, 0), cA, voffA); PG8_STAGE(PG8_SB(0, 1), cB + hstep, voffB); PG8_STAGE(PG8_SA(0, 1), cA + hstep, voffA);
        if (wr == 1) PG8_BAR;
        PG8_WAIT_V(4); PG8_BAR;
        PG8_STAGE(PG8_SB(1, 0), cB + kstep, voffB); PG8_STAGE(PG8_SA(1, 0), cA + kstep, voffA); PG8_STAGE(PG8_SB(1, 1), cB + hstep + kstep, voffB);
        PG8_WAIT_V(6); PG8_BAR;
    }
    for (;;) {
        const bool has_next = S.next(ui + 1, nxt);
        const char* nA = has_next ? (const char*)g.A + (size_t)nxt.pm * tstep : cA; const char* nB = has_next ? (const char*)g.Bt + (size_t)nxt.pn * tstep : cB;
        for (int t = 0; t < nt; t += 2) {
            const bool last = (t == nt - 2);
            const char* a1 = cA + (size_t)(t + 1) * kstep;
            const char* a2 = last ? nA : cA + (size_t)(t + 2) * kstep; const char* b2 = last ? nB : cB + (size_t)(t + 2) * kstep;
            const char* a3 = a2 + kstep; const char* b3 = b2 + kstep;
            if (last && has_next) S.a_ready(nxt);
            if constexpr (SP2) {
            PG8_LDB(B0, 0, 0); PG8_LDB(B1, 0, 1); PG8_SCHED; PG8_LDA(At, 0, 0); PG8_STAGE(PG8_SA(1, 1), a1 + hstep, voffA);
            PG8_WAIT_V(8); PG8_WAIT_L(0); PG8_BAR; PG8_MMA(0, 0, At, B0); PG8_MMA(0, 1, At, B1); PG8_BAR; PG8_SCHED;
            PG8_LDA(At, 0, 1); PG8_STAGE(PG8_SB(0, 0), b2, voffB); PG8_STAGE(PG8_SB(0, 1), b2 + hstep, voffB); PG8_STAGE(PG8_SA(0, 0), a2, voffA);
            PG8_WAIT_V(8); PG8_WAIT_L(0); PG8_BAR; PG8_MMA(1, 0, At, B0); PG8_MMA(1, 1, At, B1); PG8_BAR; PG8_SCHED;
            PG8_LDB(B0, 1, 0); PG8_LDB(B1, 1, 1); PG8_SCHED; PG8_LDA(At, 1, 0); PG8_STAGE(PG8_SA(0, 1), a2 + hstep, voffA);
            PG8_WAIT_V(8); PG8_WAIT_L(0); PG8_BAR; PG8_MMA(0, 0, At, B0); PG8_MMA(0, 1, At, B1); PG8_BAR; PG8_SCHED;
            PG8_LDA(At, 1, 1); PG8_STAGE(PG8_SB(1, 0), b3, voffB); PG8_STAGE(PG8_SB(1, 1), b3 + hstep, voffB); PG8_STAGE(PG8_SA(1, 0), a3, voffA);
            PG8_WAIT_V(8); PG8_WAIT_L(0); PG8_BAR; PG8_MMA(1, 0, At, B0); PG8_MMA(1, 1, At, B1); PG8_BAR; PG8_SCHED;
            } else {
            PG8_LDB(B0, 0, 0); PG8_SCHED; PG8_LDA(At, 0, 0); PG8_STAGE(PG8_SA(1, 1), a1 + hstep, voffA);
            PG8_WAIT_L(8); PG8_BAR; PG8_WAIT_L(0); PG8_MMA(0, 0, At, B0); PG8_BAR; PG8_SCHED;
            PG8_LDB(B1, 0, 1); PG8_STAGE(PG8_SB(0, 0), b2, voffB);
            PG8_BAR; PG8_WAIT_L(0); PG8_MMA(0, 1, At, B1); PG8_BAR;
            PG8_LDA(At, 0, 1); PG8_STAGE(PG8_SA(0, 0), a2, voffA);
            PG8_BAR; PG8_WAIT_L(0); PG8_MMA(1, 0, At, B0); PG8_BAR; PG8_SCHED;
            PG8_STAGE(PG8_SB(0, 1), b2 + hstep, voffB);
            PG8_WAIT_V(6); PG8_BAR; PG8_MMA(1, 1, At, B1); PG8_BAR;
            PG8_LDB(B0, 1, 0); PG8_SCHED; PG8_LDA(At, 1, 0); PG8_STAGE(PG8_SA(0, 1), a2 + hstep, voffA);
            PG8_WAIT_L(8); PG8_BAR; PG8_WAIT_L(0); PG8_MMA(0, 0, At, B0); PG8_BAR; PG8_SCHED;
            PG8_LDB(B1, 1, 1); PG8_STAGE(PG8_SB(1, 0), b3, voffB);
            PG8_BAR; PG8_WAIT_L(0); PG8_MMA(0, 1, At, B1); PG8_BAR;
            PG8_LDA(At, 1, 1); PG8_STAGE(PG8_SA(1, 0), a3, voffA);
            PG8_BAR; PG8_WAIT_L(0); PG8_MMA(1, 0, At, B0); PG8_BAR; PG8_SCHED;
            PG8_STAGE(PG8_SB(1, 1), b3 + hstep, voffB);
            PG8_WAIT_V(6); PG8_BAR; PG8_MMA(1, 1, At, B1); PG8_BAR;
            }
        }
        if constexpr (ALIGN_EPI) { if (wr == 0) PG8_BAR; }
        if constexpr (!Epi::AFTER_DRAIN) { if constexpr (Epi::WANTS_NEXT) E(acc, cur, wr, wc, fr, fq, has_next ? nxt.pm : -1); else E(acc, cur, wr, wc, fr, fq); S.done(cur); }
        if (!has_next) break;
#pragma unroll
        for (int a = 0; a < 2; ++a)
#pragma unroll
            for (int b = 0; b < 2; ++b)
#pragma unroll
                for (int m = 0; m < 4; ++m)
#pragma unroll
                    for (int n = 0; n < 2; ++n) acc[a][b][m][n] = (f32x4){0.f, 0.f, 0.f, 0.f};
        cur = nxt; cA = nA; cB = nB; ++ui;
        if constexpr (ALIGN_EPI) { if (wr == 1) PG8_BAR; }
    }
    PG8_WAIT_V(0);
    if constexpr (!ALIGN_EPI) { if (wr == 0) PG8_BAR; }
    PG8_BAR;
    if constexpr (Epi::AFTER_DRAIN) { E.fused(acc, cur, wr, wc, fr, fq, lds, wid, lane); S.done(cur); }
#undef PG8_SA
#undef PG8_SB
#undef PG8_STAGE
#undef PG8_LDA
#undef PG8_LDB
#undef PG8_MMA
#undef PG8_WAIT_V
#undef PG8_WAIT_L
#undef PG8_BAR
#undef PG8_SCHED
}
}
namespace att {
typedef unsigned short bf16;
using bf16x8 = __attribute__((ext_vector_type(8))) short;
using s16x4  = __attribute__((ext_vector_type(4))) short;
using f32x16 = __attribute__((ext_vector_type(16))) float;
using u32x4  = __attribute__((ext_vector_type(4))) unsigned;
constexpr int NW = 8, QBLK = 32, KVBLK = 64;
constexpr float THR = 8.f;
#define ATT_SBAR() __builtin_amdgcn_sched_barrier(0)
template <int RS> __device__ __forceinline__ int kswz(int row, int colB) { return row * RS + (colB ^ ((row & 7) << 4)); }
__device__ __forceinline__ int crow(int r, int hi) { return (r & 3) + 8 * (r >> 2) + 4 * hi; }
__device__ __forceinline__ unsigned cvtpk(float lo, float hi) { unsigned r; asm volatile("v_cvt_pk_bf16_f32 %0, %1, %2" : "=v"(r) : "v"(lo), "v"(hi)); return r; }
__device__ __forceinline__ bf16x8 ld8(const bf16* p) { return *reinterpret_cast<const bf16x8*>(p); }

__device__ __forceinline__ void partialSM(f32x16& p0, f32x16& p1, float& m_reg, float& mn, float& alpha, const float C, const float TS) {
  float pmax = p0[0];
#pragma unroll
  for (int r = 1; r < 16; ++r) pmax = fmaxf(pmax, p0[r]);
#pragma unroll
  for (int r = 0; r < 16; ++r) pmax = fmaxf(pmax, p1[r]);
  { auto rr = __builtin_amdgcn_permlane32_swap(__float_as_uint(pmax), __float_as_uint(pmax), false, false);
    pmax = fmaxf(__uint_as_float(rr[0]), __uint_as_float(rr[1])); }
  if (__builtin_expect(__all(pmax - m_reg <= TS), 1)) { mn = m_reg; alpha = 1.f; }
  else { mn = fmaxf(m_reg, pmax); alpha = __builtin_amdgcn_exp2f((m_reg - mn) * C); m_reg = mn; }
  float mnC = -mn * C;
#pragma unroll
  for (int r = 0; r < 16; ++r) p0[r] = fmaf(p0[r], C, mnC);
#pragma unroll
  for (int r = 0; r < 16; ++r) p1[r] = fmaf(p1[r], C, mnC);
#pragma unroll
  for (int r = 0; r < 16; ++r) p0[r] = __builtin_amdgcn_exp2f(p0[r]);
}
__device__ __forceinline__ void finishSM(f32x16& p0, f32x16& p1, float alpha, float& l_reg, bf16x8& pa0, bf16x8& pa1, bf16x8& pa2, bf16x8& pa3) {
#pragma unroll
  for (int r = 0; r < 16; ++r) p1[r] = __builtin_amdgcn_exp2f(p1[r]);
  float ps = 0;
#pragma unroll
  for (int r = 0; r < 16; ++r) ps += p0[r];
#pragma unroll
  for (int r = 0; r < 16; ++r) ps += p1[r];
  { auto rr = __builtin_amdgcn_permlane32_swap(__float_as_uint(ps), __float_as_uint(ps), false, false);
    ps = __uint_as_float(rr[0]) + __uint_as_float(rr[1]); }
  l_reg = l_reg * alpha + ps;
#define ATT_PK4(P, BASE, OUT) do { unsigned a0 = cvtpk(P[BASE + 0], P[BASE + 1]), a1 = cvtpk(P[BASE + 2], P[BASE + 3]);   \
    unsigned b0 = cvtpk(P[BASE + 4], P[BASE + 5]), b1 = cvtpk(P[BASE + 6], P[BASE + 7]);                              \
    auto r0 = __builtin_amdgcn_permlane32_swap(a0, b0, false, false); auto r1 = __builtin_amdgcn_permlane32_swap(a1, b1, false, false); \
    u32x4 w = {r0[0], r1[0], r0[1], r1[1]}; OUT = *reinterpret_cast<bf16x8*>(&w); } while (0)
  ATT_PK4(p0, 0, pa0); ATT_PK4(p0, 8, pa1); ATT_PK4(p1, 0, pa2); ATT_PK4(p1, 8, pa3);
#undef ATT_PK4
}
#ifndef QKT_SB0
#define QKT_SB0 3
#endif
#ifndef QKT_SB1
#define QKT_SB1 7
#endif
template <int DK, int NQR> __device__ __forceinline__ void qkt(f32x16& p0, f32x16& p1, const char* Ks, const bf16x8* qr, const char* qrl, int r32, int hi) {
  p0 = f32x16{}; p1 = f32x16{};
#pragma unroll
  for (int d0 = 0; d0 < DK / 16; ++d0) { const int cb = (d0 * 16 + hi * 8) * 2;
    const bf16x8 qf = (d0 < NQR) ? qr[d0 < NQR ? d0 : 0] : *reinterpret_cast<const bf16x8*>(qrl + (d0 - NQR) * 1024);
    bf16x8 b0 = *reinterpret_cast<const bf16x8*>(Ks + kswz<DK * 2>(r32, cb));
    bf16x8 b1 = *reinterpret_cast<const bf16x8*>(Ks + kswz<DK * 2>(32 + r32, cb));
    p0 = __builtin_amdgcn_mfma_f32_32x32x16_bf16(b0, qf, p0, 0, 0, 0);
    p1 = __builtin_amdgcn_mfma_f32_32x32x16_bf16(b1, qf, p1, 0, 0, 0);
    if constexpr (DK == 192) { if (d0 == QKT_SB0 || d0 == QKT_SB1) ATT_SBAR(); } }
}
__device__ __forceinline__ int v_st(int k, int c) { const int kk = (k & ~0xC) | ((k & 4) << 1) | ((k & 8) >> 1); return ((kk >> 3) * 4 + (c >> 5)) * 512 + ((kk & 7) * 32 + (c & 31)) * 2; }
__device__ __forceinline__ int v_rd_base(int lane) { return ((lane & 3) << 3) | (((lane >> 2) & 3) << 6) | (((lane >> 4) & 1) << 5) | (((lane >> 5) & 1) << 8); }
constexpr int v_rd_off(int d0, int ks, int half) { return d0 * 512 + ks * 4096 + half * 2048; }
template <int OFF> __device__ __forceinline__ s16x4 tr_read(int vb) {
  s16x4 r; asm volatile("ds_read_b64_tr_b16 %0, %1 offset:%2" : "=&v"(r) : "v"(vb), "i"(OFF) : "memory"); return r;
}
template <int D0> __device__ __forceinline__ void pv_one(f32x16& od, int vb, bf16x8 pa0, bf16x8 pa1, bf16x8 pa2, bf16x8 pa3) {
  const s16x4 l0 = tr_read<v_rd_off(D0, 0, 0)>(vb), h0 = tr_read<v_rd_off(D0, 0, 1)>(vb), l1 = tr_read<v_rd_off(D0, 1, 0)>(vb), h1 = tr_read<v_rd_off(D0, 1, 1)>(vb);
  const s16x4 l2 = tr_read<v_rd_off(D0, 2, 0)>(vb), h2 = tr_read<v_rd_off(D0, 2, 1)>(vb), l3 = tr_read<v_rd_off(D0, 3, 0)>(vb), h3 = tr_read<v_rd_off(D0, 3, 1)>(vb);
  asm volatile("s_waitcnt lgkmcnt(0)" ::: "memory"); ATT_SBAR();
#define ATT_PK(L, H) (bf16x8){L[0], L[1], L[2], L[3], H[0], H[1], H[2], H[3]}
  od = __builtin_amdgcn_mfma_f32_32x32x16_bf16(pa0, ATT_PK(l0, h0), od, 0, 0, 0);
  od = __builtin_amdgcn_mfma_f32_32x32x16_bf16(pa1, ATT_PK(l1, h1), od, 0, 0, 0);
  od = __builtin_amdgcn_mfma_f32_32x32x16_bf16(pa2, ATT_PK(l2, h2), od, 0, 0, 0);
  od = __builtin_amdgcn_mfma_f32_32x32x16_bf16(pa3, ATT_PK(l3, h3), od, 0, 0, 0);
#undef ATT_PK
}
__device__ __forceinline__ void pv_d0(f32x16* o, int vb, bf16x8 pa0, bf16x8 pa1, bf16x8 pa2, bf16x8 pa3) {
  pv_one<0>(o[0], vb, pa0, pa1, pa2, pa3); pv_one<1>(o[1], vb, pa0, pa1, pa2, pa3); pv_one<2>(o[2], vb, pa0, pa1, pa2, pa3); pv_one<3>(o[3], vb, pa0, pa1, pa2, pa3);
}

template <int DK, int LDQ, int LDKN, int LDV, int LDO, int SDEPTH, int NQR, int QMODE>
__device__ __forceinline__ void attn_unit(const bf16* __restrict__ Qb, const bf16* __restrict__ Kn, const bf16* __restrict__ Kr, const bf16* __restrict__ Vh,
                                          bf16* __restrict__ Ob, int seq, char* lds, const float* __restrict__ qg, const float* __restrict__ T, int tok0) {
  constexpr int SHM_V = KVBLK * 128 * 2, SHM_K = KVBLK * DK * 2, KRS = DK * 2;
  constexpr float SCALE = (DK == 128) ? 0.088388347648318440f : 0.072168783648703220f;
  constexpr float C = SCALE * 1.4426950408889634f, TS = THR / SCALE;
  int tid_ = threadIdx.x; asm volatile("" : "+v"(tid_));
  const int tid = tid_, wid = tid >> 6, lane = tid & 63, r32 = lane & 31, hi = lane >> 5;
  char* V_lds = lds; char* K_lds = lds + 2 * SHM_V;
  float* ws = (float*)(lds + 2 * SHM_V + 2 * SHM_K) + wid * 64; float* li_l = ws; float* al_l = ws + 32;
  float m_reg = -1e30f, l_reg = 0; f32x16 o[4] = {}; bf16x8 qr[NQR]; constexpr int NQL = DK / 16 - NQR;
  char* qrl = lds + 2 * SHM_V + 2 * SHM_K + 2048 + (wid * NQL * 64 + lane) * 16;
  __syncthreads();
  const bf16* Qw = Qb + (long)(wid * QBLK + r32) * LDQ + hi * 8;
  { bf16x8 qraw[DK / 16];
#pragma unroll
    for (int d0 = 0; d0 < DK / 16; ++d0) qraw[d0] = ld8(Qw + d0 * 16);
#define ATT_UNPK(vv_, oo_) do { const u32x4 w_ = *reinterpret_cast<const u32x4*>(&(vv_)); oo_[0] = __uint_as_float(w_[0] << 16); oo_[1] = __uint_as_float(w_[0] & 0xffff0000u); oo_[2] = __uint_as_float(w_[1] << 16); oo_[3] = __uint_as_float(w_[1] & 0xffff0000u); \
      oo_[4] = __uint_as_float(w_[2] << 16); oo_[5] = __uint_as_float(w_[2] & 0xffff0000u); oo_[6] = __uint_as_float(w_[3] << 16); oo_[7] = __uint_as_float(w_[3] & 0xffff0000u); } while (0)
#define ATT_PK(ii_, vv_) do { u32x4 w_ = {cvtpk(ii_[0], ii_[1]), cvtpk(ii_[2], ii_[3]), cvtpk(ii_[4], ii_[5]), cvtpk(ii_[6], ii_[7])}; vv_ = *reinterpret_cast<bf16x8*>(&w_); } while (0)
    const int tok = tok0 + wid * QBLK + r32, prow = tok >> 6, pcol = tok & 63;
    if constexpr (QMODE == 1 || QMODE == 2) {
      float x[8][8]; float ss = 0.f;
#pragma unroll
      for (int d0 = 0; d0 < 8; ++d0) { ATT_UNPK(qraw[d0], x[d0]);
#pragma unroll
        for (int j = 0; j < 8; ++j) ss += x[d0][j] * x[d0][j]; }
      { auto rr = __builtin_amdgcn_permlane32_swap(__float_as_uint(ss), __float_as_uint(ss), false, false); ss = __uint_as_float(rr[0]) + __uint_as_float(rr[1]); }
      const float rstd = 1.0f / __builtin_sqrtf(ss * (1.0f / 128.0f) + 1e-6f);
#pragma unroll
      for (int d0 = 0; d0 < 8; ++d0) { const float* gp = qg + 16 * d0 + 8 * hi;
#pragma unroll
        for (int j = 0; j < 8; ++j) x[d0][j] = x[d0][j] * rstd * gp[j]; }
      if constexpr (QMODE == 2) {
#pragma unroll
        for (int ax = 0; ax < 2; ++ax) { const int pos = ax ? pcol : prow;
#pragma unroll
          for (int b = 0; b < 2; ++b) { const float* tp = T + ((long)pos * 32 + 16 * b + 8 * hi) * 2;
#pragma unroll
            for (int j = 0; j < 8; ++j) { const float co = tp[2 * j], si = tp[2 * j + 1], x1 = x[4 * ax + b][j], x2 = x[4 * ax + 2 + b][j];
              x[4 * ax + b][j] = x1 * co - x2 * si; x[4 * ax + 2 + b][j] = x1 * si + x2 * co; } } } }
#pragma unroll
      for (int d0 = 0; d0 < 8; ++d0) ATT_PK(x[d0], qraw[d0]);
    }
    if constexpr (QMODE == 3) {
#pragma unroll
      for (int ax = 0; ax < 2; ++ax) { const int pos = ax ? pcol : prow; const float* tp = T + ((long)pos * 16 + 8 * hi) * 2; float x1[8], x2[8];
        ATT_UNPK(qraw[8 + 2 * ax], x1); ATT_UNPK(qraw[9 + 2 * ax], x2);
#pragma unroll
        for (int j = 0; j < 8; ++j) { const float co = tp[2 * j], si = tp[2 * j + 1], a1 = x1[j], a2 = x2[j]; x1[j] = a1 * co - a2 * si; x2[j] = a1 * si + a2 * co; }
        ATT_PK(x1, qraw[8 + 2 * ax]); ATT_PK(x2, qraw[9 + 2 * ax]); } }
#undef ATT_UNPK
#undef ATT_PK
#pragma unroll
    for (int d0 = 0; d0 < NQR; ++d0) qr[d0] = qraw[d0];
    if constexpr (NQL > 0) {
#pragma unroll
      for (int f = 0; f < NQL; ++f) *reinterpret_cast<bf16x8*>(qrl + f * 1024) = qraw[NQR + f]; } }
  const int sr = tid >> 4, sc = (tid & 15) * 8, vst0 = v_st(sr, sc), vst1 = v_st(32 + sr, sc);
  const int rr = tid >> 3, rc = (tid & 7) * 8;
  const int vb0 = (int)(uintptr_t)V_lds + v_rd_base(lane);
  struct { bf16x8 vs0, vs1, ks0, ks1, kr; } sr_[SDEPTH];
#define ATT_SLOAD(i, k0) do { sr_[i].vs0 = ld8(&Vh[(long)((k0) + sr) * LDV + sc]); sr_[i].vs1 = ld8(&Vh[(long)((k0) + 32 + sr) * LDV + sc]); \
    sr_[i].ks0 = ld8(&Kn[(long)((k0) + sr) * LDKN + sc]); sr_[i].ks1 = ld8(&Kn[(long)((k0) + 32 + sr) * LDKN + sc]); \
    if constexpr (DK == 192) sr_[i].kr = ld8(&Kr[(long)((k0) + rr) * 64 + rc]); } while (0)
#define ATT_SWRITE(b, i) do { *(bf16x8*)(V_lds + (b) * SHM_V + vst0) = sr_[i].vs0; *(bf16x8*)(V_lds + (b) * SHM_V + vst1) = sr_[i].vs1; const int kc = sc * 2; \
    *(bf16x8*)(K_lds + (b) * SHM_K + kswz<KRS>(sr, kc)) = sr_[i].ks0; *(bf16x8*)(K_lds + (b) * SHM_K + kswz<KRS>(32 + sr, kc)) = sr_[i].ks1; \
    if constexpr (DK == 192) *(bf16x8*)(K_lds + (b) * SHM_K + kswz<KRS>(rr, 256 + rc * 2)) = sr_[i].kr; } while (0)
#define ATT_SWAIT() do { if constexpr (SDEPTH == 1) asm volatile("s_waitcnt vmcnt(0)" ::: "memory"); else if constexpr (DK == 192) asm volatile("s_waitcnt vmcnt(5)" ::: "memory"); else asm volatile("s_waitcnt vmcnt(4)" ::: "memory"); } while (0)
#define ATT_RESC(a) do { if (__any((a) < 1.f)) { if (hi == 0) al_l[r32] = (a); asm volatile("s_waitcnt lgkmcnt(0)" ::: "memory"); \
    _Pragma("unroll") for (int d = 0; d < 4; ++d) _Pragma("unroll") for (int r = 0; r < 16; ++r) o[d][r] *= al_l[crow(r, hi)]; } } while (0)
  f32x16 pA0, pA1, pB0, pB1; float mnA, mnB, alA, alB; bf16x8 pa0, pa1, pa2, pa3; const int NT = seq / KVBLK;
  constexpr int SE = 0, SO = SDEPTH - 1;
  ATT_SLOAD(SE, 0); asm volatile("s_waitcnt vmcnt(0)" ::: "memory"); ATT_SWRITE(0, SE); __syncthreads();
  qkt<DK, NQR>(pA0, pA1, K_lds, qr, qrl, r32, hi); partialSM(pA0, pA1, m_reg, mnA, alA, C, TS);
  ATT_SLOAD(SO, KVBLK); if constexpr (SDEPTH == 2) { if (2 < NT) ATT_SLOAD(SE, 2 * KVBLK); }
  if (2 < NT) ATT_SWAIT(); else asm volatile("s_waitcnt vmcnt(0)" ::: "memory");
  ATT_SWRITE(1, SO); __syncthreads();
  for (int j = 1; j + 1 < NT; j += 2) {
    ATT_SBAR(); qkt<DK, NQR>(pB0, pB1, K_lds + SHM_K, qr, qrl, r32, hi);
    finishSM(pA0, pA1, alA, l_reg, pa0, pa1, pa2, pa3); ATT_SBAR();
    ATT_SLOAD(SO, (j + SDEPTH) * KVBLK); ATT_SBAR();
    pv_d0(o, vb0, pa0, pa1, pa2, pa3); partialSM(pB0, pB1, m_reg, mnB, alB, C, TS);
    __syncthreads(); ATT_SWAIT(); ATT_SWRITE(0, SE);
    ATT_RESC(alB); __syncthreads();
    ATT_SBAR(); qkt<DK, NQR>(pA0, pA1, K_lds, qr, qrl, r32, hi);
    finishSM(pB0, pB1, alB, l_reg, pa0, pa1, pa2, pa3); ATT_SBAR();
    if (SDEPTH == 1 || j + 3 < NT) ATT_SLOAD(SE, (j + 1 + SDEPTH) * KVBLK); ATT_SBAR();
    pv_d0(o, vb0 + SHM_V, pa0, pa1, pa2, pa3); partialSM(pA0, pA1, m_reg, mnA, alA, C, TS);
    __syncthreads(); if (SDEPTH == 1 || j + 3 < NT) ATT_SWAIT(); else asm volatile("s_waitcnt vmcnt(0)" ::: "memory");
    ATT_SWRITE(1, SO);
    ATT_RESC(alA); __syncthreads();
  }
  ATT_SBAR(); qkt<DK, NQR>(pB0, pB1, K_lds + SHM_K, qr, qrl, r32, hi);
  finishSM(pA0, pA1, alA, l_reg, pa0, pa1, pa2, pa3); ATT_SBAR();
  pv_d0(o, vb0, pa0, pa1, pa2, pa3); partialSM(pB0, pB1, m_reg, mnB, alB, C, TS);
  __syncthreads(); ATT_RESC(alB);
  finishSM(pB0, pB1, alB, l_reg, pa0, pa1, pa2, pa3); ATT_SBAR();
  pv_d0(o, vb0 + SHM_V, pa0, pa1, pa2, pa3);
  if (hi == 0) li_l[r32] = l_reg; asm volatile("s_waitcnt lgkmcnt(0)" ::: "memory");
  float rli[16];
#pragma unroll
  for (int r = 0; r < 16; ++r) rli[r] = __builtin_amdgcn_rcpf(li_l[crow(r, hi)]);
  bf16* Ow = Ob + (long)(wid * QBLK) * LDO;
#pragma unroll
  for (int r = 0; r < 16; ++r) { const int orow = crow(r, hi);
#pragma unroll
    for (int d0 = 0; d0 < 4; d0 += 1) { const unsigned w = cvtpk(o[d0][r] * rli[r], 0.f); Ow[(long)orow * LDO + d0 * 32 + r32] = (bf16)(w & 0xffffu); } }
#undef ATT_SLOAD
#undef ATT_SWRITE
#undef ATT_SWAIT
#undef ATT_RESC
}
template <int DK, int LDQ, int LDKN, int LDV, int LDO, int NQR>
__device__ __forceinline__ void attn_unit_dma(const bf16* __restrict__ Qb, const bf16* __restrict__ Kn, const bf16* __restrict__ Kr, const bf16* __restrict__ Vh,
                                              bf16* __restrict__ Ob, int seq, char* lds, __attribute__((address_space(3))) unsigned char* ldsl) {
  constexpr int SHM_V = KVBLK * 128 * 2, SHM_K = KVBLK * DK * 2, KRS = DK * 2, STG = SHM_K + SHM_V, NKI = SHM_K / 8192;
  constexpr float SCALE = (DK == 128) ? 0.088388347648318440f : 0.072168783648703220f;
  constexpr float C = SCALE * 1.4426950408889634f, TS = THR / SCALE;
  int tid_ = threadIdx.x; asm volatile("" : "+v"(tid_));
  const int tid = tid_, wid = __builtin_amdgcn_readfirstlane(tid >> 6), lane = tid & 63, r32 = lane & 31, hi = lane >> 5;
  float* ws = (float*)(lds + 3 * STG) + wid * 64; float* li_l = ws; float* al_l = ws + 32;
  float m_reg = -1e30f, l_reg = 0; f32x16 o[4] = {}; bf16x8 qr[NQR]; constexpr int NQL = DK / 16 - NQR;
  char* qrl = lds + 3 * STG + 2048 + (wid * NQL * 64 + lane) * 16;
#define ATT_BAR() do { asm volatile("" ::: "memory"); __builtin_amdgcn_s_barrier(); asm volatile("" ::: "memory"); } while (0)
#define ATT_WAITV_B() do { if constexpr (NKI == 2) asm volatile("s_waitcnt vmcnt(4)" ::: "memory"); else asm volatile("s_waitcnt vmcnt(5)" ::: "memory"); } while (0)
#define ATT_WAITV_2B() do { if constexpr (NKI == 2) asm volatile("s_waitcnt vmcnt(8)" ::: "memory"); else asm volatile("s_waitcnt vmcnt(10)" ::: "memory"); } while (0)
  asm volatile("s_waitcnt vmcnt(0) lgkmcnt(0)" ::: "memory"); ATT_BAR();
  const bf16* Qw = Qb + (long)(wid * QBLK + r32) * LDQ + hi * 8;
#pragma unroll
  for (int d0 = 0; d0 < NQR; ++d0) qr[d0] = ld8(Qw + d0 * 16);
  if constexpr (NQL > 0) {
#pragma unroll
    for (int f = 0; f < NQL; ++f) *reinterpret_cast<bf16x8*>(qrl + f * 1024) = ld8(Qw + (NQR + f) * 16); }
  const char* ksrc[NKI]; int kinc[NKI]; const char* vsrc[2];
#pragma unroll
  for (int i = 0; i < NKI; ++i) { const int p = (i * 8 + wid) * 1024 + lane * 16, row = p / KRS, cb = (p % KRS) ^ ((row & 7) << 4);
    if (DK == 128 || cb < 256) { ksrc[i] = (const char*)Kn + ((long)row * LDKN) * 2 + cb; kinc[i] = KVBLK * LDKN * 2; }
    else { ksrc[i] = (const char*)Kr + row * 128 + (cb - 256); kinc[i] = KVBLK * 128; } }
#pragma unroll
  for (int i = 0; i < 2; ++i) { const int p = (i * 8 + wid) * 1024 + lane * 16, sub = p >> 9, q = p & 511, kk = ((sub >> 2) << 3) | (q >> 6), col = (sub & 3) * 32 + ((q & 63) >> 1);
    const int key = (kk & ~0xC) | ((kk & 4) << 1) | ((kk & 8) >> 1); vsrc[i] = (const char*)Vh + ((long)key * LDV + col) * 2; }
  constexpr int vinc = KVBLK * LDV * 2;
#define ATT_ISSUE(t, s) do { const int t_ = (t); const unsigned so_ = (unsigned)(s) * STG; \
    _Pragma("unroll") for (int i_ = 0; i_ < NKI; ++i_) __builtin_amdgcn_global_load_lds((const unsigned*)(ksrc[i_] + (long)t_ * kinc[i_]), (__attribute__((address_space(3))) unsigned*)(ldsl + so_ + (i_ * 8 + wid) * 1024), 16, 0, 0); \
    _Pragma("unroll") for (int i_ = 0; i_ < 2; ++i_) __builtin_amdgcn_global_load_lds((const unsigned*)(vsrc[i_] + (long)t_ * vinc), (__attribute__((address_space(3))) unsigned*)(ldsl + so_ + SHM_K + (i_ * 8 + wid) * 1024), 16, 0, 0); } while (0)
#define ATT_RESC2(a) do { if (__any((a) < 1.f)) { if (hi == 0) al_l[r32] = (a); asm volatile("s_waitcnt lgkmcnt(0)" ::: "memory"); \
    _Pragma("unroll") for (int d = 0; d < 4; ++d) _Pragma("unroll") for (int r = 0; r < 16; ++r) o[d][r] *= al_l[crow(r, hi)]; } } while (0)
  f32x16 pA0, pA1, pB0, pB1; float mnA, mnB, alA, alB; bf16x8 pa0, pa1, pa2, pa3; const int NT = seq / KVBLK;
  const int vbase = (int)(uintptr_t)lds + SHM_K + v_rd_base(lane);
  asm volatile("s_waitcnt vmcnt(0)" ::: "memory");
  ATT_ISSUE(0, 0); ATT_ISSUE(1, 1); ATT_ISSUE(2, 2);
  ATT_WAITV_2B(); ATT_BAR();
  qkt<DK, NQR>(pA0, pA1, lds, qr, qrl, r32, hi); partialSM(pA0, pA1, m_reg, mnA, alA, C, TS);
  ATT_WAITV_B(); ATT_BAR();
  int s = 1, sp = 0;
  for (int j = 1; j + 1 < NT; j += 2) {
    const int sn = 3 - s - sp;
    ATT_SBAR(); qkt<DK, NQR>(pB0, pB1, lds + s * STG, qr, qrl, r32, hi);
    finishSM(pA0, pA1, alA, l_reg, pa0, pa1, pa2, pa3); ATT_SBAR();
    pv_d0(o, vbase + sp * STG, pa0, pa1, pa2, pa3); partialSM(pB0, pB1, m_reg, mnB, alB, C, TS);
    asm volatile("s_waitcnt lgkmcnt(0)" ::: "memory"); ATT_BAR();
    const bool i2 = j + 2 < NT; if (i2) ATT_ISSUE(j + 2, sp);
    ATT_RESC2(alB);
    if (i2) ATT_WAITV_B(); else asm volatile("s_waitcnt vmcnt(0)" ::: "memory");
    ATT_BAR();
    ATT_SBAR(); qkt<DK, NQR>(pA0, pA1, lds + sn * STG, qr, qrl, r32, hi);
    finishSM(pB0, pB1, alB, l_reg, pa0, pa1, pa2, pa3); ATT_SBAR();
    pv_d0(o, vbase + s * STG, pa0, pa1, pa2, pa3); partialSM(pA0, pA1, m_reg, mnA, alA, C, TS);
    asm volatile("s_waitcnt lgkmcnt(0)" ::: "memory"); ATT_BAR();
    const bool i3 = j + 3 < NT; if (i3) ATT_ISSUE(j + 3, s);
    ATT_RESC2(alA);
    if (i3) ATT_WAITV_B(); else asm volatile("s_waitcnt vmcnt(0)" ::: "memory");
    ATT_BAR();
    const int s2 = sp; sp = sn; s = s2;
  }
  ATT_SBAR(); qkt<DK, NQR>(pB0, pB1, lds + s * STG, qr, qrl, r32, hi);
  finishSM(pA0, pA1, alA, l_reg, pa0, pa1, pa2, pa3); ATT_SBAR();
  pv_d0(o, vbase + sp * STG, pa0, pa1, pa2, pa3); partialSM(pB0, pB1, m_reg, mnB, alB, C, TS);
  ATT_RESC2(alB);
  finishSM(pB0, pB1, alB, l_reg, pa0, pa1, pa2, pa3); ATT_SBAR();
  pv_d0(o, vbase + s * STG, pa0, pa1, pa2, pa3);
  if (hi == 0) li_l[r32] = l_reg; asm volatile("s_waitcnt lgkmcnt(0)" ::: "memory");
  float rli[16];
#pragma unroll
  for (int r = 0; r < 16; ++r) rli[r] = __builtin_amdgcn_rcpf(li_l[crow(r, hi)]);
  bf16* Ow = Ob + (long)(wid * QBLK) * LDO;
#pragma unroll
  for (int r = 0; r < 16; ++r) { const int orow = crow(r, hi);
#pragma unroll
    for (int d0 = 0; d0 < 4; d0 += 1) { const unsigned w = cvtpk(o[d0][r] * rli[r], 0.f); Ow[(long)orow * LDO + d0 * 32 + r32] = (bf16)(w & 0xffffu); } }
#undef ATT_BAR
#undef ATT_WAITV_B
#undef ATT_WAITV_2B
#undef ATT_ISSUE
#undef ATT_RESC2
}

using f32x4a = __attribute__((ext_vector_type(4))) float;
__device__ __forceinline__ float max_x16(float v) { auto rr = __builtin_amdgcn_permlane16_swap(__float_as_uint(v), __float_as_uint(v), false, false); return fmaxf(__uint_as_float(rr[0]), __uint_as_float(rr[1])); }
__device__ __forceinline__ float max_x32(float v) { auto rr = __builtin_amdgcn_permlane32_swap(__float_as_uint(v), __float_as_uint(v), false, false); return fmaxf(__uint_as_float(rr[0]), __uint_as_float(rr[1])); }
__device__ __forceinline__ float add_x16(float v) { auto rr = __builtin_amdgcn_permlane16_swap(__float_as_uint(v), __float_as_uint(v), false, false); return __uint_as_float(rr[0]) + __uint_as_float(rr[1]); }
__device__ __forceinline__ float add_x32(float v) { auto rr = __builtin_amdgcn_permlane32_swap(__float_as_uint(v), __float_as_uint(v), false, false); return __uint_as_float(rr[0]) + __uint_as_float(rr[1]); }
__device__ __forceinline__ int k16_st(int r, int c) { return r * 256 + ((c ^ (r & 15)) << 4); }
__device__ __forceinline__ int kr16_st(int r, int c) { return 16384 + (r >> 1) * 256 + ((((r & 1) << 3) | (c ^ ((r >> 1) & 7))) << 4); }
__device__ __forceinline__ int v16_st(int k, int c) { const int row = (k & 0x23) | (((k >> 2) & 3) << 3) | (((k >> 4) & 1) << 2); return 256 * row + 16 * (c ^ (((row & 3) << 2) | ((row >> 2) & 3))); }

__device__ __forceinline__ void partialSM16(f32x4a (&p)[2][4], float (&m_reg)[2], float (&alpha)[2], const float C, const float TS) {
  float pmax[2];
#pragma unroll
  for (int qb = 0; qb < 2; ++qb) { float v = p[qb][0][0];
#pragma unroll
    for (int kb = 0; kb < 4; ++kb)
#pragma unroll
      for (int r = 0; r < 4; ++r) v = fmaxf(v, p[qb][kb][r]);
    v = max_x16(v); pmax[qb] = max_x32(v); }
  float mn[2];
  if (__builtin_expect(__all((pmax[0] - m_reg[0] <= TS) && (pmax[1] - m_reg[1] <= TS)), 1)) { mn[0] = m_reg[0]; mn[1] = m_reg[1]; alpha[0] = 1.f; alpha[1] = 1.f; }
  else {
#pragma unroll
    for (int qb = 0; qb < 2; ++qb) { mn[qb] = fmaxf(m_reg[qb], pmax[qb]); alpha[qb] = __builtin_amdgcn_exp2f((m_reg[qb] - mn[qb]) * C); m_reg[qb] = mn[qb]; } }
#pragma unroll
  for (int qb = 0; qb < 2; ++qb) { const float mnC = -mn[qb] * C;
#pragma unroll
    for (int kb = 0; kb < 4; ++kb)
#pragma unroll
      for (int r = 0; r < 4; ++r) p[qb][kb][r] = fmaf(p[qb][kb][r], C, mnC); }
#pragma unroll
  for (int qb = 0; qb < 2; ++qb)
#pragma unroll
    for (int kb = 0; kb < 2; ++kb)
#pragma unroll
      for (int r = 0; r < 4; ++r) p[qb][kb][r] = __builtin_amdgcn_exp2f(p[qb][kb][r]);
}
__device__ __forceinline__ void finishSM16(f32x4a (&p)[2][4], const float (&alpha)[2], float (&l_reg)[2], bf16x8 (&pa)[2][2]) {
#pragma unroll
  for (int qb = 0; qb < 2; ++qb)
#pragma unroll
    for (int kb = 2; kb < 4; ++kb)
#pragma unroll
      for (int r = 0; r < 4; ++r) p[qb][kb][r] = __builtin_amdgcn_exp2f(p[qb][kb][r]);
#pragma unroll
  for (int qb = 0; qb < 2; ++qb) { float ps = 0.f;
#pragma unroll
    for (int kb = 0; kb < 4; ++kb) ps += (p[qb][kb][0] + p[qb][kb][1]) + (p[qb][kb][2] + p[qb][kb][3]);
    ps = add_x16(ps); ps = add_x32(ps); l_reg[qb] = l_reg[qb] * alpha[qb] + ps;
#pragma unroll
    for (int ks = 0; ks < 2; ++ks) { u32x4 w = {cvtpk(p[qb][2 * ks][0], p[qb][2 * ks][1]), cvtpk(p[qb][2 * ks][2], p[qb][2 * ks][3]), cvtpk(p[qb][2 * ks + 1][0], p[qb][2 * ks + 1][1]), cvtpk(p[qb][2 * ks + 1][2], p[qb][2 * ks + 1][3])};
      pa[qb][ks] = *reinterpret_cast<bf16x8*>(&w); } }
}
template <int DK, int NQR> __device__ __forceinline__ void qkt16(f32x4a (&p)[2][4], const char* Ks, const bf16x8* qr, const char* qrl, int kbn, int kbr) {
#pragma unroll
  for (int qb = 0; qb < 2; ++qb)
#pragma unroll
    for (int kb = 0; kb < 4; ++kb) p[qb][kb] = (f32x4a){0.f, 0.f, 0.f, 0.f};
#pragma unroll
  for (int s = 0; s < DK / 32; ++s) {
    const bf16x8 q0 = (2 * s < NQR) ? qr[2 * s < NQR ? 2 * s : 0] : *reinterpret_cast<const bf16x8*>(qrl + (2 * s - NQR) * 1024);
    const bf16x8 q1 = (2 * s + 1 < NQR) ? qr[2 * s + 1 < NQR ? 2 * s + 1 : 0] : *reinterpret_cast<const bf16x8*>(qrl + (2 * s + 1 - NQR) * 1024);
    const int ka = (s < 4) ? (kbn ^ (s << 6)) : (kbr ^ ((s - 4) << 6));
#pragma unroll
    for (int kb = 0; kb < 4; ++kb) { const bf16x8 kf = *reinterpret_cast<const bf16x8*>(Ks + ka + kb * ((s < 4) ? 4096 : 2048));
      p[0][kb] = __builtin_amdgcn_mfma_f32_16x16x32_bf16(kf, q0, p[0][kb], 0, 0, 0);
      p[1][kb] = __builtin_amdgcn_mfma_f32_16x16x32_bf16(kf, q1, p[1][kb], 0, 0, 0); }
    if constexpr (DK == 192) { if (s == 1 || s == 3) ATT_SBAR(); } }
}
template <int DB> __device__ __forceinline__ void pv16_one(f32x4a& o0, f32x4a& o1, int vb, const bf16x8 (&pa)[2][2]) {
  const int a0 = vb ^ (32 * DB), a1 = vb ^ (32 * DB + 16);
  const s16x4 b00 = tr_read<0>(a0), b01 = tr_read<1024>(a1), b10 = tr_read<8192>(a0), b11 = tr_read<9216>(a1);
  asm volatile("s_waitcnt lgkmcnt(0)" ::: "memory"); ATT_SBAR();
  const bf16x8 B0 = (bf16x8){b00[0], b00[1], b00[2], b00[3], b01[0], b01[1], b01[2], b01[3]}, B1 = (bf16x8){b10[0], b10[1], b10[2], b10[3], b11[0], b11[1], b11[2], b11[3]};
  o0 = __builtin_amdgcn_mfma_f32_16x16x32_bf16(pa[0][0], B0, o0, 0, 0, 0);
  o1 = __builtin_amdgcn_mfma_f32_16x16x32_bf16(pa[1][0], B0, o1, 0, 0, 0);
  o0 = __builtin_amdgcn_mfma_f32_16x16x32_bf16(pa[0][1], B1, o0, 0, 0, 0);
  o1 = __builtin_amdgcn_mfma_f32_16x16x32_bf16(pa[1][1], B1, o1, 0, 0, 0);
}
__device__ __forceinline__ void pv16(f32x4a (&o)[2][8], int vb, const bf16x8 (&pa)[2][2]) {
  pv16_one<0>(o[0][0], o[1][0], vb, pa); pv16_one<1>(o[0][1], o[1][1], vb, pa); pv16_one<2>(o[0][2], o[1][2], vb, pa); pv16_one<3>(o[0][3], o[1][3], vb, pa);
  pv16_one<4>(o[0][4], o[1][4], vb, pa); pv16_one<5>(o[0][5], o[1][5], vb, pa); pv16_one<6>(o[0][6], o[1][6], vb, pa); pv16_one<7>(o[0][7], o[1][7], vb, pa);
}

template <int DK, int LDQ, int LDKN, int LDV, int LDO, int SDEPTH, int NQR, int QMODE>
__device__ __forceinline__ void attn_unit16(const bf16* __restrict__ Qb, const bf16* __restrict__ Kn, const bf16* __restrict__ Kr, const bf16* __restrict__ Vh,
                                            bf16* __restrict__ Ob, int seq, char* lds, const float* __restrict__ qg, const float* __restrict__ T, int tok0) {
  constexpr int SHM_V = KVBLK * 128 * 2, SHM_K = KVBLK * DK * 2, NF = DK / 16;
  constexpr float SCALE = (DK == 128) ? 0.088388347648318440f : 0.072168783648703220f;
  constexpr float C = SCALE * 1.4426950408889634f, TS = THR / SCALE;
  int tid_ = threadIdx.x; asm volatile("" : "+v"(tid_));
  const int tid = tid_, wid = tid >> 6, lane = tid & 63, li = lane & 15, lg = lane >> 4;
  char* V_lds = lds; char* K_lds = lds + 2 * SHM_V;
  float* ws = (float*)(lds + 2 * SHM_V + 2 * SHM_K) + wid * 64; float* li_l = ws; float* al_l = ws + 32;
  float m_reg[2] = {-1e30f, -1e30f}, l_reg[2] = {0.f, 0.f}; f32x4a o[2][8]; bf16x8 qr[NQR]; constexpr int NQL = NF - NQR;
#pragma unroll
  for (int qb = 0; qb < 2; ++qb)
#pragma unroll
    for (int db = 0; db < 8; ++db) o[qb][db] = (f32x4a){0.f, 0.f, 0.f, 0.f};
  char* qrl = lds + 2 * SHM_V + 2 * SHM_K + 2048 + (wid * NQL * 64 + lane) * 16;
  __syncthreads();
  const bf16* Qw = Qb + (long)(wid * QBLK + li) * LDQ + lg * 8;
  { bf16x8 qraw[NF];
#pragma unroll
    for (int s = 0; s < DK / 32; ++s)
#pragma unroll
      for (int qb = 0; qb < 2; ++qb) qraw[2 * s + qb] = ld8(Qw + (long)(16 * qb) * LDQ + 32 * s);
#define ATT_UNPK(vv_, oo_) do { const u32x4 w_ = *reinterpret_cast<const u32x4*>(&(vv_)); oo_[0] = __uint_as_float(w_[0] << 16); oo_[1] = __uint_as_float(w_[0] & 0xffff0000u); oo_[2] = __uint_as_float(w_[1] << 16); oo_[3] = __uint_as_float(w_[1] & 0xffff0000u); \
      oo_[4] = __uint_as_float(w_[2] << 16); oo_[5] = __uint_as_float(w_[2] & 0xffff0000u); oo_[6] = __uint_as_float(w_[3] << 16); oo_[7] = __uint_as_float(w_[3] & 0xffff0000u); } while (0)
#define ATT_PK(ii_, vv_) do { u32x4 w_ = {cvtpk(ii_[0], ii_[1]), cvtpk(ii_[2], ii_[3]), cvtpk(ii_[4], ii_[5]), cvtpk(ii_[6], ii_[7])}; vv_ = *reinterpret_cast<bf16x8*>(&w_); } while (0)
    if constexpr (QMODE == 1 || QMODE == 2) {
#pragma unroll
      for (int qb = 0; qb < 2; ++qb) {
        float x[4][8]; float ss = 0.f;
#pragma unroll
        for (int s = 0; s < 4; ++s) { ATT_UNPK(qraw[2 * s + qb], x[s]);
#pragma unroll
          for (int j = 0; j < 8; ++j) ss += x[s][j] * x[s][j]; }
        ss = add_x16(ss); ss = add_x32(ss);
        const float rstd = 1.0f / __builtin_sqrtf(ss * (1.0f / 128.0f) + 1e-6f);
#pragma unroll
        for (int s = 0; s < 4; ++s) { const float* gp = qg + 32 * s + 8 * lg;
#pragma unroll
          for (int j = 0; j < 8; ++j) x[s][j] = x[s][j] * rstd * gp[j]; }
        if constexpr (QMODE == 2) {
          const int tok = tok0 + wid * QBLK + 16 * qb + li, prow = tok >> 6, pcol = tok & 63;
#pragma unroll
          for (int ax = 0; ax < 2; ++ax) { const int pos = ax ? pcol : prow; const float* tp = T + ((long)pos * 32 + 8 * lg) * 2;
#pragma unroll
            for (int j = 0; j < 8; ++j) { const float co = tp[2 * j], si = tp[2 * j + 1], x1 = x[2 * ax][j], x2 = x[2 * ax + 1][j];
              x[2 * ax][j] = x1 * co - x2 * si; x[2 * ax + 1][j] = x1 * si + x2 * co; } } }
#pragma unroll
        for (int s = 0; s < 4; ++s) ATT_PK(x[s], qraw[2 * s + qb]);
      }
    }
    if constexpr (QMODE == 3) {
#pragma unroll
      for (int qb = 0; qb < 2; ++qb) { const int tok = tok0 + wid * QBLK + 16 * qb + li, prow = tok >> 6, pcol = tok & 63;
#pragma unroll
        for (int ax = 0; ax < 2; ++ax) { const int pos = ax ? pcol : prow; const float* tp = T + ((long)pos * 16 + 8 * (lg & 1)) * 2;
          const u32x4 w = *reinterpret_cast<const u32x4*>(&qraw[2 * (4 + ax) + qb]); u32x4 wo;
#pragma unroll
          for (int k = 0; k < 4; ++k) { auto rr = __builtin_amdgcn_permlane32_swap(w[k], w[k], false, false);
            const float a1 = __uint_as_float(rr[0] << 16), b1 = __uint_as_float(rr[0] & 0xffff0000u), a2 = __uint_as_float(rr[1] << 16), b2 = __uint_as_float(rr[1] & 0xffff0000u);
            const float co0 = tp[4 * k], si0 = tp[4 * k + 1], co1 = tp[4 * k + 2], si1 = tp[4 * k + 3];
            const float r0 = (lg < 2) ? a1 * co0 - a2 * si0 : a1 * si0 + a2 * co0, r1 = (lg < 2) ? b1 * co1 - b2 * si1 : b1 * si1 + b2 * co1;
            wo[k] = cvtpk(r0, r1); }
          qraw[2 * (4 + ax) + qb] = *reinterpret_cast<bf16x8*>(&wo); } } }
#undef ATT_UNPK
#undef ATT_PK
#pragma unroll
    for (int f = 0; f < NQR; ++f) qr[f] = qraw[f];
    if constexpr (NQL > 0) {
#pragma unroll
      for (int f = 0; f < NQL; ++f) *reinterpret_cast<bf16x8*>(qrl + f * 1024) = qraw[NQR + f]; } }
  const int sr = tid >> 4, sc = (tid & 15) * 8, vst0 = v16_st(sr, tid & 15), vst1 = vst0 + 8192, kst0 = k16_st(sr, tid & 15), kst1 = kst0 + 8192;
  const int rr = tid >> 3, rc = (tid & 7) * 8, krst = kr16_st(rr, tid & 7);
  const int vb0 = (int)(uintptr_t)V_lds + 256 * (8 * lg + (li >> 2)) + 8 * (lane & 1) + 16 * ((((li >> 2) << 2) | ((lg & 1) << 1)) | ((lane >> 1) & 1));
  const int kbn = li * 256 + (((li & 12) | ((lg ^ li) & 3)) << 4), kbr = 16384 + (li >> 1) * 256 + ((((li & 1) << 3) | ((lg ^ (li >> 1)) & 7)) << 4);
  struct { bf16x8 vs0, vs1, ks0, ks1, kr; } sr_[SDEPTH];
#define ATT_SLOAD(i, k0) do { sr_[i].vs0 = ld8(&Vh[(long)((k0) + sr) * LDV + sc]); sr_[i].vs1 = ld8(&Vh[(long)((k0) + 32 + sr) * LDV + sc]); \
    sr_[i].ks0 = ld8(&Kn[(long)((k0) + sr) * LDKN + sc]); sr_[i].ks1 = ld8(&Kn[(long)((k0) + 32 + sr) * LDKN + sc]); \
    if constexpr (DK == 192) sr_[i].kr = ld8(&Kr[(long)((k0) + rr) * 64 + rc]); } while (0)
#define ATT_SWRITE(b, i) do { *(bf16x8*)(V_lds + (b) * SHM_V + vst0) = sr_[i].vs0; *(bf16x8*)(V_lds + (b) * SHM_V + vst1) = sr_[i].vs1; \
    *(bf16x8*)(K_lds + (b) * SHM_K + kst0) = sr_[i].ks0; *(bf16x8*)(K_lds + (b) * SHM_K + kst1) = sr_[i].ks1; \
    if constexpr (DK == 192) *(bf16x8*)(K_lds + (b) * SHM_K + krst) = sr_[i].kr; } while (0)
#define ATT_SWAIT() do { if constexpr (SDEPTH == 1) asm volatile("s_waitcnt vmcnt(0)" ::: "memory"); else if constexpr (DK == 192) asm volatile("s_waitcnt vmcnt(5)" ::: "memory"); else asm volatile("s_waitcnt vmcnt(4)" ::: "memory"); } while (0)
#define ATT_RESC(a) do { if (__any(((a)[0] < 1.f) || ((a)[1] < 1.f))) { if (lg == 0) { al_l[li] = (a)[0]; al_l[16 + li] = (a)[1]; } asm volatile("s_waitcnt lgkmcnt(0)" ::: "memory"); \
    const f32x4a a0_ = *reinterpret_cast<const f32x4a*>(al_l + 4 * lg), a1_ = *reinterpret_cast<const f32x4a*>(al_l + 16 + 4 * lg); \
    _Pragma("unroll") for (int d = 0; d < 8; ++d) { o[0][d] *= a0_; o[1][d] *= a1_; } } } while (0)
  f32x4a pA[2][4], pB[2][4]; float alA[2], alB[2]; bf16x8 pa[2][2]; const int NT = seq / KVBLK;
  constexpr int SE = 0, SO = SDEPTH - 1;
  ATT_SLOAD(SE, 0); asm volatile("s_waitcnt vmcnt(0)" ::: "memory"); ATT_SWRITE(0, SE); __syncthreads();
  qkt16<DK, NQR>(pA, K_lds, qr, qrl, kbn, kbr); partialSM16(pA, m_reg, alA, C, TS);
  ATT_SLOAD(SO, KVBLK); if constexpr (SDEPTH == 2) { if (2 < NT) ATT_SLOAD(SE, 2 * KVBLK); }
  if (2 < NT) ATT_SWAIT(); else asm volatile("s_waitcnt vmcnt(0)" ::: "memory");
  ATT_SWRITE(1, SO); __syncthreads();
  for (int j = 1; j + 1 < NT; j += 2) {
    ATT_SBAR(); qkt16<DK, NQR>(pB, K_lds + SHM_K, qr, qrl, kbn, kbr);
    finishSM16(pA, alA, l_reg, pa); ATT_SBAR();
    ATT_SLOAD(SO, (j + SDEPTH) * KVBLK); ATT_SBAR();
    pv16(o, vb0, pa); partialSM16(pB, m_reg, alB, C, TS);
    __syncthreads(); ATT_SWAIT(); ATT_SWRITE(0, SE);
    ATT_RESC(alB); __syncthreads();
    ATT_SBAR(); qkt16<DK, NQR>(pA, K_lds, qr, qrl, kbn, kbr);
    finishSM16(pB, alB, l_reg, pa); ATT_SBAR();
    if (SDEPTH == 1 || j + 3 < NT) ATT_SLOAD(SE, (j + 1 + SDEPTH) * KVBLK); ATT_SBAR();
    pv16(o, vb0 + SHM_V, pa); partialSM16(pA, m_reg, alA, C, TS);
    __syncthreads(); if (SDEPTH == 1 || j + 3 < NT) ATT_SWAIT(); else asm volatile("s_waitcnt vmcnt(0)" ::: "memory");
    ATT_SWRITE(1, SO);
    ATT_RESC(alA); __syncthreads();
  }
  ATT_SBAR(); qkt16<DK, NQR>(pB, K_lds + SHM_K, qr, qrl, kbn, kbr);
  finishSM16(pA, alA, l_reg, pa); ATT_SBAR();
  pv16(o, vb0, pa); partialSM16(pB, m_reg, alB, C, TS);
  __syncthreads(); ATT_RESC(alB);
  finishSM16(pB, alB, l_reg, pa); ATT_SBAR();
  pv16(o, vb0 + SHM_V, pa);
  if (lg == 0) { li_l[li] = l_reg[0]; li_l[16 + li] = l_reg[1]; } asm volatile("s_waitcnt lgkmcnt(0)" ::: "memory");
  f32x4a rl[2] = {*reinterpret_cast<const f32x4a*>(li_l + 4 * lg), *reinterpret_cast<const f32x4a*>(li_l + 16 + 4 * lg)};
#pragma unroll
  for (int qb = 0; qb < 2; ++qb)
#pragma unroll
    for (int r = 0; r < 4; ++r) rl[qb][r] = __builtin_amdgcn_rcpf(rl[qb][r]);
  bf16* Ow = Ob + (long)(wid * QBLK + 4 * lg) * LDO + li;
#pragma unroll
  for (int qb = 0; qb < 2; ++qb)
#pragma unroll
    for (int r = 0; r < 4; ++r)
#pragma unroll
      for (int db = 0; db < 8; ++db) { const unsigned w = cvtpk(o[qb][db][r] * rl[qb][r], 0.f); Ow[(long)(16 * qb + r) * LDO + 16 * db] = (bf16)(w & 0xffffu); }
#undef ATT_SLOAD
#undef ATT_SWRITE
#undef ATT_SWAIT
#undef ATT_RESC
}
}
constexpr int DM = 2048, NP = 4096  , NS = 16384  , MT = NP + NS  ;
constexpr int SEQ_P = 256, SEQ_S = 4096, PAST = 512, KEYS_S = SEQ_S + PAST  , MK = NP + 4 * KEYS_S  ;
constexpr int ZW = 3840  , AIN = 3648, FF = 5632, NLAYER = 4;
constexpr int ZC_QA = 0, ZC_KA = 1024, ZC_VA = 1280, ZC_QB = 1536, ZC_CKV = 3072, ZC_KR = 3584;
constexpr float EPS = 1e-6f;
constexpr size_t OUT_SK = (size_t)MT * DM, OUT_SV = OUT_SK + 2097152, OUT_SCKV = OUT_SV + 2097152, OUT_SKR = OUT_SCKV + 4194304;

constexpr size_t MiB = 1u << 20;
constexpr size_t WS_CTL = 0, CTL_ZERO_BYTES = 64 * 1024;
constexpr size_t WS_TAB = 1 * MiB;
constexpr size_t WS_MOD = 2 * MiB;
constexpr size_t WS_SS = 3 * MiB;
constexpr size_t WS_WIN = 6 * MiB;
constexpr size_t WS_WKV = 36 * MiB;
constexpr size_t WS_WOUT = 40 * MiB;
constexpr size_t WS_CWIN = 56 * MiB;
constexpr size_t WS_CWOUT = 88 * MiB;
constexpr size_t WS_FGU = 104 * MiB;
constexpr size_t WS_FD = 280 * MiB;
constexpr size_t WS_H = 368 * MiB;
constexpr size_t WS_ACT = 448 * MiB;
constexpr size_t WS_Z = WS_ACT;
constexpr size_t WS_KA = WS_Z + 150 * MiB;
constexpr size_t WS_VA = WS_KA + 11 * MiB;
constexpr size_t WS_CKV = WS_VA + 11 * MiB;
constexpr size_t WS_KR = WS_CKV + 22 * MiB;
constexpr size_t WS_KVB = WS_KR + 3 * MiB;
constexpr size_t WS_O = WS_KVB + 88 * MiB;
constexpr size_t WS_ACT_END = WS_O + 80 * MiB;
constexpr size_t WS_U = WS_ACT, WS_V = WS_ACT + 80 * MiB, WS_MC = WS_ACT + 160 * MiB;
constexpr size_t WS_HH = WS_ACT;
constexpr size_t WS_SSX = WS_ACT_END;
constexpr size_t WS_BIAS1 = WS_ACT_END + 3 * MiB;
constexpr size_t WS_BIAS2 = WS_ACT_END + 4 * MiB;
constexpr size_t WS_XB = WS_ACT_END + 8 * MiB;
constexpr size_t WS_PROBE = WS_ACT_END + 88 * MiB;
constexpr size_t WS_END = WS_ACT_END + 96 * MiB;
constexpr int CW_BAR = 1024;

constexpr int RING_BYTES = 131072;
#ifndef LDS_KB
#define LDS_KB 144
#endif
constexpr int LDS_BYTES = LDS_KB * 1024;
constexpr int MISC_OFF = LDS_BYTES - 64;
constexpr int NWAVES = 8, NTHREADS = 512;

#define GAS __attribute__((address_space(1)))
#define LAS __attribute__((address_space(3)))
typedef unsigned short bf16;
typedef unsigned v4u __attribute__((ext_vector_type(4)));
typedef unsigned v2u __attribute__((ext_vector_type(2)));
typedef float f32x4 __attribute__((ext_vector_type(4)));
typedef short bf16x8 __attribute__((ext_vector_type(8)));
typedef float f32x16 __attribute__((ext_vector_type(16)));
#define LDS_WAIT() asm volatile("s_waitcnt lgkmcnt(0)" ::: "memory")
#define VM_WAIT() asm volatile("s_waitcnt vmcnt(0)" ::: "memory")
__device__ __forceinline__ unsigned pk2(float lo, float hi) { unsigned r; asm volatile("v_cvt_pk_bf16_f32 %0, %1, %2" : "=v"(r) : "v"(lo), "v"(hi)); return r; }
__device__ __forceinline__ float bf_lo(unsigned w) { return __uint_as_float(w << 16); }
__device__ __forceinline__ float bf_hi(unsigned w) { return __uint_as_float(w & 0xffff0000u); }
#define SWZ_XOR(v, m) __int_as_float(__builtin_amdgcn_ds_swizzle(__float_as_int(v), ((m) << 10) | 0x1f))
__device__ __forceinline__ float add_xor32(float v) { auto rr = __builtin_amdgcn_permlane32_swap(__float_as_uint(v), __float_as_uint(v), false, false); return __uint_as_float(rr[0]) + __uint_as_float(rr[1]); }
__device__ __forceinline__ float wave_sum(float v) {
    v += SWZ_XOR(v, 1); v += SWZ_XOR(v, 2); v += SWZ_XOR(v, 4); v += SWZ_XOR(v, 8); v += SWZ_XOR(v, 16);
    return add_xor32(v);
}

#define XB_TMO      128
#define XB_XCNT(j)  (256  + 64 * (j))
#define XB_XSUB(j)  (1280 + 64 * (j))
#define XB_XGEN(j)  (2304 + 64 * (j))
#define XB_TOP      3328
#define XB_TOPGEN   3392
#define XCD_BAR_WORDS 3456
#define XB_SPIN_CAP (1u << 18)
#define LAS __attribute__((address_space(3)))

__device__ __forceinline__ unsigned xb_ld(unsigned* p)              { return __hip_atomic_load(p, __ATOMIC_RELAXED, __HIP_MEMORY_SCOPE_AGENT); }
__device__ __forceinline__ unsigned xb_add(unsigned* p, unsigned v) { return __hip_atomic_fetch_add(p, v, __ATOMIC_RELAXED, __HIP_MEMORY_SCOPE_AGENT); }
__device__ __forceinline__ unsigned xb_xcc_id() { return (unsigned)__builtin_amdgcn_s_getreg((3 << 11) | 20) & 0xFu; }
#define XB_SPIN(cond, bar) do { unsigned _sp = 0; while (cond) { __builtin_amdgcn_s_sleep(1); \
    if ((++_sp & 255u) == 0u) { if (xb_ld(&(bar)[XB_TMO])) break; if (_sp > XB_SPIN_CAP) { atomicAdd(&(bar)[XB_TMO], 1u); break; } } } } while (0)

struct XcdBarrier {
    unsigned* bar; unsigned x;
    volatile LAS unsigned* st;
};

__device__ __forceinline__ XcdBarrier xcd_barrier_post(unsigned* bar, volatile LAS unsigned* st) {
    XcdBarrier b; b.bar = bar; b.x = xb_xcc_id(); b.st = st;
    if (threadIdx.x == 0) (void)xb_add(&bar[XB_XCNT(b.x)], 1u);
    return b;
}
__device__ __forceinline__ void xcd_barrier_complete(unsigned* bar, unsigned x, unsigned& nloc, unsigned& nx) {
    const unsigned G = gridDim.x * gridDim.y * gridDim.z;
    unsigned sum, cnt, mine, sp = 0u;
    for (;;) {
        sum = 0u; cnt = 0u; mine = 0u;
#pragma unroll
        for (unsigned j = 0; j < 16; ++j) { const unsigned c = xb_ld(&bar[XB_XCNT(j)]); sum += c; cnt += (c > 0u) ? 1u : 0u; mine = (j == x) ? c : mine; }
        if (sum == G) break;
        __builtin_amdgcn_s_sleep(1);
        if ((++sp & 255u) == 0u) { if (xb_ld(&bar[XB_TMO])) break; if (sp > XB_SPIN_CAP) { atomicAdd(&bar[XB_TMO], 1u); break; } }
    }
    nloc = mine > 0u ? mine : 1u; nx = cnt > 0u ? cnt : 1u;
}

__device__ __forceinline__ void xcd_barrier(const XcdBarrier& b) {
    asm volatile("s_waitcnt vmcnt(0)" ::: "memory");
    __syncthreads();
    if (threadIdx.x == 0) {
        unsigned* bar = b.bar;
        __builtin_amdgcn_s_waitcnt(0);
        unsigned nloc = b.st[0], nx = b.st[1];
        if (nloc == 0u) { xcd_barrier_complete(bar, b.x, nloc, nx); b.st[0] = nloc; b.st[1] = nx; }
        const unsigned old = xb_add(&bar[XB_XSUB(b.x)], 1u);
        const unsigned gen = old / nloc;
        if (old + 1u == (gen + 1u) * nloc) {
            __builtin_amdgcn_fence(__ATOMIC_RELEASE, "agent");
            asm volatile("s_waitcnt vmcnt(0)" ::: "memory");
            const unsigned og = xb_add(&bar[XB_TOP], 1u);
            const unsigned tg = og / nx;
            if (og + 1u == (tg + 1u) * nx) xb_add(&bar[XB_TOPGEN], 1u);
            else XB_SPIN(xb_ld(&bar[XB_TOPGEN]) == tg, bar);
            __builtin_amdgcn_fence(__ATOMIC_ACQUIRE, "agent");
            xb_add(&bar[XB_XGEN(b.x)], 1u);
            asm volatile("s_waitcnt vmcnt(0)" ::: "memory");
        } else {
            XB_SPIN(xb_ld(&bar[XB_XGEN(b.x)]) == gen, bar);
            __builtin_amdgcn_fence(__ATOMIC_ACQUIRE, "agent");
            asm volatile("s_waitcnt vmcnt(0)" ::: "memory");
        }
    }
    __syncthreads();
}

struct Args { const GAS float* in[27]; GAS float* out_f; GAS unsigned char* ws_b; int ph_lo, ph_hi; };
typedef __attribute__((address_space(4))) const Args* KArgsPtr;
struct InProxy { KArgsPtr ka; __device__ __forceinline__ const float* operator[](int i) const { return (const float*)ka->in[i]; } };
struct Frame {
    LAS unsigned char* lds;
    char* ldsg;
    int tid, lane, wave, bid, G;
    InProxy in;
    float* out; unsigned char* ws;
};
#define PHASE_BEGIN(F) do { GAS unsigned char* w_ = (F).in.ka->ws_b; GAS float* o_ = (F).in.ka->out_f; int g_ = (int)gridDim.x, b_ = (int)blockIdx.x, t_ = (int)threadIdx.x; \
    asm volatile("" : "+s"(w_), "+s"(o_), "+s"(g_), "+s"(b_), "+v"(t_)); (F).ws = (unsigned char*)w_; (F).out = (float*)o_; (F).G = g_; (F).bid = b_; (F).tid = t_; (F).lane = t_ & 63; (F).wave = __builtin_amdgcn_readfirstlane(t_ >> 6); } while (0)
#define FRAME_REFRESH(F) do { } while (0)
#ifndef PROBE_T
#define PROBE_T 0
#endif
#define PROBE_STAMP(F, k) do { if (PROBE_T && blockIdx.x == 0 && threadIdx.x == 0) { ((unsigned long long*)((F).ws + WS_PROBE))[(k)] = __builtin_amdgcn_s_memrealtime(); ((unsigned long long*)((F).ws + WS_PROBE))[64 + (k)] = __builtin_amdgcn_s_memtime(); } } while (0)
enum { I_XP = 0, I_XS, I_C, I_CK, I_CV, I_CCKV, I_CKR, I_CCTX, I_ADAW, I_ADAB, I_NMIX, I_NFFN, I_FG, I_FU, I_FD, I_AWIN, I_AQN, I_AKN, I_AKVN, I_AWKV, I_AWOUT, I_CWIN, I_CVN, I_CWS, I_CBS, I_CWOUT, I_FNORM };

#ifndef NT_WEIGHTS
#define NT_WEIGHTS 1
#endif
#if NT_WEIGHTS
#define NT_LOAD4(p) __builtin_nontemporal_load(p)
#else
#define NT_LOAD4(p) (*(p))
#endif
struct ConvItem { const float* W; bf16* WT; int K, N, k0, n0, drow0; };
__device__ __forceinline__ void conv_issue(const ConvItem& c, f32x4 (&v)[16], int lane) {
    const int kr = lane >> 4, n4 = (lane & 15) * 4;
#pragma unroll
    for (int i = 0; i < 16; ++i) v[i] = NT_LOAD4((const GAS f32x4*)(c.W + (size_t)(c.k0 + 4 * i + kr) * c.N + c.n0 + n4));
}
__device__ __forceinline__ void conv_finish(const ConvItem& c, const f32x4 (&v)[16], LAS float* scr, int lane) {
    const int kr = lane >> 4, n4 = (lane & 15) * 4;
#pragma unroll
    for (int i = 0; i < 16; ++i) { LAS float* d = scr + (4 * i + kr) * 65 + n4; d[0] = v[i].x; d[1] = v[i].y; d[2] = v[i].z; d[3] = v[i].w; }
    LDS_WAIT(); asm volatile("" ::: "memory");
    const int cc = lane & 7;
#pragma unroll
    for (int j = 0; j < 8; ++j) { const int n = (lane >> 3) + 8 * j; const LAS float* s = scr + (8 * cc) * 65 + n;
        v4u o; o.x = pk2(s[0 * 65], s[1 * 65]); o.y = pk2(s[2 * 65], s[3 * 65]); o.z = pk2(s[4 * 65], s[5 * 65]); o.w = pk2(s[6 * 65], s[7 * 65]);
        *(GAS v4u*)(c.WT + (size_t)(c.drow0 + n) * c.K + c.k0 + 8 * cc) = o; }
    LDS_WAIT(); asm volatile("" ::: "memory");
}
__device__ __forceinline__ void rope_entry(int pos, int i, double r, float& co, float& si) {
    double inv = 1.0; for (int k = 0; k < i; ++k) inv *= r;
    const double ang = (double)pos * inv;
    const double n = __builtin_rint(ang * 0.63661977236758134308);
    const double x = (ang - n * 1.57079632679489655800) - n * 6.12323399573676603587e-17;
    const double x2 = x * x;
    const double s = x * (1.0 + x2 * (-1.0 / 6 + x2 * (1.0 / 120 + x2 * (-1.0 / 5040 + x2 * (1.0 / 362880 + x2 * (-1.0 / 39916800 + x2 * (1.0 / 6227020800.0 + x2 * (-1.0 / 1307674368000.0))))))));
    const double c = 1.0 + x2 * (-0.5 + x2 * (1.0 / 24 + x2 * (-1.0 / 720 + x2 * (1.0 / 40320 + x2 * (-1.0 / 3628800 + x2 * (1.0 / 479001600 + x2 * (-1.0 / 87178291200.0 + x2 * (1.0 / 20922789888000.0))))))));
    const int q = ((int)n) & 3;
    const double cc = (q == 0) ? c : (q == 1) ? -s : (q == 2) ? -c : s;
    const double ss = (q == 0) ? s : (q == 1) ? c : (q == 2) ? -s : -c;
    co = (float)cc; si = (float)ss;
}
__device__ __forceinline__ void ada_layer(Frame& F, int layer, int it_lo, int it_hi, int widx, int nwg) {
    LAS float* SC = (LAS float*)F.lds;
    LAS float* RED = (LAS float*)(F.lds + 40960);
    __syncthreads();
    for (int idx = F.tid; idx < 5 * DM; idx += NTHREADS) { const int cd = idx >> 11, k = idx & 2047; const float v = cd == 0 ? F.in[I_CCTX][k] : F.in[I_C][(cd - 1) * DM + k];
        SC[idx] = v / (1.0f + __expf(-v)); }
    __syncthreads();
    float* MOD = (float*)(F.ws + WS_MOD);
    for (int it = it_lo + widx; it < it_hi; it += nwg) {
        const int c0 = it * 32, cg = F.lane & 7, rsub = F.lane >> 3;
        const float* W = F.in[I_ADAW] + (size_t)layer * DM * 12288 + c0 + 4 * cg;
        f32x4 acc[5];
#pragma unroll
        for (int cd = 0; cd < 5; ++cd) acc[cd] = (f32x4){0.f, 0.f, 0.f, 0.f};
        f32x4 w[32];
#pragma unroll
        for (int i = 0; i < 32; ++i) w[i] = NT_LOAD4((const GAS f32x4*)(W + (size_t)(256 * F.wave + 8 * i + rsub) * 12288));
#pragma unroll
        for (int i = 0; i < 32; ++i) { const int k = 256 * F.wave + 8 * i + rsub;
#pragma unroll
            for (int cd = 0; cd < 5; ++cd) acc[cd] += SC[cd * DM + k] * w[i]; }
#pragma unroll
        for (int cd = 0; cd < 5; ++cd)
#pragma unroll
            for (int e = 0; e < 4; ++e) { float v = acc[cd][e]; v += SWZ_XOR(v, 8); v += SWZ_XOR(v, 16); v = add_xor32(v); acc[cd][e] = v; }
        if (rsub == 0) {
#pragma unroll
            for (int cd = 0; cd < 5; ++cd) *(LAS f32x4*)(RED + (F.wave * 5 + cd) * 32 + 4 * cg) = acc[cd]; }
        __syncthreads();
        if (F.tid < 160) { const int cd = F.tid >> 5, col = F.tid & 31; float s = 0.f;
#pragma unroll
            for (int w = 0; w < 8; ++w) s += RED[(w * 5 + cd) * 32 + col];
            MOD[((size_t)layer * 5 + cd) * 12288 + c0 + col] = s + F.in[I_ADAB][layer * 12288 + c0 + col]; }
        __syncthreads();
    }
}
__device__ __forceinline__ ConvItem conv_decode(Frame& F, int L, int part, int it) {
    constexpr int I_WIN = 32 * 57, I_WKV = 8 * 32, I_WOUT = 32 * 32, I_CWI = 32 * 64, I_FGU = 32 * 88;
    const int j = L >> 1; const bool attn = (L & 1) == 0;
    const float* W; bf16* WT; int K, N, r, gu = -1;
    if (part) { const int m = it / I_FGU; r = it % I_FGU;
        if (m < 2) { gu = m; K = DM; N = FF; W = (gu ? F.in[I_FU] : F.in[I_FG]) + (size_t)L * DM * FF; WT = (bf16*)(F.ws + WS_FGU) + (size_t)L * 2 * FF * DM; }
        else { K = FF; N = DM; W = F.in[I_FD] + (size_t)L * FF * DM; WT = (bf16*)(F.ws + WS_FD) + (size_t)L * DM * FF; } }
    else if (attn) {
        if (it < I_WIN) { r = it; K = DM; N = AIN; W = F.in[I_AWIN] + (size_t)j * DM * AIN; WT = (bf16*)(F.ws + WS_WIN) + (size_t)j * ZW * DM; }
        else if (it < I_WIN + I_WKV) { r = it - I_WIN; K = 512; N = 2048; W = F.in[I_AWKV] + (size_t)j * 512 * 2048; WT = (bf16*)(F.ws + WS_WKV) + (size_t)j * 2048 * 512; }
        else { r = it - I_WIN - I_WKV; K = DM; N = DM; W = F.in[I_AWOUT] + (size_t)j * DM * DM; WT = (bf16*)(F.ws + WS_WOUT) + (size_t)j * DM * DM; } }
    else {
        if (it < I_CWI) { r = it; K = DM; N = 4096; W = F.in[I_CWIN] + (size_t)j * DM * 4096; WT = (bf16*)(F.ws + WS_CWIN) + (size_t)j * 4096 * DM; }
        else { r = it - I_CWI; K = DM; N = DM; W = F.in[I_CWOUT] + (size_t)j * DM * DM; WT = (bf16*)(F.ws + WS_CWOUT) + (size_t)j * DM * DM; } }
    const int nblk = N / 64, kb = r / nblk, nb = r % nblk, n0 = 64 * nb;
    const int drow0 = (gu < 0) ? n0 : ((n0 >> 7) * 256 + gu * 128 + (n0 & 127));
    return ConvItem{W, WT, K, N, 64 * kb, n0, drow0};
}
__device__ __forceinline__ void conv_items(Frame& F, int L, int part, int widx, int nw, int it_lo = 0, int it_hi = 0x7fffffff) {
    LAS float* scr = (LAS float*)(F.lds + F.wave * 16640);
    constexpr int I_WIN = 32 * 57, I_WKV = 8 * 32, I_WOUT = 32 * 32, I_CWI = 32 * 64, I_FGU = 32 * 88;
    const bool attn = (L & 1) == 0;
    const int count_ = part ? 3 * I_FGU : (attn ? I_WIN + I_WKV + I_WOUT : I_CWI + I_WOUT), count = count_ < it_hi ? count_ : it_hi;
    f32x4 va[16], vb[16]; ConvItem ca, cb;
    int it = it_lo + widx;
    if (it < count) { ca = conv_decode(F, L, part, it); conv_issue(ca, va, F.lane); }
    while (it < count) {
        const int itb = it + nw; const bool hb = itb < count;
        if (hb) { cb = conv_decode(F, L, part, itb); conv_issue(cb, vb, F.lane); }
        conv_finish(ca, va, scr, F.lane);
        it = itb + nw;
        if (it < count) { ca = conv_decode(F, L, part, it); conv_issue(ca, va, F.lane); }
        if (hb) conv_finish(cb, vb, scr, F.lane);
    }
}
__device__ __forceinline__ void tail_slot(Frame& F, int first_idle, int& widx, int& nwg) {
    const int fi = (first_idle > 0 && first_idle < F.G) ? first_idle : 0; widx = F.bid - fi; nwg = F.G - fi;
}
#ifndef P0_DEFER8
#define P0_DEFER8 0
#endif
constexpr int P0_FFN_ITEMS = (3 * 32 * 88) * (8 - P0_DEFER8) / 8;
#ifndef SPAT_MRU
#define SPAT_MRU 0
#endif
#ifndef TAIL_CONV
#define TAIL_CONV 1
#endif
__device__ __forceinline__ void p0_prologue(Frame& F) {
    FRAME_REFRESH(F);
    for (int layer = 0; layer < (TAIL_CONV ? 1 : NLAYER); ++layer) ada_layer(F, layer, 0, 384, F.bid, F.G);
    if (F.bid == F.G - 1) {
        float* T128 = (float*)(F.ws + WS_TAB); float* T64 = (float*)(F.ws + WS_TAB + 16384);
        for (int e = F.tid; e < 64 * 32 + 64 * 16; e += NTHREADS) {
            float co, si;
            if (e < 2048) { rope_entry(e >> 5, e & 31, 0.74989420933245582730, co, si); T128[2 * e] = co; T128[2 * e + 1] = si; }
            else { const int f = e - 2048; rope_entry(f >> 4, f & 15, 0.56234132519034908039, co, si); T64[2 * f] = co; T64[2 * f + 1] = si; }
        }
    }
    { const size_t n16 = (size_t)(ZW - AIN) * DM * 2 / 16;
      for (size_t i = (size_t)F.bid * NTHREADS + F.tid; i < 2 * n16; i += (size_t)F.G * NTHREADS) { const size_t l = i / n16, r = i % n16;
          *(GAS v4u*)(F.ws + WS_WIN + l * ((size_t)ZW * DM * 2) + (size_t)AIN * DM * 2 + r * 16) = (v4u){0u, 0u, 0u, 0u}; } }
    __syncthreads();
    const int gw = F.bid * NWAVES + F.wave, NGW = F.G * NWAVES;
    for (int L = 0; L < (TAIL_CONV ? 1 : NLAYER); ++L) { conv_items(F, L, 0, gw, NGW); conv_items(F, L, 1, gw, NGW, 0, (L == 0 && TAIL_CONV) ? P0_FFN_ITEMS : 0x7fffffff); }
}

__device__ __forceinline__ void unpack8(const v4u w, float (&x)[8]) { x[0] = bf_lo(w.x); x[1] = bf_hi(w.x); x[2] = bf_lo(w.y); x[3] = bf_hi(w.y); x[4] = bf_lo(w.z); x[5] = bf_hi(w.z); x[6] = bf_lo(w.w); x[7] = bf_hi(w.w); }
__device__ __forceinline__ void mod0_phase(Frame& F, const float* x_lo, const float* x_hi, const float* gain, const float* modl  ) {
    bf16* H = (bf16*)(F.ws + WS_H); float* SSX = (float*)(F.ws + WS_SSX);
    const int gw = F.bid * NWAVES + F.wave, NGW = F.G * NWAVES;
    LAS float* GS = (LAS float*)F.lds;
    __syncthreads();
    for (int i = F.tid; i < 5 * DM / 4; i += NTHREADS) { const int cd = i >> 9, c4 = i & 511; const f32x4 g = ((const GAS f32x4*)gain)[c4], a = ((const GAS f32x4*)(modl + (size_t)cd * 12288 + DM))[c4];
        ((LAS f32x4*)GS)[i] = g * (1.0f + a); }
    __syncthreads();
#define MOD0_ROW(m_) (((m_) < NP) ? x_lo + (size_t)(m_) * DM : x_hi + (size_t)((m_) - NP) * DM)
    f32x4 v[8]; int m = gw;
    if (m < MT) { const float* xr = MOD0_ROW(m);
#pragma unroll
        for (int j = 0; j < 8; ++j) v[j] = ((const GAS f32x4*)xr)[F.lane + 64 * j]; }
    for (; m < MT; m += NGW) {
        const int mn = m + NGW; f32x4 vn[8];
        if (mn < MT) { const float* xn = MOD0_ROW(mn);
#pragma unroll
            for (int j = 0; j < 8; ++j) vn[j] = ((const GAS f32x4*)xn)[F.lane + 64 * j]; }
        const int cd = (m < NP) ? 0 : 1 + ((m - NP) >> 12);
        float s = 0.f;
#pragma unroll
        for (int j = 0; j < 8; ++j) s += (v[j].x * v[j].x + v[j].y * v[j].y) + (v[j].z * v[j].z + v[j].w * v[j].w);
        s = wave_sum(s);
        if (F.lane < 32) SSX[(size_t)m * 32 + F.lane] = F.lane == 0 ? s : 0.f;
        GAS v2u* o8 = (GAS v2u*)(H + (size_t)m * DM) + F.lane;
#pragma unroll
        for (int j = 0; j < 8; ++j) { const f32x4 y = v[j] * ((LAS f32x4*)GS)[cd * 512 + F.lane + 64 * j];
            v2u w; w.x = pk2(y.x, y.y); w.y = pk2(y.z, y.w); o8[64 * j] = w; }
#pragma unroll
        for (int j = 0; j < 8; ++j) v[j] = vn[j];
    }
#undef MOD0_ROW
}
__device__ __forceinline__ void bias_rows(Frame& F, const bf16* Bt, int nrows, const float* sh  , float* out, int ldb, int widx, int nw) {
    LAS float* SH = (LAS float*)F.lds;
    __syncthreads();
    for (int idx = F.tid; idx < 5 * DM; idx += NTHREADS) SH[idx] = sh[(size_t)(idx >> 11) * 12288 + (idx & 2047)];
    __syncthreads();
    v4u wn[4];
    if (widx < nrows) { const GAS v4u* bp = (const GAS v4u*)(Bt + (size_t)widx * DM) + F.lane;
#pragma unroll
        for (int i = 0; i < 4; ++i) wn[i] = bp[64 * i]; }
    for (int n = widx; n < nrows; n += nw) {
        v4u w[4];
#pragma unroll
        for (int i = 0; i < 4; ++i) w[i] = wn[i];
        if (n + nw < nrows) { const GAS v4u* bp = (const GAS v4u*)(Bt + (size_t)(n + nw) * DM) + F.lane;
#pragma unroll
            for (int i = 0; i < 4; ++i) wn[i] = bp[64 * i]; }
        float acc[5] = {0.f, 0.f, 0.f, 0.f, 0.f};
#pragma unroll
        for (int i = 0; i < 4; ++i) { float x[8]; unpack8(w[i], x);
#pragma unroll
            for (int cd = 0; cd < 5; ++cd) { const LAS f32x4* sp = (const LAS f32x4*)(SH + cd * DM + 8 * F.lane + 512 * i); const f32x4 a = sp[0], b = sp[1];
                acc[cd] += (x[0] * a.x + x[1] * a.y) + (x[2] * a.z + x[3] * a.w) + (x[4] * b.x + x[5] * b.y) + (x[6] * b.z + x[7] * b.w); } }
#pragma unroll
        for (int cd = 0; cd < 5; ++cd) { const float s = wave_sum(acc[cd]); if (F.lane == 0) out[(size_t)cd * ldb + n] = s; }
    }
    __syncthreads();
}
__device__ __forceinline__ void final_row(Frame& F, int m) {
    const bf16* HB = (const bf16*)(F.ws + WS_H); const float* SSX = (const float*)(F.ws + WS_SSX);
    const GAS v4u* xr = (const GAS v4u*)(HB + (size_t)m * DM); GAS f32x4* yr = (GAS f32x4*)(F.out + (size_t)m * DM);
    v4u w[4];
#pragma unroll
    for (int j = 0; j < 4; ++j) w[j] = xr[F.lane + 64 * j];
    float s = SSX[(size_t)m * 32 + (F.lane & 31)]; s += SWZ_XOR(s, 1); s += SWZ_XOR(s, 2); s += SWZ_XOR(s, 4); s += SWZ_XOR(s, 8); s += SWZ_XOR(s, 16);
    const float rstd = 1.0f / sqrtf(s * (1.0f / DM) + EPS);
#pragma unroll
    for (int j = 0; j < 4; ++j) { float v[8]; unpack8(w[j], v);
        yr[2 * (F.lane + 64 * j)] = (f32x4){v[0], v[1], v[2], v[3]} * rstd; yr[2 * (F.lane + 64 * j) + 1] = (f32x4){v[4], v[5], v[6], v[7]} * rstd; }
}
__device__ __forceinline__ void final_phase(Frame& F) {
    FRAME_REFRESH(F);
    const int gw = F.bid * NWAVES + F.wave, NGW = F.G * NWAVES;
    for (int m = gw; m < MT; m += NGW) final_row(F, m);
}

__device__ __forceinline__ void head_norm_rope16(float (&x)[16], int s, const float* gain128, bool rope, int prow, int pcol, const float* T128) {
    float ss = 0.f;
#pragma unroll
    for (int e = 0; e < 16; ++e) ss += x[e] * x[e];
    ss += SWZ_XOR(ss, 1); ss += SWZ_XOR(ss, 2); ss += SWZ_XOR(ss, 4);
    const float rstd = 1.0f / sqrtf(ss * (1.0f / 128.0f) + EPS);
#pragma unroll
    for (int e = 0; e < 16; ++e) x[e] = x[e] * rstd * gain128[16 * s + e];
    if (rope) {
        const int pos = (s >> 2) ? pcol : prow; const bool second = (s >> 1) & 1; const float* t = T128 + ((size_t)pos * 32 + 16 * (s & 1)) * 2;
#pragma unroll
        for (int e = 0; e < 16; ++e) { const float xp = SWZ_XOR(x[e], 2); const float co = t[2 * e], si = t[2 * e + 1];
            x[e] = x[e] * co + (second ? xp * si : -xp * si); }
    }
}
__device__ __forceinline__ void rope8(float (&x)[8], int s, int prow, int pcol, const float* T64) {
    const int pos = (s >> 2) ? pcol : prow; const bool second = (s >> 1) & 1; const float* t = T64 + ((size_t)pos * 16 + 8 * (s & 1)) * 2;
#pragma unroll
    for (int e = 0; e < 8; ++e) { const float xp = SWZ_XOR(x[e], 2); const float co = t[2 * e], si = t[2 * e + 1];
        x[e] = x[e] * co + (second ? xp * si : -xp * si); }
}
__device__ __forceinline__ v4u pack8(const float* x) { v4u w; w.x = pk2(x[0], x[1]); w.y = pk2(x[2], x[3]); w.z = pk2(x[4], x[5]); w.w = pk2(x[6], x[7]); return w; }
__device__ __forceinline__ void post_phase(Frame& F, int j, bool dry = false) {
    FRAME_REFRESH(F);
    bf16* Z = (bf16*)(F.ws + WS_Z); bf16* KA = (bf16*)(F.ws + WS_KA); bf16* VA = (bf16*)(F.ws + WS_VA); bf16* CKV = (bf16*)(F.ws + WS_CKV); bf16* KR = (bf16*)(F.ws + WS_KR);
    const float* T128 = (const float*)(F.ws + WS_TAB); const float* T64 = (const float*)(F.ws + WS_TAB + 16384);
    const float* qn = F.in[I_AQN] + j * 128; const float* kn = F.in[I_AKN] + j * 128; const float* kvn = F.in[I_AKVN] + j * 512;
    const int gw = F.bid * NWAVES + F.wave, NGW = F.G * NWAVES, lane = F.lane, s = lane & 7;
    for (int m = MT + gw; m < MT + 4 * PAST; m += NGW) {
            const int ci = m - MT, b = ci >> 9, p = ci & 511; const size_t krow = (size_t)NP + (size_t)b * KEYS_S + SEQ_S + p; const size_t src = ((size_t)(b * 2 + j) * PAST + p);
            { const f32x4 a = ((const GAS f32x4*)(F.in[I_CK] + src * 256))[lane]; v2u w; w.x = pk2(a.x, a.y); w.y = pk2(a.z, a.w); ((GAS v2u*)(KA + krow * 256))[lane] = w; }
            { const f32x4 a = ((const GAS f32x4*)(F.in[I_CV] + src * 256))[lane]; v2u w; w.x = pk2(a.x, a.y); w.y = pk2(a.z, a.w); ((GAS v2u*)(VA + krow * 256))[lane] = w; }
            { const f32x4 a = ((const GAS f32x4*)(F.in[I_CCKV] + src * 512))[2 * lane], c = ((const GAS f32x4*)(F.in[I_CCKV] + src * 512))[2 * lane + 1];
              v4u w; w.x = pk2(a.x, a.y); w.y = pk2(a.z, a.w); w.z = pk2(c.x, c.y); w.w = pk2(c.z, c.w); ((GAS v4u*)(CKV + krow * 512))[lane] = w; }
            if (lane < 16) { const f32x4 a = ((const GAS f32x4*)(F.in[I_CKR] + src * 64))[lane]; v2u w; w.x = pk2(a.x, a.y); w.y = pk2(a.z, a.w); ((GAS v2u*)(KR + krow * 64))[lane] = w; }
    }
    v4u nk0, nk1, nvv, ncw, nrw;
#define POST_LOAD(mm) do { const bf16* z_ = Z + (size_t)(mm) * ZW; \
        nk0 = ((const GAS v4u*)(z_ + ZC_KA))[2 * (lane & 15)]; nk1 = ((const GAS v4u*)(z_ + ZC_KA))[2 * (lane & 15) + 1]; \
        nvv = ((const GAS v4u*)(z_ + ZC_VA))[lane & 31]; \
        ncw = ((const GAS v4u*)(z_ + ZC_CKV))[lane]; nrw = ((const GAS v4u*)(z_ + ZC_KR))[s]; } while (0)
    if (gw < MT) POST_LOAD(gw);
    for (int m = gw; m < MT; m += NGW) {
        const bool lat = m >= NP; const int t = (m - NP) & 4095, prow = t >> 6, pcol = t & 63;
        const size_t krow = lat ? (size_t)NP + (size_t)((m - NP) >> 12) * KEYS_S + t : (size_t)m;
        bf16* zr = Z + (size_t)m * ZW;
        const v4u k0 = nk0, k1 = nk1, vv = nvv, cw = ncw, rw = nrw;
        if (m + NGW < MT) POST_LOAD(m + NGW);
        { float x[16]; float xa[8], xb[8]; unpack8(k0, xa); unpack8(k1, xb);
#pragma unroll
          for (int e = 0; e < 8; ++e) { x[e] = xa[e]; x[8 + e] = xb[e]; }
          head_norm_rope16(x, s, kn, false, 0, 0, T128);
          if (!lat && lane < 16) { float* so = F.out + OUT_SK + ((size_t)((m >> 8) * 2 + j) * SEQ_P + (m & 255)) * 256 + 16 * lane;
#pragma unroll
              for (int e = 0; e < 4; ++e) ((GAS f32x4*)so)[e] = (f32x4){x[4 * e], x[4 * e + 1], x[4 * e + 2], x[4 * e + 3]}; }
          if (lat) { const int pos = (s >> 2) ? pcol : prow; const bool second = (s >> 1) & 1; const float* tt = T128 + ((size_t)pos * 32 + 16 * (s & 1)) * 2;
#pragma unroll
              for (int e = 0; e < 16; ++e) { const float xp = SWZ_XOR(x[e], 2); x[e] = x[e] * tt[2 * e] + (second ? xp * tt[2 * e + 1] : -xp * tt[2 * e + 1]); } }
          if (lane < 16) { ((GAS v4u*)(KA + krow * 256))[2 * lane] = pack8(x); ((GAS v4u*)(KA + krow * 256))[2 * lane + 1] = pack8(x + 8); } }
        if (lane < 32) { ((GAS v4u*)(VA + krow * 256))[lane] = vv;
            if (!lat) { float x[8]; unpack8(vv, x); float* so = F.out + OUT_SV + ((size_t)((m >> 8) * 2 + j) * SEQ_P + (m & 255)) * 256 + 8 * lane;
                ((GAS f32x4*)so)[0] = (f32x4){x[0], x[1], x[2], x[3]}; ((GAS f32x4*)so)[1] = (f32x4){x[4], x[5], x[6], x[7]}; } }
        { float x[8]; unpack8(cw, x); float ss = 0.f;
#pragma unroll
          for (int e = 0; e < 8; ++e) ss += x[e] * x[e];
          const float rstd = 1.0f / sqrtf(wave_sum(ss) * (1.0f / 512.0f) + EPS);
#pragma unroll
          for (int e = 0; e < 8; ++e) x[e] = x[e] * rstd * kvn[8 * lane + e];
          ((GAS v4u*)(CKV + krow * 512))[lane] = pack8(x);
          if (!lat) { float* so = F.out + OUT_SCKV + ((size_t)((m >> 8) * 2 + j) * SEQ_P + (m & 255)) * 512 + 8 * lane;
              ((GAS f32x4*)so)[0] = (f32x4){x[0], x[1], x[2], x[3]}; ((GAS f32x4*)so)[1] = (f32x4){x[4], x[5], x[6], x[7]}; } }
        { float x[8]; unpack8(rw, x);
          if (!lat && lane < 8) { float* so = F.out + OUT_SKR + ((size_t)((m >> 8) * 2 + j) * SEQ_P + (m & 255)) * 64 + 8 * lane;
              ((GAS f32x4*)so)[0] = (f32x4){x[0], x[1], x[2], x[3]}; ((GAS f32x4*)so)[1] = (f32x4){x[4], x[5], x[6], x[7]}; }
          if (lat) rope8(x, s, prow, pcol, T64);
          if (lane < 8) ((GAS v4u*)(KR + krow * 64))[lane] = pack8(x); }
    }
}

#ifndef ATT_DMA
#define ATT_DMA 0
#endif
#ifndef ATT_MLA_SD
#define ATT_MLA_SD 1
#endif
#ifndef ATT_MLA_NQR
#define ATT_MLA_NQR 6
#endif
#ifndef EN_ATT_GQA
#define EN_ATT_GQA 1
#endif
#ifndef EN_ATT_MLA
#define EN_ATT_MLA 1
#endif
#undef POST_LOAD
constexpr int BIAS_LDS_OFF = RING_BYTES, BIAS_LDS_UNITS = 14;
static_assert(BIAS_LDS_OFF + BIAS_LDS_UNITS * 1024 <= MISC_OFF, "bias table vs the LDS map");
__device__ __forceinline__ void bias_to_lds(Frame& F, const pg8::StaticOrder& S, const float* bias, int ldb) {
    LAS float* tb = (LAS float*)(F.lds + BIAS_LDS_OFF);
    __syncthreads();
    const int half = F.tid >> 8, t = F.tid & 255; pg8::Unit u;
#pragma unroll
    for (int i0 = 0; i0 < BIAS_LDS_UNITS; i0 += 2) { const int i = i0 + half; if (S.next(i, u)) tb[i * 256 + t] = bias[(size_t)pg8::cond_of_pm(u.pm) * ldb + u.pn * 256 + t]; }
    __syncthreads();
}
constexpr int RES_LDS_UNITS = 4;
static_assert(BIAS_LDS_OFF + RES_LDS_UNITS * 3072 <= MISC_OFF, "residual tables vs the LDS map");
__device__ __forceinline__ void res_tables_to_lds(Frame& F, const pg8::StaticOrder& S, const float* gate, const float* gnorm, const float* scale, const float* pnorm, const float* pscale) {
    LAS float* tb = (LAS float*)(F.lds + BIAS_LDS_OFF);
    __syncthreads();
    const int half = F.tid >> 8, t = F.tid & 255; pg8::Unit u;
#pragma unroll
    for (int i0 = 0; i0 < RES_LDS_UNITS; i0 += 2) { const int i = i0 + half;
        if (S.next(i, u)) { const int cd = pg8::cond_of_pm(u.pm), col = u.pn * 256 + t;
            tb[i * 768 + t] = gate[(size_t)cd * 12288 + col];
            tb[i * 768 + 256 + t] = gnorm[col] * (scale ? 1.0f + scale[(size_t)cd * 12288 + col] : 1.0f);
            const float tp = pnorm[col] * (1.0f + pscale[(size_t)cd * 12288 + col]); tb[i * 768 + 512 + t] = tp != 0.f ? 1.0f / tp : 0.f; } }
    __syncthreads();
}
static_assert(2 * 16384 + 2 * 64 * 192 * 2 + 2048 + 8 * (12 - ATT_MLA_NQR) * 1024 <= MISC_OFF, "attention LDS use vs the LDS map");
static_assert(384 * 272 + 1024 <= MISC_OFF && 8 * 16640 <= MISC_OFF, "phase scratch vs the LDS map");
#if ATT_DMA
#ifndef ATT_DMA_NQR
#define ATT_DMA_NQR 10
#endif
#error the LDS-DMA attention variant does not carry the fused Q-side norm/rope
#define ATT_GQA_UNIT(QM) att::attn_unit_dma<128, ZW, 256, 256, DM, 8>
#define ATT_MLA_UNIT(QM) att::attn_unit_dma<192, ZW, DM, DM, DM, ATT_DMA_NQR>
#define ATT_LDSL , F.lds
static_assert(3 * (64 * 192 * 2 + 16384) + 2048 + 8 * (12 - ATT_DMA_NQR) * 1024 <= MISC_OFF, "attention ring vs the LDS map");
#else
#ifndef ATT16
#define ATT16 0
#endif
#ifndef ATT16_GSD
#define ATT16_GSD 2
#endif
#ifndef ATT16_GNQR
#define ATT16_GNQR 8
#endif
#if ATT16 & 1
#define ATT_GQA_UNIT(QM) att::attn_unit16<128, ZW, 256, 256, DM, ATT16_GSD, ATT16_GNQR, QM>
#else
#define ATT_GQA_UNIT(QM) att::attn_unit<128, ZW, 256, 256, DM, 2, 8, QM>
#endif
#if ATT16 & 2
#define ATT_MLA_UNIT(QM) att::attn_unit16<192, ZW, DM, DM, DM, ATT_MLA_SD, ATT_MLA_NQR, QM>
#else
#define ATT_MLA_UNIT(QM) att::attn_unit<192, ZW, DM, DM, DM, ATT_MLA_SD, ATT_MLA_NQR, QM>
#endif
#define ATT_LDSL
#endif
__device__ __forceinline__ void attn_phase(Frame& F, int j) {
    const float* qn = F.in[I_AQN] + j * 128; const float* T128 = (const float*)(F.ws + WS_TAB); const float* T64 = (const float*)(F.ws + WS_TAB + 16384);
    const bf16* Z = (const bf16*)(F.ws + WS_Z); const bf16* KA = (const bf16*)(F.ws + WS_KA); const bf16* VA = (const bf16*)(F.ws + WS_VA);
    const bf16* KR = (const bf16*)(F.ws + WS_KR); const bf16* KVB = (const bf16*)(F.ws + WS_KVB); bf16* O = (bf16*)(F.ws + WS_O);
#if EN_ATT_GQA
    for (int L = F.bid; L < 512; L += F.G) {
        const int x = L & 7, s = L >> 3, b = x >> 1, kvh = x & 1, h = kvh * 4 + (s >> 4), qb = s & 15;
        const size_t qrow = (size_t)NP + (size_t)b * SEQ_S + qb * 256, krow = (size_t)NP + (size_t)b * KEYS_S;
        ATT_GQA_UNIT(2)(Z + qrow * ZW + ZC_QA + h * 128, KA + krow * 256 + kvh * 128, nullptr, VA + krow * 256 + kvh * 128, O + qrow * DM + h * 128, KEYS_S, F.ldsg ATT_LDSL, qn, T128, qb * 256);
    }
#endif
#if EN_ATT_MLA
    for (int L = F.bid; L < 512; L += F.G) {
        const int x = L & 7, s = L >> 3, b = x >> 1, h = (x & 1) * 4 + (s >> 4), qb = s & 15;
        const size_t qrow = (size_t)NP + (size_t)b * SEQ_S + qb * 256, krow = (size_t)NP + (size_t)b * KEYS_S;
        ATT_MLA_UNIT(3)(Z + qrow * ZW + ZC_QB + h * 192, KVB + krow * DM + h * 256, KR + krow * 64, KVB + krow * DM + h * 256 + 128, O + qrow * DM + 1024 + h * 128, KEYS_S, F.ldsg ATT_LDSL, nullptr, T64, qb * 256);
    }
#endif
#if EN_ATT_GQA
    for (int L = F.bid; L < 128; L += F.G) {
        const int b = L >> 3, h = L & 7, kvh = h >> 2; const size_t row = (size_t)b * SEQ_P;
        ATT_GQA_UNIT(1)(Z + row * ZW + ZC_QA + h * 128, KA + row * 256 + kvh * 128, nullptr, VA + row * 256 + kvh * 128, O + row * DM + h * 128, SEQ_P, F.ldsg ATT_LDSL, qn, nullptr, 0);
    }
#endif
#if EN_ATT_MLA
    for (int L2 = F.bid; L2 < 256; L2 += F.G) { if (L2 < 128 && F.G > 128) continue; const int L = L2 & 127;
        const int b = L >> 3, h = L & 7; const size_t row = (size_t)b * SEQ_P;
        ATT_MLA_UNIT(0)(Z + row * ZW + ZC_QB + h * 192, KVB + row * DM + h * 256, KR + row * 64, KVB + row * DM + h * 256 + 128, O + row * DM + 1024 + h * 128, SEQ_P, F.ldsg ATT_LDSL, nullptr, nullptr, 0);
    }
#endif
    __syncthreads();
}

__device__ __forceinline__ void spatial_phase(Frame& F, int j) {
    FRAME_REFRESH(F);
    const bf16* U = (const bf16*)(F.ws + WS_U); const bf16* V = (const bf16*)(F.ws + WS_V); bf16* MC = (bf16*)(F.ws + WS_MC); const float* SS = (const float*)(F.ws + WS_SS);
    const float* Ws = F.in[I_CWS] + (size_t)j * 8 * 128 * 128; const float* bs = F.in[I_CBS] + j * 8 * 128; const float* gn = F.in[I_CVN] + j * DM;
    constexpr int RSB = 272, UTB = 528;
    LAS unsigned char* As = F.lds; LAS unsigned char* Vt = F.lds + 128 * RSB; LAS float* RS = (LAS float*)(F.lds + 384 * RSB); LAS float* BS = RS + 128; LAS unsigned char* UT = Vt;
    static_assert(128 * UTB <= 256 * RSB, "UT overlays Vt");
    const int tid0 = F.tid, wr = F.wave >> 2, wc = F.wave & 3;
    v4u vr[8], ur[8]; f32x4 ssa, ssb; int g_built = -1;
#define SPAT_ITEM(it_, n_, g_) const int g_ = (it_) & 7; int n_ = (it_) >> 3; \
        if (SPAT_MRU && F.G == 256) { const int r_ = (it_) >> 8, q_ = ((it_) >> 3) & 31, off_ = r_ == 0 ? 16 : r_ == 1 ? 4 : r_ == 2 ? 12 : r_ == 3 ? 8 : 0; n_ = 2 * (20 * (q_ >> 3) + off_ + ((q_ >> 1) & 3)) + (q_ & 1); }
#define SPAT_LOADS(it_) do { SPAT_ITEM(it_, nn_, gg_); const int rr0_ = nn_ * 128; int tid = tid0; asm volatile("" : "+v"(tid)); \
        { const GAS f32x4* sp = (const GAS f32x4*)(SS + (size_t)rr0_ * 32) + 2 * tid; ssa = sp[0]; ssb = sp[1]; }     \
        _Pragma("unroll") for (int i = 0; i < 8; ++i) { const int idx = tid + NTHREADS * i, q = idx >> 5, c8 = (idx & 31) * 8; vr[i] = *(const GAS v4u*)(V + (size_t)(rr0_ + q) * DM + gg_ * 256 + c8); } } while (0)
    if (F.bid < 160 * 8) SPAT_LOADS(F.bid);
    for (int it = F.bid; it < 160 * 8; it += F.G) {
        SPAT_ITEM(it, n, g); const int r0 = n * 128;
        int tid = tid0; asm volatile("" : "+v"(tid)); const int lane = tid & 63, r32 = lane & 31, hi = lane >> 5;
        __syncthreads();
        { float s = ((ssa.x + ssa.y) + (ssa.z + ssa.w)) + ((ssb.x + ssb.y) + (ssb.z + ssb.w)); s += SWZ_XOR(s, 1); s += SWZ_XOR(s, 2);
          if ((tid & 3) == 0) RS[tid >> 2] = 1.0f / sqrtf(s * (1.0f / 2048.0f) + EPS); }
        if (g != g_built) { g_built = g;
            if (tid < 128) BS[tid] = bs[g * 128 + tid];
#pragma unroll
            for (int i = 0; i < 8; ++i) { const int idx = tid + NTHREADS * i, p = idx >> 5, q4 = (idx & 31) * 4; const f32x4 w = *(const GAS f32x4*)(Ws + (size_t)g * 16384 + p * 128 + q4);
                v2u o; o.x = pk2(w.x, w.y); o.y = pk2(w.z, w.w); *(LAS v2u*)(As + p * RSB + q4 * 2) = o; } }
#pragma unroll
        for (int i = 0; i < 8; ++i) { const int idx = tid + NTHREADS * i, p = idx >> 5, c8 = (idx & 31) * 8; ur[i] = *(const GAS v4u*)(U + (size_t)(r0 + p) * DM + g * 256 + c8); }
        __syncthreads();
#pragma unroll
        for (int i = 0; i < 8; ++i) { const int idx = tid + NTHREADS * i, q = idx >> 5, cb = idx & 31; const v4u w = vr[i]; const float rs = RS[q];
            const unsigned w0 = pk2(bf_lo(w.x) * rs, bf_hi(w.x) * rs), w1 = pk2(bf_lo(w.y) * rs, bf_hi(w.y) * rs), w2 = pk2(bf_lo(w.z) * rs, bf_hi(w.z) * rs), w3 = pk2(bf_lo(w.w) * rs, bf_hi(w.w) * rs);
            LAS unsigned short* d = (LAS unsigned short*)(Vt + (cb * 8) * RSB + ((((q >> 3) ^ (cb & 15)) << 4) | ((q & 7) * 2)));
            d[0 * (RSB / 2)] = (unsigned short)(w0 & 0xffffu); d[1 * (RSB / 2)] = (unsigned short)(w0 >> 16); d[2 * (RSB / 2)] = (unsigned short)(w1 & 0xffffu); d[3 * (RSB / 2)] = (unsigned short)(w1 >> 16);
            d[4 * (RSB / 2)] = (unsigned short)(w2 & 0xffffu); d[5 * (RSB / 2)] = (unsigned short)(w2 >> 16); d[6 * (RSB / 2)] = (unsigned short)(w3 & 0xffffu); d[7 * (RSB / 2)] = (unsigned short)(w3 >> 16); }
        __syncthreads();
        f32x16 acc[2][2];
#pragma unroll
        for (int a = 0; a < 2; ++a)
#pragma unroll
            for (int b = 0; b < 2; ++b) acc[a][b] = (f32x16){};
#pragma unroll
        for (int ks = 0; ks < 8; ++ks) { bf16x8 af[2], bfr[2];
#pragma unroll
            for (int a = 0; a < 2; ++a) af[a] = *(LAS bf16x8*)(As + (64 * wr + 32 * a + r32) * RSB + (16 * ks + 8 * hi) * 2);
#pragma unroll
            for (int b = 0; b < 2; ++b) { const int c = 64 * wc + 32 * b + r32; bfr[b] = *(LAS bf16x8*)(Vt + c * RSB + (((2 * ks + hi) ^ ((c >> 3) & 15)) << 4)); }
#pragma unroll
            for (int a = 0; a < 2; ++a)
#pragma unroll
                for (int b = 0; b < 2; ++b) acc[a][b] = __builtin_amdgcn_mfma_f32_32x32x16_bf16(af[a], bfr[b], acc[a][b], 0, 0, 0); }
        __syncthreads();
#pragma unroll
        for (int i = 0; i < 8; ++i) { const int idx = tid + NTHREADS * i, p = idx >> 5, c8 = (idx & 31) * 8; *(LAS v4u*)(UT + p * UTB + c8 * 2) = ur[i]; }
        __syncthreads();
        if (it + F.G < 160 * 8) SPAT_LOADS(it + F.G);
#pragma unroll
        for (int b = 0; b < 2; ++b) { const int cl = 64 * wc + 32 * b + r32; const float gnc = gn[g * 256 + cl];
#pragma unroll
            for (int a = 0; a < 2; ++a)
#pragma unroll
                for (int r = 0; r < 16; ++r) { const int p = 64 * wr + 32 * a + (r & 3) + 8 * (r >> 2) + 4 * hi; LAS unsigned short* e = (LAS unsigned short*)(UT + p * UTB + cl * 2);
                    const float u = __uint_as_float(((unsigned)*e) << 16);
                    const unsigned w = pk2(u * (gnc * acc[a][b][r] + BS[p]), 0.f); *e = (unsigned short)(w & 0xffffu); } }
        __syncthreads();
#pragma unroll
        for (int i = 0; i < 8; ++i) { const int idx = tid + NTHREADS * i, p = idx >> 5, c8 = (idx & 31) * 8; *(GAS v4u*)(MC + (size_t)(r0 + p) * DM + g * 256 + c8) = *(LAS v4u*)(UT + p * UTB + c8 * 2); }
    }
#undef SPAT_ITEM
#undef SPAT_LOADS
}

#ifndef EN_DEFAULT
#define EN_DEFAULT 1
#endif
#ifndef EN_P0
#define EN_P0 EN_DEFAULT
#endif
#ifndef EN_MOD
#define EN_MOD EN_DEFAULT
#endif
#ifndef EN_G1
#define EN_G1 EN_DEFAULT
#endif
#ifndef EN_POST
#define EN_POST EN_DEFAULT
#endif
#ifndef EN_KVUP
#define EN_KVUP EN_DEFAULT
#endif
#ifndef EN_ATT
#define EN_ATT EN_DEFAULT
#endif
#ifndef EN_G4
#define EN_G4 EN_DEFAULT
#endif
#ifndef EN_SPAT
#define EN_SPAT EN_DEFAULT
#endif
#ifndef EN_OUT
#define EN_OUT EN_DEFAULT
#endif
#ifndef EN_FUP
#define EN_FUP EN_DEFAULT
#endif
#ifndef EN_FDN
#define EN_FDN EN_DEFAULT
#endif
#ifndef EN_FIN
#define EN_FIN EN_DEFAULT
#endif
#ifndef REP_POST
#define REP_POST 1
#endif
#ifndef REP_BAR
#define REP_BAR 1
#endif
#ifndef REP_P0
#define REP_P0 1
#endif
#ifndef REP_MOD
#define REP_MOD 1
#endif
#ifndef REP_G1
#define REP_G1 1
#endif
#ifndef REP_KVUP
#define REP_KVUP 1
#endif
#ifndef REP_ATT
#define REP_ATT 1
#endif
#ifndef REP_G4
#define REP_G4 1
#endif
#ifndef REP_SPAT
#define REP_SPAT 1
#endif
#ifndef REP_FUP
#define REP_FUP 1
#endif
#ifndef REP_OUT
#define REP_OUT 1
#endif
#ifndef REP_FDN
#define REP_FDN 1
#endif
#ifndef WGM_G1
#define WGM_G1 PG8_WGM
#endif
#ifndef WGM_KV
#define WGM_KV PG8_WGM
#endif
#ifndef WGM_G4
#define WGM_G4 PG8_WGM
#endif
#ifndef WGM_FUP
#define WGM_FUP PG8_WGM
#endif
#ifndef WGM_RES
#define WGM_RES PG8_WGM
#endif
#ifndef STAGGER_TICKS
#define STAGGER_TICKS 0
#endif
#define STAGGER(F) do { if (STAGGER_TICKS > 0) { const unsigned long long t0_ = __builtin_amdgcn_s_memrealtime(), d_ = (unsigned long long)(((F).bid >> 3) & 3) * STAGGER_TICKS; \
    while (__builtin_amdgcn_s_memrealtime() - t0_ < d_) __builtin_amdgcn_s_sleep(4); } } while (0)
#ifndef FDN_REV
#define FDN_REV 1
#endif
#ifndef G1_DEFER2
#define G1_DEFER2 1
#endif
#ifndef DEFER_DOWN3
#define DEFER_DOWN3 1
#endif
#ifndef DEFER2_8
#define DEFER2_8 P0_DEFER8
#endif
constexpr int P2_FFN_ITEMS = (3 * 32 * 88) * (8 - DEFER2_8) / 8;
#ifndef FDN_ALL_ITEMS
#define FDN_ALL_ITEMS 0
#endif
#ifndef FUP_ALIGN_EPI
#define FUP_ALIGN_EPI true
#endif
#ifndef G1_ALIGN_EPI
#define G1_ALIGN_EPI true
#endif
#ifndef G4_ALIGN_EPI
#define G4_ALIGN_EPI true
#endif
#ifndef KV_ALIGN_EPI
#define KV_ALIGN_EPI true
#endif
#ifndef ADA_FUP_ITEMS
#define ADA_FUP_ITEMS 128
#endif
#ifndef ADA_IN_FUP
#define ADA_IN_FUP 1
#endif
#ifndef EARLY_FIN
#define EARLY_FIN 1
#endif
constexpr int CW_RDY = 6144;
static_assert(CW_RDY >= CW_BAR + XCD_BAR_WORDS && (CW_RDY + 64 * 80) * 4 <= (int)CTL_ZERO_BYTES, "arrival counters vs the control block");
__device__ __forceinline__ void fdn_panel_lists(Frame& F, LAS unsigned* lst) {
    LAS unsigned* msk = lst + 60;
    __syncthreads();
    if (F.tid < 3) msk[F.tid] = 0u;
    __syncthreads();
    if (F.tid < F.G) { pg8::StaticOrder S; S.init(MT, DM, F.G, F.tid, WGM_RES, FDN_REV); pg8::Unit u; if (S.next(2, u)) (void)__hip_atomic_fetch_or(&msk[u.pm >> 5], 1u << (u.pm & 31), __ATOMIC_RELAXED, __HIP_MEMORY_SCOPE_WORKGROUP); }
    __syncthreads();
    if (F.tid == 0) { unsigned ne = 0, nl = 0; LAS unsigned char* eb = (LAS unsigned char*)lst + 16; LAS unsigned char* lb = (LAS unsigned char*)lst + 112;
        for (int pm = 0; pm < MT / 256; ++pm) { if ((msk[pm >> 5] >> (pm & 31)) & 1u) lb[nl++] = (unsigned char)pm; else eb[ne++] = (unsigned char)pm; }
        lst[0] = ne; lst[1] = nl; }
    __syncthreads();
}
#define EARLY_FIN_ON(F) (EARLY_FIN && (F).G == 256)
__device__ __forceinline__ void early_final(Frame& F, int widx) {
    LAS unsigned* lst = (LAS unsigned*)F.lds;
    fdn_panel_lists(F, lst);
    const int ne = (int)lst[0];
    if (widx < 2 * ne && widx < 128) {
        const int pm = ((LAS unsigned char*)lst)[16 + (widx >> 1)];
        if (F.tid < 64) { unsigned* arr = (unsigned*)(F.ws + WS_CTL) + CW_RDY; unsigned sp = 0;
            while ((unsigned)__builtin_amdgcn_readfirstlane(__hip_atomic_load(arr, __ATOMIC_RELAXED, __HIP_MEMORY_SCOPE_AGENT)) < (unsigned)F.G) { __builtin_amdgcn_s_sleep(4); if (++sp > (1u << 20)) break; }
            __builtin_amdgcn_fence(__ATOMIC_ACQUIRE, "agent"); asm volatile("s_waitcnt vmcnt(0)" ::: "memory"); }
        __syncthreads();
        for (int r = F.wave; r < 128; r += NWAVES) final_row(F, pm * 256 + (widx & 1) * 128 + r);
    }
}
__device__ __forceinline__ void final_phase_rest(Frame& F) {
    LAS unsigned* lst = (LAS unsigned*)F.lds;
    fdn_panel_lists(F, lst);
    const int ne = (int)lst[0], nl = (int)lst[1], nx = ne > 64 ? ne - 64 : 0, rows = (nl + nx) * 256;
    const int gw = F.bid * NWAVES + F.wave, NGW = F.G * NWAVES;
    for (int idx = gw; idx < rows; idx += NGW) { const int pi = idx >> 8; const int pm = pi < nl ? ((LAS unsigned char*)lst)[112 + pi] : ((LAS unsigned char*)lst)[16 + 64 + (pi - nl)];
        final_row(F, pm * 256 + (idx & 255)); }
}
constexpr int NPHASE = 38;
__global__ void __launch_bounds__(NTHREADS, 2) fwd(Args args) {
    extern __shared__ __attribute__((aligned(1024))) unsigned char lds[];
    Frame F;
    F.lds = (LAS unsigned char*)lds; F.ldsg = (char*)lds;
    F.in.ka = (KArgsPtr)__builtin_amdgcn_kernarg_segment_ptr();
    PHASE_BEGIN(F);
    const int lo = args.ph_lo, hi = args.ph_hi; const bool multi = (hi - lo) > 1;
    if (F.tid < 4) ((LAS unsigned*)(F.lds + MISC_OFF))[F.tid] = 0u;
    __syncthreads();
    if (multi) (void)xcd_barrier_post((unsigned*)(F.ws + WS_CTL) + CW_BAR, (volatile LAS unsigned*)(F.lds + MISC_OFF));
#define IN(k) (lo <= (k) && (k) < hi)
#ifndef CODE_WARM
#define CODE_WARM 0
#endif
#if CODE_WARM
    if (lo == 0) { const char* pc = (const char*)(__builtin_amdgcn_s_getpc() & ~0xFFull); unsigned acc = 0;
#pragma unroll 8
        for (int i = F.tid; i < 14848; i += NTHREADS) { const v4u w = *(const GAS v4u*)(pc + (size_t)i * 16); acc ^= (w.x ^ w.y) ^ (w.z ^ w.w); }
        if (acc == 0x9e3779b9u && F.tid == 12345) ((GAS unsigned*)(F.ws + WS_PROBE))[0] = acc; }
#endif
#define SEAM(k) do { if (multi && (k) + 1 < hi) { XcdBarrier b_; b_.bar = (unsigned*)(F.ws + WS_CTL) + CW_BAR; b_.x = xb_xcc_id(); b_.st = (volatile LAS unsigned*)(F.lds + MISC_OFF); for (int rb_ = 0; rb_ < REP_BAR; ++rb_) xcd_barrier(b_); } } while (0)

#define X (F.out)
#define H ((bf16*)(F.ws + WS_H))
#define LAYER_VARS() PHASE_BEGIN(F); int L = L_; asm volatile("" : "+s"(L)); const int j = L >> 1; const bool attn = (L & 1) == 0; const float* modl = (const float*)(F.ws + WS_MOD) + (size_t)L * 5 * 12288; (void)j; (void)attn; (void)modl

    #if EN_P0
    if (IN(0)) { PHASE_BEGIN(F); PROBE_STAMP(F, 0); for (int rep_ = 0; rep_ < REP_P0; ++rep_) { p0_prologue(F); __syncthreads(); } SEAM(0); }
#endif

    for (int L_ = 0; L_ < NLAYER; ++L_) {
        const int pb = 1 + 9 * L_; const bool attn_ = (L_ & 1) == 0;
#if EN_MOD
        if (L_ == 0 && IN(pb + 0)) { LAYER_VARS(); PROBE_STAMP(F, pb + 0);
            mod0_phase(F, F.in[I_XP], F.in[I_XS], F.in[I_NMIX], modl);
            const int gw = F.bid * NWAVES + F.wave, NGW = F.G * NWAVES;
            bias_rows(F, (const bf16*)(F.ws + WS_WIN), ZW, modl, (float*)(F.ws + WS_BIAS1), 4096, gw, NGW);
            if (P0_DEFER8 == 0) bias_rows(F, (const bf16*)(F.ws + WS_FGU), 2 * FF, modl + 3 * DM, (float*)(F.ws + WS_BIAS2), 2 * FF, gw, NGW);
            SEAM(pb + 0);
        }
#endif
        if (attn_) {
#if EN_G1
            if (IN(pb + 1)) { LAYER_VARS(); PROBE_STAMP(F, pb + 1);
                pg8::Gemm g{H, (const bf16*)(F.ws + WS_WIN) + (size_t)j * ZW * DM, MT, ZW, DM}; pg8::StaticOrder S; S.init(MT, ZW, F.G, F.bid, WGM_G1);
                pg8::EpiBf16Plain E{(bf16*)(F.ws + WS_Z), ZW, (const float*)(F.ws + WS_SSX), (const float*)(F.ws + WS_BIAS1) + (size_t)L * 5 * 4096, 4096, -1, (PG8_LAS const float*)(F.lds + BIAS_LDS_OFF), 0};
                if (P0_DEFER8 > 0 && (L == 0 || G1_DEFER2)) { int widx, nwg; tail_slot(F, 1200 - 4 * F.G, widx, nwg);
                    if (widx >= 0) conv_items(F, L, 1, widx * NWAVES + F.wave, nwg * NWAVES, L == 0 ? P0_FFN_ITEMS : P2_FFN_ITEMS); __syncthreads(); }
                bias_to_lds(F, S, E.bias, 4096);
                for (int rep_ = 0; rep_ < REP_G1; ++rep_) pg8::gemm_phase<pg8::EpiBf16Plain, pg8::StaticOrder, G1_ALIGN_EPI, true>(F.lds, g, S, E);
                SEAM(pb + 1);
            }
#endif
#if EN_POST
            if (IN(pb + 2)) { LAYER_VARS(); PROBE_STAMP(F, pb + 2); post_phase(F, j);
#if REP_POST > 1
              for (int rep_ = 1; rep_ < REP_POST; ++rep_) post_phase(F, j, true);
#endif
              SEAM(pb + 2); }
#endif
#if EN_KVUP
            if (IN(pb + 3)) { LAYER_VARS(); PROBE_STAMP(F, pb + 3);
                pg8::Gemm g{(const bf16*)(F.ws + WS_CKV), (const bf16*)(F.ws + WS_WKV) + (size_t)j * 2048 * 512, MK, 2048, 512}; pg8::StaticOrder S; S.init(MK, 2048, F.G, F.bid, WGM_KV);
                pg8::EpiBf16Plain E{(bf16*)(F.ws + WS_KVB), DM, nullptr, nullptr, 0, -1, nullptr, 0};
                for (int rep_ = 0; rep_ < REP_KVUP; ++rep_) pg8::gemm_phase<pg8::EpiBf16Plain, pg8::StaticOrder, KV_ALIGN_EPI, true>(F.lds, g, S, E);
                SEAM(pb + 3);
            }
#endif
#if EN_ATT
            if (IN(pb + 4)) { LAYER_VARS(); PROBE_STAMP(F, pb + 4); for (int rep_ = 0; rep_ < REP_ATT; ++rep_) attn_phase(F, j); SEAM(pb + 4); }
#endif
        } else {
#if EN_G4
            if (IN(pb + 1)) { LAYER_VARS(); PROBE_STAMP(F, pb + 1);
                pg8::Gemm g{H, (const bf16*)(F.ws + WS_CWIN) + (size_t)j * 4096 * DM, MT, 4096, DM}; pg8::StaticOrder S; S.init(MT, 4096, F.G, F.bid, WGM_G4);
                pg8::EpiGeluUV E{(bf16*)(F.ws + WS_U), (bf16*)(F.ws + WS_V), (float*)(F.ws + WS_SS), (const float*)(F.ws + WS_SSX), (const float*)(F.ws + WS_BIAS1) + (size_t)L * 5 * 4096, 4096, -1, (PG8_LAS const float*)(F.lds + BIAS_LDS_OFF), 0};
                bias_to_lds(F, S, E.bias, 4096);
                for (int rep_ = 0; rep_ < REP_G4; ++rep_) pg8::gemm_phase<pg8::EpiGeluUV, pg8::StaticOrder, G4_ALIGN_EPI, true>(F.lds, g, S, E);
                SEAM(pb + 1);
            }
#endif
#if EN_SPAT
            if (IN(pb + 2)) { LAYER_VARS(); PROBE_STAMP(F, pb + 2); for (int rep_ = 0; rep_ < REP_SPAT; ++rep_) spatial_phase(F, j); SEAM(pb + 2); }
#endif
        }
#if EN_OUT
        if (IN(pb + 5)) { LAYER_VARS(); PROBE_STAMP(F, pb + 5);
            const bf16* A = attn ? (const bf16*)(F.ws + WS_O) : (const bf16*)(F.ws + WS_MC);
            const bf16* Bt = (attn ? (const bf16*)(F.ws + WS_WOUT) : (const bf16*)(F.ws + WS_CWOUT)) + (size_t)j * DM * DM;
            pg8::Gemm g{A, Bt, MT, DM, DM}; pg8::StaticOrder S; S.init(MT, DM, F.G, F.bid, WGM_RES);
            pg8::EpiRes E{H, (float*)(F.ws + WS_SSX), (PG8_LAS const float*)(F.lds + BIAS_LDS_OFF), 0};
#if 1
            { int widx, nwg; tail_slot(F, 640 - 2 * F.G, widx, nwg); if (widx >= 0) {
                if (L > 0 || P0_DEFER8 > 0) bias_rows(F, (const bf16*)(F.ws + WS_FGU) + (size_t)L * 2 * FF * DM, 2 * FF, modl + 3 * DM, (float*)(F.ws + WS_BIAS2) + (size_t)L * 5 * 2 * FF, 2 * FF, widx * NWAVES + F.wave, nwg * NWAVES);
                if (L + 1 < NLAYER) { if (!ADA_IN_FUP) ada_layer(F, L + 1, 0, 128, widx, nwg); __syncthreads(); conv_items(F, L + 1, 0, widx * NWAVES + F.wave, nwg * NWAVES); }
                else if (DEFER_DOWN3) { __syncthreads(); conv_items(F, L, 1, widx * NWAVES + F.wave, nwg * NWAVES, 2 * 32 * 88); } } }
            __syncthreads();
#endif
            res_tables_to_lds(F, S, modl + 2 * DM, F.in[I_NFFN] + L * DM, modl + 4 * DM, F.in[I_NMIX] + L * DM, modl + 1 * DM);
            STAGGER(F);
            pg8::gemm_phase<pg8::EpiRes, pg8::StaticOrder, true, true>(F.lds, g, S, E);
#if REP_OUT > 1
            { pg8::EpiBf16Plain E2{(bf16*)(F.ws + WS_PROBE), DM, nullptr, nullptr, 0, -1, nullptr, 0}; pg8::gemm_phase<pg8::EpiBf16Plain, pg8::StaticOrder, true, true>(F.lds, g, S, E2); }
#endif
            SEAM(pb + 5);
        }
#endif
#if EN_FUP
        if (IN(pb + 7)) { LAYER_VARS(); PROBE_STAMP(F, pb + 7);
            pg8::Gemm g{H, (const bf16*)(F.ws + WS_FGU) + (size_t)L * 2 * FF * DM, MT, 2 * FF, DM}; pg8::StaticOrder S; S.init(MT, 2 * FF, F.G, F.bid, WGM_FUP);
            pg8::EpiSwiGLU E{(bf16*)(F.ws + WS_HH), FF, (const float*)(F.ws + WS_SSX), (const float*)(F.ws + WS_BIAS2) + (size_t)L * 5 * 2 * FF, 2 * FF, -1, (PG8_LAS const float*)(F.lds + BIAS_LDS_OFF), 0};
            if (ADA_IN_FUP && TAIL_CONV && L + 1 < NLAYER) { int widx, nwg; tail_slot(F, 3520 - 13 * F.G, widx, nwg);
                if (widx >= 0) ada_layer(F, L + 1, 0, ADA_FUP_ITEMS, widx, nwg); __syncthreads(); }
            bias_to_lds(F, S, E.bias, 2 * FF);
            for (int rep_ = 0; rep_ < REP_FUP; ++rep_) pg8::gemm_phase<pg8::EpiSwiGLU, pg8::StaticOrder, FUP_ALIGN_EPI, true>(F.lds, g, S, E);
            SEAM(pb + 7);
        }
#endif
#if EN_FDN
        if (IN(pb + 8)) { LAYER_VARS(); PROBE_STAMP(F, pb + 8);
            pg8::Gemm g{(const bf16*)(F.ws + WS_HH), (const bf16*)(F.ws + WS_FD) + (size_t)L * DM * FF, MT, DM, FF}; pg8::CountedDone S; S.init(MT, DM, F.G, F.bid, WGM_RES, FDN_REV);
            const bool more = L + 1 < NLAYER;
            S.arrive = (!more && EARLY_FIN_ON(F)) ? (unsigned*)(F.ws + WS_CTL) + CW_RDY : nullptr; S.nd = 0;
            pg8::EpiRes E{H, (float*)(F.ws + WS_SSX), (PG8_LAS const float*)(F.lds + BIAS_LDS_OFF), 0};
#if TAIL_CONV
            if (L + 1 < NLAYER) { int widx, nwg; tail_slot(F, 640 - 2 * F.G, widx, nwg);
              if (FDN_ALL_ITEMS > 0 && widx != F.bid) conv_items(F, L + 1, 1, F.bid * NWAVES + F.wave, F.G * NWAVES, 0, FDN_ALL_ITEMS);
              if (widx >= 0) { ada_layer(F, L + 1, (ADA_IN_FUP ? ADA_FUP_ITEMS : 128), 384, widx, nwg); __syncthreads(); conv_items(F, L + 1, 1, widx * NWAVES + F.wave, nwg * NWAVES, (FDN_ALL_ITEMS > 0 && widx != F.bid) ? FDN_ALL_ITEMS : 0, (G1_DEFER2 && P0_DEFER8 > 0 && L + 1 == 2) ? P2_FFN_ITEMS : (DEFER_DOWN3 && L + 1 == 3) ? 2 * 32 * 88 : 0x7fffffff);
                const int j1 = (L + 1) >> 1; const bool attn1 = ((L + 1) & 1) == 0;
                bias_rows(F, attn1 ? (const bf16*)(F.ws + WS_WIN) + (size_t)j1 * ZW * DM : (const bf16*)(F.ws + WS_CWIN) + (size_t)j1 * 4096 * DM, attn1 ? ZW : 4096, modl + 5 * 12288, (float*)(F.ws + WS_BIAS1) + (size_t)(L + 1) * 5 * 4096, 4096, widx * NWAVES + F.wave, nwg * NWAVES); } }
            __syncthreads();
#endif
            res_tables_to_lds(F, S, modl + 5 * DM, more ? F.in[I_NMIX] + (L + 1) * DM : F.in[I_FNORM], more ? modl + 5 * 12288 + DM : nullptr, F.in[I_NFFN] + L * DM, modl + 4 * DM);
            STAGGER(F);
            pg8::gemm_phase<pg8::EpiRes, pg8::CountedDone, true, true>(F.lds, g, S, E);
            if (!more && EARLY_FIN_ON(F) && F.bid >= 128) early_final(F, F.bid - 128);
#if REP_FDN > 1
            { pg8::EpiBf16Plain E2{(bf16*)(F.ws + WS_PROBE), DM, nullptr, nullptr, 0, -1, nullptr, 0}; pg8::gemm_phase<pg8::EpiBf16Plain, pg8::StaticOrder, true, true>(F.lds, g, S, E2); }
#endif
            SEAM(pb + 8);
        }
#endif
    }
#if EN_FIN
    if (IN(37)) { PHASE_BEGIN(F); PROBE_STAMP(F, 37);
#ifdef IDLE_US
        { const unsigned long long t0_ = __builtin_amdgcn_s_memrealtime(); while (__builtin_amdgcn_s_memrealtime() - t0_ < (unsigned long long)(IDLE_US) * 100ull) __builtin_amdgcn_s_sleep(16); }
#endif
        if (EARLY_FIN_ON(F)) final_phase_rest(F); else final_phase(F); asm volatile("s_waitcnt vmcnt(0)" ::: "memory"); __syncthreads(); PROBE_STAMP(F, 38);
#if PROBE_T
#ifndef PROBE_SA
#define PROBE_SA 1e-4f
#endif
#ifndef PROBE_OA
#define PROBE_OA 0.0f
#endif
#ifndef PROBE_SB
#define PROBE_SB 1e-3f
#endif
        if (blockIdx.x == 0) {
            __syncthreads(); asm volatile("s_waitcnt vmcnt(0)" ::: "memory");
            const unsigned long long* ts = (const unsigned long long*)(F.ws + WS_PROBE);
            const float ta = (float)(long long)(__hip_atomic_load(ts + PROBE_A1, __ATOMIC_RELAXED, __HIP_MEMORY_SCOPE_AGENT) - __hip_atomic_load(ts + PROBE_A0, __ATOMIC_RELAXED, __HIP_MEMORY_SCOPE_AGENT)) * 0.01f - PROBE_OA;
            const float tb = (float)(long long)(__hip_atomic_load(ts + PROBE_B1, __ATOMIC_RELAXED, __HIP_MEMORY_SCOPE_AGENT) - __hip_atomic_load(ts + PROBE_B0, __ATOMIC_RELAXED, __HIP_MEMORY_SCOPE_AGENT)) * 0.01f;
            for (int i = F.tid; i < 524288; i += NTHREADS) F.out[OUT_SKR + i] *= (1.0f + ta * PROBE_SA);
            if (F.tid == 0) F.out[0] += tb * PROBE_SB;
        }
#endif
    }
#endif
#undef IN
#undef SEAM
#undef X
#undef H
}

#ifndef MK_ONE_LAUNCH
#define MK_ONE_LAUNCH 0
#endif
extern "C" void kernel_launch(void* const* d_in, const int* in_sizes, int n_in, void* d_out, int out_size, void* d_ws, size_t ws_size, hipStream_t stream) {
    static int grid = 0;
    if (grid == 0) {
        if (n_in != 27 || out_size != 50855936 || ws_size < WS_END) { fprintf(stderr, "kernel_launch: built for 27 inputs, 50855936 outputs, >= %zu bytes of workspace; got n_in %d, out %d, ws %zu\n", (size_t)WS_END, n_in, out_size, ws_size); grid = -1; return; }
        int dev = 0, cus = 0, per_cu = 0;
        if (hipGetDevice(&dev) != hipSuccess || hipDeviceGetAttribute(&cus, hipDeviceAttributeMultiprocessorCount, dev) != hipSuccess) { fprintf(stderr, "kernel_launch: device query failed\n"); grid = -1; return; }
        if (hipFuncSetAttribute((const void*)fwd, hipFuncAttributeMaxDynamicSharedMemorySize, LDS_BYTES) != hipSuccess) { fprintf(stderr, "kernel_launch: hipFuncSetAttribute failed\n"); grid = -1; return; }
        if (hipOccupancyMaxActiveBlocksPerMultiprocessor(&per_cu, (const void*)fwd, NTHREADS, LDS_BYTES) != hipSuccess || per_cu < 1)
            fprintf(stderr, "kernel_launch: note: occupancy query reports %d workgroups per CU\n", per_cu);
        (void)hipGetLastError();
        grid = cus;
    }
    if (grid < 0) return;
    if (hipMemsetAsync((char*)d_ws + WS_CTL, 0, CTL_ZERO_BYTES, stream) != hipSuccess) { fprintf(stderr, "kernel_launch: memset failed\n"); return; }
    Args a{};
    for (int i = 0; i < 27; ++i) a.in[i] = (const GAS float*)d_in[i];
    a.out_f = (GAS float*)d_out; a.ws_b = (GAS unsigned char*)d_ws;
#if MK_ONE_LAUNCH
    a.ph_lo = 0; a.ph_hi = NPHASE;
    hipLaunchKernelGGL(fwd, dim3(grid), dim3(NTHREADS), LDS_BYTES, stream, a);
#else
    for (int ph = 0; ph < NPHASE; ++ph) {
        if (ph >= 1 && ph < 37) { const int L = (ph - 1) / 9, s = (ph - 1) % 9; if (((L & 1) && (s == 3 || s == 4)) || s == 6 || (s == 0 && L > 0)) continue; }
        a.ph_lo = ph; a.ph_hi = ph + 1;
        hipLaunchKernelGGL(fwd, dim3(grid), dim3(NTHREADS), LDS_BYTES, stream, a);
    }
#endif
    const hipError_t le = hipPeekAtLastError();
    if (le != hipSuccess) fprintf(stderr, "kernel_launch: launch failed: %s\n", hipGetErrorName(le));
}
```

```cpp
#define MK_ONE_LAUNCH 1
#define P0_DEFER8 4
#define EARLY_FIN 0
#define G1_DEFER2 1
#define DEFER_DOWN3 0
#define KV_ALIGN_EPI false
#define WGM_G4 8
#include <hip/hip_runtime.h>
#include <cstdio>
#include <cstdint>
#ifndef PG8_WGM
#define PG8_WGM 4
#endif
namespace pg8 {
#define PG8_LAS __attribute__((address_space(3)))
typedef unsigned short bf16_t;
typedef short bf16x8 __attribute__((ext_vector_type(8)));
typedef float f32x4 __attribute__((ext_vector_type(4)));
typedef unsigned u32x4 __attribute__((ext_vector_type(4)));
constexpr int BM = 256, BK = 64, HALF = 128, HTB = HALF * BK * 2  , STAGE_BYTES = 8 * HTB, NXCD = 8, WGM = PG8_WGM;

__host__ __device__ __forceinline__ int lds_byte(int r, int c) { const int st = (r >> 4) * 2 + (c >> 5), rr = r & 15, cc = c & 31, ob = rr * 64 + cc * 2; return st * 1024 + (ob ^ (((ob >> 9) & 1) << 5)); }
__host__ __device__ __forceinline__ void stage_rc(int b, int& R, int& C) { const int st = b / 1024, sb = b % 1024, swz = sb ^ (((sb >> 9) & 1) << 5); R = (st >> 1) * 16 + swz / 64; C = (st & 1) * 32 + (swz % 64) / 2; }
__host__ __device__ __forceinline__ int perm32(int rho) { const int n = rho >> 4, i = rho & 15; return 8 * (i >> 2) + 4 * n + (i & 3); }

struct Unit { int pm, pn; };
struct Gemm { const bf16_t* A; const bf16_t* Bt; int M, N, K; };

struct StaticOrder {
    int nM, nN, nwg, G, c, wgm, rev;
    __host__ __device__ void init(int M, int N, int G_, int c_, int wgm_ = WGM, int rev_ = 0) { nM = M / BM; nN = N / BM; nwg = nM * nN; G = G_; c = c_; wgm = wgm_; rev = rev_; }
    __host__ __device__ bool next(int i, Unit& u) const {
        const int L = i * G + c; if (L >= nwg) return false;
        int wgid = L; { const int q = nwg / NXCD, r = nwg % NXCD, xcd = wgid % NXCD, off = wgid / NXCD; wgid = (xcd < r ? xcd * (q + 1) : r * (q + 1) + (xcd - r) * q) + off; }
        const int nig = wgm * nN, gid = wgid / nig, fm = gid * wgm, gsz = (nM - fm) < wgm ? (nM - fm) : wgm;
        u.pm = fm + ((wgid % nig) % gsz); u.pn = (wgid % nig) / gsz; if (rev) u.pm = nM - 1 - u.pm; return true;
    }
    __device__ __forceinline__ void a_ready(const Unit&) const {}
    __device__ __forceinline__ void done(const Unit&) const {}
};
struct CountedDone : StaticOrder {
    unsigned* arrive; mutable int nd;
    __device__ __forceinline__ void done(const Unit&) const {
        if (arrive && nd++ == 1) { asm volatile("s_waitcnt vmcnt(0)" ::: "memory"); __builtin_amdgcn_s_barrier();
            if (threadIdx.x < 64) { __builtin_amdgcn_fence(__ATOMIC_RELEASE, "agent"); if (threadIdx.x == 0) (void)__hip_atomic_fetch_add(arrive, 1u, __ATOMIC_RELAXED, __HIP_MEMORY_SCOPE_AGENT); } }
    }
};
__device__ __forceinline__ unsigned cvt_pk_bf16(float lo, float hi) { unsigned r; asm volatile("v_cvt_pk_bf16_f32 %0, %1, %2" : "=v"(r) : "v"(lo), "v"(hi)); return r; }
constexpr int ROWS_P = 4096;
__device__ __forceinline__ int cond_of_pm(int pm) { return pm < 16 ? 0 : 1 + ((pm - 16) >> 4); }

__device__ __forceinline__ float epi_add_x16_x32(float v) {
    v += __int_as_float(__builtin_amdgcn_ds_swizzle(__float_as_int(v), (16 << 10) | 0x1f));
    auto rr = __builtin_amdgcn_permlane32_swap(__float_as_uint(v), __float_as_uint(v), false, false); return __uint_as_float(rr[0]) + __uint_as_float(rr[1]);
}
#ifndef EPI_RSTD_PF_PLAIN
#define EPI_RSTD_PF_PLAIN 0
#endif
#ifndef EPI_RSTD_PF_SWIGLU
#define EPI_RSTD_PF_SWIGLU 0
#endif
#ifndef EPI_RSTD_PF_GELU
#define EPI_RSTD_PF_GELU 0
#endif
__device__ __forceinline__ void epi_row_rstd(const float* SSX, int row0, int fq, float (&rs)[2][4]) {
#pragma unroll
    for (int ai = 0; ai < 2; ++ai)
#pragma unroll
        for (int m = 0; m < 4; ++m) { const f32x4* p = (const f32x4*)(SSX + (size_t)(row0 + ai * HALF + m * 16) * 32 + 8 * fq); const f32x4 a = p[0], b = p[1];
            const float s = epi_add_x16_x32(((a[0] + a[1]) + (a[2] + a[3])) + ((b[0] + b[1]) + (b[2] + b[3])));
            rs[ai][m] = 1.0f / __builtin_sqrtf(s * (1.0f / 2048.0f) + 1e-6f); }
}

__device__ __forceinline__ void epi_rstd_issue(const float* SSX, int row0, int fq, f32x4 (&p)[16]) {
#pragma unroll
    for (int ai = 0; ai < 2; ++ai)
#pragma unroll
        for (int m = 0; m < 4; ++m) { const f32x4* q = (const f32x4*)(SSX + (size_t)(row0 + ai * HALF + m * 16) * 32 + 8 * fq); p[2 * (ai * 4 + m)] = q[0]; p[2 * (ai * 4 + m) + 1] = q[1]; }
}
__device__ __forceinline__ void epi_rstd_finish(const f32x4 (&p)[16], float (&rs)[2][4]) {
#pragma unroll
    for (int ai = 0; ai < 2; ++ai)
#pragma unroll
        for (int m = 0; m < 4; ++m) { const f32x4 a = p[2 * (ai * 4 + m)], b = p[2 * (ai * 4 + m) + 1];
            const float s = epi_add_x16_x32(((a[0] + a[1]) + (a[2] + a[3])) + ((b[0] + b[1]) + (b[2] + b[3])));
            rs[ai][m] = 1.0f / __builtin_sqrtf(s * (1.0f / 2048.0f) + 1e-6f); }
}

struct EpiBf16Plain {
    static constexpr bool PERM = true, AFTER_DRAIN = false;
    bf16_t* O; int ldc; const float* SSX; const float* bias; int ldb;
    mutable int pm_; PG8_LAS const float* lb; mutable int ui_;
    mutable float rs[2][4];
    static constexpr bool WANTS_NEXT = true;
    __device__ __forceinline__ void operator()(const f32x4 (&acc)[2][2][4][2], const Unit& u, int wr, int wc, int fr, int fq, int next_pm_ = -1) const {
        const int row0 = u.pm * BM + wr * 64 + fr, col0 = u.pn * BM + wc * 32 + 8 * fq;
        f32x4 bv[2][2];
        const bool pf = EPI_RSTD_PF_PLAIN && SSX && next_pm_ >= 0 && next_pm_ != u.pm; f32x4 pp[16];
        if (pf) epi_rstd_issue(SSX, next_pm_ * BM + wr * 64 + fr, fq, pp);
        if (SSX) { if (u.pm != pm_) { epi_row_rstd(SSX, row0, fq, rs); pm_ = u.pm; } PG8_LAS const float* bp = lb + ui_ * 256 + wc * 32 + 8 * fq; ++ui_;
#pragma unroll
            for (int bj = 0; bj < 2; ++bj)
#pragma unroll
                for (int n = 0; n < 2; ++n) bv[bj][n] = *(PG8_LAS const f32x4*)(bp + bj * HALF + 4 * n); }
#pragma unroll
        for (int ai = 0; ai < 2; ++ai)
#pragma unroll
            for (int m = 0; m < 4; ++m) { bf16_t* rowp = O + (size_t)(row0 + ai * HALF + m * 16) * ldc + col0;
#pragma unroll
                for (int bj = 0; bj < 2; ++bj) { f32x4 v0 = acc[ai][bj][m][0], v1 = acc[ai][bj][m][1];
                    if (SSX) { v0 = v0 * rs[ai][m] + bv[bj][0]; v1 = v1 * rs[ai][m] + bv[bj][1]; }
                    u32x4 w; w.x = cvt_pk_bf16(v0[0], v0[1]); w.y = cvt_pk_bf16(v0[2], v0[3]); w.z = cvt_pk_bf16(v1[0], v1[1]); w.w = cvt_pk_bf16(v1[2], v1[3]);
                    *(u32x4*)(rowp + bj * HALF) = w; } }
        if (pf) { epi_rstd_finish(pp, rs); pm_ = next_pm_; }
    }
};
#ifndef EPI_RES_DIAG
#define EPI_RES_DIAG 0
#endif
struct EpiRes {
    static constexpr bool PERM = true, AFTER_DRAIN = false, WANTS_NEXT = false;
    bf16_t* H; float* SSX;
    PG8_LAS const float* tab; mutable int ui_;
    __device__ __forceinline__ void operator()(const f32x4 (&acc)[2][2][4][2], const Unit& u, int wr, int wc, int fr, int fq) const {
        const int row0 = u.pm * BM + wr * 64 + fr, col0 = u.pn * BM + wc * 32 + 8 * fq;
        bf16_t* hp = H + (size_t)row0 * 2048 + col0;
        PG8_LAS const float* tp = tab + ui_ * 768 + wc * 32 + 8 * fq; ++ui_;
        u32x4 r[2][4][2];
#pragma unroll
        for (int ai = 0; ai < 2; ++ai)
#pragma unroll
            for (int m = 0; m < 4; ++m)
#pragma unroll
                for (int bj = 0; bj < 2; ++bj) r[ai][m][bj] = *(const u32x4*)(hp + (size_t)(ai * HALF + m * 16) * 2048 + bj * HALF);
#pragma unroll
        for (int ai = 0; ai < 2; ++ai) { float ss[4] = {0.f, 0.f, 0.f, 0.f};
#pragma unroll
            for (int bj = 0; bj < 2; ++bj) { f32x4 g[2], gs[2], gpi[2];
#pragma unroll
                for (int n = 0; n < 2; ++n) { g[n] = *(PG8_LAS const f32x4*)(tp + bj * HALF + n * 4); gs[n] = *(PG8_LAS const f32x4*)(tp + 256 + bj * HALF + n * 4); gpi[n] = *(PG8_LAS const f32x4*)(tp + 512 + bj * HALF + n * 4); }
#pragma unroll
                for (int m = 0; m < 4; ++m) { const size_t ro = (size_t)(ai * HALF + m * 16) * 2048; const u32x4 w0 = r[ai][m][bj]; u32x4 w;
                    { const f32x4 bs = (f32x4){__uint_as_float(w0.x << 16), __uint_as_float(w0.x & 0xffff0000u), __uint_as_float(w0.y << 16), __uint_as_float(w0.y & 0xffff0000u)} * gpi[0];
                      const f32x4 x = bs + g[0] * acc[ai][bj][m][0]; ss[m] += (x[0] * x[0] + x[1] * x[1]) + (x[2] * x[2] + x[3] * x[3]); const f32x4 a = x * gs[0];
                      w.x = cvt_pk_bf16(a[0], a[1]); w.y = cvt_pk_bf16(a[2], a[3]); }
                    { const f32x4 bs = (f32x4){__uint_as_float(w0.z << 16), __uint_as_float(w0.z & 0xffff0000u), __uint_as_float(w0.w << 16), __uint_as_float(w0.w & 0xffff0000u)} * gpi[1];
                      const f32x4 x = bs + g[1] * acc[ai][bj][m][1]; ss[m] += (x[0] * x[0] + x[1] * x[1]) + (x[2] * x[2] + x[3] * x[3]); const f32x4 a = x * gs[1];
                      w.z = cvt_pk_bf16(a[0], a[1]); w.w = cvt_pk_bf16(a[2], a[3]); }
                    *(u32x4*)(hp + ro + bj * HALF) = w; } }
#pragma unroll
            for (int m = 0; m < 4; ++m) { const float s1 = epi_add_x16_x32(ss[m]); if (fq == 0) SSX[(size_t)(row0 + ai * HALF + m * 16) * 32 + u.pn * 4 + wc] = s1; } }
    }
};
#ifndef NT_HH
#define NT_HH 0
#endif
#if NT_HH
#define EPI_HH_STORE(p, v) __builtin_nontemporal_store(v, p)
#else
#define EPI_HH_STORE(p, v) (*(p) = (v))
#endif
typedef float epi_f32x2 __attribute__((ext_vector_type(2)));
struct EpiSwiGLU {
    static constexpr bool PERM = true, AFTER_DRAIN = false;
    bf16_t* O; int ldc; const float* SSX; const float* bias; int ldb;
    mutable int pm_; PG8_LAS const float* lb; mutable int ui_; mutable float rs[2][4];
    static constexpr bool WANTS_NEXT = true;
    __device__ __forceinline__ void operator()(const f32x4 (&acc)[2][2][4][2], const Unit& u, int wr, int wc, int fr, int fq, int next_pm_ = -1) const {
        const int row0 = u.pm * BM + wr * 64 + fr, col0 = u.pn * HALF + wc * 32 + 8 * fq;
        const bool pf = EPI_RSTD_PF_SWIGLU && next_pm_ >= 0 && next_pm_ != u.pm; f32x4 pp[8];
        const float* nss = SSX + (size_t)(next_pm_ * BM + wr * 64 + fr) * 32 + 8 * fq;
        if (u.pm != pm_) { epi_row_rstd(SSX, row0, fq, rs); pm_ = u.pm; } f32x4 bv[2][2]; { PG8_LAS const float* bp = lb + ui_ * 256 + wc * 32 + 8 * fq; ++ui_;
#pragma unroll
            for (int bj = 0; bj < 2; ++bj)
#pragma unroll
                for (int n = 0; n < 2; ++n) bv[bj][n] = *(PG8_LAS const f32x4*)(bp + bj * HALF + 4 * n); }
#pragma unroll
        for (int ai = 0; ai < 2; ++ai) {
            if (pf) {
#pragma unroll
                for (int m = 0; m < 4; ++m) { const f32x4* q = (const f32x4*)(nss + (size_t)(ai * HALF + m * 16) * 32); pp[2 * m] = q[0]; pp[2 * m + 1] = q[1]; } }
#pragma unroll
            for (int m = 0; m < 4; ++m) { bf16_t* rowp = O + (size_t)(row0 + ai * HALF + m * 16) * ldc + col0;
                epi_f32x2 z[4]; const float rsm = rs[ai][m];
#pragma unroll
                for (int n = 0; n < 2; ++n)
#pragma unroll
                    for (int h = 0; h < 2; ++h) { const epi_f32x2 ag = {acc[ai][0][m][n][2 * h], acc[ai][0][m][n][2 * h + 1]}, au = {acc[ai][1][m][n][2 * h], acc[ai][1][m][n][2 * h + 1]};
                        const epi_f32x2 bg = {bv[0][n][2 * h], bv[0][n][2 * h + 1]}, bu = {bv[1][n][2 * h], bv[1][n][2 * h + 1]};
                        const epi_f32x2 gt = ag * rsm + bg, up = au * rsm + bu, q = gt * -1.4426950408889634f;
                        epi_f32x2 e; e.x = __builtin_amdgcn_exp2f(q.x); e.y = __builtin_amdgcn_exp2f(q.y);
                        const epi_f32x2 d = e + 1.0f; epi_f32x2 rc; rc.x = __builtin_amdgcn_rcpf(d.x); rc.y = __builtin_amdgcn_rcpf(d.y);
                        z[2 * n + h] = (gt * up) * rc; }
                u32x4 w; w.x = cvt_pk_bf16(z[0].x, z[0].y); w.y = cvt_pk_bf16(z[1].x, z[1].y); w.z = cvt_pk_bf16(z[2].x, z[2].y); w.w = cvt_pk_bf16(z[3].x, z[3].y);
                EPI_HH_STORE((u32x4*)rowp, w); }
            if (pf) {
#pragma unroll
                for (int m = 0; m < 4; ++m) { const f32x4 a = pp[2 * m], b = pp[2 * m + 1];
                    const float s1 = epi_add_x16_x32(((a[0] + a[1]) + (a[2] + a[3])) + ((b[0] + b[1]) + (b[2] + b[3])));
                    rs[ai][m] = 1.0f / __builtin_sqrtf(s1 * (1.0f / 2048.0f) + 1e-6f); } } }
        if (pf) pm_ = next_pm_;
    }
};
__device__ __forceinline__ float gelu_tanh(float x) {
    const float u = 0.7978845608028654f * (x + 0.044715f * x * x * x);
    const float e = __builtin_amdgcn_exp2f(u * -2.8853900817779268f);
    return x * __builtin_amdgcn_rcpf(1.0f + e);
}
__device__ __forceinline__ epi_f32x2 gelu_tanh2(epi_f32x2 x) {
    const epi_f32x2 t = (x * x) * (-0.10294324f) + (-2.3022082f), u = x * t;
    epi_f32x2 e; e.x = __builtin_amdgcn_exp2f(u.x); e.y = __builtin_amdgcn_exp2f(u.y);
    const epi_f32x2 d = e + 1.0f; epi_f32x2 r; r.x = __builtin_amdgcn_rcpf(d.x); r.y = __builtin_amdgcn_rcpf(d.y);
    return x * r;
}
struct EpiGeluUV {
    static constexpr bool PERM = true, AFTER_DRAIN = false;
    bf16_t* U; bf16_t* V; float* SS; const float* SSX; const float* bias; int ldb;
    mutable int pm_; PG8_LAS const float* lb; mutable int ui_; mutable float rs[2][4];
    static constexpr bool WANTS_NEXT = true;
    __device__ __forceinline__ void operator()(const f32x4 (&acc)[2][2][4][2], const Unit& u, int wr, int wc, int fr, int fq, int next_pm_ = -1) const {
        const bool isv = u.pn >= 8; const int pn = isv ? u.pn - 8 : u.pn;
        const int row0 = u.pm * BM + wr * 64 + fr, col0 = pn * BM + wc * 32 + 8 * fq;
        const bool pf = EPI_RSTD_PF_GELU && next_pm_ >= 0 && next_pm_ != u.pm; f32x4 pp[16];
        if (pf) epi_rstd_issue(SSX, next_pm_ * BM + wr * 64 + fr, fq, pp);
        if (u.pm != pm_) { epi_row_rstd(SSX, row0, fq, rs); pm_ = u.pm; } f32x4 bv[2][2]; { PG8_LAS const float* bp = lb + ui_ * 256 + wc * 32 + 8 * fq; ++ui_;
#pragma unroll
            for (int bj = 0; bj < 2; ++bj)
#pragma unroll
                for (int n = 0; n < 2; ++n) bv[bj][n] = *(PG8_LAS const f32x4*)(bp + bj * HALF + 4 * n); }
        bf16_t* O = isv ? V : U;
#pragma unroll
        for (int ai = 0; ai < 2; ++ai)
#pragma unroll
            for (int m = 0; m < 4; ++m) { const int row = row0 + ai * HALF + m * 16; bf16_t* rowp = O + (size_t)row * 2048 + col0; epi_f32x2 ss2 = {0.f, 0.f}; const float rsm = rs[ai][m];
#pragma unroll
                for (int bj = 0; bj < 2; ++bj) { epi_f32x2 z[4];
#pragma unroll
                    for (int n = 0; n < 2; ++n)
#pragma unroll
                        for (int h = 0; h < 2; ++h) { const epi_f32x2 a = {acc[ai][bj][m][n][2 * h], acc[ai][bj][m][n][2 * h + 1]}, b = {bv[bj][n][2 * h], bv[bj][n][2 * h + 1]};
                            z[2 * n + h] = gelu_tanh2(a * rsm + b); ss2 += z[2 * n + h] * z[2 * n + h]; }
                    u32x4 w; w.x = cvt_pk_bf16(z[0].x, z[0].y); w.y = cvt_pk_bf16(z[1].x, z[1].y); w.z = cvt_pk_bf16(z[2].x, z[2].y); w.w = cvt_pk_bf16(z[3].x, z[3].y);
                    *(u32x4*)(rowp + bj * HALF) = w; }
                float ss = ss2.x + ss2.y;
                if (isv) { ss += __int_as_float(__builtin_amdgcn_ds_swizzle(__float_as_int(ss), (16 << 10) | 0x1f)); { auto rr = __builtin_amdgcn_permlane32_swap(__float_as_uint(ss), __float_as_uint(ss), false, false); ss = __uint_as_float(rr[0]) + __uint_as_float(rr[1]); } if (fq == 0) SS[(size_t)row * 32 + pn * 4 + wc] = ss; } }
        if (pf) { epi_rstd_finish(pp, rs); pm_ = next_pm_; }
    }
};
template <class Epi, class Sched, bool ALIGN_EPI = false, bool SP2 = false>
__device__ __forceinline__ void gemm_phase(PG8_LAS unsigned char* lds, const Gemm g, const Sched& S, const Epi& E) {
    int tid_ = threadIdx.x; asm volatile("" : "+v"(tid_));
    const int tid = tid_, wid = __builtin_amdgcn_readfirstlane(tid >> 6), lane = tid & 63, wr = wid >> 2, wc = wid & 3, fr = lane & 15, fq = lane >> 4;
    const int K = g.K, nt = K / BK;
    unsigned voffA[2], voffB[2];
#pragma unroll
    for (int i = 0; i < 2; ++i) { int R, C; stage_rc(tid * 16 + i * 8192, R, C); const int Rb = Epi::PERM ? ((R & ~31) + perm32(R & 31)) : R;
        voffA[i] = (unsigned)(R * K + C) * 2u; voffB[i] = (unsigned)(Rb * K + C) * 2u; }
    const size_t kstep = (size_t)(BK * 2);
    const size_t hstep = (size_t)HALF * K * 2;
    const size_t tstep = 2 * hstep;
    const unsigned ldsw = (unsigned)wid * 1024u;
    const int aoff = lds_byte(wr * 64 + fr, fq * 8), boff = lds_byte(wc * 32 + fr, fq * 8);
#define PG8_SA(b, h) (((b) * 2 + (h)) * HTB)
#define PG8_SB(b, h) ((4 + (b) * 2 + (h)) * HTB)
#define PG8_STAGE(bufoff, gbase, voff) do { _Pragma("unroll") for (int _i = 0; _i < 2; ++_i) \
        __builtin_amdgcn_global_load_lds((const unsigned*)((const char*)(gbase) + (voff)[_i]), (PG8_LAS unsigned*)(lds + (bufoff) + ldsw + _i * 8192), 16, 0, 0); } while (0)
#define PG8_LDA(dst, b, h) do { _Pragma("unroll") for (int m = 0; m < 4; ++m) _Pragma("unroll") for (int k = 0; k < 2; ++k) dst[m][k] = *(const PG8_LAS bf16x8*)(lds + PG8_SA(b, h) + aoff + m * 2048 + k * 1024); } while (0)
#define PG8_LDB(dst, b, h) do { _Pragma("unroll") for (int n = 0; n < 2; ++n) _Pragma("unroll") for (int k = 0; k < 2; ++k) dst[n][k] = *(const PG8_LAS bf16x8*)(lds + PG8_SB(b, h) + boff + n * 2048 + k * 1024); } while (0)
#define PG8_MMA(ai, bj, At, Bt) do { __builtin_amdgcn_s_setprio(1); _Pragma("unroll") for (int m = 0; m < 4; ++m) _Pragma("unroll") for (int n = 0; n < 2; ++n) _Pragma("unroll") for (int k = 0; k < 2; ++k) \
        acc[ai][bj][m][n] = __builtin_amdgcn_mfma_f32_16x16x32_bf16(Bt[n][k], At[m][k], acc[ai][bj][m][n], 0, 0, 0); __builtin_amdgcn_s_setprio(0); } while (0)
#define PG8_WAIT_V(n) asm volatile("s_waitcnt vmcnt(" #n ")" ::: "memory")
#define PG8_WAIT_L(n) asm volatile("s_waitcnt lgkmcnt(" #n ")" ::: "memory")
#define PG8_BAR __builtin_amdgcn_s_barrier()
#define PG8_SCHED __builtin_amdgcn_sched_barrier(0)
    Unit cur, nxt; int ui = 0;
    if (!S.next(0, cur)) return;
    f32x4 acc[2][2][4][2];
#pragma unroll
    for (int a = 0; a < 2; ++a)
#pragma unroll
        for (int b = 0; b < 2; ++b)
#pragma unroll
            for (int m = 0; m < 4; ++m)
#pragma unroll
                for (int n = 0; n < 2; ++n) acc[a][b][m][n] = (f32x4){0.f, 0.f, 0.f, 0.f};
    bf16x8 At[4][2], B0[2][2], B1[2][2];
    const char* cA = (const char*)g.A + (size_t)cur.pm * tstep; const char* cB = (const char*)g.Bt + (size_t)cur.pn * tstep;
    S.a_ready(cur);
    if constexpr (SP2) {
        PG8_STAGE(PG8_SB(0, 0), cB, voffB); PG8_STAGE(PG8_SB(0, 1), cB + hstep, voffB); PG8_STAGE(PG8_SA(0, 0), cA, voffA); PG8_STAGE(PG8_SA(0, 1), cA + hstep, voffA);
        if (wr == 1) PG8_BAR;
        PG8_WAIT_V(2); PG8_BAR;
        PG8_STAGE(PG8_SB(1, 0), cB + kstep, voffB); PG8_STAGE(PG8_SA(1, 0), cA + kstep, voffA); PG8_STAGE(PG8_SB(1, 1), cB + hstep + kstep, voffB);
        PG8_WAIT_V(6); PG8_BAR;
    } else {
        PG8_STAGE(PG8_SB(0, 0), cB, voffB); PG8_STAGE(PG8_SA(0, 0), cA, voffA); PG8_STAGE(PG8_SB(0, 1), cB + hstep, voffB); PG8_STAGE(PG8_SA(0, 1), cA + hstep, voffA);
        if (wr == 1) PG8_BAR;
        PG8_WAIT_V(4); PG8_BAR;
        PG8_STAGE(PG8_SB(1, 0), cB + kstep, voffB); PG8_STAGE(PG8_SA(1, 0), cA + kstep, voffA); PG8_STAGE(PG8_SB(1, 1), cB + hstep + kstep, voffB);
        PG8_WAIT_V(6); PG8_BAR;
    }
    for (;;) {
        const bool has_next = S.next(ui + 1, nxt);
        const char* nA = has_next ? (const char*)g.A + (size_t)nxt.pm * tstep : cA; const char* nB = has_next ? (const char*)g.Bt + (size_t)nxt.pn * tstep : cB;
        for (int t = 0; t < nt; t += 2) {
            const bool last = (t == nt - 2);
            const char* a1 = cA + (size_t)(t + 1) * kstep;
            const char* a2 = last ? nA : cA + (size_t)(t + 2) * kstep; const char* b2 = last ? nB : cB + (size_t)(t + 2) * kstep;
            const char* a3 = a2 + kstep; const char* b3 = b2 + kstep;
            if (last && has_next) S.a_ready(nxt);
            if constexpr (SP2) {
            PG8_LDB(B0, 0, 0); PG8_LDB(B1, 0, 1); PG8_SCHED; PG8_LDA(At, 0, 0); PG8_STAGE(PG8_SA(1, 1), a1 + hstep, voffA);
            PG8_WAIT_V(8); PG8_WAIT_L(0); PG8_BAR; PG8_MMA(0, 0, At, B0); PG8_MMA(0, 1, At, B1); PG8_BAR; PG8_SCHED;
            PG8_LDA(At, 0, 1); PG8_STAGE(PG8_SB(0, 0), b2, voffB); PG8_STAGE(PG8_SB(0, 1), b2 + hstep, voffB); PG8_STAGE(PG8_SA(0, 0), a2, voffA);
            PG8_WAIT_V(8); PG8_WAIT_L(0); PG8_BAR; PG8_MMA(1, 0, At, B0); PG8_MMA(1, 1, At, B1); PG8_BAR; PG8_SCHED;
            PG8_LDB(B0, 1, 0); PG8_LDB(B1, 1, 1); PG8_SCHED; PG8_LDA(At, 1, 0); PG8_STAGE(PG8_SA(0, 1), a2 + hstep, voffA);
            PG8_WAIT_V(8); PG8_WAIT_L(0); PG8_BAR; PG8_MMA(0, 0, At, B0); PG8_MMA(0, 1, At, B1); PG8_BAR; PG8_SCHED;
            PG8_LDA(At, 1, 1); PG8_STAGE(PG8_SB(1, 0), b3, voffB); PG8_STAGE(PG8_SB(1, 1), b3 + hstep, voffB); PG8_STAGE(PG8_SA(1, 0), a3, voffA);
            PG8_WAIT_V(8); PG8_WAIT_L(0); PG8_BAR; PG8_MMA(1, 0, At, B0); PG8_MMA(1, 1, At, B1); PG8_BAR; PG8_SCHED;
            } else {
            PG8_LDB(B0, 0, 0); PG8_SCHED; PG8_LDA(At, 0, 0); PG8_STAGE(PG8_SA(1, 1), a1 + hstep, voffA);
            PG8_WAIT_L(8); PG8_BAR; PG8_WAIT_L(0); PG8_MMA(0, 0, At, B0); PG8_BAR; PG8_SCHED;
            PG8_LDB(B1, 0, 1); PG8_STAGE(PG8_SB(0, 0), b2, voffB);
            PG8_BAR; PG8_WAIT_L(0); PG8_MMA(0, 1, At, B1); PG8_BAR;
            PG8_LDA(At, 0, 1); PG8_STAGE(PG8_SA(0, 0), a2, voffA);
            PG8_BAR; PG8_WAIT_L(0); PG8_MMA(1, 0, At, B0); PG8_BAR; PG8_SCHED;
            PG8_STAGE(PG8_SB(0, 1), b2 + hstep, voffB);
            PG8_WAIT_V(6); PG8_BAR; PG8_MMA(1, 1, At, B1); PG8_BAR;
            PG8_LDB(B0, 1, 0); PG8_SCHED; PG8_LDA(At, 1, 0); PG8_STAGE(PG8_SA(0, 1), a2 + hstep, voffA);
            PG8_WAIT_L(8); PG8_BAR; PG8_WAIT_L(0); PG8_MMA(0, 0, At, B0); PG8_BAR; PG8_SCHED;
            PG8_LDB(B1, 1, 1); PG8_STAGE(PG8_SB(1, 0), b3, voffB);
            PG8_BAR; PG8_WAIT_L(0); PG8_MMA(0, 1, At, B1); PG8_BAR;
            PG8_LDA(At, 1, 1); PG8_STAGE(PG8_SA(1, 0), a3, voffA);
            PG8_BAR; PG8_WAIT_L(0); PG8_MMA(1, 0, At, B0); PG8_BAR; PG8_SCHED;
            PG8_STAGE(PG8_SB(1, 1), b3 + hstep, voffB);
            PG8_WAIT_V(6); PG8_BAR; PG8_MMA(1, 1, At, B1); PG8_BAR;
            }
        }
        if constexpr (ALIGN_EPI) { if (wr == 0) PG8_BAR; }
        if constexpr (!Epi::AFTER_DRAIN) { if constexpr (Epi::WANTS_NEXT) E(acc, cur, wr, wc, fr, fq, has_next ? nxt.pm : -1); else E(acc, cur, wr, wc, fr, fq); S.done(cur); }
        if (!has_next) break;
#pragma unroll
        for (int a = 0; a < 2; ++a)
#pragma unroll
            for (int b = 0; b < 2; ++b)
#pragma unroll
                for (int m = 0; m < 4; ++m)
#pragma unroll
                    for (int n = 0; n < 2; ++n) acc[a][b][m][n] = (f32x4){0.f, 0.f, 0.f, 0.f};
        cur = nxt; cA = nA; cB = nB; ++ui;
        if constexpr (ALIGN_EPI) { if (wr == 1) PG8_BAR; }
    }
    PG8_WAIT_V(0);
    if constexpr (!ALIGN_EPI) { if (wr == 0) PG8_BAR; }
    PG8_BAR;
    if constexpr (Epi::AFTER_DRAIN) { E.fused(acc, cur, wr, wc, fr, fq, lds, wid, lane); S.done(cur); }
#undef PG8_SA
#undef PG8_SB
#undef PG8_STAGE
#undef PG8_LDA
#undef PG8_LDB
#undef PG8_MMA
#undef PG8_WAIT_V
#undef PG8_WAIT_L
#undef PG8_BAR
#undef PG8_SCHED
}
}
namespace att {
typedef unsigned short bf16;
using bf16x8 = __attribute__((ext_vector_type(8))) short;
using s16x4  = __attribute__((ext_vector_type(4))) short;
using f32x16 = __attribute__((ext_vector_type(16))) float;
using u32x4  = __attribute__((ext_vector_type(4))) unsigned;
constexpr int NW = 8, QBLK = 32, KVBLK = 64;
constexpr float THR = 8.f;
#define ATT_SBAR() __builtin_amdgcn_sched_barrier(0)
template <int RS> __device__ __forceinline__ int kswz(int row, int colB) { return row * RS + (colB ^ ((row & 7) << 4)); }
__device__ __forceinline__ int crow(int r, int hi) { return (r & 3) + 8 * (r >> 2) + 4 * hi; }
__device__ __forceinline__ unsigned cvtpk(float lo, float hi) { unsigned r; asm volatile("v_cvt_pk_bf16_f32 %0, %1, %2" : "=v"(r) : "v"(lo), "v"(hi)); return r; }
__device__ __forceinline__ bf16x8 ld8(const bf16* p) { return *reinterpret_cast<const bf16x8*>(p); }

__device__ __forceinline__ void partialSM(f32x16& p0, f32x16& p1, float& m_reg, float& mn, float& alpha, const float C, const float TS) {
  float pmax = p0[0];
#pragma unroll
  for (int r = 1; r < 16; ++r) pmax = fmaxf(pmax, p0[r]);
#pragma unroll
  for (int r = 0; r < 16; ++r) pmax = fmaxf(pmax, p1[r]);
  { auto rr = __builtin_amdgcn_permlane32_swap(__float_as_uint(pmax), __float_as_uint(pmax), false, false);
    pmax = fmaxf(__uint_as_float(rr[0]), __uint_as_float(rr[1])); }
  if (__builtin_expect(__all(pmax - m_reg <= TS), 1)) { mn = m_reg; alpha = 1.f; }
  else { mn = fmaxf(m_reg, pmax); alpha = __builtin_amdgcn_exp2f((m_reg - mn) * C); m_reg = mn; }
  float mnC = -mn * C;
#pragma unroll
  for (int r = 0; r < 16; ++r) p0[r] = fmaf(p0[r], C, mnC);
#pragma unroll
  for (int r = 0; r < 16; ++r) p1[r] = fmaf(p1[r], C, mnC);
#pragma unroll
  for (int r = 0; r < 16; ++r) p0[r] = __builtin_amdgcn_exp2f(p0[r]);
}
__device__ __forceinline__ void finishSM(f32x16& p0, f32x16& p1, float alpha, float& l_reg, bf16x8& pa0, bf16x8& pa1, bf16x8& pa2, bf16x8& pa3) {
#pragma unroll
  for (int r = 0; r < 16; ++r) p1[r] = __builtin_amdgcn_exp2f(p1[r]);
  float ps = 0;
#pragma unroll
  for (int r = 0; r < 16; ++r) ps += p0[r];
#pragma unroll
  for (int r = 0; r < 16; ++r) ps += p1[r];
  { auto rr = __builtin_amdgcn_permlane32_swap(__float_as_uint(ps), __float_as_uint(ps), false, false);
    ps = __uint_as_float(rr[0]) + __uint_as_float(rr[1]); }
  l_reg = l_reg * alpha + ps;
#define ATT_PK4(P, BASE, OUT) do { unsigned a0 = cvtpk(P[BASE + 0], P[BASE + 1]), a1 = cvtpk(P[BASE + 2], P[BASE + 3]);   \
    unsigned b0 = cvtpk(P[BASE + 4], P[BASE + 5]), b1 = cvtpk(P[BASE + 6], P[BASE + 7]);                              \
    auto r0 = __builtin_amdgcn_permlane32_swap(a0, b0, false, false); auto r1 = __builtin_amdgcn_permlane32_swap(a1, b1, false, false); \
    u32x4 w = {r0[0], r1[0], r0[1], r1[1]}; OUT = *reinterpret_cast<bf16x8*>(&w); } while (0)
  ATT_PK4(p0, 0, pa0); ATT_PK4(p0, 8, pa1); ATT_PK4(p1, 0, pa2); ATT_PK4(p1, 8, pa3);
#undef ATT_PK4
}
#ifndef QKT_SB0
#define QKT_SB0 3
#endif
#ifndef QKT_SB1
#define QKT_SB1 7
#endif
template <int DK, int NQR> __device__ __forceinline__ void qkt(f32x16& p0, f32x16& p1, const char* Ks, const bf16x8* qr, const char* qrl, int r32, int hi) {
  p0 = f32x16{}; p1 = f32x16{};
#pragma unroll
  for (int d0 = 0; d0 < DK / 16; ++d0) { const int cb = (d0 * 16 + hi * 8) * 2;
    const bf16x8 qf = (d0 < NQR) ? qr[d0 < NQR ? d0 : 0] : *reinterpret_cast<const bf16x8*>(qrl + (d0 - NQR) * 1024);
    bf16x8 b0 = *reinterpret_cast<const bf16x8*>(Ks + kswz<DK * 2>(r32, cb));
    bf16x8 b1 = *reinterpret_cast<const bf16x8*>(Ks + kswz<DK * 2>(32 + r32, cb));
    p0 = __builtin_amdgcn_mfma_f32_32x32x16_bf16(b0, qf, p0, 0, 0, 0);
    p1 = __builtin_amdgcn_mfma_f32_32x32x16_bf16(b1, qf, p1, 0, 0, 0);
    if constexpr (DK == 192) { if (d0 == QKT_SB0 || d0 == QKT_SB1) ATT_SBAR(); } }
}
__device__ __forceinline__ int v_st(int k, int c) { const int kk = (k & ~0xC) | ((k & 4) << 1) | ((k & 8) >> 1); return ((kk >> 3) * 4 + (c >> 5)) * 512 + ((kk & 7) * 32 + (c & 31)) * 2; }
__device__ __forceinline__ int v_rd_base(int lane) { return ((lane & 3) << 3) | (((lane >> 2) & 3) << 6) | (((lane >> 4) & 1) << 5) | (((lane >> 5) & 1) << 8); }
constexpr int v_rd_off(int d0, int ks, int half) { return d0 * 512 + ks * 4096 + half * 2048; }
template <int OFF> __device__ __forceinline__ s16x4 tr_read(int vb) {
  s16x4 r; asm volatile("ds_read_b64_tr_b16 %0, %1 offset:%2" : "=&v"(r) : "v"(vb), "i"(OFF) : "memory"); return r;
}
template <int D0> __device__ __forceinline__ void pv_one(f32x16& od, int vb, bf16x8 pa0, bf16x8 pa1, bf16x8 pa2, bf16x8 pa3) {
  const s16x4 l0 = tr_read<v_rd_off(D0, 0, 0)>(vb), h0 = tr_read<v_rd_off(D0, 0, 1)>(vb), l1 = tr_read<v_rd_off(D0, 1, 0)>(vb), h1 = tr_read<v_rd_off(D0, 1, 1)>(vb);
  const s16x4 l2 = tr_read<v_rd_off(D0, 2, 0)>(vb), h2 = tr_read<v_rd_off(D0, 2, 1)>(vb), l3 = tr_read<v_rd_off(D0, 3, 0)>(vb), h3 = tr_read<v_rd_off(D0, 3, 1)>(vb);
  asm volatile("s_waitcnt lgkmcnt(0)" ::: "memory"); ATT_SBAR();
#define ATT_PK(L, H) (bf16x8){L[0], L[1], L[2], L[3], H[0], H[1], H[2], H[3]}
  od = __builtin_amdgcn_mfma_f32_32x32x16_bf16(pa0, ATT_PK(l0, h0), od, 0, 0, 0);
  od = __builtin_amdgcn_mfma_f32_32x32x16_bf16(pa1, ATT_PK(l1, h1), od, 0, 0, 0);
  od = __builtin_amdgcn_mfma_f32_32x32x16_bf16(pa2, ATT_PK(l2, h2), od, 0, 0, 0);
  od = __builtin_amdgcn_mfma_f32_32x32x16_bf16(pa3, ATT_PK(l3, h3), od, 0, 0, 0);
#undef ATT_PK
}
__device__ __forceinline__ void pv_d0(f32x16* o, int vb, bf16x8 pa0, bf16x8 pa1, bf16x8 pa2, bf16x8 pa3) {
  pv_one<0>(o[0], vb, pa0, pa1, pa2, pa3); pv_one<1>(o[1], vb, pa0, pa1, pa2, pa3); pv_one<2>(o[2], vb, pa0, pa1, pa2, pa3); pv_one<3>(o[3], vb, pa0, pa1, pa2, pa3);
}

template <int DK, int LDQ, int LDKN, int LDV, int LDO, int SDEPTH, int NQR, int QMODE>
__device__ __forceinline__ void attn_unit(const bf16* __restrict__ Qb, const bf16* __restrict__ Kn, const bf16* __restrict__ Kr, const bf16* __restrict__ Vh,
                                          bf16* __restrict__ Ob, int seq, char* lds, const float* __restrict__ qg, const float* __restrict__ T, int tok0) {
  constexpr int SHM_V = KVBLK * 128 * 2, SHM_K = KVBLK * DK * 2, KRS = DK * 2;
  constexpr float SCALE = (DK == 128) ? 0.088388347648318440f : 0.072168783648703220f;
  constexpr float C = SCALE * 1.4426950408889634f, TS = THR / SCALE;
  int tid_ = threadIdx.x; asm volatile("" : "+v"(tid_));
  const int tid = tid_, wid = tid >> 6, lane = tid & 63, r32 = lane & 31, hi = lane >> 5;
  char* V_lds = lds; char* K_lds = lds + 2 * SHM_V;
  float* ws = (float*)(lds + 2 * SHM_V + 2 * SHM_K) + wid * 64; float* li_l = ws; float* al_l = ws + 32;
  float m_reg = -1e30f, l_reg = 0; f32x16 o[4] = {}; bf16x8 qr[NQR]; constexpr int NQL = DK / 16 - NQR;
  char* qrl = lds + 2 * SHM_V + 2 * SHM_K + 2048 + (wid * NQL * 64 + lane) * 16;
  __syncthreads();
  const bf16* Qw = Qb + (long)(wid * QBLK + r32) * LDQ + hi * 8;
  { bf16x8 qraw[DK / 16];
#pragma unroll
    for (int d0 = 0; d0 < DK / 16; ++d0) qraw[d0] = ld8(Qw + d0 * 16);
#define ATT_UNPK(vv_, oo_) do { const u32x4 w_ = *reinterpret_cast<const u32x4*>(&(vv_)); oo_[0] = __uint_as_float(w_[0] << 16); oo_[1] = __uint_as_float(w_[0] & 0xffff0000u); oo_[2] = __uint_as_float(w_[1] << 16); oo_[3] = __uint_as_float(w_[1] & 0xffff0000u); \
      oo_[4] = __uint_as_float(w_[2] << 16); oo_[5] = __uint_as_float(w_[2] & 0xffff0000u); oo_[6] = __uint_as_float(w_[3] << 16); oo_[7] = __uint_as_float(w_[3] & 0xffff0000u); } while (0)
#define ATT_PK(ii_, vv_) do { u32x4 w_ = {cvtpk(ii_[0], ii_[1]), cvtpk(ii_[2], ii_[3]), cvtpk(ii_[4], ii_[5]), cvtpk(ii_[6], ii_[7])}; vv_ = *reinterpret_cast<bf16x8*>(&w_); } while (0)
    const int tok = tok0 + wid * QBLK + r32, prow = tok >> 6, pcol = tok & 63;
    if constexpr (QMODE == 1 || QMODE == 2) {
      float x[8][8]; float ss = 0.f;
#pragma unroll
      for (int d0 = 0; d0 < 8; ++d0) { ATT_UNPK(qraw[d0], x[d0]);
#pragma unroll
        for (int j = 0; j < 8; ++j) ss += x[d0][j] * x[d0][j]; }
      { auto rr = __builtin_amdgcn_permlane32_swap(__float_as_uint(ss), __float_as_uint(ss), false, false); ss = __uint_as_float(rr[0]) + __uint_as_float(rr[1]); }
      const float rstd = 1.0f / __builtin_sqrtf(ss * (1.0f / 128.0f) + 1e-6f);
#pragma unroll
      for (int d0 = 0; d0 < 8; ++d0) { const float* gp = qg + 16 * d0 + 8 * hi;
#pragma unroll
        for (int j = 0; j < 8; ++j) x[d0][j] = x[d0][j] * rstd * gp[j]; }
      if constexpr (QMODE == 2) {
#pragma unroll
        for (int ax = 0; ax < 2; ++ax) { const int pos = ax ? pcol : prow;
#pragma unroll
          for (int b = 0; b < 2; ++b) { const float* tp = T + ((long)pos * 32 + 16 * b + 8 * hi) * 2;
#pragma unroll
            for (int j = 0; j < 8; ++j) { const float co = tp[2 * j], si = tp[2 * j + 1], x1 = x[4 * ax + b][j], x2 = x[4 * ax + 2 + b][j];
              x[4 * ax + b][j] = x1 * co - x2 * si; x[4 * ax + 2 + b][j] = x1 * si + x2 * co; } } } }
#pragma unroll
      for (int d0 = 0; d0 < 8; ++d0) ATT_PK(x[d0], qraw[d0]);
    }
    if constexpr (QMODE == 3) {
#pragma unroll
      for (int ax = 0; ax < 2; ++ax) { const int pos = ax ? pcol : prow; const float* tp = T + ((long)pos * 16 + 8 * hi) * 2; float x1[8], x2[8];
        ATT_UNPK(qraw[8 + 2 * ax], x1); ATT_UNPK(qraw[9 + 2 * ax], x2);
#pragma unroll
        for (int j = 0; j < 8; ++j) { const float co = tp[2 * j], si = tp[2 * j + 1], a1 = x1[j], a2 = x2[j]; x1[j] = a1 * co - a2 * si; x2[j] = a1 * si + a2 * co; }
        ATT_PK(x1, qraw[8 + 2 * ax]); ATT_PK(x2, qraw[9 + 2 * ax]); } }
#undef ATT_UNPK
#undef ATT_PK
#pragma unroll
    for (int d0 = 0; d0 < NQR; ++d0) qr[d0] = qraw[d0];
    if constexpr (NQL > 0) {
#pragma unroll
      for (int f = 0; f < NQL; ++f) *reinterpret_cast<bf16x8*>(qrl + f * 1024) = qraw[NQR + f]; } }
  const int sr = tid >> 4, sc = (tid & 15) * 8, vst0 = v_st(sr, sc), vst1 = v_st(32 + sr, sc);
  const int rr = tid >> 3, rc = (tid & 7) * 8;
  const int vb0 = (int)(uintptr_t)V_lds + v_rd_base(lane);
  struct { bf16x8 vs0, vs1, ks0, ks1, kr; } sr_[SDEPTH];
#define ATT_SLOAD(i, k0) do { sr_[i].vs0 = ld8(&Vh[(long)((k0) + sr) * LDV + sc]); sr_[i].vs1 = ld8(&Vh[(long)((k0) + 32 + sr) * LDV + sc]); \
    sr_[i].ks0 = ld8(&Kn[(long)((k0) + sr) * LDKN + sc]); sr_[i].ks1 = ld8(&Kn[(long)((k0) + 32 + sr) * LDKN + sc]); \
    if constexpr (DK == 192) sr_[i].kr = ld8(&Kr[(long)((k0) + rr) * 64 + rc]); } while (0)
#define ATT_SWRITE(b, i) do { *(bf16x8*)(V_lds + (b) * SHM_V + vst0) = sr_[i].vs0; *(bf16x8*)(V_lds + (b) * SHM_V + vst1) = sr_[i].vs1; const int kc = sc * 2; \
    *(bf16x8*)(K_lds + (b) * SHM_K + kswz<KRS>(sr, kc)) = sr_[i].ks0; *(bf16x8*)(K_lds + (b) * SHM_K + kswz<KRS>(32 + sr, kc)) = sr_[i].ks1; \
    if constexpr (DK == 192) *(bf16x8*)(K_lds + (b) * SHM_K + kswz<KRS>(rr, 256 + rc * 2)) = sr_[i].kr; } while (0)
#define ATT_SWAIT() do { if constexpr (SDEPTH == 1) asm volatile("s_waitcnt vmcnt(0)" ::: "memory"); else if constexpr (DK == 192) asm volatile("s_waitcnt vmcnt(5)" ::: "memory"); else asm volatile("s_waitcnt vmcnt(4)" ::: "memory"); } while (0)
#define ATT_RESC(a) do { if (__any((a) < 1.f)) { if (hi == 0) al_l[r32] = (a); asm volatile("s_waitcnt lgkmcnt(0)" ::: "memory"); \
    _Pragma("unroll") for (int d = 0; d < 4; ++d) _Pragma("unroll") for (int r = 0; r < 16; ++r) o[d][r] *= al_l[crow(r, hi)]; } } while (0)
  f32x16 pA0, pA1, pB0, pB1; float mnA, mnB, alA, alB; bf16x8 pa0, pa1, pa2, pa3; const int NT = seq / KVBLK;
  constexpr int SE = 0, SO = SDEPTH - 1;
  ATT_SLOAD(SE, 0); asm volatile("s_waitcnt vmcnt(0)" ::: "memory"); ATT_SWRITE(0, SE); __syncthreads();
  qkt<DK, NQR>(pA0, pA1, K_lds, qr, qrl, r32, hi); partialSM(pA0, pA1, m_reg, mnA, alA, C, TS);
  ATT_SLOAD(SO, KVBLK); if constexpr (SDEPTH == 2) { if (2 < NT) ATT_SLOAD(SE, 2 * KVBLK); }
  if (2 < NT) ATT_SWAIT(); else asm volatile("s_waitcnt vmcnt(0)" ::: "memory");
  ATT_SWRITE(1, SO); __syncthreads();
  for (int j = 1; j + 1 < NT; j += 2) {
    ATT_SBAR(); qkt<DK, NQR>(pB0, pB1, K_lds + SHM_K, qr, qrl, r32, hi);
    finishSM(pA0, pA1, alA, l_reg, pa0, pa1, pa2, pa3); ATT_SBAR();
    ATT_SLOAD(SO, (j + SDEPTH) * KVBLK); ATT_SBAR();
    pv_d0(o, vb0, pa0, pa1, pa2, pa3); partialSM(pB0, pB1, m_reg, mnB, alB, C, TS);
    __syncthreads(); ATT_SWAIT(); ATT_SWRITE(0, SE);
    ATT_RESC(alB); __syncthreads();
    ATT_SBAR(); qkt<DK, NQR>(pA0, pA1, K_lds, qr, qrl, r32, hi);
    finishSM(pB0, pB1, alB, l_reg, pa0, pa1, pa2, pa3); ATT_SBAR();
    if (SDEPTH == 1 || j + 3 < NT) ATT_SLOAD(SE, (j + 1 + SDEPTH) * KVBLK); ATT_SBAR();
    pv_d0(o, vb0 + SHM_V, pa0, pa1, pa2, pa3); partialSM(pA0, pA1, m_reg, mnA, alA, C, TS);
    __syncthreads(); if (SDEPTH == 1 || j + 3 < NT) ATT_SWAIT(); else asm volatile("s_waitcnt vmcnt(0)" ::: "memory");
    ATT_SWRITE(1, SO);
    ATT_RESC(alA); __syncthreads();
  }
  ATT_SBAR(); qkt<DK, NQR>(pB0, pB1, K_lds + SHM_K, qr, qrl, r32, hi);
  finishSM(pA0, pA1, alA, l_reg, pa0, pa1, pa2, pa3); ATT_SBAR();
  pv_d0(o, vb0, pa0, pa1, pa2, pa3); partialSM(pB0, pB1, m_reg, mnB, alB, C, TS);
  __syncthreads(); ATT_RESC(alB);
  finishSM(pB0, pB1, alB, l_reg, pa0, pa1, pa2, pa3); ATT_SBAR();
  pv_d0(o, vb0 + SHM_V, pa0, pa1, pa2, pa3);
  if (hi == 0) li_l[r32] = l_reg; asm volatile("s_waitcnt lgkmcnt(0)" ::: "memory");
  float rli[16];
#pragma unroll
  for (int r = 0; r < 16; ++r) rli[r] = __builtin_amdgcn_rcpf(li_l[crow(r, hi)]);
  bf16* Ow = Ob + (long)(wid * QBLK) * LDO;
#pragma unroll
  for (int r = 0; r < 16; ++r) { const int orow = crow(r, hi);
#pragma unroll
    for (int d0 = 0; d0 < 4; d0 += 1) { const unsigned w = cvtpk(o[d0][r] * rli[r], 0.f); Ow[(long)orow * LDO + d0 * 32 + r32] = (bf16)(w & 0xffffu); } }
#undef ATT_SLOAD
#undef ATT_SWRITE
#undef ATT_SWAIT
#undef ATT_RESC
}
template <int DK, int LDQ, int LDKN, int LDV, int LDO, int NQR>
__device__ __forceinline__ void attn_unit_dma(const bf16* __restrict__ Qb, const bf16* __restrict__ Kn, const bf16* __restrict__ Kr, const bf16* __restrict__ Vh,
                                              bf16* __restrict__ Ob, int seq, char* lds, __attribute__((address_space(3))) unsigned char* ldsl) {
  constexpr int SHM_V = KVBLK * 128 * 2, SHM_K = KVBLK * DK * 2, KRS = DK * 2, STG = SHM_K + SHM_V, NKI = SHM_K / 8192;
  constexpr float SCALE = (DK == 128) ? 0.088388347648318440f : 0.072168783648703220f;
  constexpr float C = SCALE * 1.4426950408889634f, TS = THR / SCALE;
  int tid_ = threadIdx.x; asm volatile("" : "+v"(tid_));
  const int tid = tid_, wid = __builtin_amdgcn_readfirstlane(tid >> 6), lane = tid & 63, r32 = lane & 31, hi = lane >> 5;
  float* ws = (float*)(lds + 3 * STG) + wid * 64; float* li_l = ws; float* al_l = ws + 32;
  float m_reg = -1e30f, l_reg = 0; f32x16 o[4] = {}; bf16x8 qr[NQR]; constexpr int NQL = DK / 16 - NQR;
  char* qrl = lds + 3 * STG + 2048 + (wid * NQL * 64 + lane) * 16;
#define ATT_BAR() do { asm volatile("" ::: "memory"); __builtin_amdgcn_s_barrier(); asm volatile("" ::: "memory"); } while (0)
#define ATT_WAITV_B() do { if constexpr (NKI == 2) asm volatile("s_waitcnt vmcnt(4)" ::: "memory"); else asm volatile("s_waitcnt vmcnt(5)" ::: "memory"); } while (0)
#define ATT_WAITV_2B() do { if constexpr (NKI == 2) asm volatile("s_waitcnt vmcnt(8)" ::: "memory"); else asm volatile("s_waitcnt vmcnt(10)" ::: "memory"); } while (0)
  asm volatile("s_waitcnt vmcnt(0) lgkmcnt(0)" ::: "memory"); ATT_BAR();
  const bf16* Qw = Qb + (long)(wid * QBLK + r32) * LDQ + hi * 8;
#pragma unroll
  for (int d0 = 0; d0 < NQR; ++d0) qr[d0] = ld8(Qw + d0 * 16);
  if constexpr (NQL > 0) {
#pragma unroll
    for (int f = 0; f < NQL; ++f) *reinterpret_cast<bf16x8*>(qrl + f * 1024) = ld8(Qw + (NQR + f) * 16); }
  const char* ksrc[NKI]; int kinc[NKI]; const char* vsrc[2];
#pragma unroll
  for (int i = 0; i < NKI; ++i) { const int p = (i * 8 + wid) * 1024 + lane * 16, row = p / KRS, cb = (p % KRS) ^ ((row & 7) << 4);
    if (DK == 128 || cb < 256) { ksrc[i] = (const char*)Kn + ((long)row * LDKN) * 2 + cb; kinc[i] = KVBLK * LDKN * 2; }
    else { ksrc[i] = (const char*)Kr + row * 128 + (cb - 256); kinc[i] = KVBLK * 128; } }
#pragma unroll
  for (int i = 0; i < 2; ++i) { const int p = (i * 8 + wid) * 1024 + lane * 16, sub = p >> 9, q = p & 511, kk = ((sub >> 2) << 3) | (q >> 6), col = (sub & 3) * 32 + ((q & 63) >> 1);
    const int key = (kk & ~0xC) | ((kk & 4) << 1) | ((kk & 8) >> 1); vsrc[i] = (const char*)Vh + ((long)key * LDV + col) * 2; }
  constexpr int vinc = KVBLK * LDV * 2;
#define ATT_ISSUE(t, s) do { const int t_ = (t); const unsigned so_ = (unsigned)(s) * STG; \
    _Pragma("unroll") for (int i_ = 0; i_ < NKI; ++i_) __builtin_amdgcn_global_load_lds((const unsigned*)(ksrc[i_] + (long)t_ * kinc[i_]), (__attribute__((address_space(3))) unsigned*)(ldsl + so_ + (i_ * 8 + wid) * 1024), 16, 0, 0); \
    _Pragma("unroll") for (int i_ = 0; i_ < 2; ++i_) __builtin_amdgcn_global_load_lds((const unsigned*)(vsrc[i_] + (long)t_ * vinc), (__attribute__((address_space(3))) unsigned*)(ldsl + so_ + SHM_K + (i_ * 8 + wid) * 1024), 16, 0, 0); } while (0)
#define ATT_RESC2(a) do { if (__any((a) < 1.f)) { if (hi == 0) al_l[r32] = (a); asm volatile("s_waitcnt lgkmcnt(0)" ::: "memory"); \
    _Pragma("unroll") for (int d = 0; d < 4; ++d) _Pragma("unroll") for (int r = 0; r < 16; ++r) o[d][r] *= al_l[crow(r, hi)]; } } while (0)
  f32x16 pA0, pA1, pB0, pB1; float mnA, mnB, alA, alB; bf16x8 pa0, pa1, pa2, pa3; const int NT = seq / KVBLK;
  const int vbase = (int)(uintptr_t)lds + SHM_K + v_rd_base(lane);
  asm volatile("s_waitcnt vmcnt(0)" ::: "memory");
  ATT_ISSUE(0, 0); ATT_ISSUE(1, 1); ATT_ISSUE(2, 2);
  ATT_WAITV_2B(); ATT_BAR();
  qkt<DK, NQR>(pA0, pA1, lds, qr, qrl, r32, hi); partialSM(pA0, pA1, m_reg, mnA, alA, C, TS);
  ATT_WAITV_B(); ATT_BAR();
  int s = 1, sp = 0;
  for (int j = 1; j + 1 < NT; j += 2) {
    const int sn = 3 - s - sp;
    ATT_SBAR(); qkt<DK, NQR>(pB0, pB1, lds + s * STG, qr, qrl, r32, hi);
    finishSM(pA0, pA1, alA, l_reg, pa0, pa1, pa2, pa3); ATT_SBAR();
    pv_d0(o, vbase + sp * STG, pa0, pa1, pa2, pa3); partialSM(pB0, pB1, m_reg, mnB, alB, C, TS);
    asm volatile("s_waitcnt lgkmcnt(0)" ::: "memory"); ATT_BAR();
    const bool i2 = j + 2 < NT; if (i2) ATT_ISSUE(j + 2, sp);
    ATT_RESC2(alB);
    if (i2) ATT_WAITV_B(); else asm volatile("s_waitcnt vmcnt(0)" ::: "memory");
    ATT_BAR();
    ATT_SBAR(); qkt<DK, NQR>(pA0, pA1, lds + sn * STG, qr, qrl, r32, hi);
    finishSM(pB0, pB1, alB, l_reg, pa0, pa1, pa2, pa3); ATT_SBAR();
    pv_d0(o, vbase + s * STG, pa0, pa1, pa2, pa3); partialSM(pA0, pA1, m_reg, mnA, alA, C, TS);
    asm volatile("s_waitcnt lgkmcnt(0)" ::: "memory"); ATT_BAR();
    const bool i3 = j + 3 < NT; if (i3) ATT_ISSUE(j + 3, s);
    ATT_RESC2(alA);
    if (i3) ATT_WAITV_B(); else asm volatile("s_waitcnt vmcnt(0)" ::: "memory");
    ATT_BAR();
    const int s2 = sp; sp = sn; s = s2;
  }
  ATT_SBAR(); qkt<DK, NQR>(pB0, pB1, lds + s * STG, qr, qrl, r32, hi);
  finishSM(pA0, pA1, alA, l_reg, pa0, pa1, pa2, pa3); ATT_SBAR();
  pv_d0(o, vbase + sp * STG, pa0, pa1, pa2, pa3); partialSM(pB0, pB1, m_reg, mnB, alB, C, TS);
  ATT_RESC2(alB);
  finishSM(pB0, pB1, alB, l_reg, pa0, pa1, pa2, pa3); ATT_SBAR();
  pv_d0(o, vbase + s * STG, pa0, pa1, pa2, pa3);
  if (hi == 0) li_l[r32] = l_reg; asm volatile("s_waitcnt lgkmcnt(0)" ::: "memory");
  float rli[16];
#pragma unroll
  for (int r = 0; r < 16; ++r) rli[r] = __builtin_amdgcn_rcpf(li_l[crow(r, hi)]);
  bf16* Ow = Ob + (long)(wid * QBLK) * LDO;
#pragma unroll
  for (int r = 0; r < 16; ++r) { const int orow = crow(r, hi);
#pragma unroll
    for (int d0 = 0; d0 < 4; d0 += 1) { const unsigned w = cvtpk(o[d0][r] * rli[r], 0.f); Ow[(long)orow * LDO + d0 * 32 + r32] = (bf16)(w & 0xffffu); } }
#undef ATT_BAR
#undef ATT_WAITV_B
#undef ATT_WAITV_2B
#undef ATT_ISSUE
#undef ATT_RESC2
}

using f32x4a = __attribute__((ext_vector_type(4))) float;
__device__ __forceinline__ float max_x16(float v) { auto rr = __builtin_amdgcn_permlane16_swap(__float_as_uint(v), __float_as_uint(v), false, false); return fmaxf(__uint_as_float(rr[0]), __uint_as_float(rr[1])); }
__device__ __forceinline__ float max_x32(float v) { auto rr = __builtin_amdgcn_permlane32_swap(__float_as_uint(v), __float_as_uint(v), false, false); return fmaxf(__uint_as_float(rr[0]), __uint_as_float(rr[1])); }
__device__ __forceinline__ float add_x16(float v) { auto rr = __builtin_amdgcn_permlane16_swap(__float_as_uint(v), __float_as_uint(v), false, false); return __uint_as_float(rr[0]) + __uint_as_float(rr[1]); }
__device__ __forceinline__ float add_x32(float v) { auto rr = __builtin_amdgcn_permlane32_swap(__float_as_uint(v), __float_as_uint(v), false, false); return __uint_as_float(rr[0]) + __uint_as_float(rr[1]); }
__device__ __forceinline__ int k16_st(int r, int c) { return r * 256 + ((c ^ (r & 15)) << 4); }
__device__ __forceinline__ int kr16_st(int r, int c) { return 16384 + (r >> 1) * 256 + ((((r & 1) << 3) | (c ^ ((r >> 1) & 7))) << 4); }
__device__ __forceinline__ int v16_st(int k, int c) { const int row = (k & 0x23) | (((k >> 2) & 3) << 3) | (((k >> 4) & 1) << 2); return 256 * row + 16 * (c ^ (((row & 3) << 2) | ((row >> 2) & 3))); }

__device__ __forceinline__ void partialSM16(f32x4a (&p)[2][4], float (&m_reg)[2], float (&alpha)[2], const float C, const float TS) {
  float pmax[2];
#pragma unroll
  for (int qb = 0; qb < 2; ++qb) { float v = p[qb][0][0];
#pragma unroll
    for (int kb = 0; kb < 4; ++kb)
#pragma unroll
      for (int r = 0; r < 4; ++r) v = fmaxf(v, p[qb][kb][r]);
    v = max_x16(v); pmax[qb] = max_x32(v); }
  float mn[2];
  if (__builtin_expect(__all((pmax[0] - m_reg[0] <= TS) && (pmax[1] - m_reg[1] <= TS)), 1)) { mn[0] = m_reg[0]; mn[1] = m_reg[1]; alpha[0] = 1.f; alpha[1] = 1.f; }
  else {
#pragma unroll
    for (int qb = 0; qb < 2; ++qb) { mn[qb] = fmaxf(m_reg[qb], pmax[qb]); alpha[qb] = __builtin_amdgcn_exp2f((m_reg[qb] - mn[qb]) * C); m_reg[qb] = mn[qb]; } }
#pragma unroll
  for (int qb = 0; qb < 2; ++qb) { const float mnC = -mn[qb] * C;
#pragma unroll
    for (int kb = 0; kb < 4; ++kb)
#pragma unroll
      for (int r = 0; r < 4; ++r) p[qb][kb][r] = fmaf(p[qb][kb][r], C, mnC); }
#pragma unroll
  for (int qb = 0; qb < 2; ++qb)
#pragma unroll
    for (int kb = 0; kb < 2; ++kb)
#pragma unroll
      for (int r = 0; r < 4; ++r) p[qb][kb][r] = __builtin_amdgcn_exp2f(p[qb][kb][r]);
}
__device__ __forceinline__ void finishSM16(f32x4a (&p)[2][4], const float (&alpha)[2], float (&l_reg)[2], bf16x8 (&pa)[2][2]) {
#pragma unroll
  for (int qb = 0; qb < 2; ++qb)
#pragma unroll
    for (int kb = 2; kb < 4; ++kb)
#pragma unroll
      for (int r = 0; r < 4; ++r) p[qb][kb][r] = __builtin_amdgcn_exp2f(p[qb][kb][r]);
#pragma unroll
  for (int qb = 0; qb < 2; ++qb) { float ps = 0.f;
#pragma unroll
    for (int kb = 0; kb < 4; ++kb) ps += (p[qb][kb][0] + p[qb][kb][1]) + (p[qb][kb][2] + p[qb][kb][3]);
    ps = add_x16(ps); ps = add_x32(ps); l_reg[qb] = l_reg[qb] * alpha[qb] + ps;
#pragma unroll
    for (int ks = 0; ks < 2; ++ks) { u32x4 w = {cvtpk(p[qb][2 * ks][0], p[qb][2 * ks][1]), cvtpk(p[qb][2 * ks][2], p[qb][2 * ks][3]), cvtpk(p[qb][2 * ks + 1][0], p[qb][2 * ks + 1][1]), cvtpk(p[qb][2 * ks + 1][2], p[qb][2 * ks + 1][3])};
      pa[qb][ks] = *reinterpret_cast<bf16x8*>(&w); } }
}
template <int DK, int NQR> __device__ __forceinline__ void qkt16(f32x4a (&p)[2][4], const char* Ks, const bf16x8* qr, const char* qrl, int kbn, int kbr) {
#pragma unroll
  for (int qb = 0; qb < 2; ++qb)
#pragma unroll
    for (int kb = 0; kb < 4; ++kb) p[qb][kb] = (f32x4a){0.f, 0.f, 0.f, 0.f};
#pragma unroll
  for (int s = 0; s < DK / 32; ++s) {
    const bf16x8 q0 = (2 * s < NQR) ? qr[2 * s < NQR ? 2 * s : 0] : *reinterpret_cast<const bf16x8*>(qrl + (2 * s - NQR) * 1024);
    const bf16x8 q1 = (2 * s + 1 < NQR) ? qr[2 * s + 1 < NQR ? 2 * s + 1 : 0] : *reinterpret_cast<const bf16x8*>(qrl + (2 * s + 1 - NQR) * 1024);
    const int ka = (s < 4) ? (kbn ^ (s << 6)) : (kbr ^ ((s - 4) << 6));
#pragma unroll
    for (int kb = 0; kb < 4; ++kb) { const bf16x8 kf = *reinterpret_cast<const bf16x8*>(Ks + ka + kb * ((s < 4) ? 4096 : 2048));
      p[0][kb] = __builtin_amdgcn_mfma_f32_16x16x32_bf16(kf, q0, p[0][kb], 0, 0, 0);
      p[1][kb] = __builtin_amdgcn_mfma_f32_16x16x32_bf16(kf, q1, p[1][kb], 0, 0, 0); }
    if constexpr (DK == 192) { if (s == 1 || s == 3) ATT_SBAR(); } }
}
template <int DB> __device__ __forceinline__ void pv16_one(f32x4a& o0, f32x4a& o1, int vb, const bf16x8 (&pa)[2][2]) {
  const int a0 = vb ^ (32 * DB), a1 = vb ^ (32 * DB + 16);
  const s16x4 b00 = tr_read<0>(a0), b01 = tr_read<1024>(a1), b10 = tr_read<8192>(a0), b11 = tr_read<9216>(a1);
  asm volatile("s_waitcnt lgkmcnt(0)" ::: "memory"); ATT_SBAR();
  const bf16x8 B0 = (bf16x8){b00[0], b00[1], b00[2], b00[3], b01[0], b01[1], b01[2], b01[3]}, B1 = (bf16x8){b10[0], b10[1], b10[2], b10[3], b11[0], b11[1], b11[2], b11[3]};
  o0 = __builtin_amdgcn_mfma_f32_16x16x32_bf16(pa[0][0], B0, o0, 0, 0, 0);
  o1 = __builtin_amdgcn_mfma_f32_16x16x32_bf16(pa[1][0], B0, o1, 0, 0, 0);
  o0 = __builtin_amdgcn_mfma_f32_16x16x32_bf16(pa[0][1], B1, o0, 0, 0, 0);
  o1 = __builtin_amdgcn_mfma_f32_16x16x32_bf16(pa[1][1], B1, o1, 0, 0, 0);
}
__device__ __forceinline__ void pv16(f32x4a (&o)[2][8], int vb, const bf16x8 (&pa)[2][2]) {
  pv16_one<0>(o[0][0], o[1][0], vb, pa); pv16_one<1>(o[0][1], o[1][1], vb, pa); pv16_one<2>(o[0][2], o[1][2], vb, pa); pv16_one<3>(o[0][3], o[1][3], vb, pa);
  pv16_one<4>(o[0][4], o[1][4], vb, pa); pv16_one<5>(o[0][5], o[1][5], vb, pa); pv16_one<6>(o[0][6], o[1][6], vb, pa); pv16_one<7>(o[0][7], o[1][7], vb, pa);
}

template <int DK, int LDQ, int LDKN, int LDV, int LDO, int SDEPTH, int NQR, int QMODE>
__device__ __forceinline__ void attn_unit16(const bf16* __restrict__ Qb, const bf16* __restrict__ Kn, const bf16* __restrict__ Kr, const bf16* __restrict__ Vh,
                                            bf16* __restrict__ Ob, int seq, char* lds, const float* __restrict__ qg, const float* __restrict__ T, int tok0) {
  constexpr int SHM_V = KVBLK * 128 * 2, SHM_K = KVBLK * DK * 2, NF = DK / 16;
  constexpr float SCALE = (DK == 128) ? 0.088388347648318440f : 0.072168783648703220f;
  constexpr float C = SCALE * 1.4426950408889634f, TS = THR / SCALE;
  int tid_ = threadIdx.x; asm volatile("" : "+v"(tid_));
  const int tid = tid_, wid = tid >> 6, lane = tid & 63, li = lane & 15, lg = lane >> 4;
  char* V_lds = lds; char* K_lds = lds + 2 * SHM_V;
  float* ws = (float*)(lds + 2 * SHM_V + 2 * SHM_K) + wid * 64; float* li_l = ws; float* al_l = ws + 32;
  float m_reg[2] = {-1e30f, -1e30f}, l_reg[2] = {0.f, 0.f}; f32x4a o[2][8]; bf16x8 qr[NQR]; constexpr int NQL = NF - NQR;
#pragma unroll
  for (int qb = 0; qb < 2; ++qb)
#pragma unroll
    for (int db = 0; db < 8; ++db) o[qb][db] = (f32x4a){0.f, 0.f, 0.f, 0.f};
  char* qrl = lds + 2 * SHM_V + 2 * SHM_K + 2048 + (wid * NQL * 64 + lane) * 16;
  __syncthreads();
  const bf16* Qw = Qb + (long)(wid * QBLK + li) * LDQ + lg * 8;
  { bf16x8 qraw[NF];
#pragma unroll
    for (int s = 0; s < DK / 32; ++s)
#pragma unroll
      for (int qb = 0; qb < 2; ++qb) qraw[2 * s + qb] = ld8(Qw + (long)(16 * qb) * LDQ + 32 * s);
#define ATT_UNPK(vv_, oo_) do { const u32x4 w_ = *reinterpret_cast<const u32x4*>(&(vv_)); oo_[0] = __uint_as_float(w_[0] << 16); oo_[1] = __uint_as_float(w_[0] & 0xffff0000u); oo_[2] = __uint_as_float(w_[1] << 16); oo_[3] = __uint_as_float(w_[1] & 0xffff0000u); \
      oo_[4] = __uint_as_float(w_[2] << 16); oo_[5] = __uint_as_float(w_[2] & 0xffff0000u); oo_[6] = __uint_as_float(w_[3] << 16); oo_[7] = __uint_as_float(w_[3] & 0xffff0000u); } while (0)
#define ATT_PK(ii_, vv_) do { u32x4 w_ = {cvtpk(ii_[0], ii_[1]), cvtpk(ii_[2], ii_[3]), cvtpk(ii_[4], ii_[5]), cvtpk(ii_[6], ii_[7])}; vv_ = *reinterpret_cast<bf16x8*>(&w_); } while (0)
    if constexpr (QMODE == 1 || QMODE == 2) {
#pragma unroll
      for (int qb = 0; qb < 2; ++qb) {
        float x[4][8]; float ss = 0.f;
#pragma unroll
        for (int s = 0; s < 4; ++s) { ATT_UNPK(qraw[2 * s + qb], x[s]);
#pragma unroll
          for (int j = 0; j < 8; ++j) ss += x[s][j] * x[s][j]; }
        ss = add_x16(ss); ss = add_x32(ss);
        const float rstd = 1.0f / __builtin_sqrtf(ss * (1.0f / 128.0f) + 1e-6f);
#pragma unroll
        for (int s = 0; s < 4; ++s) { const float* gp = qg + 32 * s + 8 * lg;
#pragma unroll
          for (int j = 0; j < 8; ++j) x[s][j] = x[s][j] * rstd * gp[j]; }
        if constexpr (QMODE == 2) {
          const int tok = tok0 + wid * QBLK + 16 * qb + li, prow = tok >> 6, pcol = tok & 63;
#pragma unroll
          for (int ax = 0; ax < 2; ++ax) { const int pos = ax ? pcol : prow; const float* tp = T + ((long)pos * 32 + 8 * lg) * 2;
#pragma unroll
            for (int j = 0; j < 8; ++j) { const float co = tp[2 * j], si = tp[2 * j + 1], x1 = x[2 * ax][j], x2 = x[2 * ax + 1][j];
              x[2 * ax][j] = x1 * co - x2 * si; x[2 * ax + 1][j] = x1 * si + x2 * co; } } }
#pragma unroll
        for (int s = 0; s < 4; ++s) ATT_PK(x[s], qraw[2 * s + qb]);
      }
    }
    if constexpr (QMODE == 3) {
#pragma unroll
      for (int qb = 0; qb < 2; ++qb) { const int tok = tok0 + wid * QBLK + 16 * qb + li, prow = tok >> 6, pcol = tok & 63;
#pragma unroll
        for (int ax = 0; ax < 2; ++ax) { const int pos = ax ? pcol : prow; const float* tp = T + ((long)pos * 16 + 8 * (lg & 1)) * 2;
          const u32x4 w = *reinterpret_cast<const u32x4*>(&qraw[2 * (4 + ax) + qb]); u32x4 wo;
#pragma unroll
          for (int k = 0; k < 4; ++k) { auto rr = __builtin_amdgcn_permlane32_swap(w[k], w[k], false, false);
            const float a1 = __uint_as_float(rr[0] << 16), b1 = __uint_as_float(rr[0] & 0xffff0000u), a2 = __uint_as_float(rr[1] << 16), b2 = __uint_as_float(rr[1] & 0xffff0000u);
            const float co0 = tp[4 * k], si0 = tp[4 * k + 1], co1 = tp[4 * k + 2], si1 = tp[4 * k + 3];
            const float r0 = (lg < 2) ? a1 * co0 - a2 * si0 : a1 * si0 + a2 * co0, r1 = (lg < 2) ? b1 * co1 - b2 * si1 : b1 * si1 + b2 * co1;
            wo[k] = cvtpk(r0, r1); }
          qraw[2 * (4 + ax) + qb] = *reinterpret_cast<bf16x8*>(&wo); } } }
#undef ATT_UNPK
#undef ATT_PK
#pragma unroll
    for (int f = 0; f < NQR; ++f) qr[f] = qraw[f];
    if constexpr (NQL > 0) {
#pragma unroll
      for (int f = 0; f < NQL; ++f) *reinterpret_cast<bf16x8*>(qrl + f * 1024) = qraw[NQR + f]; } }
  const int sr = tid >> 4, sc = (tid & 15) * 8, vst0 = v16_st(sr, tid & 15), vst1 = vst0 + 8192, kst0 = k16_st(sr, tid & 15), kst1 = kst0 + 8192;
  const int rr = tid >> 3, rc = (tid & 7) * 8, krst = kr16_st(rr, tid & 7);
  const int vb0 = (int)(uintptr_t)V_lds + 256 * (8 * lg + (li >> 2)) + 8 * (lane & 1) + 16 * ((((li >> 2) << 2) | ((lg & 1) << 1)) | ((lane >> 1) & 1));
  const int kbn = li * 256 + (((li & 12) | ((lg ^ li) & 3)) << 4), kbr = 16384 + (li >> 1) * 256 + ((((li & 1) << 3) | ((lg ^ (li >> 1)) & 7)) << 4);
  struct { bf16x8 vs0, vs1, ks0, ks1, kr; } sr_[SDEPTH];
#define ATT_SLOAD(i, k0) do { sr_[i].vs0 = ld8(&Vh[(long)((k0) + sr) * LDV + sc]); sr_[i].vs1 = ld8(&Vh[(long)((k0) + 32 + sr) * LDV + sc]); \
    sr_[i].ks0 = ld8(&Kn[(long)((k0) + sr) * LDKN + sc]); sr_[i].ks1 = ld8(&Kn[(long)((k0) + 32 + sr) * LDKN + sc]); \
    if constexpr (DK == 192) sr_[i].kr = ld8(&Kr[(long)((k0) + rr) * 64 + rc]); } while (0)
#define ATT_SWRITE(b, i) do { *(bf16x8*)(V_lds + (b) * SHM_V + vst0) = sr_[i].vs0; *(bf16x8*)(V_lds + (b) * SHM_V + vst1) = sr_[i].vs1; \
    *(bf16x8*)(K_lds + (b) * SHM_K + kst0) = sr_[i].ks0; *(bf16x8*)(K_lds + (b) * SHM_K + kst1) = sr_[i].ks1; \
    if constexpr (DK == 192) *(bf16x8*)(K_lds + (b) * SHM_K + krst) = sr_[i].kr; } while (0)
#define ATT_SWAIT() do { if constexpr (SDEPTH == 1) asm volatile("s_waitcnt vmcnt(0)" ::: "memory"); else if constexpr (DK == 192) asm volatile("s_waitcnt vmcnt(5)" ::: "memory"); else asm volatile("s_waitcnt vmcnt(4)" ::: "memory"); } while (0)
#define ATT_RESC(a) do { if (__any(((a)[0] < 1.f) || ((a)[1] < 1.f))) { if (lg == 0) { al_l[li] = (a)[0]; al_l[16 + li] = (a)[1]; } asm volatile("s_waitcnt lgkmcnt(0)" ::: "memory"); \
    const f32x4a a0_ = *reinterpret_cast<const f32x4a*>(al_l + 4 * lg), a1_ = *reinterpret_cast<const f32x4a*>(al_l + 16 + 4 * lg); \
    _Pragma("unroll") for (int d = 0; d < 8; ++d) { o[0][d] *= a0_; o[1][d] *= a1_; } } } while (0)
  f32x4a pA[2][4], pB[2][4]; float alA[2], alB[2]; bf16x8 pa[2][2]; const int NT = seq / KVBLK;
  constexpr int SE = 0, SO = SDEPTH - 1;
  ATT_SLOAD(SE, 0); asm volatile("s_waitcnt vmcnt(0)" ::: "memory"); ATT_SWRITE(0, SE); __syncthreads();
  qkt16<DK, NQR>(pA, K_lds, qr, qrl, kbn, kbr); partialSM16(pA, m_reg, alA, C, TS);
  ATT_SLOAD(SO, KVBLK); if constexpr (SDEPTH == 2) { if (2 < NT) ATT_SLOAD(SE, 2 * KVBLK); }
  if (2 < NT) ATT_SWAIT(); else asm volatile("s_waitcnt vmcnt(0)" ::: "memory");
  ATT_SWRITE(1, SO); __syncthreads();
  for (int j = 1; j + 1 < NT; j += 2) {
    ATT_SBAR(); qkt16<DK, NQR>(pB, K_lds + SHM_K, qr, qrl, kbn, kbr);
    finishSM16(pA, alA, l_reg, pa); ATT_SBAR();
    ATT_SLOAD(SO, (j + SDEPTH) * KVBLK); ATT_SBAR();
    pv16(o, vb0, pa); partialSM16(pB, m_reg, alB, C, TS);
    __syncthreads(); ATT_SWAIT(); ATT_SWRITE(0, SE);
    ATT_RESC(alB); __syncthreads();
    ATT_SBAR(); qkt16<DK, NQR>(pA, K_lds, qr, qrl, kbn, kbr);
    finishSM16(pB, alB, l_reg, pa); ATT_SBAR();
    if (SDEPTH == 1 || j + 3 < NT) ATT_SLOAD(SE, (j + 1 + SDEPTH) * KVBLK); ATT_SBAR();
    pv16(o, vb0 + SHM_V, pa); partialSM16(pA, m_reg, alA, C, TS);
    __syncthreads(); if (SDEPTH == 1 || j + 3 < NT) ATT_SWAIT(); else asm volatile("s_waitcnt vmcnt(0)" ::: "memory");
    ATT_SWRITE(1, SO);
    ATT_RESC(alA); __syncthreads();
  }
  ATT_SBAR(); qkt16<DK, NQR>(pB, K_lds + SHM_K, qr, qrl, kbn, kbr);
  finishSM16(pA, alA, l_reg, pa); ATT_SBAR();
  pv16(o, vb0, pa); partialSM16(pB, m_reg, alB, C, TS);
  __syncthreads(); ATT_RESC(alB);
  finishSM16(pB, alB, l_reg, pa); ATT_SBAR();
  pv16(o, vb0 + SHM_V, pa);
  if (lg == 0) { li_l[li] = l_reg[0]; li_l[16 + li] = l_reg[1]; } asm volatile("s_waitcnt lgkmcnt(0)" ::: "memory");
  f32x4a rl[2] = {*reinterpret_cast<const f32x4a*>(li_l + 4 * lg), *reinterpret_cast<const f32x4a*>(li_l + 16 + 4 * lg)};
#pragma unroll
  for (int qb = 0; qb < 2; ++qb)
#pragma unroll
    for (int r = 0; r < 4; ++r) rl[qb][r] = __builtin_amdgcn_rcpf(rl[qb][r]);
  bf16* Ow = Ob + (long)(wid * QBLK + 4 * lg) * LDO + li;
#pragma unroll
  for (int qb = 0; qb < 2; ++qb)
#pragma unroll
    for (int r = 0; r < 4; ++r)
#pragma unroll
      for (int db = 0; db < 8; ++db) { const unsigned w = cvtpk(o[qb][db][r] * rl[qb][r], 0.f); Ow[(long)(16 * qb + r) * LDO + 16 * db] = (bf16)(w & 0xffffu); }
#undef ATT_SLOAD
#undef ATT_SWRITE
#undef ATT_SWAIT
#undef ATT_RESC
}
}
constexpr int DM = 2048, NP = 4096  , NS = 16384  , MT = NP + NS  ;
constexpr int SEQ_P = 256, SEQ_S = 4096, PAST = 512, KEYS_S = SEQ_S + PAST  , MK = NP + 4 * KEYS_S  ;
constexpr int ZW = 3840  , AIN = 3648, FF = 5632, NLAYER = 4;
constexpr int ZC_QA = 0, ZC_KA = 1024, ZC_VA = 1280, ZC_QB = 1536, ZC_CKV = 3072, ZC_KR = 3584;
constexpr float EPS = 1e-6f;
constexpr size_t OUT_SK = (size_t)MT * DM, OUT_SV = OUT_SK + 2097152, OUT_SCKV = OUT_SV + 2097152, OUT_SKR = OUT_SCKV + 4194304;

constexpr size_t MiB = 1u << 20;
constexpr size_t WS_CTL = 0, CTL_ZERO_BYTES = 64 * 1024;
constexpr size_t WS_TAB = 1 * MiB;
constexpr size_t WS_MOD = 2 * MiB;
constexpr size_t WS_SS = 3 * MiB;
constexpr size_t WS_WIN = 6 * MiB;
constexpr size_t WS_WKV = 36 * MiB;
constexpr size_t WS_WOUT = 40 * MiB;
constexpr size_t WS_CWIN = 56 * MiB;
constexpr size_t WS_CWOUT = 88 * MiB;
constexpr size_t WS_FGU = 104 * MiB;
constexpr size_t WS_FD = 280 * MiB;
constexpr size_t WS_H = 368 * MiB;
constexpr size_t WS_ACT = 448 * MiB;
constexpr size_t WS_Z = WS_ACT;
constexpr size_t WS_KA = WS_Z + 150 * MiB;
constexpr size_t WS_VA = WS_KA + 11 * MiB;
constexpr size_t WS_CKV = WS_VA + 11 * MiB;
constexpr size_t WS_KR = WS_CKV + 22 * MiB;
constexpr size_t WS_KVB = WS_KR + 3 * MiB;
constexpr size_t WS_O = WS_KVB + 88 * MiB;
constexpr size_t WS_ACT_END = WS_O + 80 * MiB;
constexpr size_t WS_U = WS_ACT, WS_V = WS_ACT + 80 * MiB, WS_MC = WS_ACT + 160 * MiB;
constexpr size_t WS_HH = WS_ACT;
constexpr size_t WS_SSX = WS_ACT_END;
constexpr size_t WS_BIAS1 = WS_ACT_END + 3 * MiB;
constexpr size_t WS_BIAS2 = WS_ACT_END + 4 * MiB;
constexpr size_t WS_XB = WS_ACT_END + 8 * MiB;
constexpr size_t WS_PROBE = WS_ACT_END + 88 * MiB;
constexpr size_t WS_END = WS_ACT_END + 96 * MiB;
constexpr int CW_BAR = 1024;

constexpr int RING_BYTES = 131072;
#ifndef LDS_KB
#define LDS_KB 144
#endif
constexpr int LDS_BYTES = LDS_KB * 1024;
constexpr int MISC_OFF = LDS_BYTES - 64;
constexpr int NWAVES = 8, NTHREADS = 512;

#define GAS __attribute__((address_space(1)))
#define LAS __attribute__((address_space(3)))
typedef unsigned short bf16;
typedef unsigned v4u __attribute__((ext_vector_type(4)));
typedef unsigned v2u __attribute__((ext_vector_type(2)));
typedef float f32x4 __attribute__((ext_vector_type(4)));
typedef short bf16x8 __attribute__((ext_vector_type(8)));
typedef float f32x16 __attribute__((ext_vector_type(16)));
#define LDS_WAIT() asm volatile("s_waitcnt lgkmcnt(0)" ::: "memory")
#define VM_WAIT() asm volatile("s_waitcnt vmcnt(0)" ::: "memory")
__device__ __forceinline__ unsigned pk2(float lo, float hi) { unsigned r; asm volatile("v_cvt_pk_bf16_f32 %0, %1, %2" : "=v"(r) : "v"(lo), "v"(hi)); return r; }
__device__ __forceinline__ float bf_lo(unsigned w) { return __uint_as_float(w << 16); }
__device__ __forceinline__ float bf_hi(unsigned w) { return __uint_as_float(w & 0xffff0000u); }
#define SWZ_XOR(v, m) __int_as_float(__builtin_amdgcn_ds_swizzle(__float_as_int(v), ((m) << 10) | 0x1f))
__device__ __forceinline__ float add_xor32(float v) { auto rr = __builtin_amdgcn_permlane32_swap(__float_as_uint(v), __float_as_uint(v), false, false); return __uint_as_float(rr[0]) + __uint_as_float(rr[1]); }
__device__ __forceinline__ float wave_sum(float v) {
    v += SWZ_XOR(v, 1); v += SWZ_XOR(v, 2); v += SWZ_XOR(v, 4); v += SWZ_XOR(v, 8); v += SWZ_XOR(v, 16);
    return add_xor32(v);
}

#define XB_TMO      128
#define XB_XCNT(j)  (256  + 64 * (j))
#define XB_XSUB(j)  (1280 + 64 * (j))
#define XB_XGEN(j)  (2304 + 64 * (j))
#define XB_TOP      3328
#define XB_TOPGEN   3392
#define XCD_BAR_WORDS 3456
#define XB_SPIN_CAP (1u << 18)
#define LAS __attribute__((address_space(3)))

__device__ __forceinline__ unsigned xb_ld(unsigned* p)              { return __hip_atomic_load(p, __ATOMIC_RELAXED, __HIP_MEMORY_SCOPE_AGENT); }
__device__ __forceinline__ unsigned xb_add(unsigned* p, unsigned v) { return __hip_atomic_fetch_add(p, v, __ATOMIC_RELAXED, __HIP_MEMORY_SCOPE_AGENT); }
__device__ __forceinline__ unsigned xb_xcc_id() { return (unsigned)__builtin_amdgcn_s_getreg((3 << 11) | 20) & 0xFu; }
#define XB_SPIN(cond, bar) do { unsigned _sp = 0; while (cond) { __builtin_amdgcn_s_sleep(1); \
    if ((++_sp & 255u) == 0u) { if (xb_ld(&(bar)[XB_TMO])) break; if (_sp > XB_SPIN_CAP) { atomicAdd(&(bar)[XB_TMO], 1u); break; } } } } while (0)

struct XcdBarrier {
    unsigned* bar; unsigned x;
    volatile LAS unsigned* st;
};

__device__ __forceinline__ XcdBarrier xcd_barrier_post(unsigned* bar, volatile LAS unsigned* st) {
    XcdBarrier b; b.bar = bar; b.x = xb_xcc_id(); b.st = st;
    if (threadIdx.x == 0) (void)xb_add(&bar[XB_XCNT(b.x)], 1u);
    return b;
}
__device__ __forceinline__ void xcd_barrier_complete(unsigned* bar, unsigned x, unsigned& nloc, unsigned& nx) {
    const unsigned G = gridDim.x * gridDim.y * gridDim.z;
    unsigned sum, cnt, mine, sp = 0u;
    for (;;) {
        sum = 0u; cnt = 0u; mine = 0u;
#pragma unroll
        for (unsigned j = 0; j < 16; ++j) { const unsigned c = xb_ld(&bar[XB_XCNT(j)]); sum += c; cnt += (c > 0u) ? 1u : 0u; mine = (j == x) ? c : mine; }
        if (sum == G) break;
        __builtin_amdgcn_s_sleep(1);
        if ((++sp & 255u) == 0u) { if (xb_ld(&bar[XB_TMO])) break; if (sp > XB_SPIN_CAP) { atomicAdd(&bar[XB_TMO], 1u); break; } }
    }
    nloc = mine > 0u ? mine : 1u; nx = cnt > 0u ? cnt : 1u;
}

__device__ __forceinline__ void xcd_barrier(const XcdBarrier& b) {
    asm volatile("s_waitcnt vmcnt(0)" ::: "memory");
    __syncthreads();
    if (threadIdx.x == 0) {
        unsigned* bar = b.bar;
        __builtin_amdgcn_s_waitcnt(0);
        unsigned nloc = b.st[0], nx = b.st[1];
        if (nloc == 0u) { xcd_barrier_complete(bar, b.x, nloc, nx); b.st[0] = nloc; b.st[1] = nx; }
        const unsigned old = xb_add(&bar[XB_XSUB(b.x)], 1u);
        const unsigned gen = old / nloc;
        if (old + 1u == (gen + 1u) * nloc) {
            __builtin_amdgcn_fence(__ATOMIC_RELEASE, "agent");
            asm volatile("s_waitcnt vmcnt(0)" ::: "memory");
            const unsigned og = xb_add(&bar[XB_TOP], 1u);
            const unsigned tg = og / nx;
            if (og + 1u == (tg + 1u) * nx) xb_add(&bar[XB_TOPGEN], 1u);
            else XB_SPIN(xb_ld(&bar[XB_TOPGEN]) == tg, bar);
            __builtin_amdgcn_fence(__ATOMIC_ACQUIRE, "agent");
            xb_add(&bar[XB_XGEN(b.x)], 1u);
            asm volatile("s_waitcnt vmcnt(0)" ::: "memory");
        } else {
            XB_SPIN(xb_ld(&bar[XB_XGEN(b.x)]) == gen, bar);
            __builtin_amdgcn_fence(__ATOMIC_ACQUIRE, "agent");
            asm volatile("s_waitcnt vmcnt(0)" ::: "memory");
        }
    }
    __syncthreads();
}

struct Args { const GAS float* in[27]; GAS float* out_f; GAS unsigned char* ws_b; int ph_lo, ph_hi; };
typedef __attribute__((address_space(4))) const Args* KArgsPtr;
struct InProxy { KArgsPtr ka; __device__ __forceinline__ const float* operator[](int i) const { return (const float*)ka->in[i]; } };
struct Frame {
    LAS unsigned char* lds;
    char* ldsg;
    int tid, lane, wave, bid, G;
    InProxy in;
    float* out; unsigned char* ws;
};
#define PHASE_BEGIN(F) do { GAS unsigned char* w_ = (F).in.ka->ws_b; GAS float* o_ = (F).in.ka->out_f; int g_ = (int)gridDim.x, b_ = (int)blockIdx.x, t_ = (int)threadIdx.x; \
    asm volatile("" : "+s"(w_), "+s"(o_), "+s"(g_), "+s"(b_), "+v"(t_)); (F).ws = (unsigned char*)w_; (F).out = (float*)o_; (F).G = g_; (F).bid = b_; (F).tid = t_; (F).lane = t_ & 63; (F).wave = __builtin_amdgcn_readfirstlane(t_ >> 6); } while (0)
#define FRAME_REFRESH(F) do { } while (0)
#ifndef PROBE_T
#define PROBE_T 0
#endif
#define PROBE_STAMP(F, k) do { if (PROBE_T && blockIdx.x == 0 && threadIdx.x == 0) { ((unsigned long long*)((F).ws + WS_PROBE))[(k)] = __builtin_amdgcn_s_memrealtime(); ((unsigned long long*)((F).ws + WS_PROBE))[64 + (k)] = __builtin_amdgcn_s_memtime(); } } while (0)
enum { I_XP = 0, I_XS, I_C, I_CK, I_CV, I_CCKV, I_CKR, I_CCTX, I_ADAW, I_ADAB, I_NMIX, I_NFFN, I_FG, I_FU, I_FD, I_AWIN, I_AQN, I_AKN, I_AKVN, I_AWKV, I_AWOUT, I_CWIN, I_CVN, I_CWS, I_CBS, I_CWOUT, I_FNORM };

#ifndef NT_WEIGHTS
#define NT_WEIGHTS 1
#endif
#if NT_WEIGHTS
#define NT_LOAD4(p) __builtin_nontemporal_load(p)
#else
#define NT_LOAD4(p) (*(p))
#endif
struct ConvItem { const float* W; bf16* WT; int K, N, k0, n0, drow0; };
__device__ __forceinline__ void conv_issue(const ConvItem& c, f32x4 (&v)[16], int lane) {
    const int kr = lane >> 4, n4 = (lane & 15) * 4;
#pragma unroll
    for (int i = 0; i < 16; ++i) v[i] = NT_LOAD4((const GAS f32x4*)(c.W + (size_t)(c.k0 + 4 * i + kr) * c.N + c.n0 + n4));
}
__device__ __forceinline__ void conv_finish(const ConvItem& c, const f32x4 (&v)[16], LAS float* scr, int lane) {
    const int kr = lane >> 4, n4 = (lane & 15) * 4;
#pragma unroll
    for (int i = 0; i < 16; ++i) { LAS float* d = scr + (4 * i + kr) * 65 + n4; d[0] = v[i].x; d[1] = v[i].y; d[2] = v[i].z; d[3] = v[i].w; }
    LDS_WAIT(); asm volatile("" ::: "memory");
    const int cc = lane & 7;
#pragma unroll
    for (int j = 0; j < 8; ++j) { const int n = (lane >> 3) + 8 * j; const LAS float* s = scr + (8 * cc) * 65 + n;
        v4u o; o.x = pk2(s[0 * 65], s[1 * 65]); o.y = pk2(s[2 * 65], s[3 * 65]); o.z = pk2(s[4 * 65], s[5 * 65]); o.w = pk2(s[6 * 65], s[7 * 65]);
        *(GAS v4u*)(c.WT + (size_t)(c.drow0 + n) * c.K + c.k0 + 8 * cc) = o; }
    LDS_WAIT(); asm volatile("" ::: "memory");
}
__device__ __forceinline__ void rope_entry(int pos, int i, double r, float& co, float& si) {
    double inv = 1.0; for (int k = 0; k < i; ++k) inv *= r;
    const double ang = (double)pos * inv;
    const double n = __builtin_rint(ang * 0.63661977236758134308);
    const double x = (ang - n * 1.57079632679489655800) - n * 6.12323399573676603587e-17;
    const double x2 = x * x;
    const double s = x * (1.0 + x2 * (-1.0 / 6 + x2 * (1.0 / 120 + x2 * (-1.0 / 5040 + x2 * (1.0 / 362880 + x2 * (-1.0 / 39916800 + x2 * (1.0 / 6227020800.0 + x2 * (-1.0 / 1307674368000.0))))))));
    const double c = 1.0 + x2 * (-0.5 + x2 * (1.0 / 24 + x2 * (-1.0 / 720 + x2 * (1.0 / 40320 + x2 * (-1.0 / 3628800 + x2 * (1.0 / 479001600 + x2 * (-1.0 / 87178291200.0 + x2 * (1.0 / 20922789888000.0))))))));
    const int q = ((int)n) & 3;
    const double cc = (q == 0) ? c : (q == 1) ? -s : (q == 2) ? -c : s;
    const double ss = (q == 0) ? s : (q == 1) ? c : (q == 2) ? -s : -c;
    co = (float)cc; si = (float)ss;
}
__device__ __forceinline__ void ada_layer(Frame& F, int layer, int it_lo, int it_hi, int widx, int nwg) {
    LAS float* SC = (LAS float*)F.lds;
    LAS float* RED = (LAS float*)(F.lds + 40960);
    __syncthreads();
    for (int idx = F.tid; idx < 5 * DM; idx += NTHREADS) { const int cd = idx >> 11, k = idx & 2047; const float v = cd == 0 ? F.in[I_CCTX][k] : F.in[I_C][(cd - 1) * DM + k];
        SC[idx] = v / (1.0f + __expf(-v)); }
    __syncthreads();
    float* MOD = (float*)(F.ws + WS_MOD);
    for (int it = it_lo + widx; it < it_hi; it += nwg) {
        const int c0 = it * 32, cg = F.lane & 7, rsub = F.lane >> 3;
        const float* W = F.in[I_ADAW] + (size_t)layer * DM * 12288 + c0 + 4 * cg;
        f32x4 acc[5];
#pragma unroll
        for (int cd = 0; cd < 5; ++cd) acc[cd] = (f32x4){0.f, 0.f, 0.f, 0.f};
        f32x4 w[32];
#pragma unroll
        for (int i = 0; i < 32; ++i) w[i] = NT_LOAD4((const GAS f32x4*)(W + (size_t)(256 * F.wave + 8 * i + rsub) * 12288));
#pragma unroll
        for (int i = 0; i < 32; ++i) { const int k = 256 * F.wave + 8 * i + rsub;
#pragma unroll
            for (int cd = 0; cd < 5; ++cd) acc[cd] += SC[cd * DM + k] * w[i]; }
#pragma unroll
        for (int cd = 0; cd < 5; ++cd)
#pragma unroll
            for (int e = 0; e < 4; ++e) { float v = acc[cd][e]; v += SWZ_XOR(v, 8); v += SWZ_XOR(v, 16); v = add_xor32(v); acc[cd][e] = v; }
        if (rsub == 0) {
#pragma unroll
            for (int cd = 0; cd < 5; ++cd) *(LAS f32x4*)(RED + (F.wave * 5 + cd) * 32 + 4 * cg) = acc[cd]; }
        __syncthreads();
        if (F.tid < 160) { const int cd = F.tid >> 5, col = F.tid & 31; float s = 0.f;
#pragma unroll
            for (int w = 0; w < 8; ++w) s += RED[(w * 5 + cd) * 32 + col];
            MOD[((size_t)layer * 5 + cd) * 12288 + c0 + col] = s + F.in[I_ADAB][layer * 12288 + c0 + col]; }
        __syncthreads();
    }
}
__device__ __forceinline__ ConvItem conv_decode(Frame& F, int L, int part, int it) {
    constexpr int I_WIN = 32 * 57, I_WKV = 8 * 32, I_WOUT = 32 * 32, I_CWI = 32 * 64, I_FGU = 32 * 88;
    const int j = L >> 1; const bool attn = (L & 1) == 0;
    const float* W; bf16* WT; int K, N, r, gu = -1;
    if (part) { const int m = it / I_FGU; r = it % I_FGU;
        if (m < 2) { gu = m; K = DM; N = FF; W = (gu ? F.in[I_FU] : F.in[I_FG]) + (size_t)L * DM * FF; WT = (bf16*)(F.ws + WS_FGU) + (size_t)L * 2 * FF * DM; }
        else { K = FF; N = DM; W = F.in[I_FD] + (size_t)L * FF * DM; WT = (bf16*)(F.ws + WS_FD) + (size_t)L * DM * FF; } }
    else if (attn) {
        if (it < I_WIN) { r = it; K = DM; N = AIN; W = F.in[I_AWIN] + (size_t)j * DM * AIN; WT = (bf16*)(F.ws + WS_WIN) + (size_t)j * ZW * DM; }
        else if (it < I_WIN + I_WKV) { r = it - I_WIN; K = 512; N = 2048; W = F.in[I_AWKV] + (size_t)j * 512 * 2048; WT = (bf16*)(F.ws + WS_WKV) + (size_t)j * 2048 * 512; }
        else { r = it - I_WIN - I_WKV; K = DM; N = DM; W = F.in[I_AWOUT] + (size_t)j * DM * DM; WT = (bf16*)(F.ws + WS_WOUT) + (size_t)j * DM * DM; } }
    else {
        if (it < I_CWI) { r = it; K = DM; N = 4096; W = F.in[I_CWIN] + (size_t)j * DM * 4096; WT = (bf16*)(F.ws + WS_CWIN) + (size_t)j * 4096 * DM; }
        else { r = it - I_CWI; K = DM; N = DM; W = F.in[I_CWOUT] + (size_t)j * DM * DM; WT = (bf16*)(F.ws + WS_CWOUT) + (size_t)j * DM * DM; } }
    const int nblk = N / 64, kb = r / nblk, nb = r % nblk, n0 = 64 * nb;
    const int drow0 = (gu < 0) ? n0 : ((n0 >> 7) * 256 + gu * 128 + (n0 & 127));
    return ConvItem{W, WT, K, N, 64 * kb, n0, drow0};
}
__device__ __forceinline__ void conv_items(Frame& F, int L, int part, int widx, int nw, int it_lo = 0, int it_hi = 0x7fffffff) {
    LAS float* scr = (LAS float*)(F.lds + F.wave * 16640);
    constexpr int I_WIN = 32 * 57, I_WKV = 8 * 32, I_WOUT = 32 * 32, I_CWI = 32 * 64, I_FGU = 32 * 88;
    const bool attn = (L & 1) == 0;
    const int count_ = part ? 3 * I_FGU : (attn ? I_WIN + I_WKV + I_WOUT : I_CWI + I_WOUT), count = count_ < it_hi ? count_ : it_hi;
    f32x4 va[16], vb[16]; ConvItem ca, cb;
    int it = it_lo + widx;
    if (it < count) { ca = conv_decode(F, L, part, it); conv_issue(ca, va, F.lane); }
    while (it < count) {
        const int itb = it + nw; const bool hb = itb < count;
        if (hb) { cb = conv_decode(F, L, part, itb); conv_issue(cb, vb, F.lane); }
        conv_finish(ca, va, scr, F.lane);
        it = itb + nw;
        if (it < count) { ca = conv_decode(F, L, part, it); conv_issue(ca, va, F.lane); }
        if (hb) conv_finish(cb, vb, scr, F.lane);
    }
}
__device__ __forceinline__ void tail_slot(Frame& F, int first_idle, int& widx, int& nwg) {
    const int fi = (first_idle > 0 && first_idle < F.G) ? first_idle : 0; widx = F.bid - fi; nwg = F.G - fi;
}
#ifndef P0_DEFER8
#define P0_DEFER8 0
#endif
constexpr int P0_FFN_ITEMS = (3 * 32 * 88) * (8 - P0_DEFER8) / 8;
#ifndef SPAT_MRU
#define SPAT_MRU 0
#endif
#ifndef TAIL_CONV
#define TAIL_CONV 1
#endif
__device__ __forceinline__ void p0_prologue(Frame& F) {
    FRAME_REFRESH(F);
    for (int layer = 0; layer < (TAIL_CONV ? 1 : NLAYER); ++layer) ada_layer(F, layer, 0, 384, F.bid, F.G);
    if (F.bid == F.G - 1) {
        float* T128 = (float*)(F.ws + WS_TAB); float* T64 = (float*)(F.ws + WS_TAB + 16384);
        for (int e = F.tid; e < 64 * 32 + 64 * 16; e += NTHREADS) {
            float co, si;
            if (e < 2048) { rope_entry(e >> 5, e & 31, 0.74989420933245582730, co, si); T128[2 * e] = co; T128[2 * e + 1] = si; }
            else { const int f = e - 2048; rope_entry(f >> 4, f & 15, 0.56234132519034908039, co, si); T64[2 * f] = co; T64[2 * f + 1] = si; }
        }
    }
    { const size_t n16 = (size_t)(ZW - AIN) * DM * 2 / 16;
      for (size_t i = (size_t)F.bid * NTHREADS + F.tid; i < 2 * n16; i += (size_t)F.G * NTHREADS) { const size_t l = i / n16, r = i % n16;
          *(GAS v4u*)(F.ws + WS_WIN + l * ((size_t)ZW * DM * 2) + (size_t)AIN * DM * 2 + r * 16) = (v4u){0u, 0u, 0u, 0u}; } }
    __syncthreads();
    const int gw = F.bid * NWAVES + F.wave, NGW = F.G * NWAVES;
    for (int L = 0; L < (TAIL_CONV ? 1 : NLAYER); ++L) { conv_items(F, L, 0, gw, NGW); conv_items(F, L, 1, gw, NGW, 0, (L == 0 && TAIL_CONV) ? P0_FFN_ITEMS : 0x7fffffff); }
}

__device__ __forceinline__ void unpack8(const v4u w, float (&x)[8]) { x[0] = bf_lo(w.x); x[1] = bf_hi(w.x); x[2] = bf_lo(w.y); x[3] = bf_hi(w.y); x[4] = bf_lo(w.z); x[5] = bf_hi(w.z); x[6] = bf_lo(w.w); x[7] = bf_hi(w.w); }
__device__ __forceinline__ void mod0_phase(Frame& F, const float* x_lo, const float* x_hi, const float* gain, const float* modl  ) {
    bf16* H = (bf16*)(F.ws + WS_H); float* SSX = (float*)(F.ws + WS_SSX);
    const int gw = F.bid * NWAVES + F.wave, NGW = F.G * NWAVES;
    LAS float* GS = (LAS float*)F.lds;
    __syncthreads();
    for (int i = F.tid; i < 5 * DM / 4; i += NTHREADS) { const int cd = i >> 9, c4 = i & 511; const f32x4 g = ((const GAS f32x4*)gain)[c4], a = ((const GAS f32x4*)(modl + (size_t)cd * 12288 + DM))[c4];
        ((LAS f32x4*)GS)[i] = g * (1.0f + a); }
    __syncthreads();
#define MOD0_ROW(m_) (((m_) < NP) ? x_lo + (size_t)(m_) * DM : x_hi + (size_t)((m_) - NP) * DM)
    f32x4 v[8]; int m = gw;
    if (m < MT) { const float* xr = MOD0_ROW(m);
#pragma unroll
        for (int j = 0; j < 8; ++j) v[j] = ((const GAS f32x4*)xr)[F.lane + 64 * j]; }
    for (; m < MT; m += NGW) {
        const int mn = m + NGW; f32x4 vn[8];
        if (mn < MT) { const float* xn = MOD0_ROW(mn);
#pragma unroll
            for (int j = 0; j < 8; ++j) vn[j] = ((const GAS f32x4*)xn)[F.lane + 64 * j]; }
        const int cd = (m < NP) ? 0 : 1 + ((m - NP) >> 12);
        float s = 0.f;
#pragma unroll
        for (int j = 0; j < 8; ++j) s += (v[j].x * v[j].x + v[j].y * v[j].y) + (v[j].z * v[j].z + v[j].w * v[j].w);
        s = wave_sum(s);
        if (F.lane < 32) SSX[(size_t)m * 32 + F.lane] = F.lane == 0 ? s : 0.f;
        GAS v2u* o8 = (GAS v2u*)(H + (size_t)m * DM) + F.lane;
#pragma unroll
        for (int j = 0; j < 8; ++j) { const f32x4 y = v[j] * ((LAS f32x4*)GS)[cd * 512 + F.lane + 64 * j];
            v2u w; w.x = pk2(y.x, y.y); w.y = pk2(y.z, y.w); o8[64 * j] = w; }
#pragma unroll
        for (int j = 0; j < 8; ++j) v[j] = vn[j];
    }
#undef MOD0_ROW
}
__device__ __forceinline__ void bias_rows(Frame& F, const bf16* Bt, int nrows, const float* sh  , float* out, int ldb, int widx, int nw) {
    LAS float* SH = (LAS float*)F.lds;
    __syncthreads();
    for (int idx = F.tid; idx < 5 * DM; idx += NTHREADS) SH[idx] = sh[(size_t)(idx >> 11) * 12288 + (idx & 2047)];
    __syncthreads();
    v4u wn[4];
    if (widx < nrows) { const GAS v4u* bp = (const GAS v4u*)(Bt + (size_t)widx * DM) + F.lane;
#pragma unroll
        for (int i = 0; i < 4; ++i) wn[i] = bp[64 * i]; }
    for (int n = widx; n < nrows; n += nw) {
        v4u w[4];
#pragma unroll
        for (int i = 0; i < 4; ++i) w[i] = wn[i];
        if (n + nw < nrows) { const GAS v4u* bp = (const GAS v4u*)(Bt + (size_t)(n + nw) * DM) + F.lane;
#pragma unroll
            for (int i = 0; i < 4; ++i) wn[i] = bp[64 * i]; }
        float acc[5] = {0.f, 0.f, 0.f, 0.f, 0.f};
#pragma unroll
        for (int i = 0; i < 4; ++i) { float x[8]; unpack8(w[i], x);
#pragma unroll
            for (int cd = 0; cd < 5; ++cd) { const LAS f32x4* sp = (const LAS f32x4*)(SH + cd * DM + 8 * F.lane + 512 * i); const f32x4 a = sp[0], b = sp[1];
                acc[cd] += (x[0] * a.x + x[1] * a.y) + (x[2] * a.z + x[3] * a.w) + (x[4] * b.x + x[5] * b.y) + (x[6] * b.z + x[7] * b.w); } }
#pragma unroll
        for (int cd = 0; cd < 5; ++cd) { const float s = wave_sum(acc[cd]); if (F.lane == 0) out[(size_t)cd * ldb + n] = s; }
    }
    __syncthreads();
}
__device__ __forceinline__ void final_row(Frame& F, int m) {
    const bf16* HB = (const bf16*)(F.ws + WS_H); const float* SSX = (const float*)(F.ws + WS_SSX);
    const GAS v4u* xr = (const GAS v4u*)(HB + (size_t)m * DM); GAS f32x4* yr = (GAS f32x4*)(F.out + (size_t)m * DM);
    v4u w[4];
#pragma unroll
    for (int j = 0; j < 4; ++j) w[j] = xr[F.lane + 64 * j];
    float s = SSX[(size_t)m * 32 + (F.lane & 31)]; s += SWZ_XOR(s, 1); s += SWZ_XOR(s, 2); s += SWZ_XOR(s, 4); s += SWZ_XOR(s, 8); s += SWZ_XOR(s, 16);
    const float rstd = 1.0f / sqrtf(s * (1.0f / DM) + EPS);
#pragma unroll
    for (int j = 0; j < 4; ++j) { float v[8]; unpack8(w[j], v);
        yr[2 * (F.lane + 64 * j)] = (f32x4){v[0], v[1], v[2], v[3]} * rstd; yr[2 * (F.lane + 64 * j) + 1] = (f32x4){v[4], v[5], v[6], v[7]} * rstd; }
}
__device__ __forceinline__ void final_phase(Frame& F) {
    FRAME_REFRESH(F);
    const int gw = F.bid * NWAVES + F.wave, NGW = F.G * NWAVES;
    for (int m = gw; m < MT; m += NGW) final_row(F, m);
}

__device__ __forceinline__ void head_norm_rope16(float (&x)[16], int s, const float* gain128, bool rope, int prow, int pcol, const float* T128) {
    float ss = 0.f;
#pragma unroll
    for (int e = 0; e < 16; ++e) ss += x[e] * x[e];
    ss += SWZ_XOR(ss, 1); ss += SWZ_XOR(ss, 2); ss += SWZ_XOR(ss, 4);
    const float rstd = 1.0f / sqrtf(ss * (1.0f / 128.0f) + EPS);
#pragma unroll
    for (int e = 0; e < 16; ++e) x[e] = x[e] * rstd * gain128[16 * s + e];
    if (rope) {
        const int pos = (s >> 2) ? pcol : prow; const bool second = (s >> 1) & 1; const float* t = T128 + ((size_t)pos * 32 + 16 * (s & 1)) * 2;
#pragma unroll
        for (int e = 0; e < 16; ++e) { const float xp = SWZ_XOR(x[e], 2); const float co = t[2 * e], si = t[2 * e + 1];
            x[e] = x[e] * co + (second ? xp * si : -xp * si); }
    }
}
__device__ __forceinline__ void rope8(float (&x)[8], int s, int prow, int pcol, const float* T64) {
    const int pos = (s >> 2) ? pcol : prow; const bool second = (s >> 1) & 1; const float* t = T64 + ((size_t)pos * 16 + 8 * (s & 1)) * 2;
#pragma unroll
    for (int e = 0; e < 8; ++e) { const float xp = SWZ_XOR(x[e], 2); const float co = t[2 * e], si = t[2 * e + 1];
        x[e] = x[e] * co + (second ? xp * si : -xp * si); }
}
__device__ __forceinline__ v4u pack8(const float* x) { v4u w; w.x = pk2(x[0], x[1]); w.y = pk2(x[2], x[3]); w.z = pk2(x[4], x[5]); w.w = pk2(x[6], x[7]); return w; }
__device__ __forceinline__ void post_phase(Frame& F, int j, bool dry = false) {
    FRAME_REFRESH(F);
    bf16* Z = (bf16*)(F.ws + WS_Z); bf16* KA = (bf16*)(F.ws + WS_KA); bf16* VA = (bf16*)(F.ws + WS_VA); bf16* CKV = (bf16*)(F.ws + WS_CKV); bf16* KR = (bf16*)(F.ws + WS_KR);
    const float* T128 = (const float*)(F.ws + WS_TAB); const float* T64 = (const float*)(F.ws + WS_TAB + 16384);
    const float* qn = F.in[I_AQN] + j * 128; const float* kn = F.in[I_AKN] + j * 128; const float* kvn = F.in[I_AKVN] + j * 512;
    const int gw = F.bid * NWAVES + F.wave, NGW = F.G * NWAVES, lane = F.lane, s = lane & 7;
    for (int m = MT + gw; m < MT + 4 * PAST; m += NGW) {
            const int ci = m - MT, b = ci >> 9, p = ci & 511; const size_t krow = (size_t)NP + (size_t)b * KEYS_S + SEQ_S + p; const size_t src = ((size_t)(b * 2 + j) * PAST + p);
            { const f32x4 a = ((const GAS f32x4*)(F.in[I_CK] + src * 256))[lane]; v2u w; w.x = pk2(a.x, a.y); w.y = pk2(a.z, a.w); ((GAS v2u*)(KA + krow * 256))[lane] = w; }
            { const f32x4 a = ((const GAS f32x4*)(F.in[I_CV] + src * 256))[lane]; v2u w; w.x = pk2(a.x, a.y); w.y = pk2(a.z, a.w); ((GAS v2u*)(VA + krow * 256))[lane] = w; }
            { const f32x4 a = ((const GAS f32x4*)(F.in[I_CCKV] + src * 512))[2 * lane], c = ((const GAS f32x4*)(F.in[I_CCKV] + src * 512))[2 * lane + 1];
              v4u w; w.x = pk2(a.x, a.y); w.y = pk2(a.z, a.w); w.z = pk2(c.x, c.y); w.w = pk2(c.z, c.w); ((GAS v4u*)(CKV + krow * 512))[lane] = w; }
            if (lane < 16) { const f32x4 a = ((const GAS f32x4*)(F.in[I_CKR] + src * 64))[lane]; v2u w; w.x = pk2(a.x, a.y); w.y = pk2(a.z, a.w); ((GAS v2u*)(KR + krow * 64))[lane] = w; }
    }
    v4u nk0, nk1, nvv, ncw, nrw;
#define POST_LOAD(mm) do { const bf16* z_ = Z + (size_t)(mm) * ZW; \
        nk0 = ((const GAS v4u*)(z_ + ZC_KA))[2 * (lane & 15)]; nk1 = ((const GAS v4u*)(z_ + ZC_KA))[2 * (lane & 15) + 1]; \
        nvv = ((const GAS v4u*)(z_ + ZC_VA))[lane & 31]; \
        ncw = ((const GAS v4u*)(z_ + ZC_CKV))[lane]; nrw = ((const GAS v4u*)(z_ + ZC_KR))[s]; } while (0)
    if (gw < MT) POST_LOAD(gw);
    for (int m = gw; m < MT; m += NGW) {
        const bool lat = m >= NP; const int t = (m - NP) & 4095, prow = t >> 6, pcol = t & 63;
        const size_t krow = lat ? (size_t)NP + (size_t)((m - NP) >> 12) * KEYS_S + t : (size_t)m;
        bf16* zr = Z + (size_t)m * ZW;
        const v4u k0 = nk0, k1 = nk1, vv = nvv, cw = ncw, rw = nrw;
        if (m + NGW < MT) POST_LOAD(m + NGW);
        { float x[16]; float xa[8], xb[8]; unpack8(k0, xa); unpack8(k1, xb);
#pragma unroll
          for (int e = 0; e < 8; ++e) { x[e] = xa[e]; x[8 + e] = xb[e]; }
          head_norm_rope16(x, s, kn, false, 0, 0, T128);
          if (!lat && lane < 16) { float* so = F.out + OUT_SK + ((size_t)((m >> 8) * 2 + j) * SEQ_P + (m & 255)) * 256 + 16 * lane;
#pragma unroll
              for (int e = 0; e < 4; ++e) ((GAS f32x4*)so)[e] = (f32x4){x[4 * e], x[4 * e + 1], x[4 * e + 2], x[4 * e + 3]}; }
          if (lat) { const int pos = (s >> 2) ? pcol : prow; const bool second = (s >> 1) & 1; const float* tt = T128 + ((size_t)pos * 32 + 16 * (s & 1)) * 2;
#pragma unroll
              for (int e = 0; e < 16; ++e) { const float xp = SWZ_XOR(x[e], 2); x[e] = x[e] * tt[2 * e] + (second ? xp * tt[2 * e + 1] : -xp * tt[2 * e + 1]); } }
          if (lane < 16) { ((GAS v4u*)(KA + krow * 256))[2 * lane] = pack8(x); ((GAS v4u*)(KA + krow * 256))[2 * lane + 1] = pack8(x + 8); } }
        if (lane < 32) { ((GAS v4u*)(VA + krow * 256))[lane] = vv;
            if (!lat) { float x[8]; unpack8(vv, x); float* so = F.out + OUT_SV + ((size_t)((m >> 8) * 2 + j) * SEQ_P + (m & 255)) * 256 + 8 * lane;
                ((GAS f32x4*)so)[0] = (f32x4){x[0], x[1], x[2], x[3]}; ((GAS f32x4*)so)[1] = (f32x4){x[4], x[5], x[6], x[7]}; } }
        { float x[8]; unpack8(cw, x); float ss = 0.f;
#pragma unroll
          for (int e = 0; e < 8; ++e) ss += x[e] * x[e];
          const float rstd = 1.0f / sqrtf(wave_sum(ss) * (1.0f / 512.0f) + EPS);
#pragma unroll
          for (int e = 0; e < 8; ++e) x[e] = x[e] * rstd * kvn[8 * lane + e];
          ((GAS v4u*)(CKV + krow * 512))[lane] = pack8(x);
          if (!lat) { float* so = F.out + OUT_SCKV + ((size_t)((m >> 8) * 2 + j) * SEQ_P + (m & 255)) * 512 + 8 * lane;
              ((GAS f32x4*)so)[0] = (f32x4){x[0], x[1], x[2], x[3]}; ((GAS f32x4*)so)[1] = (f32x4){x[4], x[5], x[6], x[7]}; } }
        { float x[8]; unpack8(rw, x);
          if (!lat && lane < 8) { float* so = F.out + OUT_SKR + ((size_t)((m >> 8) * 2 + j) * SEQ_P + (m & 255)) * 64 + 8 * lane;
              ((GAS f32x4*)so)[0] = (f32x4){x[0], x[1], x[2], x[3]}; ((GAS f32x4*)so)[1] = (f32x4){x[4], x[5], x[6], x[7]}; }
          if (lat) rope8(x, s, prow, pcol, T64);
          if (lane < 8) ((GAS v4u*)(KR + krow * 64))[lane] = pack8(x); }
    }
}

#ifndef ATT_DMA
#define ATT_DMA 0
#endif
#ifndef ATT_MLA_SD
#define ATT_MLA_SD 1
#endif
#ifndef ATT_MLA_NQR
#define ATT_MLA_NQR 6
#endif
#ifndef EN_ATT_GQA
#define EN_ATT_GQA 1
#endif
#ifndef EN_ATT_MLA
#define EN_ATT_MLA 1
#endif
#undef POST_LOAD
constexpr int BIAS_LDS_OFF = RING_BYTES, BIAS_LDS_UNITS = 14;
static_assert(BIAS_LDS_OFF + BIAS_LDS_UNITS * 1024 <= MISC_OFF, "bias table vs the LDS map");
__device__ __forceinline__ void bias_to_lds(Frame& F, const pg8::StaticOrder& S, const float* bias, int ldb) {
    LAS float* tb = (LAS float*)(F.lds + BIAS_LDS_OFF);
    __syncthreads();
    const int half = F.tid >> 8, t = F.tid & 255; pg8::Unit u;
#pragma unroll
    for (int i0 = 0; i0 < BIAS_LDS_UNITS; i0 += 2) { const int i = i0 + half; if (S.next(i, u)) tb[i * 256 + t] = bias[(size_t)pg8::cond_of_pm(u.pm) * ldb + u.pn * 256 + t]; }
    __syncthreads();
}
constexpr int RES_LDS_UNITS = 4;
static_assert(BIAS_LDS_OFF + RES_LDS_UNITS * 3072 <= MISC_OFF, "residual tables vs the LDS map");
__device__ __forceinline__ void res_tables_to_lds(Frame& F, const pg8::StaticOrder& S, const float* gate, const float* gnorm, const float* scale, const float* pnorm, const float* pscale) {
    LAS float* tb = (LAS float*)(F.lds + BIAS_LDS_OFF);
    __syncthreads();
    const int half = F.tid >> 8, t = F.tid & 255; pg8::Unit u;
#pragma unroll
    for (int i0 = 0; i0 < RES_LDS_UNITS; i0 += 2) { const int i = i0 + half;
        if (S.next(i, u)) { const int cd = pg8::cond_of_pm(u.pm), col = u.pn * 256 + t;
            tb[i * 768 + t] = gate[(size_t)cd * 12288 + col];
            tb[i * 768 + 256 + t] = gnorm[col] * (scale ? 1.0f + scale[(size_t)cd * 12288 + col] : 1.0f);
            const float tp = pnorm[col] * (1.0f + pscale[(size_t)cd * 12288 + col]); tb[i * 768 + 512 + t] = tp != 0.f ? 1.0f / tp : 0.f; } }
    __syncthreads();
}
static_assert(2 * 16384 + 2 * 64 * 192 * 2 + 2048 + 8 * (12 - ATT_MLA_NQR) * 1024 <= MISC_OFF, "attention LDS use vs the LDS map");
static_assert(384 * 272 + 1024 <= MISC_OFF && 8 * 16640 <= MISC_OFF, "phase scratch vs the LDS map");
#if ATT_DMA
#ifndef ATT_DMA_NQR
#define ATT_DMA_NQR 10
#endif
#error the LDS-DMA attention variant does not carry the fused Q-side norm/rope
#define ATT_GQA_UNIT(QM) att::attn_unit_dma<128, ZW, 256, 256, DM, 8>
#define ATT_MLA_UNIT(QM) att::attn_unit_dma<192, ZW, DM, DM, DM, ATT_DMA_NQR>
#define ATT_LDSL , F.lds
static_assert(3 * (64 * 192 * 2 + 16384) + 2048 + 8 * (12 - ATT_DMA_NQR) * 1024 <= MISC_OFF, "attention ring vs the LDS map");
#else
#ifndef ATT16
#define ATT16 0
#endif
#ifndef ATT16_GSD
#define ATT16_GSD 2
#endif
#ifndef ATT16_GNQR
#define ATT16_GNQR 8
#endif
#if ATT16 & 1
#define ATT_GQA_UNIT(QM) att::attn_unit16<128, ZW, 256, 256, DM, ATT16_GSD, ATT16_GNQR, QM>
#else
#define ATT_GQA_UNIT(QM) att::attn_unit<128, ZW, 256, 256, DM, 2, 8, QM>
#endif
#if ATT16 & 2
#define ATT_MLA_UNIT(QM) att::attn_unit16<192, ZW, DM, DM, DM, ATT_MLA_SD, ATT_MLA_NQR, QM>
#else
#define ATT_MLA_UNIT(QM) att::attn_unit<192, ZW, DM, DM, DM, ATT_MLA_SD, ATT_MLA_NQR, QM>
#endif
#define ATT_LDSL
#endif
__device__ __forceinline__ void attn_phase(Frame& F, int j) {
    const float* qn = F.in[I_AQN] + j * 128; const float* T128 = (const float*)(F.ws + WS_TAB); const float* T64 = (const float*)(F.ws + WS_TAB + 16384);
    const bf16* Z = (const bf16*)(F.ws + WS_Z); const bf16* KA = (const bf16*)(F.ws + WS_KA); const bf16* VA = (const bf16*)(F.ws + WS_VA);
    const bf16* KR = (const bf16*)(F.ws + WS_KR); const bf16* KVB = (const bf16*)(F.ws + WS_KVB); bf16* O = (bf16*)(F.ws + WS_O);
#if EN_ATT_GQA
    for (int L = F.bid; L < 512; L += F.G) {
        const int x = L & 7, s = L >> 3, b = x >> 1, kvh = x & 1, h = kvh * 4 + (s >> 4), qb = s & 15;
        const size_t qrow = (size_t)NP + (size_t)b * SEQ_S + qb * 256, krow = (size_t)NP + (size_t)b * KEYS_S;
        ATT_GQA_UNIT(2)(Z + qrow * ZW + ZC_QA + h * 128, KA + krow * 256 + kvh * 128, nullptr, VA + krow * 256 + kvh * 128, O + qrow * DM + h * 128, KEYS_S, F.ldsg ATT_LDSL, qn, T128, qb * 256);
    }
#endif
#if EN_ATT_MLA
    for (int L = F.bid; L < 512; L += F.G) {
        const int x = L & 7, s = L >> 3, b = x >> 1, h = (x & 1) * 4 + (s >> 4), qb = s & 15;
        const size_t qrow = (size_t)NP + (size_t)b * SEQ_S + qb * 256, krow = (size_t)NP + (size_t)b * KEYS_S;
        ATT_MLA_UNIT(3)(Z + qrow * ZW + ZC_QB + h * 192, KVB + krow * DM + h * 256, KR + krow * 64, KVB + krow * DM + h * 256 + 128, O + qrow * DM + 1024 + h * 128, KEYS_S, F.ldsg ATT_LDSL, nullptr, T64, qb * 256);
    }
#endif
#if EN_ATT_GQA
    for (int L = F.bid; L < 128; L += F.G) {
        const int b = L >> 3, h = L & 7, kvh = h >> 2; const size_t row = (size_t)b * SEQ_P;
        ATT_GQA_UNIT(1)(Z + row * ZW + ZC_QA + h * 128, KA + row * 256 + kvh * 128, nullptr, VA + row * 256 + kvh * 128, O + row * DM + h * 128, SEQ_P, F.ldsg ATT_LDSL, qn, nullptr, 0);
    }
#endif
#if EN_ATT_MLA
    for (int L2 = F.bid; L2 < 256; L2 += F.G) { if (L2 < 128 && F.G > 128) continue; const int L = L2 & 127;
        const int b = L >> 3, h = L & 7; const size_t row = (size_t)b * SEQ_P;
        ATT_MLA_UNIT(0)(Z + row * ZW + ZC_QB + h * 192, KVB + row * DM + h * 256, KR + row * 64, KVB + row * DM + h * 256 + 128, O + row * DM + 1024 + h * 128, SEQ_P, F.ldsg ATT_LDSL, nullptr, nullptr, 0);
    }
#endif
    __syncthreads();
}

__device__ __forceinline__ void spatial_phase(Frame& F, int j) {
    FRAME_REFRESH(F);
    const bf16* U = (const bf16*)(F.ws + WS_U); const bf16* V = (const bf16*)(F.ws + WS_V); bf16* MC = (bf16*)(F.ws + WS_MC); const float* SS = (const float*)(F.ws + WS_SS);
    const float* Ws = F.in[I_CWS] + (size_t)j * 8 * 128 * 128; const float* bs = F.in[I_CBS] + j * 8 * 128; const float* gn = F.in[I_CVN] + j * DM;
    constexpr int RSB = 272, UTB = 528;
    LAS unsigned char* As = F.lds; LAS unsigned char* Vt = F.lds + 128 * RSB; LAS float* RS = (LAS float*)(F.lds + 384 * RSB); LAS float* BS = RS + 128; LAS unsigned char* UT = Vt;
    static_assert(128 * UTB <= 256 * RSB, "UT overlays Vt");
    const int tid0 = F.tid, wr = F.wave >> 2, wc = F.wave & 3;
    v4u vr[8], ur[8]; f32x4 ssa, ssb; int g_built = -1;
#define SPAT_ITEM(it_, n_, g_) const int g_ = (it_) & 7; int n_ = (it_) >> 3; \
        if (SPAT_MRU && F.G == 256) { const int r_ = (it_) >> 8, q_ = ((it_) >> 3) & 31, off_ = r_ == 0 ? 16 : r_ == 1 ? 4 : r_ == 2 ? 12 : r_ == 3 ? 8 : 0; n_ = 2 * (20 * (q_ >> 3) + off_ + ((q_ >> 1) & 3)) + (q_ & 1); }
#define SPAT_LOADS(it_) do { SPAT_ITEM(it_, nn_, gg_); const int rr0_ = nn_ * 128; int tid = tid0; asm volatile("" : "+v"(tid)); \
        { const GAS f32x4* sp = (const GAS f32x4*)(SS + (size_t)rr0_ * 32) + 2 * tid; ssa = sp[0]; ssb = sp[1]; }     \
        _Pragma("unroll") for (int i = 0; i < 8; ++i) { const int idx = tid + NTHREADS * i, q = idx >> 5, c8 = (idx & 31) * 8; vr[i] = *(const GAS v4u*)(V + (size_t)(rr0_ + q) * DM + gg_ * 256 + c8); } } while (0)
    if (F.bid < 160 * 8) SPAT_LOADS(F.bid);
    for (int it = F.bid; it < 160 * 8; it += F.G) {
        SPAT_ITEM(it, n, g); const int r0 = n * 128;
        int tid = tid0; asm volatile("" : "+v"(tid)); const int lane = tid & 63, r32 = lane & 31, hi = lane >> 5;
        __syncthreads();
        { float s = ((ssa.x + ssa.y) + (ssa.z + ssa.w)) + ((ssb.x + ssb.y) + (ssb.z + ssb.w)); s += SWZ_XOR(s, 1); s += SWZ_XOR(s, 2);
          if ((tid & 3) == 0) RS[tid >> 2] = 1.0f / sqrtf(s * (1.0f / 2048.0f) + EPS); }
        if (g != g_built) { g_built = g;
            if (tid < 128) BS[tid] = bs[g * 128 + tid];
#pragma unroll
            for (int i = 0; i < 8; ++i) { const int idx = tid + NTHREADS * i, p = idx >> 5, q4 = (idx & 31) * 4; const f32x4 w = *(const GAS f32x4*)(Ws + (size_t)g * 16384 + p * 128 + q4);
                v2u o; o.x = pk2(w.x, w.y); o.y = pk2(w.z, w.w); *(LAS v2u*)(As + p * RSB + q4 * 2) = o; } }
#pragma unroll
        for (int i = 0; i < 8; ++i) { const int idx = tid + NTHREADS * i, p = idx >> 5, c8 = (idx & 31) * 8; ur[i] = *(const GAS v4u*)(U + (size_t)(r0 + p) * DM + g * 256 + c8); }
        __syncthreads();
#pragma unroll
        for (int i = 0; i < 8; ++i) { const int idx = tid + NTHREADS * i, q = idx >> 5, cb = idx & 31; const v4u w = vr[i]; const float rs = RS[q];
            const unsigned w0 = pk2(bf_lo(w.x) * rs, bf_hi(w.x) * rs), w1 = pk2(bf_lo(w.y) * rs, bf_hi(w.y) * rs), w2 = pk2(bf_lo(w.z) * rs, bf_hi(w.z) * rs), w3 = pk2(bf_lo(w.w) * rs, bf_hi(w.w) * rs);
            LAS unsigned short* d = (LAS unsigned short*)(Vt + (cb * 8) * RSB + ((((q >> 3) ^ (cb & 15)) << 4) | ((q & 7) * 2)));
            d[0 * (RSB / 2)] = (unsigned short)(w0 & 0xffffu); d[1 * (RSB / 2)] = (unsigned short)(w0 >> 16); d[2 * (RSB / 2)] = (unsigned short)(w1 & 0xffffu); d[3 * (RSB / 2)] = (unsigned short)(w1 >> 16);
            d[4 * (RSB / 2)] = (unsigned short)(w2 & 0xffffu); d[5 * (RSB / 2)] = (unsigned short)(w2 >> 16); d[6 * (RSB / 2)] = (unsigned short)(w3 & 0xffffu); d[7 * (RSB / 2)] = (unsigned short)(w3 >> 16); }
        __syncthreads();
        f32x16 acc[2][2];
#pragma unroll
        for (int a = 0; a < 2; ++a)
#pragma unroll
            for (int b = 0; b < 2; ++b) acc[a][b] = (f32x16){};
#pragma unroll
        for (int ks = 0; ks < 8; ++ks) { bf16x8 af[2], bfr[2];
#pragma unroll
            for (int a = 0; a < 2; ++a) af[a] = *(LAS bf16x8*)(As + (64 * wr + 32 * a + r32) * RSB + (16 * ks + 8 * hi) * 2);
#pragma unroll
            for (int b = 0; b < 2; ++b) { const int c = 64 * wc + 32 * b + r32; bfr[b] = *(LAS bf16x8*)(Vt + c * RSB + (((2 * ks + hi) ^ ((c >> 3) & 15)) << 4)); }
#pragma unroll
            for (int a = 0; a < 2; ++a)
#pragma unroll
                for (int b = 0; b < 2; ++b) acc[a][b] = __builtin_amdgcn_mfma_f32_32x32x16_bf16(af[a], bfr[b], acc[a][b], 0, 0, 0); }
        __syncthreads();
#pragma unroll
        for (int i = 0; i < 8; ++i) { const int idx = tid + NTHREADS * i, p = idx >> 5, c8 = (idx & 31) * 8; *(LAS v4u*)(UT + p * UTB + c8 * 2) = ur[i]; }
        __syncthreads();
        if (it + F.G < 160 * 8) SPAT_LOADS(it + F.G);
#pragma unroll
        for (int b = 0; b < 2; ++b) { const int cl = 64 * wc + 32 * b + r32; const float gnc = gn[g * 256 + cl];
#pragma unroll
            for (int a = 0; a < 2; ++a)
#pragma unroll
                for (int r = 0; r < 16; ++r) { const int p = 64 * wr + 32 * a + (r & 3) + 8 * (r >> 2) + 4 * hi; LAS unsigned short* e = (LAS unsigned short*)(UT + p * UTB + cl * 2);
                    const float u = __uint_as_float(((unsigned)*e) << 16);
                    const unsigned w = pk2(u * (gnc * acc[a][b][r] + BS[p]), 0.f); *e = (unsigned short)(w & 0xffffu); } }
        __syncthreads();
#pragma unroll
        for (int i = 0; i < 8; ++i) { const int idx = tid + NTHREADS * i, p = idx >> 5, c8 = (idx & 31) * 8; *(GAS v4u*)(MC + (size_t)(r0 + p) * DM + g * 256 + c8) = *(LAS v4u*)(UT + p * UTB + c8 * 2); }
    }
#undef SPAT_ITEM
#undef SPAT_LOADS
}

#ifndef EN_DEFAULT
#define EN_DEFAULT 1
#endif
#ifndef EN_P0
#define EN_P0 EN_DEFAULT
#endif
#ifndef EN_MOD
#define EN_MOD EN_DEFAULT
#endif
#ifndef EN_G1
#define EN_G1 EN_DEFAULT
#endif
#ifndef EN_POST
#define EN_POST EN_DEFAULT
#endif
#ifndef EN_KVUP
#define EN_KVUP EN_DEFAULT
#endif
#ifndef EN_ATT
#define EN_ATT EN_DEFAULT
#endif
#ifndef EN_G4
#define EN_G4 EN_DEFAULT
#endif
#ifndef EN_SPAT
#define EN_SPAT EN_DEFAULT
#endif
#ifndef EN_OUT
#define EN_OUT EN_DEFAULT
#endif
#ifndef EN_FUP
#define EN_FUP EN_DEFAULT
#endif
#ifndef EN_FDN
#define EN_FDN EN_DEFAULT
#endif
#ifndef EN_FIN
#define EN_FIN EN_DEFAULT
#endif
#ifndef REP_POST
#define REP_POST 1
#endif
#ifndef REP_BAR
#define REP_BAR 1
#endif
#ifndef REP_P0
#define REP_P0 1
#endif
#ifndef REP_MOD
#define REP_MOD 1
#endif
#ifndef REP_G1
#define REP_G1 1
#endif
#ifndef REP_KVUP
#define REP_KVUP 1
#endif
#ifndef REP_ATT
#define REP_ATT 1
#endif
#ifndef REP_G4
#define REP_G4 1
#endif
#ifndef REP_SPAT
#define REP_SPAT 1
#endif
#ifndef REP_FUP
#define REP_FUP 1
#endif
#ifndef REP_OUT
#define REP_OUT 1
#endif
#ifndef REP_FDN
#define REP_FDN 1
#endif
#ifndef WGM_G1
#define WGM_G1 PG8_WGM
#endif
#ifndef WGM_KV
#define WGM_KV PG8_WGM
#endif
#ifndef WGM_G4
#define WGM_G4 PG8_WGM
#endif
#ifndef WGM_FUP
#define WGM_FUP PG8_WGM
#endif
#ifndef WGM_RES
#define WGM_RES PG8_WGM
#endif
#ifndef STAGGER_TICKS
#define STAGGER_TICKS 0
#endif
#define STAGGER(F) do { if (STAGGER_TICKS > 0) { const unsigned long long t0_ = __builtin_amdgcn_s_memrealtime(), d_ = (unsigned long long)(((F).bid >> 3) & 3) * STAGGER_TICKS; \
    while (__builtin_amdgcn_s_memrealtime() - t0_ < d_) __builtin_amdgcn_s_sleep(4); } } while (0)
#ifndef FDN_REV
#define FDN_REV 1
#endif
#ifndef G1_DEFER2
#define G1_DEFER2 1
#endif
#ifndef DEFER_DOWN3
#define DEFER_DOWN3 1
#endif
#ifndef DEFER2_8
#define DEFER2_8 P0_DEFER8
#endif
constexpr int P2_FFN_ITEMS = (3 * 32 * 88) * (8 - DEFER2_8) / 8;
#ifndef FDN_ALL_ITEMS
#define FDN_ALL_ITEMS 0
#endif
#ifndef FUP_ALIGN_EPI
#define FUP_ALIGN_EPI true
#endif
#ifndef G1_ALIGN_EPI
#define G1_ALIGN_EPI true
#endif
#ifndef G4_ALIGN_EPI
#define G4_ALIGN_EPI true
#endif
#ifndef KV_ALIGN_EPI
#define KV_ALIGN_EPI true
#endif
#ifndef ADA_FUP_ITEMS
#define ADA_FUP_ITEMS 128
#endif
#ifndef ADA_IN_FUP
#define ADA_IN_FUP 1
#endif
#ifndef EARLY_FIN
#define EARLY_FIN 1
#endif
constexpr int CW_RDY = 6144;
static_assert(CW_RDY >= CW_BAR + XCD_BAR_WORDS && (CW_RDY + 64 * 80) * 4 <= (int)CTL_ZERO_BYTES, "arrival counters vs the control block");
__device__ __forceinline__ void fdn_panel_lists(Frame& F, LAS unsigned* lst) {
    LAS unsigned* msk = lst + 60;
    __syncthreads();
    if (F.tid < 3) msk[F.tid] = 0u;
    __syncthreads();
    if (F.tid < F.G) { pg8::StaticOrder S; S.init(MT, DM, F.G, F.tid, WGM_RES, FDN_REV); pg8::Unit u; if (S.next(2, u)) (void)__hip_atomic_fetch_or(&msk[u.pm >> 5], 1u << (u.pm & 31), __ATOMIC_RELAXED, __HIP_MEMORY_SCOPE_WORKGROUP); }
    __syncthreads();
    if (F.tid == 0) { unsigned ne = 0, nl = 0; LAS unsigned char* eb = (LAS unsigned char*)lst + 16; LAS unsigned char* lb = (LAS unsigned char*)lst + 112;
        for (int pm = 0; pm < MT / 256; ++pm) { if ((msk[pm >> 5] >> (pm & 31)) & 1u) lb[nl++] = (unsigned char)pm; else eb[ne++] = (unsigned char)pm; }
        lst[0] = ne; lst[1] = nl; }
    __syncthreads();
}
#define EARLY_FIN_ON(F) (EARLY_FIN && (F).G == 256)
__device__ __forceinline__ void early_final(Frame& F, int widx) {
    LAS unsigned* lst = (LAS unsigned*)F.lds;
    fdn_panel_lists(F, lst);
    const int ne = (int)lst[0];
    if (widx < 2 * ne && widx < 128) {
        const int pm = ((LAS unsigned char*)lst)[16 + (widx >> 1)];
        if (F.tid < 64) { unsigned* arr = (unsigned*)(F.ws + WS_CTL) + CW_RDY; unsigned sp = 0;
            while ((unsigned)__builtin_amdgcn_readfirstlane(__hip_atomic_load(arr, __ATOMIC_RELAXED, __HIP_MEMORY_SCOPE_AGENT)) < (unsigned)F.G) { __builtin_amdgcn_s_sleep(4); if (++sp > (1u << 20)) break; }
            __builtin_amdgcn_fence(__ATOMIC_ACQUIRE, "agent"); asm volatile("s_waitcnt vmcnt(0)" ::: "memory"); }
        __syncthreads();
        for (int r = F.wave; r < 128; r += NWAVES) final_row(F, pm * 256 + (widx & 1) * 128 + r);
    }
}
__device__ __forceinline__ void final_phase_rest(Frame& F) {
    LAS unsigned* lst = (LAS unsigned*)F.lds;
    fdn_panel_lists(F, lst);
    const int ne = (int)lst[0], nl = (int)lst[1], nx = ne > 64 ? ne - 64 : 0, rows = (nl + nx) * 256;
    const int gw = F.bid * NWAVES + F.wave, NGW = F.G * NWAVES;
    for (int idx = gw; idx < rows; idx += NGW) { const int pi = idx >> 8; const int pm = pi < nl ? ((LAS unsigned char*)lst)[112 + pi] : ((LAS unsigned char*)lst)[16 + 64 + (pi - nl)];
        final_row(F, pm * 256 + (idx & 255)); }
}
constexpr int NPHASE = 38;
__global__ void __launch_bounds__(NTHREADS, 2) fwd(Args args) {
    extern __shared__ __attribute__((aligned(1024))) unsigned char lds[];
    Frame F;
    F.lds = (LAS unsigned char*)lds; F.ldsg = (char*)lds;
    F.in.ka = (KArgsPtr)__builtin_amdgcn_kernarg_segment_ptr();
    PHASE_BEGIN(F);
    const int lo = args.ph_lo, hi = args.ph_hi; const bool multi = (hi - lo) > 1;
    if (F.tid < 4) ((LAS unsigned*)(F.lds + MISC_OFF))[F.tid] = 0u;
    __syncthreads();
    if (multi) (void)xcd_barrier_post((unsigned*)(F.ws + WS_CTL) + CW_BAR, (volatile LAS unsigned*)(F.lds + MISC_OFF));
#define IN(k) (lo <= (k) && (k) < hi)
#ifndef CODE_WARM
#define CODE_WARM 0
#endif
#if CODE_WARM
    if (lo == 0) { const char* pc = (const char*)(__builtin_amdgcn_s_getpc() & ~0xFFull); unsigned acc = 0;
#pragma unroll 8
        for (int i = F.tid; i < 14848; i += NTHREADS) { const v4u w = *(const GAS v4u*)(pc + (size_t)i * 16); acc ^= (w.x ^ w.y) ^ (w.z ^ w.w); }
        if (acc == 0x9e3779b9u && F.tid == 12345) ((GAS unsigned*)(F.ws + WS_PROBE))[0] = acc; }
#endif
#define SEAM(k) do { if (multi && (k) + 1 < hi) { XcdBarrier b_; b_.bar = (unsigned*)(F.ws + WS_CTL) + CW_BAR; b_.x = xb_xcc_id(); b_.st = (volatile LAS unsigned*)(F.lds + MISC_OFF); for (int rb_ = 0; rb_ < REP_BAR; ++rb_) xcd_barrier(b_); } } while (0)

#define X (F.out)
#define H ((bf16*)(F.ws + WS_H))
#define LAYER_VARS() PHASE_BEGIN(F); int L = L_; asm volatile("" : "+s"(L)); const int j = L >> 1; const bool attn = (L & 1) == 0; const float* modl = (const float*)(F.ws + WS_MOD) + (size_t)L * 5 * 12288; (void)j; (void)attn; (void)modl

    #if EN_P0
    if (IN(0)) { PHASE_BEGIN(F); PROBE_STAMP(F, 0); for (int rep_ = 0; rep_ < REP_P0; ++rep_) { p0_prologue(F); __syncthreads(); } SEAM(0); }
#endif

    for (int L_ = 0; L_ < NLAYER; ++L_) {
        const int pb = 1 + 9 * L_; const bool attn_ = (L_ & 1) == 0;
#if EN_MOD
        if (L_ == 0 && IN(pb + 0)) { LAYER_VARS(); PROBE_STAMP(F, pb + 0);
            mod0_phase(F, F.in[I_XP], F.in[I_XS], F.in[I_NMIX], modl);
            const int gw = F.bid * NWAVES + F.wave, NGW = F.G * NWAVES;
            bias_rows(F, (const bf16*)(F.ws + WS_WIN), ZW, modl, (float*)(F.ws + WS_BIAS1), 4096, gw, NGW);
            if (P0_DEFER8 == 0) bias_rows(F, (const bf16*)(F.ws + WS_FGU), 2 * FF, modl + 3 * DM, (float*)(F.ws + WS_BIAS2), 2 * FF, gw, NGW);
            SEAM(pb + 0);
        }
#endif
        if (attn_) {
#if EN_G1
            if (IN(pb + 1)) { LAYER_VARS(); PROBE_STAMP(F, pb + 1);
                pg8::Gemm g{H, (const bf16*)(F.ws + WS_WIN) + (size_t)j * ZW * DM, MT, ZW, DM}; pg8::StaticOrder S; S.init(MT, ZW, F.G, F.bid, WGM_G1);
                pg8::EpiBf16Plain E{(bf16*)(F.ws + WS_Z), ZW, (const float*)(F.ws + WS_SSX), (const float*)(F.ws + WS_BIAS1) + (size_t)L * 5 * 4096, 4096, -1, (PG8_LAS const float*)(F.lds + BIAS_LDS_OFF), 0};
                if (P0_DEFER8 > 0 && (L == 0 || G1_DEFER2)) { int widx, nwg; tail_slot(F, 1200 - 4 * F.G, widx, nwg);
                    if (widx >= 0) conv_items(F, L, 1, widx * NWAVES + F.wave, nwg * NWAVES, L == 0 ? P0_FFN_ITEMS : P2_FFN_ITEMS); __syncthreads(); }
                bias_to_lds(F, S, E.bias, 4096);
                for (int rep_ = 0; rep_ < REP_G1; ++rep_) pg8::gemm_phase<pg8::EpiBf16Plain, pg8::StaticOrder, G1_ALIGN_EPI, true>(F.lds, g, S, E);
                SEAM(pb + 1);
            }
#endif
#if EN_POST
            if (IN(pb + 2)) { LAYER_VARS(); PROBE_STAMP(F, pb + 2); post_phase(F, j);
#if REP_POST > 1
              for (int rep_ = 1; rep_ < REP_POST; ++rep_) post_phase(F, j, true);
#endif
              SEAM(pb + 2); }
#endif
#if EN_KVUP
            if (IN(pb + 3)) { LAYER_VARS(); PROBE_STAMP(F, pb + 3);
                pg8::Gemm g{(const bf16*)(F.ws + WS_CKV), (const bf16*)(F.ws + WS_WKV) + (size_t)j * 2048 * 512, MK, 2048, 512}; pg8::StaticOrder S; S.init(MK, 2048, F.G, F.bid, WGM_KV);
                pg8::EpiBf16Plain E{(bf16*)(F.ws + WS_KVB), DM, nullptr, nullptr, 0, -1, nullptr, 0};
                for (int rep_ = 0; rep_ < REP_KVUP; ++rep_) pg8::gemm_phase<pg8::EpiBf16Plain, pg8::StaticOrder, KV_ALIGN_EPI, true>(F.lds, g, S, E);
                SEAM(pb + 3);
            }
#endif
#if EN_ATT
            if (IN(pb + 4)) { LAYER_VARS(); PROBE_STAMP(F, pb + 4); for (int rep_ = 0; rep_ < REP_ATT; ++rep_) attn_phase(F, j); SEAM(pb + 4); }
#endif
        } else {
#if EN_G4
            if (IN(pb + 1)) { LAYER_VARS(); PROBE_STAMP(F, pb + 1);
                pg8::Gemm g{H, (const bf16*)(F.ws + WS_CWIN) + (size_t)j * 4096 * DM, MT, 4096, DM}; pg8::StaticOrder S; S.init(MT, 4096, F.G, F.bid, WGM_G4);
                pg8::EpiGeluUV E{(bf16*)(F.ws + WS_U), (bf16*)(F.ws + WS_V), (float*)(F.ws + WS_SS), (const float*)(F.ws + WS_SSX), (const float*)(F.ws + WS_BIAS1) + (size_t)L * 5 * 4096, 4096, -1, (PG8_LAS const float*)(F.lds + BIAS_LDS_OFF), 0};
                bias_to_lds(F, S, E.bias, 4096);
                for (int rep_ = 0; rep_ < REP_G4; ++rep_) pg8::gemm_phase<pg8::EpiGeluUV, pg8::StaticOrder, G4_ALIGN_EPI, true>(F.lds, g, S, E);
                SEAM(pb + 1);
            }
#endif
#if EN_SPAT
            if (IN(pb + 2)) { LAYER_VARS(); PROBE_STAMP(F, pb + 2); for (int rep_ = 0; rep_ < REP_SPAT; ++rep_) spatial_phase(F, j); SEAM(pb + 2); }
#endif
        }
#if EN_OUT
        if (IN(pb + 5)) { LAYER_VARS(); PROBE_STAMP(F, pb + 5);
            const bf16* A = attn ? (const bf16*)(F.ws + WS_O) : (const bf16*)(F.ws + WS_MC);
            const bf16* Bt = (attn ? (const bf16*)(F.ws + WS_WOUT) : (const bf16*)(F.ws + WS_CWOUT)) + (size_t)j * DM * DM;
            pg8::Gemm g{A, Bt, MT, DM, DM}; pg8::StaticOrder S; S.init(MT, DM, F.G, F.bid, WGM_RES);
            pg8::EpiRes E{H, (float*)(F.ws + WS_SSX), (PG8_LAS const float*)(F.lds + BIAS_LDS_OFF), 0};
#if 1
            { int widx, nwg; tail_slot(F, 640 - 2 * F.G, widx, nwg); if (widx >= 0) {
                if (L > 0 || P0_DEFER8 > 0) bias_rows(F, (const bf16*)(F.ws + WS_FGU) + (size_t)L * 2 * FF * DM, 2 * FF, modl + 3 * DM, (float*)(F.ws + WS_BIAS2) + (size_t)L * 5 * 2 * FF, 2 * FF, widx * NWAVES + F.wave, nwg * NWAVES);
                if (L + 1 < NLAYER) { if (!ADA_IN_FUP) ada_layer(F, L + 1, 0, 128, widx, nwg); __syncthreads(); conv_items(F, L + 1, 0, widx * NWAVES + F.wave, nwg * NWAVES); }
                else if (DEFER_DOWN3) { __syncthreads(); conv_items(F, L, 1, widx * NWAVES + F.wave, nwg * NWAVES, 2 * 32 * 88); } } }
            __syncthreads();
#endif
            res_tables_to_lds(F, S, modl + 2 * DM, F.in[I_NFFN] + L * DM, modl + 4 * DM, F.in[I_NMIX] + L * DM, modl + 1 * DM);
            STAGGER(F);
            pg8::gemm_phase<pg8::EpiRes, pg8::StaticOrder, true, true>(F.lds, g, S, E);
#if REP_OUT > 1
            { pg8::EpiBf16Plain E2{(bf16*)(F.ws + WS_PROBE), DM, nullptr, nullptr, 0, -1, nullptr, 0}; pg8::gemm_phase<pg8::EpiBf16Plain, pg8::StaticOrder, true, true>(F.lds, g, S, E2); }
#endif
            SEAM(pb + 5);
        }
#endif
#if EN_FUP
        if (IN(pb + 7)) { LAYER_VARS(); PROBE_STAMP(F, pb + 7);
            pg8::Gemm g{H, (const bf16*)(F.ws + WS_FGU) + (size_t)L * 2 * FF * DM, MT, 2 * FF, DM}; pg8::StaticOrder S; S.init(MT, 2 * FF, F.G, F.bid, WGM_FUP);
            pg8::EpiSwiGLU E{(bf16*)(F.ws + WS_HH), FF, (const float*)(F.ws + WS_SSX), (const float*)(F.ws + WS_BIAS2) + (size_t)L * 5 * 2 * FF, 2 * FF, -1, (PG8_LAS const float*)(F.lds + BIAS_LDS_OFF), 0};
            if (ADA_IN_FUP && TAIL_CONV && L + 1 < NLAYER) { int widx, nwg; tail_slot(F, 3520 - 13 * F.G, widx, nwg);
                if (widx >= 0) ada_layer(F, L + 1, 0, ADA_FUP_ITEMS, widx, nwg); __syncthreads(); }
            bias_to_lds(F, S, E.bias, 2 * FF);
            for (int rep_ = 0; rep_ < REP_FUP; ++rep_) pg8::gemm_phase<pg8::EpiSwiGLU, pg8::StaticOrder, FUP_ALIGN_EPI, true>(F.lds, g, S, E);
            SEAM(pb + 7);
        }
#endif
#if EN_FDN
        if (IN(pb + 8)) { LAYER_VARS(); PROBE_STAMP(F, pb + 8);
            pg8::Gemm g{(const bf16*)(F.ws + WS_HH), (const bf16*)(F.ws + WS_FD) + (size_t)L * DM * FF, MT, DM, FF}; pg8::CountedDone S; S.init(MT, DM, F.G, F.bid, WGM_RES, FDN_REV);
            const bool more = L + 1 < NLAYER;
            S.arrive = (!more && EARLY_FIN_ON(F)) ? (unsigned*)(F.ws + WS_CTL) + CW_RDY : nullptr; S.nd = 0;
            pg8::EpiRes E{H, (float*)(F.ws + WS_SSX), (PG8_LAS const float*)(F.lds + BIAS_LDS_OFF), 0};
#if TAIL_CONV
            if (L + 1 < NLAYER) { int widx, nwg; tail_slot(F, 640 - 2 * F.G, widx, nwg);
              if (FDN_ALL_ITEMS > 0 && widx != F.bid) conv_items(F, L + 1, 1, F.bid * NWAVES + F.wave, F.G * NWAVES, 0, FDN_ALL_ITEMS);
              if (widx >= 0) { ada_layer(F, L + 1, (ADA_IN_FUP ? ADA_FUP_ITEMS : 128), 384, widx, nwg); __syncthreads(); conv_items(F, L + 1, 1, widx * NWAVES + F.wave, nwg * NWAVES, (FDN_ALL_ITEMS > 0 && widx != F.bid) ? FDN_ALL_ITEMS : 0, (G1_DEFER2 && P0_DEFER8 > 0 && L + 1 == 2) ? P2_FFN_ITEMS : (DEFER_DOWN3 && L + 1 == 3) ? 2 * 32 * 88 : 0x7fffffff);
                const int j1 = (L + 1) >> 1; const bool attn1 = ((L + 1) & 1) == 0;
                bias_rows(F, attn1 ? (const bf16*)(F.ws + WS_WIN) + (size_t)j1 * ZW * DM : (const bf16*)(F.ws + WS_CWIN) + (size_t)j1 * 4096 * DM, attn1 ? ZW : 4096, modl + 5 * 12288, (float*)(F.ws + WS_BIAS1) + (size_t)(L + 1) * 5 * 4096, 4096, widx * NWAVES + F.wave, nwg * NWAVES); } }
            __syncthreads();
#endif
            res_tables_to_lds(F, S, modl + 5 * DM, more ? F.in[I_NMIX] + (L + 1) * DM : F.in[I_FNORM], more ? modl + 5 * 12288 + DM : nullptr, F.in[I_NFFN] + L * DM, modl + 4 * DM);
            STAGGER(F);
            pg8::gemm_phase<pg8::EpiRes, pg8::CountedDone, true, true>(F.lds, g, S, E);
            if (!more && EARLY_FIN_ON(F) && F.bid >= 128) early_final(F, F.bid - 128);
#if REP_FDN > 1
            { pg8::EpiBf16Plain E2{(bf16*)(F.ws + WS_PROBE), DM, nullptr, nullptr, 0, -1, nullptr, 0}; pg8::gemm_phase<pg8::EpiBf16Plain, pg8::StaticOrder, true, true>(F.lds, g, S, E2); }
#endif
            SEAM(pb + 8);
        }
#endif
    }
#if EN_FIN
    if (IN(37)) { PHASE_BEGIN(F); PROBE_STAMP(F, 37);
#ifdef IDLE_US
        { const unsigned long long t0_ = __builtin_amdgcn_s_memrealtime(); while (__builtin_amdgcn_s_memrealtime() - t0_ < (unsigned long long)(IDLE_US) * 100ull) __builtin_amdgcn_s_sleep(16); }
#endif
        if (EARLY_FIN_ON(F)) final_phase_rest(F); else final_phase(F); asm volatile("s_waitcnt vmcnt(0)" ::: "memory"); __syncthreads(); PROBE_STAMP(F, 38);
#if PROBE_T
#ifndef PROBE_SA
#define PROBE_SA 1e-4f
#endif
#ifndef PROBE_OA
#define PROBE_OA 0.0f
#endif
#ifndef PROBE_SB
#define PROBE_SB 1e-3f
#endif
        if (blockIdx.x == 0) {
            __syncthreads(); asm volatile("s_waitcnt vmcnt(0)" ::: "memory");
            const unsigned long long* ts = (const unsigned long long*)(F.ws + WS_PROBE);
            const float ta = (float)(long long)(__hip_atomic_load(ts + PROBE_A1, __ATOMIC_RELAXED, __HIP_MEMORY_SCOPE_AGENT) - __hip_atomic_load(ts + PROBE_A0, __ATOMIC_RELAXED, __HIP_MEMORY_SCOPE_AGENT)) * 0.01f - PROBE_OA;
            const float tb = (float)(long long)(__hip_atomic_load(ts + PROBE_B1, __ATOMIC_RELAXED, __HIP_MEMORY_SCOPE_AGENT) - __hip_atomic_load(ts + PROBE_B0, __ATOMIC_RELAXED, __HIP_MEMORY_SCOPE_AGENT)) * 0.01f;
            for (int i = F.tid; i < 524288; i += NTHREADS) F.out[OUT_SKR + i] *= (1.0f + ta * PROBE_SA);
            if (F.tid == 0) F.out[0] += tb * PROBE_SB;
        }
#endif
    }
#endif
#undef IN
#undef SEAM
#undef X
#undef H
}

#ifndef MK_ONE_LAUNCH
#define MK_ONE_LAUNCH 0
#endif
extern "C" void kernel_launch(void* const* d_in, const int* in_sizes, int n_in, void* d_out, int out_size, void* d_ws, size_t ws_size, hipStream_t stream) {
    static int grid = 0;
    if (grid == 0) {
        if (n_in != 27 || out_size != 50855936 || ws_size < WS_END) { fprintf(stderr, "kernel_launch: built for 27 inputs, 50855936 outputs, >= %zu bytes of workspace; got n_in %d, out %d, ws %zu\n", (size_t)WS_END, n_in, out_size, ws_size); grid = -1; return; }
        int dev = 0, cus = 0, per_cu = 0;
        if (hipGetDevice(&dev) != hipSuccess || hipDeviceGetAttribute(&cus, hipDeviceAttributeMultiprocessorCount, dev) != hipSuccess) { fprintf(stderr, "kernel_launch: device query failed\n"); grid = -1; return; }
        if (hipFuncSetAttribute((const void*)fwd, hipFuncAttributeMaxDynamicSharedMemorySize, LDS_BYTES) != hipSuccess) { fprintf(stderr, "kernel_launch: hipFuncSetAttribute failed\n"); grid = -1; return; }
        if (hipOccupancyMaxActiveBlocksPerMultiprocessor(&per_cu, (const void*)fwd, NTHREADS, LDS_BYTES) != hipSuccess || per_cu < 1)
            fprintf(stderr, "kernel_launch: note: occupancy query reports %d workgroups per CU\n", per_cu);
        (void)hipGetLastError();
        grid = cus;
    }
    if (grid < 0) return;
    if (hipMemsetAsync((char*)d_ws + WS_CTL, 0, CTL_ZERO_BYTES, stream) != hipSuccess) { fprintf(stderr, "kernel_launch: memset failed\n"); return; }
    Args a{};
    for (int i = 0; i < 27; ++i) a.in[i] = (const GAS float*)d_in[i];
    a.out_f = (GAS float*)d_out; a.ws_b = (GAS unsigned char*)d_ws;
#if MK_ONE_LAUNCH
    a.ph_lo = 0; a.ph_hi = NPHASE;
    hipLaunchKernelGGL(fwd, dim3(grid), dim3(NTHREADS), LDS_BYTES, stream, a);
#else
    for (int ph = 0; ph < NPHASE; ++ph) {
        if (ph >= 1 && ph < 37) { const int L = (ph - 1) / 9, s = (ph - 1) % 9; if (((L & 1) && (s == 3 || s == 4)) || s == 6 || (s == 0 && L > 0)) continue; }
        a.ph_lo = ph; a.ph_hi = ph + 1;
        hipLaunchKernelGGL(fwd, dim3(grid), dim3(NTHREADS), LDS_BYTES, stream, a);
    }
#endif
    const hipError_t le = hipPeekAtLastError();
    if (le != hipSuccess) fprintf(stderr, "kernel_launch: launch failed: %s\n", hipGetErrorName(le));
}
```

```cpp
#define MK_ONE_LAUNCH 1
#define P0_DEFER8 4
#define EARLY_FIN 0
#define G1_DEFER2 1
#define DEFER_DOWN3 0
#define KV_ALIGN_EPI false
#define WGM_G4 8
#define WGM_G1 8
#include <hip/hip_runtime.h>
#include <cstdio>
#include <cstdint>
#ifndef PG8_WGM
#define PG8_WGM 4
#endif
namespace pg8 {
#define PG8_LAS __attribute__((address_space(3)))
typedef unsigned short bf16_t;
typedef short bf16x8 __attribute__((ext_vector_type(8)));
typedef float f32x4 __attribute__((ext_vector_type(4)));
typedef unsigned u32x4 __attribute__((ext_vector_type(4)));
constexpr int BM = 256, BK = 64, HALF = 128, HTB = HALF * BK * 2  , STAGE_BYTES = 8 * HTB, NXCD = 8, WGM = PG8_WGM;

__host__ __device__ __forceinline__ int lds_byte(int r, int c) { const int st = (r >> 4) * 2 + (c >> 5), rr = r & 15, cc = c & 31, ob = rr * 64 + cc * 2; return st * 1024 + (ob ^ (((ob >> 9) & 1) << 5)); }
__host__ __device__ __forceinline__ void stage_rc(int b, int& R, int& C) { const int st = b / 1024, sb = b % 1024, swz = sb ^ (((sb >> 9) & 1) << 5); R = (st >> 1) * 16 + swz / 64; C = (st & 1) * 32 + (swz % 64) / 2; }
__host__ __device__ __forceinline__ int perm32(int rho) { const int n = rho >> 4, i = rho & 15; return 8 * (i >> 2) + 4 * n + (i & 3); }

struct Unit { int pm, pn; };
struct Gemm { const bf16_t* A; const bf16_t* Bt; int M, N, K; };

struct StaticOrder {
    int nM, nN, nwg, G, c, wgm, rev;
    __host__ __device__ void init(int M, int N, int G_, int c_, int wgm_ = WGM, int rev_ = 0) { nM = M / BM; nN = N / BM; nwg = nM * nN; G = G_; c = c_; wgm = wgm_; rev = rev_; }
    __host__ __device__ bool next(int i, Unit& u) const {
        const int L = i * G + c; if (L >= nwg) return false;
        int wgid = L; { const int q = nwg / NXCD, r = nwg % NXCD, xcd = wgid % NXCD, off = wgid / NXCD; wgid = (xcd < r ? xcd * (q + 1) : r * (q + 1) + (xcd - r) * q) + off; }
        const int nig = wgm * nN, gid = wgid / nig, fm = gid * wgm, gsz = (nM - fm) < wgm ? (nM - fm) : wgm;
        u.pm = fm + ((wgid % nig) % gsz); u.pn = (wgid % nig) / gsz; if (rev) u.pm = nM - 1 - u.pm; return true;
    }
    __device__ __forceinline__ void a_ready(const Unit&) const {}
    __device__ __forceinline__ void done(const Unit&) const {}
};
struct CountedDone : StaticOrder {
    unsigned* arrive; mutable int nd;
    __device__ __forceinline__ void done(const Unit&) const {
        if (arrive && nd++ == 1) { asm volatile("s_waitcnt vmcnt(0)" ::: "memory"); __builtin_amdgcn_s_barrier();
            if (threadIdx.x < 64) { __builtin_amdgcn_fence(__ATOMIC_RELEASE, "agent"); if (threadIdx.x == 0) (void)__hip_atomic_fetch_add(arrive, 1u, __ATOMIC_RELAXED, __HIP_MEMORY_SCOPE_AGENT); } }
    }
};
__device__ __forceinline__ unsigned cvt_pk_bf16(float lo, float hi) { unsigned r; asm volatile("v_cvt_pk_bf16_f32 %0, %1, %2" : "=v"(r) : "v"(lo), "v"(hi)); return r; }
constexpr int ROWS_P = 4096;
__device__ __forceinline__ int cond_of_pm(int pm) { return pm < 16 ? 0 : 1 + ((pm - 16) >> 4); }

__device__ __forceinline__ float epi_add_x16_x32(float v) {
    v += __int_as_float(__builtin_amdgcn_ds_swizzle(__float_as_int(v), (16 << 10) | 0x1f));
    auto rr = __builtin_amdgcn_permlane32_swap(__float_as_uint(v), __float_as_uint(v), false, false); return __uint_as_float(rr[0]) + __uint_as_float(rr[1]);
}
#ifndef EPI_RSTD_PF_PLAIN
#define EPI_RSTD_PF_PLAIN 0
#endif
#ifndef EPI_RSTD_PF_SWIGLU
#define EPI_RSTD_PF_SWIGLU 0
#endif
#ifndef EPI_RSTD_PF_GELU
#define EPI_RSTD_PF_GELU 0
#endif
__device__ __forceinline__ void epi_row_rstd(const float* SSX, int row0, int fq, float (&rs)[2][4]) {
#pragma unroll
    for (int ai = 0; ai < 2; ++ai)
#pragma unroll
        for (int m = 0; m < 4; ++m) { const f32x4* p = (const f32x4*)(SSX + (size_t)(row0 + ai * HALF + m * 16) * 32 + 8 * fq); const f32x4 a = p[0], b = p[1];
            const float s = epi_add_x16_x32(((a[0] + a[1]) + (a[2] + a[3])) + ((b[0] + b[1]) + (b[2] + b[3])));
            rs[ai][m] = 1.0f / __builtin_sqrtf(s * (1.0f / 2048.0f) + 1e-6f); }
}

__device__ __forceinline__ void epi_rstd_issue(const float* SSX, int row0, int fq, f32x4 (&p)[16]) {
#pragma unroll
    for (int ai = 0; ai < 2; ++ai)
#pragma unroll
        for (int m = 0; m < 4; ++m) { const f32x4* q = (const f32x4*)(SSX + (size_t)(row0 + ai * HALF + m * 16) * 32 + 8 * fq); p[2 * (ai * 4 + m)] = q[0]; p[2 * (ai * 4 + m) + 1] = q[1]; }
}
__device__ __forceinline__ void epi_rstd_finish(const f32x4 (&p)[16], float (&rs)[2][4]) {
#pragma unroll
    for (int ai = 0; ai < 2; ++ai)
#pragma unroll
        for (int m = 0; m < 4; ++m) { const f32x4 a = p[2 * (ai * 4 + m)], b = p[2 * (ai * 4 + m) + 1];
            const float s = epi_add_x16_x32(((a[0] + a[1]) + (a[2] + a[3])) + ((b[0] + b[1]) + (b[2] + b[3])));
            rs[ai][m] = 1.0f / __builtin_sqrtf(s * (1.0f / 2048.0f) + 1e-6f); }
}

struct EpiBf16Plain {
    static constexpr bool PERM = true, AFTER_DRAIN = false;
    bf16_t* O; int ldc; const float* SSX; const float* bias; int ldb;
    mutable int pm_; PG8_LAS const float* lb; mutable int ui_;
    mutable float rs[2][4];
    static constexpr bool WANTS_NEXT = true;
    __device__ __forceinline__ void operator()(const f32x4 (&acc)[2][2][4][2], const Unit& u, int wr, int wc, int fr, int fq, int next_pm_ = -1) const {
        const int row0 = u.pm * BM + wr * 64 + fr, col0 = u.pn * BM + wc * 32 + 8 * fq;
        f32x4 bv[2][2];
        const bool pf = EPI_RSTD_PF_PLAIN && SSX && next_pm_ >= 0 && next_pm_ != u.pm; f32x4 pp[16];
        if (pf) epi_rstd_issue(SSX, next_pm_ * BM + wr * 64 + fr, fq, pp);
        if (SSX) { if (u.pm != pm_) { epi_row_rstd(SSX, row0, fq, rs); pm_ = u.pm; } PG8_LAS const float* bp = lb + ui_ * 256 + wc * 32 + 8 * fq; ++ui_;
#pragma unroll
            for (int bj = 0; bj < 2; ++bj)
#pragma unroll
                for (int n = 0; n < 2; ++n) bv[bj][n] = *(PG8_LAS const f32x4*)(bp + bj * HALF + 4 * n); }
#pragma unroll
        for (int ai = 0; ai < 2; ++ai)
#pragma unroll
            for (int m = 0; m < 4; ++m) { bf16_t* rowp = O + (size_t)(row0 + ai * HALF + m * 16) * ldc + col0;
#pragma unroll
                for (int bj = 0; bj < 2; ++bj) { f32x4 v0 = acc[ai][bj][m][0], v1 = acc[ai][bj][m][1];
                    if (SSX) { v0 = v0 * rs[ai][m] + bv[bj][0]; v1 = v1 * rs[ai][m] + bv[bj][1]; }
                    u32x4 w; w.x = cvt_pk_bf16(v0[0], v0[1]); w.y = cvt_pk_bf16(v0[2], v0[3]); w.z = cvt_pk_bf16(v1[0], v1[1]); w.w = cvt_pk_bf16(v1[2], v1[3]);
                    *(u32x4*)(rowp + bj * HALF) = w; } }
        if (pf) { epi_rstd_finish(pp, rs); pm_ = next_pm_; }
    }
};
#ifndef EPI_RES_DIAG
#define EPI_RES_DIAG 0
#endif
struct EpiRes {
    static constexpr bool PERM = true, AFTER_DRAIN = false, WANTS_NEXT = false;
    bf16_t* H; float* SSX;
    PG8_LAS const float* tab; mutable int ui_;
    __device__ __forceinline__ void operator()(const f32x4 (&acc)[2][2][4][2], const Unit& u, int wr, int wc, int fr, int fq) const {
        const int row0 = u.pm * BM + wr * 64 + fr, col0 = u.pn * BM + wc * 32 + 8 * fq;
        bf16_t* hp = H + (size_t)row0 * 2048 + col0;
        PG8_LAS const float* tp = tab + ui_ * 768 + wc * 32 + 8 * fq; ++ui_;
        u32x4 r[2][4][2];
#pragma unroll
        for (int ai = 0; ai < 2; ++ai)
#pragma unroll
            for (int m = 0; m < 4; ++m)
#pragma unroll
                for (int bj = 0; bj < 2; ++bj) r[ai][m][bj] = *(const u32x4*)(hp + (size_t)(ai * HALF + m * 16) * 2048 + bj * HALF);
#pragma unroll
        for (int ai = 0; ai < 2; ++ai) { float ss[4] = {0.f, 0.f, 0.f, 0.f};
#pragma unroll
            for (int bj = 0; bj < 2; ++bj) { f32x4 g[2], gs[2], gpi[2];
#pragma unroll
                for (int n = 0; n < 2; ++n) { g[n] = *(PG8_LAS const f32x4*)(tp + bj * HALF + n * 4); gs[n] = *(PG8_LAS const f32x4*)(tp + 256 + bj * HALF + n * 4); gpi[n] = *(PG8_LAS const f32x4*)(tp + 512 + bj * HALF + n * 4); }
#pragma unroll
                for (int m = 0; m < 4; ++m) { const size_t ro = (size_t)(ai * HALF + m * 16) * 2048; const u32x4 w0 = r[ai][m][bj]; u32x4 w;
                    { const f32x4 bs = (f32x4){__uint_as_float(w0.x << 16), __uint_as_float(w0.x & 0xffff0000u), __uint_as_float(w0.y << 16), __uint_as_float(w0.y & 0xffff0000u)} * gpi[0];
                      const f32x4 x = bs + g[0] * acc[ai][bj][m][0]; ss[m] += (x[0] * x[0] + x[1] * x[1]) + (x[2] * x[2] + x[3] * x[3]); const f32x4 a = x * gs[0];
                      w.x = cvt_pk_bf16(a[0], a[1]); w.y = cvt_pk_bf16(a[2], a[3]); }
                    { const f32x4 bs = (f32x4){__uint_as_float(w0.z << 16), __uint_as_float(w0.z & 0xffff0000u), __uint_as_float(w0.w << 16), __uint_as_float(w0.w & 0xffff0000u)} * gpi[1];
                      const f32x4 x = bs + g[1] * acc[ai][bj][m][1]; ss[m] += (x[0] * x[0] + x[1] * x[1]) + (x[2] * x[2] + x[3] * x[3]); const f32x4 a = x * gs[1];
                      w.z = cvt_pk_bf16(a[0], a[1]); w.w = cvt_pk_bf16(a[2], a[3]); }
                    *(u32x4*)(hp + ro + bj * HALF) = w; } }
#pragma unroll
            for (int m = 0; m < 4; ++m) { const float s1 = epi_add_x16_x32(ss[m]); if (fq == 0) SSX[(size_t)(row0 + ai * HALF + m * 16) * 32 + u.pn * 4 + wc] = s1; } }
    }
};
#ifndef NT_HH
#define NT_HH 0
#endif
#if NT_HH
#define EPI_HH_STORE(p, v) __builtin_nontemporal_store(v, p)
#else
#define EPI_HH_STORE(p, v) (*(p) = (v))
#endif
typedef float epi_f32x2 __attribute__((ext_vector_type(2)));
struct EpiSwiGLU {
    static constexpr bool PERM = true, AFTER_DRAIN = false;
    bf16_t* O; int ldc; const float* SSX; const float* bias; int ldb;
    mutable int pm_; PG8_LAS const float* lb; mutable int ui_; mutable float rs[2][4];
    static constexpr bool WANTS_NEXT = true;
    __device__ __forceinline__ void operator()(const f32x4 (&acc)[2][2][4][2], const Unit& u, int wr, int wc, int fr, int fq, int next_pm_ = -1) const {
        const int row0 = u.pm * BM + wr * 64 + fr, col0 = u.pn * HALF + wc * 32 + 8 * fq;
        const bool pf = EPI_RSTD_PF_SWIGLU && next_pm_ >= 0 && next_pm_ != u.pm; f32x4 pp[8];
        const float* nss = SSX + (size_t)(next_pm_ * BM + wr * 64 + fr) * 32 + 8 * fq;
        if (u.pm != pm_) { epi_row_rstd(SSX, row0, fq, rs); pm_ = u.pm; } f32x4 bv[2][2]; { PG8_LAS const float* bp = lb + ui_ * 256 + wc * 32 + 8 * fq; ++ui_;
#pragma unroll
            for (int bj = 0; bj < 2; ++bj)
#pragma unroll
                for (int n = 0; n < 2; ++n) bv[bj][n] = *(PG8_LAS const f32x4*)(bp + bj * HALF + 4 * n); }
#pragma unroll
        for (int ai = 0; ai < 2; ++ai) {
            if (pf) {
#pragma unroll
                for (int m = 0; m < 4; ++m) { const f32x4* q = (const f32x4*)(nss + (size_t)(ai * HALF + m * 16) * 32); pp[2 * m] = q[0]; pp[2 * m + 1] = q[1]; } }
#pragma unroll
            for (int m = 0; m < 4; ++m) { bf16_t* rowp = O + (size_t)(row0 + ai * HALF + m * 16) * ldc + col0;
                epi_f32x2 z[4]; const float rsm = rs[ai][m];
#pragma unroll
                for (int n = 0; n < 2; ++n)
#pragma unroll
                    for (int h = 0; h < 2; ++h) { const epi_f32x2 ag = {acc[ai][0][m][n][2 * h], acc[ai][0][m][n][2 * h + 1]}, au = {acc[ai][1][m][n][2 * h], acc[ai][1][m][n][2 * h + 1]};
                        const epi_f32x2 bg = {bv[0][n][2 * h], bv[0][n][2 * h + 1]}, bu = {bv[1][n][2 * h], bv[1][n][2 * h + 1]};
                        const epi_f32x2 gt = ag * rsm + bg, up = au * rsm + bu, q = gt * -1.4426950408889634f;
                        epi_f32x2 e; e.x = __builtin_amdgcn_exp2f(q.x); e.y = __builtin_amdgcn_exp2f(q.y);
                        const epi_f32x2 d = e + 1.0f; epi_f32x2 rc; rc.x = __builtin_amdgcn_rcpf(d.x); rc.y = __builtin_amdgcn_rcpf(d.y);
                        z[2 * n + h] = (gt * up) * rc; }
                u32x4 w; w.x = cvt_pk_bf16(z[0].x, z[0].y); w.y = cvt_pk_bf16(z[1].x, z[1].y); w.z = cvt_pk_bf16(z[2].x, z[2].y); w.w = cvt_pk_bf16(z[3].x, z[3].y);
                EPI_HH_STORE((u32x4*)rowp, w); }
            if (pf) {
#pragma unroll
                for (int m = 0; m < 4; ++m) { const f32x4 a = pp[2 * m], b = pp[2 * m + 1];
                    const float s1 = epi_add_x16_x32(((a[0] + a[1]) + (a[2] + a[3])) + ((b[0] + b[1]) + (b[2] + b[3])));
                    rs[ai][m] = 1.0f / __builtin_sqrtf(s1 * (1.0f / 2048.0f) + 1e-6f); } } }
        if (pf) pm_ = next_pm_;
    }
};
__device__ __forceinline__ float gelu_tanh(float x) {
    const float u = 0.7978845608028654f * (x + 0.044715f * x * x * x);
    const float e = __builtin_amdgcn_exp2f(u * -2.8853900817779268f);
    return x * __builtin_amdgcn_rcpf(1.0f + e);
}
__device__ __forceinline__ epi_f32x2 gelu_tanh2(epi_f32x2 x) {
    const epi_f32x2 t = (x * x) * (-0.10294324f) + (-2.3022082f), u = x * t;
    epi_f32x2 e; e.x = __builtin_amdgcn_exp2f(u.x); e.y = __builtin_amdgcn_exp2f(u.y);
    const epi_f32x2 d = e + 1.0f; epi_f32x2 r; r.x = __builtin_amdgcn_rcpf(d.x); r.y = __builtin_amdgcn_rcpf(d.y);
    return x * r;
}
struct EpiGeluUV {
    static constexpr bool PERM = true, AFTER_DRAIN = false;
    bf16_t* U; bf16_t* V; float* SS; const float* SSX; const float* bias; int ldb;
    mutable int pm_; PG8_LAS const float* lb; mutable int ui_; mutable float rs[2][4];
    static constexpr bool WANTS_NEXT = true;
    __device__ __forceinline__ void operator()(const f32x4 (&acc)[2][2][4][2], const Unit& u, int wr, int wc, int fr, int fq, int next_pm_ = -1) const {
        const bool isv = u.pn >= 8; const int pn = isv ? u.pn - 8 : u.pn;
        const int row0 = u.pm * BM + wr * 64 + fr, col0 = pn * BM + wc * 32 + 8 * fq;
        const bool pf = EPI_RSTD_PF_GELU && next_pm_ >= 0 && next_pm_ != u.pm; f32x4 pp[16];
        if (pf) epi_rstd_issue(SSX, next_pm_ * BM + wr * 64 + fr, fq, pp);
        if (u.pm != pm_) { epi_row_rstd(SSX, row0, fq, rs); pm_ = u.pm; } f32x4 bv[2][2]; { PG8_LAS const float* bp = lb + ui_ * 256 + wc * 32 + 8 * fq; ++ui_;
#pragma unroll
            for (int bj = 0; bj < 2; ++bj)
#pragma unroll
                for (int n = 0; n < 2; ++n) bv[bj][n] = *(PG8_LAS const f32x4*)(bp + bj * HALF + 4 * n); }
        bf16_t* O = isv ? V : U;
#pragma unroll
        for (int ai = 0; ai < 2; ++ai)
#pragma unroll
            for (int m = 0; m < 4; ++m) { const int row = row0 + ai * HALF + m * 16; bf16_t* rowp = O + (size_t)row * 2048 + col0; epi_f32x2 ss2 = {0.f, 0.f}; const float rsm = rs[ai][m];
#pragma unroll
                for (int bj = 0; bj < 2; ++bj) { epi_f32x2 z[4];
#pragma unroll
                    for (int n = 0; n < 2; ++n)
#pragma unroll
                        for (int h = 0; h < 2; ++h) { const epi_f32x2 a = {acc[ai][bj][m][n][2 * h], acc[ai][bj][m][n][2 * h + 1]}, b = {bv[bj][n][2 * h], bv[bj][n][2 * h + 1]};
                            z[2 * n + h] = gelu_tanh2(a * rsm + b); ss2 += z[2 * n + h] * z[2 * n + h]; }
                    u32x4 w; w.x = cvt_pk_bf16(z[0].x, z[0].y); w.y = cvt_pk_bf16(z[1].x, z[1].y); w.z = cvt_pk_bf16(z[2].x, z[2].y); w.w = cvt_pk_bf16(z[3].x, z[3].y);
                    *(u32x4*)(rowp + bj * HALF) = w; }
                float ss = ss2.x + ss2.y;
                if (isv) { ss += __int_as_float(__builtin_amdgcn_ds_swizzle(__float_as_int(ss), (16 << 10) | 0x1f)); { auto rr = __builtin_amdgcn_permlane32_swap(__float_as_uint(ss), __float_as_uint(ss), false, false); ss = __uint_as_float(rr[0]) + __uint_as_float(rr[1]); } if (fq == 0) SS[(size_t)row * 32 + pn * 4 + wc] = ss; } }
        if (pf) { epi_rstd_finish(pp, rs); pm_ = next_pm_; }
    }
};
template <class Epi, class Sched, bool ALIGN_EPI = false, bool SP2 = false>
__device__ __forceinline__ void gemm_phase(PG8_LAS unsigned char* lds, const Gemm g, const Sched& S, const Epi& E) {
    int tid_ = threadIdx.x; asm volatile("" : "+v"(tid_));
    const int tid = tid_, wid = __builtin_amdgcn_readfirstlane(tid >> 6), lane = tid & 63, wr = wid >> 2, wc = wid & 3, fr = lane & 15, fq = lane >> 4;
    const int K = g.K, nt = K / BK;
    unsigned voffA[2], voffB[2];
#pragma unroll
    for (int i = 0; i < 2; ++i) { int R, C; stage_rc(tid * 16 + i * 8192, R, C); const int Rb = Epi::PERM ? ((R & ~31) + perm32(R & 31)) : R;
        voffA[i] = (unsigned)(R * K + C) * 2u; voffB[i] = (unsigned)(Rb * K + C) * 2u; }
    const size_t kstep = (size_t)(BK * 2);
    const size_t hstep = (size_t)HALF * K * 2;
    const size_t tstep = 2 * hstep;
    const unsigned ldsw = (unsigned)wid * 1024u;
    const int aoff = lds_byte(wr * 64 + fr, fq * 8), boff = lds_byte(wc * 32 + fr, fq * 8);
#define PG8_SA(b, h) (((b) * 2 + (h)) * HTB)
#define PG8_SB(b, h) ((4 + (b) * 2 + (h)) * HTB)
#define PG8_STAGE(bufoff, gbase, voff) do { _Pragma("unroll") for (int _i = 0; _i < 2; ++_i) \
        __builtin_amdgcn_global_load_lds((const unsigned*)((const char*)(gbase) + (voff)[_i]), (PG8_LAS unsigned*)(lds + (bufoff) + ldsw + _i * 8192), 16, 0, 0); } while (0)
#define PG8_LDA(dst, b, h) do { _Pragma("unroll") for (int m = 0; m < 4; ++m) _Pragma("unroll") for (int k = 0; k < 2; ++k) dst[m][k] = *(const PG8_LAS bf16x8*)(lds + PG8_SA(b, h) + aoff + m * 2048 + k * 1024); } while (0)
#define PG8_LDB(dst, b, h) do { _Pragma("unroll") for (int n = 0; n < 2; ++n) _Pragma("unroll") for (int k = 0; k < 2; ++k) dst[n][k] = *(const PG8_LAS bf16x8*)(lds + PG8_SB(b, h) + boff + n * 2048 + k * 1024); } while (0)
#define PG8_MMA(ai, bj, At, Bt) do { __builtin_amdgcn_s_setprio(1); _Pragma("unroll") for (int m = 0; m < 4; ++m) _Pragma("unroll") for (int n = 0; n < 2; ++n) _Pragma("unroll") for (int k = 0; k < 2; ++k) \
        acc[ai][bj][m][n] = __builtin_amdgcn_mfma_f32_16x16x32_bf16(Bt[n][k], At[m][k], acc[ai][bj][m][n], 0, 0, 0); __builtin_amdgcn_s_setprio(0); } while (0)
#define PG8_WAIT_V(n) asm volatile("s_waitcnt vmcnt(" #n ")" ::: "memory")
#define PG8_WAIT_L(n) asm volatile("s_waitcnt lgkmcnt(" #n ")" ::: "memory")
#define PG8_BAR __builtin_amdgcn_s_barrier()
#define PG8_SCHED __builtin_amdgcn_sched_barrier(0)
    Unit cur, nxt; int ui = 0;
    if (!S.next(0, cur)) return;
    f32x4 acc[2][2][4][2];
#pragma unroll
    for (int a = 0; a < 2; ++a)
#pragma unroll
        for (int b = 0; b < 2; ++b)
#pragma unroll
            for (int m = 0; m < 4; ++m)
#pragma unroll
                for (int n = 0; n < 2; ++n) acc[a][b][m][n] = (f32x4){0.f, 0.f, 0.f, 0.f};
    bf16x8 At[4][2], B0[2][2], B1[2][2];
    const char* cA = (const char*)g.A + (size_t)cur.pm * tstep; const char* cB = (const char*)g.Bt + (size_t)cur.pn * tstep;
    S.a_ready(cur);
    if constexpr (SP2) {
        PG8_STAGE(PG8_SB(0, 0), cB, voffB); PG8_STAGE(PG8_SB(0, 1), cB + hstep, voffB); PG8_STAGE(PG8_SA(0, 0), cA, voffA); PG8_STAGE(PG8_SA(0, 1), cA + hstep, voffA);
        if (wr == 1) PG8_BAR;
        PG8_WAIT_V(2); PG8_BAR;
        PG8_STAGE(PG8_SB(1, 0), cB + kstep, voffB); PG8_STAGE(PG8_SA(1, 0), cA + kstep, voffA); PG8_STAGE(PG8_SB(1, 1), cB + hstep + kstep, voffB);
        PG8_WAIT_V(6); PG8_BAR;
    } else {
        PG8_STAGE(PG8_SB(0, 0), cB, voffB); PG8_STAGE(PG8_SA(0, 0), cA, voffA); PG8_STAGE(PG8_SB(0, 1), cB + hstep, voffB); PG8_STAGE(PG8_SA(0, 1), cA + hstep, voffA);
        if (wr == 1) PG8_BAR;
        PG8_WAIT_V(4); PG8_BAR;
        PG8_STAGE(PG8_SB(1, 0), cB + kstep, voffB); PG8_STAGE(PG8_SA(1, 0), cA + kstep, voffA); PG8_STAGE(PG8_SB(1, 1), cB + hstep + kstep, voffB);
        PG8_WAIT_V(6); PG8_BAR;
    }
    for (;;) {
        const bool has_next = S.next(ui + 1, nxt);
        const char* nA = has_next ? (const char*)g.A + (size_t)nxt.pm * tstep : cA; const char* nB = has_next ? (const char*)g.Bt + (size_t)nxt.pn * tstep : cB;
        for (int t = 0; t < nt; t += 2) {
            const bool last = (t == nt - 2);
            const char* a1 = cA + (size_t)(t + 1) * kstep;
            const char* a2 = last ? nA : cA + (size_t)(t + 2) * kstep; const char* b2 = last ? nB : cB + (size_t)(t + 2) * kstep;
            const char* a3 = a2 + kstep; const char* b3 = b2 + kstep;
            if (last && has_next) S.a_ready(nxt);
            if constexpr (SP2) {
            PG8_LDB(B0, 0, 0); PG8_LDB(B1, 0, 1); PG8_SCHED; PG8_LDA(At, 0, 0); PG8_STAGE(PG8_SA(1, 1), a1 + hstep, voffA);
            PG8_WAIT_V(8); PG8_WAIT_L(0); PG8_BAR; PG8_MMA(0, 0, At, B0); PG8_MMA(0, 1, At, B1); PG8_BAR; PG8_SCHED;
            PG8_LDA(At, 0, 1); PG8_STAGE(PG8_SB(0, 0), b2, voffB); PG8_STAGE(PG8_SB(0, 1), b2 + hstep, voffB); PG8_STAGE(PG8_SA(0, 0), a2, voffA);
            PG8_WAIT_V(8); PG8_WAIT_L(0); PG8_BAR; PG8_MMA(1, 0, At, B0); PG8_MMA(1, 1, At, B1); PG8_BAR; PG8_SCHED;
            PG8_LDB(B0, 1, 0); PG8_LDB(B1, 1, 1); PG8_SCHED; PG8_LDA(At, 1, 0); PG8_STAGE(PG8_SA(0, 1), a2 + hstep, voffA);
            PG8_WAIT_V(8); PG8_WAIT_L(0); PG8_BAR; PG8_MMA(0, 0, At, B0); PG8_MMA(0, 1, At, B1); PG8_BAR; PG8_SCHED;
            PG8_LDA(At, 1, 1); PG8_STAGE(PG8_SB(1, 0), b3, voffB); PG8_STAGE(PG8_SB(1, 1), b3 + hstep, voffB); PG8_STAGE(PG8_SA(1, 0), a3, voffA);
            PG8_WAIT_V(8); PG8_WAIT_L(0); PG8_BAR; PG8_MMA(1, 0, At, B0); PG8_MMA(1, 1, At, B1); PG8_BAR; PG8_SCHED;
            } else {
            PG8_LDB(B0, 0, 0); PG8_SCHED; PG8_LDA(At, 0, 0); PG8_STAGE(PG8_SA(1, 1), a1 + hstep, voffA);
            PG8_WAIT_L(8); PG8_BAR; PG8_WAIT_L(0); PG8_MMA(0, 0, At, B0); PG8_BAR; PG8_SCHED;
            PG8_LDB(B1, 0, 1); PG8_STAGE(PG8_SB(0, 0), b2, voffB);
            PG8_BAR; PG8_WAIT_L(0); PG8_MMA(0, 1, At, B1); PG8_BAR;
            PG8_LDA(At, 0, 1); PG8_STAGE(PG8_SA(0, 0), a2, voffA);
            PG8_BAR; PG8_WAIT_L(0); PG8_MMA(1, 0, At, B0); PG8_BAR; PG8_SCHED;
            PG8_STAGE(PG8_SB(0, 1), b2 + hstep, voffB);
            PG8_WAIT_V(6); PG8_BAR; PG8_MMA(1, 1, At, B1); PG8_BAR;
            PG8_LDB(B0, 1, 0); PG8_SCHED; PG8_LDA(At, 1, 0); PG8_STAGE(PG8_SA(0, 1), a2 + hstep, voffA);
            PG8_WAIT_L(8); PG8_BAR; PG8_WAIT_L(0); PG8_MMA(0, 0, At, B0); PG8_BAR; PG8_SCHED;
            PG8_LDB(B1, 1, 1); PG8_STAGE(PG8_SB(1, 0), b3, voffB);
            PG8_BAR; PG8_WAIT_L(0); PG8_MMA(0, 1, At, B1); PG8_BAR;
            PG8_LDA(At, 1, 1); PG8_STAGE(PG8_SA(1, 0), a3, voffA);
            PG8_BAR; PG8_WAIT_L(0); PG8_MMA(1, 0, At, B0); PG8_BAR; PG8_SCHED;
            PG8_STAGE(PG8_SB(1, 1), b3 + hstep, voffB);
            PG8_WAIT_V(6); PG8_BAR; PG8_MMA(1, 1, At, B1); PG8_BAR;
            }
        }
        if constexpr (ALIGN_EPI) { if (wr == 0) PG8_BAR; }
        if constexpr (!Epi::AFTER_DRAIN) { if constexpr (Epi::WANTS_NEXT) E(acc, cur, wr, wc, fr, fq, has_next ? nxt.pm : -1); else E(acc, cur, wr, wc, fr, fq); S.done(cur); }
        if (!has_next) break;
#pragma unroll
        for (int a = 0; a < 2; ++a)
#pragma unroll
            for (int b = 0; b < 2; ++b)
#pragma unroll
                for (int m = 0; m < 4; ++m)
#pragma unroll
                    for (int n = 0; n < 2; ++n) acc[a][b][m][n] = (f32x4){0.f, 0.f, 0.f, 0.f};
        cur = nxt; cA = nA; cB = nB; ++ui;
        if constexpr (ALIGN_EPI) { if (wr == 1) PG8_BAR; }
    }
    PG8_WAIT_V(0);
    if constexpr (!ALIGN_EPI) { if (wr == 0) PG8_BAR; }
    PG8_BAR;
    if constexpr (Epi::AFTER_DRAIN) { E.fused(acc, cur, wr, wc, fr, fq, lds, wid, lane); S.done(cur); }
#undef PG8_SA
#undef PG8_SB
#undef PG8_STAGE
#undef PG8_LDA
#undef PG8_LDB
#undef PG8_MMA
#undef PG8_WAIT_V
#undef PG8_WAIT_L
#undef PG8_BAR
#undef PG8_SCHED
}
}
namespace att {
typedef unsigned short bf16;
using bf16x8 = __attribute__((ext_vector_type(8))) short;
using s16x4  = __attribute__((ext_vector_type(4))) short;
using f32x16 = __attribute__((ext_vector_type(16))) float;
using u32x4  = __attribute__((ext_vector_type(4))) unsigned;
constexpr int NW = 8, QBLK = 32, KVBLK = 64;
constexpr float THR = 8.f;
#define ATT_SBAR() __builtin_amdgcn_sched_barrier(0)
template <int RS> __device__ __forceinline__ int kswz(int row, int colB) { return row * RS + (colB ^ ((row & 7) << 4)); }
__device__ __forceinline__ int crow(int r, int hi) { return (r & 3) + 8 * (r >> 2) + 4 * hi; }
__device__ __forceinline__ unsigned cvtpk(float lo, float hi) { unsigned r; asm volatile("v_cvt_pk_bf16_f32 %0, %1, %2" : "=v"(r) : "v"(lo), "v"(hi)); return r; }
__device__ __forceinline__ bf16x8 ld8(const bf16* p) { return *reinterpret_cast<const bf16x8*>(p); }

__device__ __forceinline__ void partialSM(f32x16& p0, f32x16& p1, float& m_reg, float& mn, float& alpha, const float C, const float TS) {
  float pmax = p0[0];
#pragma unroll
  for (int r = 1; r < 16; ++r) pmax = fmaxf(pmax, p0[r]);
#pragma unroll
  for (int r = 0; r < 16; ++r) pmax = fmaxf(pmax, p1[r]);
  { auto rr = __builtin_amdgcn_permlane32_swap(__float_as_uint(pmax), __float_as_uint(pmax), false, false);
    pmax = fmaxf(__uint_as_float(rr[0]), __uint_as_float(rr[1])); }
  if (__builtin_expect(__all(pmax - m_reg <= TS), 1)) { mn = m_reg; alpha = 1.f; }
  else { mn = fmaxf(m_reg, pmax); alpha = __builtin_amdgcn_exp2f((m_reg - mn) * C); m_reg = mn; }
  float mnC = -mn * C;
#pragma unroll
  for (int r = 0; r < 16; ++r) p0[r] = fmaf(p0[r], C, mnC);
#pragma unroll
  for (int r = 0; r < 16; ++r) p1[r] = fmaf(p1[r], C, mnC);
#pragma unroll
  for (int r = 0; r < 16; ++r) p0[r] = __builtin_amdgcn_exp2f(p0[r]);
}
__device__ __forceinline__ void finishSM(f32x16& p0, f32x16& p1, float alpha, float& l_reg, bf16x8& pa0, bf16x8& pa1, bf16x8& pa2, bf16x8& pa3) {
#pragma unroll
  for (int r = 0; r < 16; ++r) p1[r] = __builtin_amdgcn_exp2f(p1[r]);
  float ps = 0;
#pragma unroll
  for (int r = 0; r < 16; ++r) ps += p0[r];
#pragma unroll
  for (int r = 0; r < 16; ++r) ps += p1[r];
  { auto rr = __builtin_amdgcn_permlane32_swap(__float_as_uint(ps), __float_as_uint(ps), false, false);
    ps = __uint_as_float(rr[0]) + __uint_as_float(rr[1]); }
  l_reg = l_reg * alpha + ps;
#define ATT_PK4(P, BASE, OUT) do { unsigned a0 = cvtpk(P[BASE + 0], P[BASE + 1]), a1 = cvtpk(P[BASE + 2], P[BASE + 3]);   \
    unsigned b0 = cvtpk(P[BASE + 4], P[BASE + 5]), b1 = cvtpk(P[BASE + 6], P[BASE + 7]);                              \
    auto r0 = __builtin_amdgcn_permlane32_swap(a0, b0, false, false); auto r1 = __builtin_amdgcn_permlane32_swap(a1, b1, false, false); \
    u32x4 w = {r0[0], r1[0], r0[1], r1[1]}; OUT = *reinterpret_cast<bf16x8*>(&w); } while (0)
  ATT_PK4(p0, 0, pa0); ATT_PK4(p0, 8, pa1); ATT_PK4(p1, 0, pa2); ATT_PK4(p1, 8, pa3);
#undef ATT_PK4
}
#ifndef QKT_SB0
#define QKT_SB0 3
#endif
#ifndef QKT_SB1
#define QKT_SB1 7
#endif
template <int DK, int NQR> __device__ __forceinline__ void qkt(f32x16& p0, f32x16& p1, const char* Ks, const bf16x8* qr, const char* qrl, int r32, int hi) {
  p0 = f32x16{}; p1 = f32x16{};
#pragma unroll
  for (int d0 = 0; d0 < DK / 16; ++d0) { const int cb = (d0 * 16 + hi * 8) * 2;
    const bf16x8 qf = (d0 < NQR) ? qr[d0 < NQR ? d0 : 0] : *reinterpret_cast<const bf16x8*>(qrl + (d0 - NQR) * 1024);
    bf16x8 b0 = *reinterpret_cast<const bf16x8*>(Ks + kswz<DK * 2>(r32, cb));
    bf16x8 b1 = *reinterpret_cast<const bf16x8*>(Ks + kswz<DK * 2>(32 + r32, cb));
    p0 = __builtin_amdgcn_mfma_f32_32x32x16_bf16(b0, qf, p0, 0, 0, 0);
    p1 = __builtin_amdgcn_mfma_f32_32x32x16_bf16(b1, qf, p1, 0, 0, 0);
    if constexpr (DK == 192) { if (d0 == QKT_SB0 || d0 == QKT_SB1) ATT_SBAR(); } }
}
__device__ __forceinline__ int v_st(int k, int c) { const int kk = (k & ~0xC) | ((k & 4) << 1) | ((k & 8) >> 1); return ((kk >> 3) * 4 + (c >> 5)) * 512 + ((kk & 7) * 32 + (c & 31)) * 2; }
__device__ __forceinline__ int v_rd_base(int lane) { return ((lane & 3) << 3) | (((lane >> 2) & 3) << 6) | (((lane >> 4) & 1) << 5) | (((lane >> 5) & 1) << 8); }
constexpr int v_rd_off(int d0, int ks, int half) { return d0 * 512 + ks * 4096 + half * 2048; }
template <int OFF> __device__ __forceinline__ s16x4 tr_read(int vb) {
  s16x4 r; asm volatile("ds_read_b64_tr_b16 %0, %1 offset:%2" : "=&v"(r) : "v"(vb), "i"(OFF) : "memory"); return r;
}
template <int D0> __device__ __forceinline__ void pv_one(f32x16& od, int vb, bf16x8 pa0, bf16x8 pa1, bf16x8 pa2, bf16x8 pa3) {
  const s16x4 l0 = tr_read<v_rd_off(D0, 0, 0)>(vb), h0 = tr_read<v_rd_off(D0, 0, 1)>(vb), l1 = tr_read<v_rd_off(D0, 1, 0)>(vb), h1 = tr_read<v_rd_off(D0, 1, 1)>(vb);
  const s16x4 l2 = tr_read<v_rd_off(D0, 2, 0)>(vb), h2 = tr_read<v_rd_off(D0, 2, 1)>(vb), l3 = tr_read<v_rd_off(D0, 3, 0)>(vb), h3 = tr_read<v_rd_off(D0, 3, 1)>(vb);
  asm volatile("s_waitcnt lgkmcnt(0)" ::: "memory"); ATT_SBAR();
#define ATT_PK(L, H) (bf16x8){L[0], L[1], L[2], L[3], H[0], H[1], H[2], H[3]}
  od = __builtin_amdgcn_mfma_f32_32x32x16_bf16(pa0, ATT_PK(l0, h0), od, 0, 0, 0);
  od = __builtin_amdgcn_mfma_f32_32x32x16_bf16(pa1, ATT_PK(l1, h1), od, 0, 0, 0);
  od = __builtin_amdgcn_mfma_f32_32x32x16_bf16(pa2, ATT_PK(l2, h2), od, 0, 0, 0);
  od = __builtin_amdgcn_mfma_f32_32x32x16_bf16(pa3, ATT_PK(l3, h3), od, 0, 0, 0);
#undef ATT_PK
}
__device__ __forceinline__ void pv_d0(f32x16* o, int vb, bf16x8 pa0, bf16x8 pa1, bf16x8 pa2, bf16x8 pa3) {
  pv_one<0>(o[0], vb, pa0, pa1, pa2, pa3); pv_one<1>(o[1], vb, pa0, pa1, pa2, pa3); pv_one<2>(o[2], vb, pa0, pa1, pa2, pa3); pv_one<3>(o[3], vb, pa0, pa1, pa2, pa3);
}

template <int DK, int LDQ, int LDKN, int LDV, int LDO, int SDEPTH, int NQR, int QMODE>
__device__ __forceinline__ void attn_unit(const bf16* __restrict__ Qb, const bf16* __restrict__ Kn, const bf16* __restrict__ Kr, const bf16* __restrict__ Vh,
                                          bf16* __restrict__ Ob, int seq, char* lds, const float* __restrict__ qg, const float* __restrict__ T, int tok0) {
  constexpr int SHM_V = KVBLK * 128 * 2, SHM_K = KVBLK * DK * 2, KRS = DK * 2;
  constexpr float SCALE = (DK == 128) ? 0.088388347648318440f : 0.072168783648703220f;
  constexpr float C = SCALE * 1.4426950408889634f, TS = THR / SCALE;
  int tid_ = threadIdx.x; asm volatile("" : "+v"(tid_));
  const int tid = tid_, wid = tid >> 6, lane = tid & 63, r32 = lane & 31, hi = lane >> 5;
  char* V_lds = lds; char* K_lds = lds + 2 * SHM_V;
  float* ws = (float*)(lds + 2 * SHM_V + 2 * SHM_K) + wid * 64; float* li_l = ws; float* al_l = ws + 32;
  float m_reg = -1e30f, l_reg = 0; f32x16 o[4] = {}; bf16x8 qr[NQR]; constexpr int NQL = DK / 16 - NQR;
  char* qrl = lds + 2 * SHM_V + 2 * SHM_K + 2048 + (wid * NQL * 64 + lane) * 16;
  __syncthreads();
  const bf16* Qw = Qb + (long)(wid * QBLK + r32) * LDQ + hi * 8;
  { bf16x8 qraw[DK / 16];
#pragma unroll
    for (int d0 = 0; d0 < DK / 16; ++d0) qraw[d0] = ld8(Qw + d0 * 16);
#define ATT_UNPK(vv_, oo_) do { const u32x4 w_ = *reinterpret_cast<const u32x4*>(&(vv_)); oo_[0] = __uint_as_float(w_[0] << 16); oo_[1] = __uint_as_float(w_[0] & 0xffff0000u); oo_[2] = __uint_as_float(w_[1] << 16); oo_[3] = __uint_as_float(w_[1] & 0xffff0000u); \
      oo_[4] = __uint_as_float(w_[2] << 16); oo_[5] = __uint_as_float(w_[2] & 0xffff0000u); oo_[6] = __uint_as_float(w_[3] << 16); oo_[7] = __uint_as_float(w_[3] & 0xffff0000u); } while (0)
#define ATT_PK(ii_, vv_) do { u32x4 w_ = {cvtpk(ii_[0], ii_[1]), cvtpk(ii_[2], ii_[3]), cvtpk(ii_[4], ii_[5]), cvtpk(ii_[6], ii_[7])}; vv_ = *reinterpret_cast<bf16x8*>(&w_); } while (0)
    const int tok = tok0 + wid * QBLK + r32, prow = tok >> 6, pcol = tok & 63;
    if constexpr (QMODE == 1 || QMODE == 2) {
      float x[8][8]; float ss = 0.f;
#pragma unroll
      for (int d0 = 0; d0 < 8; ++d0) { ATT_UNPK(qraw[d0], x[d0]);
#pragma unroll
        for (int j = 0; j < 8; ++j) ss += x[d0][j] * x[d0][j]; }
      { auto rr = __builtin_amdgcn_permlane32_swap(__float_as_uint(ss), __float_as_uint(ss), false, false); ss = __uint_as_float(rr[0]) + __uint_as_float(rr[1]); }
      const float rstd = 1.0f / __builtin_sqrtf(ss * (1.0f / 128.0f) + 1e-6f);
#pragma unroll
      for (int d0 = 0; d0 < 8; ++d0) { const float* gp = qg + 16 * d0 + 8 * hi;
#pragma unroll
        for (int j = 0; j < 8; ++j) x[d0][j] = x[d0][j] * rstd * gp[j]; }
      if constexpr (QMODE == 2) {
#pragma unroll
        for (int ax = 0; ax < 2; ++ax) { const int pos = ax ? pcol : prow;
#pragma unroll
          for (int b = 0; b < 2; ++b) { const float* tp = T + ((long)pos * 32 + 16 * b + 8 * hi) * 2;
#pragma unroll
            for (int j = 0; j < 8; ++j) { const float co = tp[2 * j], si = tp[2 * j + 1], x1 = x[4 * ax + b][j], x2 = x[4 * ax + 2 + b][j];
              x[4 * ax + b][j] = x1 * co - x2 * si; x[4 * ax + 2 + b][j] = x1 * si + x2 * co; } } } }
#pragma unroll
      for (int d0 = 0; d0 < 8; ++d0) ATT_PK(x[d0], qraw[d0]);
    }
    if constexpr (QMODE == 3) {
#pragma unroll
      for (int ax = 0; ax < 2; ++ax) { const int pos = ax ? pcol : prow; const float* tp = T + ((long)pos * 16 + 8 * hi) * 2; float x1[8], x2[8];
        ATT_UNPK(qraw[8 + 2 * ax], x1); ATT_UNPK(qraw[9 + 2 * ax], x2);
#pragma unroll
        for (int j = 0; j < 8; ++j) { const float co = tp[2 * j], si = tp[2 * j + 1], a1 = x1[j], a2 = x2[j]; x1[j] = a1 * co - a2 * si; x2[j] = a1 * si + a2 * co; }
        ATT_PK(x1, qraw[8 + 2 * ax]); ATT_PK(x2, qraw[9 + 2 * ax]); } }
#undef ATT_UNPK
#undef ATT_PK
#pragma unroll
    for (int d0 = 0; d0 < NQR; ++d0) qr[d0] = qraw[d0];
    if constexpr (NQL > 0) {
#pragma unroll
      for (int f = 0; f < NQL; ++f) *reinterpret_cast<bf16x8*>(qrl + f * 1024) = qraw[NQR + f]; } }
  const int sr = tid >> 4, sc = (tid & 15) * 8, vst0 = v_st(sr, sc), vst1 = v_st(32 + sr, sc);
  const int rr = tid >> 3, rc = (tid & 7) * 8;
  const int vb0 = (int)(uintptr_t)V_lds + v_rd_base(lane);
  struct { bf16x8 vs0, vs1, ks0, ks1, kr; } sr_[SDEPTH];
#define ATT_SLOAD(i, k0) do { sr_[i].vs0 = ld8(&Vh[(long)((k0) + sr) * LDV + sc]); sr_[i].vs1 = ld8(&Vh[(long)((k0) + 32 + sr) * LDV + sc]); \
    sr_[i].ks0 = ld8(&Kn[(long)((k0) + sr) * LDKN + sc]); sr_[i].ks1 = ld8(&Kn[(long)((k0) + 32 + sr) * LDKN + sc]); \
    if constexpr (DK == 192) sr_[i].kr = ld8(&Kr[(long)((k0) + rr) * 64 + rc]); } while (0)
#define ATT_SWRITE(b, i) do { *(bf16x8*)(V_lds + (b) * SHM_V + vst0) = sr_[i].vs0; *(bf16x8*)(V_lds + (b) * SHM_V + vst1) = sr_[i].vs1; const int kc = sc * 2; \
    *(bf16x8*)(K_lds + (b) * SHM_K + kswz<KRS>(sr, kc)) = sr_[i].ks0; *(bf16x8*)(K_lds + (b) * SHM_K + kswz<KRS>(32 + sr, kc)) = sr_[i].ks1; \
    if constexpr (DK == 192) *(bf16x8*)(K_lds + (b) * SHM_K + kswz<KRS>(rr, 256 + rc * 2)) = sr_[i].kr; } while (0)
#define ATT_SWAIT() do { if constexpr (SDEPTH == 1) asm volatile("s_waitcnt vmcnt(0)" ::: "memory"); else if constexpr (DK == 192) asm volatile("s_waitcnt vmcnt(5)" ::: "memory"); else asm volatile("s_waitcnt vmcnt(4)" ::: "memory"); } while (0)
#define ATT_RESC(a) do { if (__any((a) < 1.f)) { if (hi == 0) al_l[r32] = (a); asm volatile("s_waitcnt lgkmcnt(0)" ::: "memory"); \
    _Pragma("unroll") for (int d = 0; d < 4; ++d) _Pragma("unroll") for (int r = 0; r < 16; ++r) o[d][r] *= al_l[crow(r, hi)]; } } while (0)
  f32x16 pA0, pA1, pB0, pB1; float mnA, mnB, alA, alB; bf16x8 pa0, pa1, pa2, pa3; const int NT = seq / KVBLK;
  constexpr int SE = 0, SO = SDEPTH - 1;
  ATT_SLOAD(SE, 0); asm volatile("s_waitcnt vmcnt(0)" ::: "memory"); ATT_SWRITE(0, SE); __syncthreads();
  qkt<DK, NQR>(pA0, pA1, K_lds, qr, qrl, r32, hi); partialSM(pA0, pA1, m_reg, mnA, alA, C, TS);
  ATT_SLOAD(SO, KVBLK); if constexpr (SDEPTH == 2) { if (2 < NT) ATT_SLOAD(SE, 2 * KVBLK); }
  if (2 < NT) ATT_SWAIT(); else asm volatile("s_waitcnt vmcnt(0)" ::: "memory");
  ATT_SWRITE(1, SO); __syncthreads();
  for (int j = 1; j + 1 < NT; j += 2) {
    ATT_SBAR(); qkt<DK, NQR>(pB0, pB1, K_lds + SHM_K, qr, qrl, r32, hi);
    finishSM(pA0, pA1, alA, l_reg, pa0, pa1, pa2, pa3); ATT_SBAR();
    ATT_SLOAD(SO, (j + SDEPTH) * KVBLK); ATT_SBAR();
    pv_d0(o, vb0, pa0, pa1, pa2, pa3); partialSM(pB0, pB1, m_reg, mnB, alB, C, TS);
    __syncthreads(); ATT_SWAIT(); ATT_SWRITE(0, SE);
    ATT_RESC(alB); __syncthreads();
    ATT_SBAR(); qkt<DK, NQR>(pA0, pA1, K_lds, qr, qrl, r32, hi);
    finishSM(pB0, pB1, alB, l_reg, pa0, pa1, pa2, pa3); ATT_SBAR();
    if (SDEPTH == 1 || j + 3 < NT) ATT_SLOAD(SE, (j + 1 + SDEPTH) * KVBLK); ATT_SBAR();
    pv_d0(o, vb0 + SHM_V, pa0, pa1, pa2, pa3); partialSM(pA0, pA1, m_reg, mnA, alA, C, TS);
    __syncthreads(); if (SDEPTH == 1 || j + 3 < NT) ATT_SWAIT(); else asm volatile("s_waitcnt vmcnt(0)" ::: "memory");
    ATT_SWRITE(1, SO);
    ATT_RESC(alA); __syncthreads();
  }
  ATT_SBAR(); qkt<DK, NQR>(pB0, pB1, K_lds + SHM_K, qr, qrl, r32, hi);
  finishSM(pA0, pA1, alA, l_reg, pa0, pa1, pa2, pa3); ATT_SBAR();
  pv_d0(o, vb0, pa0, pa1, pa2, pa3); partialSM(pB0, pB1, m_reg, mnB, alB, C, TS);
  __syncthreads(); ATT_RESC(alB);
  finishSM(pB0, pB1, alB, l_reg, pa0, pa1, pa2, pa3); ATT_SBAR();
  pv_d0(o, vb0 + SHM_V, pa0, pa1, pa2, pa3);
  if (hi == 0) li_l[r32] = l_reg; asm volatile("s_waitcnt lgkmcnt(0)" ::: "memory");
  float rli[16];
#pragma unroll
  for (int r = 0; r < 16; ++r) rli[r] = __builtin_amdgcn_rcpf(li_l[crow(r, hi)]);
  bf16* Ow = Ob + (long)(wid * QBLK) * LDO;
#pragma unroll
  for (int r = 0; r < 16; ++r) { const int orow = crow(r, hi);
#pragma unroll
    for (int d0 = 0; d0 < 4; d0 += 1) { const unsigned w = cvtpk(o[d0][r] * rli[r], 0.f); Ow[(long)orow * LDO + d0 * 32 + r32] = (bf16)(w & 0xffffu); } }
#undef ATT_SLOAD
#undef ATT_SWRITE
#undef ATT_SWAIT
#undef ATT_RESC
}
template <int DK, int LDQ, int LDKN, int LDV, int LDO, int NQR>
__device__ __forceinline__ void attn_unit_dma(const bf16* __restrict__ Qb, const bf16* __restrict__ Kn, const bf16* __restrict__ Kr, const bf16* __restrict__ Vh,
                                              bf16* __restrict__ Ob, int seq, char* lds, __attribute__((address_space(3))) unsigned char* ldsl) {
  constexpr int SHM_V = KVBLK * 128 * 2, SHM_K = KVBLK * DK * 2, KRS = DK * 2, STG = SHM_K + SHM_V, NKI = SHM_K / 8192;
  constexpr float SCALE = (DK == 128) ? 0.088388347648318440f : 0.072168783648703220f;
  constexpr float C = SCALE * 1.4426950408889634f, TS = THR / SCALE;
  int tid_ = threadIdx.x; asm volatile("" : "+v"(tid_));
  const int tid = tid_, wid = __builtin_amdgcn_readfirstlane(tid >> 6), lane = tid & 63, r32 = lane & 31, hi = lane >> 5;
  float* ws = (float*)(lds + 3 * STG) + wid * 64; float* li_l = ws; float* al_l = ws + 32;
  float m_reg = -1e30f, l_reg = 0; f32x16 o[4] = {}; bf16x8 qr[NQR]; constexpr int NQL = DK / 16 - NQR;
  char* qrl = lds + 3 * STG + 2048 + (wid * NQL * 64 + lane) * 16;
#define ATT_BAR() do { asm volatile("" ::: "memory"); __builtin_amdgcn_s_barrier(); asm volatile("" ::: "memory"); } while (0)
#define ATT_WAITV_B() do { if constexpr (NKI == 2) asm volatile("s_waitcnt vmcnt(4)" ::: "memory"); else asm volatile("s_waitcnt vmcnt(5)" ::: "memory"); } while (0)
#define ATT_WAITV_2B() do { if constexpr (NKI == 2) asm volatile("s_waitcnt vmcnt(8)" ::: "memory"); else asm volatile("s_waitcnt vmcnt(10)" ::: "memory"); } while (0)
  asm volatile("s_waitcnt vmcnt(0) lgkmcnt(0)" ::: "memory"); ATT_BAR();
  const bf16* Qw = Qb + (long)(wid * QBLK + r32) * LDQ + hi * 8;
#pragma unroll
  for (int d0 = 0; d0 < NQR; ++d0) qr[d0] = ld8(Qw + d0 * 16);
  if constexpr (NQL > 0) {
#pragma unroll
    for (int f = 0; f < NQL; ++f) *reinterpret_cast<bf16x8*>(qrl + f * 1024) = ld8(Qw + (NQR + f) * 16); }
  const char* ksrc[NKI]; int kinc[NKI]; const char* vsrc[2];
#pragma unroll
  for (int i = 0; i < NKI; ++i) { const int p = (i * 8 + wid) * 1024 + lane * 16, row = p / KRS, cb = (p % KRS) ^ ((row & 7) << 4);
    if (DK == 128 || cb < 256) { ksrc[i] = (const char*)Kn + ((long)row * LDKN) * 2 + cb; kinc[i] = KVBLK * LDKN * 2; }
    else { ksrc[i] = (const char*)Kr + row * 128 + (cb - 256); kinc[i] = KVBLK * 128; } }
#pragma unroll
  for (int i = 0; i < 2; ++i) { const int p = (i * 8 + wid) * 1024 + lane * 16, sub = p >> 9, q = p & 511, kk = ((sub >> 2) << 3) | (q >> 6), col = (sub & 3) * 32 + ((q & 63) >> 1);
    const int key = (kk & ~0xC) | ((kk & 4) << 1) | ((kk & 8) >> 1); vsrc[i] = (const char*)Vh + ((long)key * LDV + col) * 2; }
  constexpr int vinc = KVBLK * LDV * 2;
#define ATT_ISSUE(t, s) do { const int t_ = (t); const unsigned so_ = (unsigned)(s) * STG; \
    _Pragma("unroll") for (int i_ = 0; i_ < NKI; ++i_) __builtin_amdgcn_global_load_lds((const unsigned*)(ksrc[i_] + (long)t_ * kinc[i_]), (__attribute__((address_space(3))) unsigned*)(ldsl + so_ + (i_ * 8 + wid) * 1024), 16, 0, 0); \
    _Pragma("unroll") for (int i_ = 0; i_ < 2; ++i_) __builtin_amdgcn_global_load_lds((const unsigned*)(vsrc[i_] + (long)t_ * vinc), (__attribute__((address_space(3))) unsigned*)(ldsl + so_ + SHM_K + (i_ * 8 + wid) * 1024), 16, 0, 0); } while (0)
#define ATT_RESC2(a) do { if (__any((a) < 1.f)) { if (hi == 0) al_l[r32] = (a); asm volatile("s_waitcnt lgkmcnt(0)" ::: "memory"); \
    _Pragma("unroll") for (int d = 0; d < 4; ++d) _Pragma("unroll") for (int r = 0; r < 16; ++r) o[d][r] *= al_l[crow(r, hi)]; } } while (0)
  f32x16 pA0, pA1, pB0, pB1; float mnA, mnB, alA, alB; bf16x8 pa0, pa1, pa2, pa3; const int NT = seq / KVBLK;
  const int vbase = (int)(uintptr_t)lds + SHM_K + v_rd_base(lane);
  asm volatile("s_waitcnt vmcnt(0)" ::: "memory");
  ATT_ISSUE(0, 0); ATT_ISSUE(1, 1); ATT_ISSUE(2, 2);
  ATT_WAITV_2B(); ATT_BAR();
  qkt<DK, NQR>(pA0, pA1, lds, qr, qrl, r32, hi); partialSM(pA0, pA1, m_reg, mnA, alA, C, TS);
  ATT_WAITV_B(); ATT_BAR();
  int s = 1, sp = 0;
  for (int j = 1; j + 1 < NT; j += 2) {
    const int sn = 3 - s - sp;
    ATT_SBAR(); qkt<DK, NQR>(pB0, pB1, lds + s * STG, qr, qrl, r32, hi);
    finishSM(pA0, pA1, alA, l_reg, pa0, pa1, pa2, pa3); ATT_SBAR();
    pv_d0(o, vbase + sp * STG, pa0, pa1, pa2, pa3); partialSM(pB0, pB1, m_reg, mnB, alB, C, TS);
    asm volatile("s_waitcnt lgkmcnt(0)" ::: "memory"); ATT_BAR();
    const bool i2 = j + 2 < NT; if (i2) ATT_ISSUE(j + 2, sp);
    ATT_RESC2(alB);
    if (i2) ATT_WAITV_B(); else asm volatile("s_waitcnt vmcnt(0)" ::: "memory");
    ATT_BAR();
    ATT_SBAR(); qkt<DK, NQR>(pA0, pA1, lds + sn * STG, qr, qrl, r32, hi);
    finishSM(pB0, pB1, alB, l_reg, pa0, pa1, pa2, pa3); ATT_SBAR();
    pv_d0(o, vbase + s * STG, pa0, pa1, pa2, pa3); partialSM(pA0, pA1, m_reg, mnA, alA, C, TS);
    asm volatile("s_waitcnt lgkmcnt(0)" ::: "memory"); ATT_BAR();
    const bool i3 = j + 3 < NT; if (i3) ATT_ISSUE(j + 3, s);
    ATT_RESC2(alA);
    if (i3) ATT_WAITV_B(); else asm volatile("s_waitcnt vmcnt(0)" ::: "memory");
    ATT_BAR();
    const int s2 = sp; sp = sn; s = s2;
  }
  ATT_SBAR(); qkt<DK, NQR>(pB0, pB1, lds + s * STG, qr, qrl, r32, hi);
  finishSM(pA0, pA1, alA, l_reg, pa0, pa1, pa2, pa3); ATT_SBAR();
  pv_d0(o, vbase + sp * STG, pa0, pa1, pa2, pa3); partialSM(pB0, pB1, m_reg, mnB, alB, C, TS);
  ATT_RESC2(alB);
  finishSM(pB0, pB1, alB, l_reg, pa0, pa1, pa2, pa3); ATT_SBAR();
  pv_d0(o, vbase + s * STG, pa0, pa1, pa2, pa3);
  if (hi == 0) li_l[r32] = l_reg; asm volatile("s_waitcnt lgkmcnt(0)" ::: "memory");
  float rli[16];
#pragma unroll
  for (int r = 0; r < 16; ++r) rli[r] = __builtin_amdgcn_rcpf(li_l[crow(r, hi)]);
  bf16* Ow = Ob + (long)(wid * QBLK) * LDO;
#pragma unroll
  for (int r = 0; r < 16; ++r) { const int orow = crow(r, hi);
#pragma unroll
    for (int d0 = 0; d0 < 4; d0 += 1) { const unsigned w = cvtpk(o[d0][r] * rli[r], 0.f); Ow[(long)orow * LDO + d0 * 32 + r32] = (bf16)(w & 0xffffu); } }
#undef ATT_BAR
#undef ATT_WAITV_B
#undef ATT_WAITV_2B
#undef ATT_ISSUE
#undef ATT_RESC2
}

using f32x4a = __attribute__((ext_vector_type(4))) float;
__device__ __forceinline__ float max_x16(float v) { auto rr = __builtin_amdgcn_permlane16_swap(__float_as_uint(v), __float_as_uint(v), false, false); return fmaxf(__uint_as_float(rr[0]), __uint_as_float(rr[1])); }
__device__ __forceinline__ float max_x32(float v) { auto rr = __builtin_amdgcn_permlane32_swap(__float_as_uint(v), __float_as_uint(v), false, false); return fmaxf(__uint_as_float(rr[0]), __uint_as_float(rr[1])); }
__device__ __forceinline__ float add_x16(float v) { auto rr = __builtin_amdgcn_permlane16_swap(__float_as_uint(v), __float_as_uint(v), false, false); return __uint_as_float(rr[0]) + __uint_as_float(rr[1]); }
__device__ __forceinline__ float add_x32(float v) { auto rr = __builtin_amdgcn_permlane32_swap(__float_as_uint(v), __float_as_uint(v), false, false); return __uint_as_float(rr[0]) + __uint_as_float(rr[1]); }
__device__ __forceinline__ int k16_st(int r, int c) { return r * 256 + ((c ^ (r & 15)) << 4); }
__device__ __forceinline__ int kr16_st(int r, int c) { return 16384 + (r >> 1) * 256 + ((((r & 1) << 3) | (c ^ ((r >> 1) & 7))) << 4); }
__device__ __forceinline__ int v16_st(int k, int c) { const int row = (k & 0x23) | (((k >> 2) & 3) << 3) | (((k >> 4) & 1) << 2); return 256 * row + 16 * (c ^ (((row & 3) << 2) | ((row >> 2) & 3))); }

__device__ __forceinline__ void partialSM16(f32x4a (&p)[2][4], float (&m_reg)[2], float (&alpha)[2], const float C, const float TS) {
  float pmax[2];
#pragma unroll
  for (int qb = 0; qb < 2; ++qb) { float v = p[qb][0][0];
#pragma unroll
    for (int kb = 0; kb < 4; ++kb)
#pragma unroll
      for (int r = 0; r < 4; ++r) v = fmaxf(v, p[qb][kb][r]);
    v = max_x16(v); pmax[qb] = max_x32(v); }
  float mn[2];
  if (__builtin_expect(__all((pmax[0] - m_reg[0] <= TS) && (pmax[1] - m_reg[1] <= TS)), 1)) { mn[0] = m_reg[0]; mn[1] = m_reg[1]; alpha[0] = 1.f; alpha[1] = 1.f; }
  else {
#pragma unroll
    for (int qb = 0; qb < 2; ++qb) { mn[qb] = fmaxf(m_reg[qb], pmax[qb]); alpha[qb] = __builtin_amdgcn_exp2f((m_reg[qb] - mn[qb]) * C); m_reg[qb] = mn[qb]; } }
#pragma unroll
  for (int qb = 0; qb < 2; ++qb) { const float mnC = -mn[qb] * C;
#pragma unroll
    for (int kb = 0; kb < 4; ++kb)
#pragma unroll
      for (int r = 0; r < 4; ++r) p[qb][kb][r] = fmaf(p[qb][kb][r], C, mnC); }
#pragma unroll
  for (int qb = 0; qb < 2; ++qb)
#pragma unroll
    for (int kb = 0; kb < 2; ++kb)
#pragma unroll
      for (int r = 0; r < 4; ++r) p[qb][kb][r] = __builtin_amdgcn_exp2f(p[qb][kb][r]);
}
__device__ __forceinline__ void finishSM16(f32x4a (&p)[2][4], const float (&alpha)[2], float (&l_reg)[2], bf16x8 (&pa)[2][2]) {
#pragma unroll
  for (int qb = 0; qb < 2; ++qb)
#pragma unroll
    for (int kb = 2; kb < 4; ++kb)
#pragma unroll
      for (int r = 0; r < 4; ++r) p[qb][kb][r] = __builtin_amdgcn_exp2f(p[qb][kb][r]);
#pragma unroll
  for (int qb = 0; qb < 2; ++qb) { float ps = 0.f;
#pragma unroll
    for (int kb = 0; kb < 4; ++kb) ps += (p[qb][kb][0] + p[qb][kb][1]) + (p[qb][kb][2] + p[qb][kb][3]);
    ps = add_x16(ps); ps = add_x32(ps); l_reg[qb] = l_reg[qb] * alpha[qb] + ps;
#pragma unroll
    for (int ks = 0; ks < 2; ++ks) { u32x4 w = {cvtpk(p[qb][2 * ks][0], p[qb][2 * ks][1]), cvtpk(p[qb][2 * ks][2], p[qb][2 * ks][3]), cvtpk(p[qb][2 * ks + 1][0], p[qb][2 * ks + 1][1]), cvtpk(p[qb][2 * ks + 1][2], p[qb][2 * ks + 1][3])};
      pa[qb][ks] = *reinterpret_cast<bf16x8*>(&w); } }
}
template <int DK, int NQR> __device__ __forceinline__ void qkt16(f32x4a (&p)[2][4], const char* Ks, const bf16x8* qr, const char* qrl, int kbn, int kbr) {
#pragma unroll
  for (int qb = 0; qb < 2; ++qb)
#pragma unroll
    for (int kb = 0; kb < 4; ++kb) p[qb][kb] = (f32x4a){0.f, 0.f, 0.f, 0.f};
#pragma unroll
  for (int s = 0; s < DK / 32; ++s) {
    const bf16x8 q0 = (2 * s < NQR) ? qr[2 * s < NQR ? 2 * s : 0] : *reinterpret_cast<const bf16x8*>(qrl + (2 * s - NQR) * 1024);
    const bf16x8 q1 = (2 * s + 1 < NQR) ? qr[2 * s + 1 < NQR ? 2 * s + 1 : 0] : *reinterpret_cast<const bf16x8*>(qrl + (2 * s + 1 - NQR) * 1024);
    const int ka = (s < 4) ? (kbn ^ (s << 6)) : (kbr ^ ((s - 4) << 6));
#pragma unroll
    for (int kb = 0; kb < 4; ++kb) { const bf16x8 kf = *reinterpret_cast<const bf16x8*>(Ks + ka + kb * ((s < 4) ? 4096 : 2048));
      p[0][kb] = __builtin_amdgcn_mfma_f32_16x16x32_bf16(kf, q0, p[0][kb], 0, 0, 0);
      p[1][kb] = __builtin_amdgcn_mfma_f32_16x16x32_bf16(kf, q1, p[1][kb], 0, 0, 0); }
    if constexpr (DK == 192) { if (s == 1 || s == 3) ATT_SBAR(); } }
}
template <int DB> __device__ __forceinline__ void pv16_one(f32x4a& o0, f32x4a& o1, int vb, const bf16x8 (&pa)[2][2]) {
  const int a0 = vb ^ (32 * DB), a1 = vb ^ (32 * DB + 16);
  const s16x4 b00 = tr_read<0>(a0), b01 = tr_read<1024>(a1), b10 = tr_read<8192>(a0), b11 = tr_read<9216>(a1);
  asm volatile("s_waitcnt lgkmcnt(0)" ::: "memory"); ATT_SBAR();
  const bf16x8 B0 = (bf16x8){b00[0], b00[1], b00[2], b00[3], b01[0], b01[1], b01[2], b01[3]}, B1 = (bf16x8){b10[0], b10[1], b10[2], b10[3], b11[0], b11[1], b11[2], b11[3]};
  o0 = __builtin_amdgcn_mfma_f32_16x16x32_bf16(pa[0][0], B0, o0, 0, 0, 0);
  o1 = __builtin_amdgcn_mfma_f32_16x16x32_bf16(pa[1][0], B0, o1, 0, 0, 0);
  o0 = __builtin_amdgcn_mfma_f32_16x16x32_bf16(pa[0][1], B1, o0, 0, 0, 0);
  o1 = __builtin_amdgcn_mfma_f32_16x16x32_bf16(pa[1][1], B1, o1, 0, 0, 0);
}
__device__ __forceinline__ void pv16(f32x4a (&o)[2][8], int vb, const bf16x8 (&pa)[2][2]) {
  pv16_one<0>(o[0][0], o[1][0], vb, pa); pv16_one<1>(o[0][1], o[1][1], vb, pa); pv16_one<2>(o[0][2], o[1][2], vb, pa); pv16_one<3>(o[0][3], o[1][3], vb, pa);
  pv16_one<4>(o[0][4], o[1][4], vb, pa); pv16_one<5>(o[0][5], o[1][5], vb, pa); pv16_one<6>(o[0][6], o[1][6], vb, pa); pv16_one<7>(o[0][7], o[1][7], vb, pa);
}

template <int DK, int LDQ, int LDKN, int LDV, int LDO, int SDEPTH, int NQR, int QMODE>
__device__ __forceinline__ void attn_unit16(const bf16* __restrict__ Qb, const bf16* __restrict__ Kn, const bf16* __restrict__ Kr, const bf16* __restrict__ Vh,
                                            bf16* __restrict__ Ob, int seq, char* lds, const float* __restrict__ qg, const float* __restrict__ T, int tok0) {
  constexpr int SHM_V = KVBLK * 128 * 2, SHM_K = KVBLK * DK * 2, NF = DK / 16;
  constexpr float SCALE = (DK == 128) ? 0.088388347648318440f : 0.072168783648703220f;
  constexpr float C = SCALE * 1.4426950408889634f, TS = THR / SCALE;
  int tid_ = threadIdx.x; asm volatile("" : "+v"(tid_));
  const int tid = tid_, wid = tid >> 6, lane = tid & 63, li = lane & 15, lg = lane >> 4;
  char* V_lds = lds; char* K_lds = lds + 2 * SHM_V;
  float* ws = (float*)(lds + 2 * SHM_V + 2 * SHM_K) + wid * 64; float* li_l = ws; float* al_l = ws + 32;
  float m_reg[2] = {-1e30f, -1e30f}, l_reg[2] = {0.f, 0.f}; f32x4a o[2][8]; bf16x8 qr[NQR]; constexpr int NQL = NF - NQR;
#pragma unroll
  for (int qb = 0; qb < 2; ++qb)
#pragma unroll
    for (int db = 0; db < 8; ++db) o[qb][db] = (f32x4a){0.f, 0.f, 0.f, 0.f};
  char* qrl = lds + 2 * SHM_V + 2 * SHM_K + 2048 + (wid * NQL * 64 + lane) * 16;
  __syncthreads();
  const bf16* Qw = Qb + (long)(wid * QBLK + li) * LDQ + lg * 8;
  { bf16x8 qraw[NF];
#pragma unroll
    for (int s = 0; s < DK / 32; ++s)
#pragma unroll
      for (int qb = 0; qb < 2; ++qb) qraw[2 * s + qb] = ld8(Qw + (long)(16 * qb) * LDQ + 32 * s);
#define ATT_UNPK(vv_, oo_) do { const u32x4 w_ = *reinterpret_cast<const u32x4*>(&(vv_)); oo_[0] = __uint_as_float(w_[0] << 16); oo_[1] = __uint_as_float(w_[0] & 0xffff0000u); oo_[2] = __uint_as_float(w_[1] << 16); oo_[3] = __uint_as_float(w_[1] & 0xffff0000u); \
      oo_[4] = __uint_as_float(w_[2] << 16); oo_[5] = __uint_as_float(w_[2] & 0xffff0000u); oo_[6] = __uint_as_float(w_[3] << 16); oo_[7] = __uint_as_float(w_[3] & 0xffff0000u); } while (0)
#define ATT_PK(ii_, vv_) do { u32x4 w_ = {cvtpk(ii_[0], ii_[1]), cvtpk(ii_[2], ii_[3]), cvtpk(ii_[4], ii_[5]), cvtpk(ii_[6], ii_[7])}; vv_ = *reinterpret_cast<bf16x8*>(&w_); } while (0)
    if constexpr (QMODE == 1 || QMODE == 2) {
#pragma unroll
      for (int qb = 0; qb < 2; ++qb) {
        float x[4][8]; float ss = 0.f;
#pragma unroll
        for (int s = 0; s < 4; ++s) { ATT_UNPK(qraw[2 * s + qb], x[s]);
#pragma unroll
          for (int j = 0; j < 8; ++j) ss += x[s][j] * x[s][j]; }
        ss = add_x16(ss); ss = add_x32(ss);
        const float rstd = 1.0f / __builtin_sqrtf(ss * (1.0f / 128.0f) + 1e-6f);
#pragma unroll
        for (int s = 0; s < 4; ++s) { const float* gp = qg + 32 * s + 8 * lg;
#pragma unroll
          for (int j = 0; j < 8; ++j) x[s][j] = x[s][j] * rstd * gp[j]; }
        if constexpr (QMODE == 2) {
          const int tok = tok0 + wid * QBLK + 16 * qb + li, prow = tok >> 6, pcol = tok & 63;
#pragma unroll
          for (int ax = 0; ax < 2; ++ax) { const int pos = ax ? pcol : prow; const float* tp = T + ((long)pos * 32 + 8 * lg) * 2;
#pragma unroll
            for (int j = 0; j < 8; ++j) { const float co = tp[2 * j], si = tp[2 * j + 1], x1 = x[2 * ax][j], x2 = x[2 * ax + 1][j];
              x[2 * ax][j] = x1 * co - x2 * si; x[2 * ax + 1][j] = x1 * si + x2 * co; } } }
#pragma unroll
        for (int s = 0; s < 4; ++s) ATT_PK(x[s], qraw[2 * s + qb]);
      }
    }
    if constexpr (QMODE == 3) {
#pragma unroll
      for (int qb = 0; qb < 2; ++qb) { const int tok = tok0 + wid * QBLK + 16 * qb + li, prow = tok >> 6, pcol = tok & 63;
#pragma unroll
        for (int ax = 0; ax < 2; ++ax) { const int pos = ax ? pcol : prow; const float* tp = T + ((long)pos * 16 + 8 * (lg & 1)) * 2;
          const u32x4 w = *reinterpret_cast<const u32x4*>(&qraw[2 * (4 + ax) + qb]); u32x4 wo;
#pragma unroll
          for (int k = 0; k < 4; ++k) { auto rr = __builtin_amdgcn_permlane32_swap(w[k], w[k], false, false);
            const float a1 = __uint_as_float(rr[0] << 16), b1 = __uint_as_float(rr[0] & 0xffff0000u), a2 = __uint_as_float(rr[1] << 16), b2 = __uint_as_float(rr[1] & 0xffff0000u);
            const float co0 = tp[4 * k], si0 = tp[4 * k + 1], co1 = tp[4 * k + 2], si1 = tp[4 * k + 3];
            const float r0 = (lg < 2) ? a1 * co0 - a2 * si0 : a1 * si0 + a2 * co0, r1 = (lg < 2) ? b1 * co1 - b2 * si1 : b1 * si1 + b2 * co1;
            wo[k] = cvtpk(r0, r1); }
          qraw[2 * (4 + ax) + qb] = *reinterpret_cast<bf16x8*>(&wo); } } }
#undef ATT_UNPK
#undef ATT_PK
#pragma unroll
    for (int f = 0; f < NQR; ++f) qr[f] = qraw[f];
    if constexpr (NQL > 0) {
#pragma unroll
      for (int f = 0; f < NQL; ++f) *reinterpret_cast<bf16x8*>(qrl + f * 1024) = qraw[NQR + f]; } }
  const int sr = tid >> 4, sc = (tid & 15) * 8, vst0 = v16_st(sr, tid & 15), vst1 = vst0 + 8192, kst0 = k16_st(sr, tid & 15), kst1 = kst0 + 8192;
  const int rr = tid >> 3, rc = (tid & 7) * 8, krst = kr16_st(rr, tid & 7);
  const int vb0 = (int)(uintptr_t)V_lds + 256 * (8 * lg + (li >> 2)) + 8 * (lane & 1) + 16 * ((((li >> 2) << 2) | ((lg & 1) << 1)) | ((lane >> 1) & 1));
  const int kbn = li * 256 + (((li & 12) | ((lg ^ li) & 3)) << 4), kbr = 16384 + (li >> 1) * 256 + ((((li & 1) << 3) | ((lg ^ (li >> 1)) & 7)) << 4);
  struct { bf16x8 vs0, vs1, ks0, ks1, kr; } sr_[SDEPTH];
#define ATT_SLOAD(i, k0) do { sr_[i].vs0 = ld8(&Vh[(long)((k0) + sr) * LDV + sc]); sr_[i].vs1 = ld8(&Vh[(long)((k0) + 32 + sr) * LDV + sc]); \
    sr_[i].ks0 = ld8(&Kn[(long)((k0) + sr) * LDKN + sc]); sr_[i].ks1 = ld8(&Kn[(long)((k0) + 32 + sr) * LDKN + sc]); \
    if constexpr (DK == 192) sr_[i].kr = ld8(&Kr[(long)((k0) + rr) * 64 + rc]); } while (0)
#define ATT_SWRITE(b, i) do { *(bf16x8*)(V_lds + (b) * SHM_V + vst0) = sr_[i].vs0; *(bf16x8*)(V_lds + (b) * SHM_V + vst1) = sr_[i].vs1; \
    *(bf16x8*)(K_lds + (b) * SHM_K + kst0) = sr_[i].ks0; *(bf16x8*)(K_lds + (b) * SHM_K + kst1) = sr_[i].ks1; \
    if constexpr (DK == 192) *(bf16x8*)(K_lds + (b) * SHM_K + krst) = sr_[i].kr; } while (0)
#define ATT_SWAIT() do { if constexpr (SDEPTH == 1) asm volatile("s_waitcnt vmcnt(0)" ::: "memory"); else if constexpr (DK == 192) asm volatile("s_waitcnt vmcnt(5)" ::: "memory"); else asm volatile("s_waitcnt vmcnt(4)" ::: "memory"); } while (0)
#define ATT_RESC(a) do { if (__any(((a)[0] < 1.f) || ((a)[1] < 1.f))) { if (lg == 0) { al_l[li] = (a)[0]; al_l[16 + li] = (a)[1]; } asm volatile("s_waitcnt lgkmcnt(0)" ::: "memory"); \
    const f32x4a a0_ = *reinterpret_cast<const f32x4a*>(al_l + 4 * lg), a1_ = *reinterpret_cast<const f32x4a*>(al_l + 16 + 4 * lg); \
    _Pragma("unroll") for (int d = 0; d < 8; ++d) { o[0][d] *= a0_; o[1][d] *= a1_; } } } while (0)
  f32x4a pA[2][4], pB[2][4]; float alA[2], alB[2]; bf16x8 pa[2][2]; const int NT = seq / KVBLK;
  constexpr int SE = 0, SO = SDEPTH - 1;
  ATT_SLOAD(SE, 0); asm volatile("s_waitcnt vmcnt(0)" ::: "memory"); ATT_SWRITE(0, SE); __syncthreads();
  qkt16<DK, NQR>(pA, K_lds, qr, qrl, kbn, kbr); partialSM16(pA, m_reg, alA, C, TS);
  ATT_SLOAD(SO, KVBLK); if constexpr (SDEPTH == 2) { if (2 < NT) ATT_SLOAD(SE, 2 * KVBLK); }
  if (2 < NT) ATT_SWAIT(); else asm volatile("s_waitcnt vmcnt(0)" ::: "memory");
  ATT_SWRITE(1, SO); __syncthreads();
  for (int j = 1; j + 1 < NT; j += 2) {
    ATT_SBAR(); qkt16<DK, NQR>(pB, K_lds + SHM_K, qr, qrl, kbn, kbr);
    finishSM16(pA, alA, l_reg, pa); ATT_SBAR();
    ATT_SLOAD(SO, (j + SDEPTH) * KVBLK); ATT_SBAR();
    pv16(o, vb0, pa); partialSM16(pB, m_reg, alB, C, TS);
    __syncthreads(); ATT_SWAIT(); ATT_SWRITE(0, SE);
    ATT_RESC(alB); __syncthreads();
    ATT_SBAR(); qkt16<DK, NQR>(pA, K_lds, qr, qrl, kbn, kbr);
    finishSM16(pB, alB, l_reg, pa); ATT_SBAR();
    if (SDEPTH == 1 || j + 3 < NT) ATT_SLOAD(SE, (j + 1 + SDEPTH) * KVBLK); ATT_SBAR();
    pv16(o, vb0 + SHM_V, pa); partialSM16(pA, m_reg, alA, C, TS);
    __syncthreads(); if (SDEPTH == 1 || j + 3 < NT) ATT_SWAIT(); else asm volatile("s_waitcnt vmcnt(0)" ::: "memory");
    ATT_SWRITE(1, SO);
    ATT_RESC(alA); __syncthreads();
  }
  ATT_SBAR(); qkt16<DK, NQR>(pB, K_lds + SHM_K, qr, qrl, kbn, kbr);
  finishSM16(pA, alA, l_reg, pa); ATT_SBAR();
  pv16(o, vb0, pa); partialSM16(pB, m_reg, alB, C, TS);
  __syncthreads(); ATT_RESC(alB);
  finishSM16(pB, alB, l_reg, pa); ATT_SBAR();
  pv16(o, vb0 + SHM_V, pa);
  if (lg == 0) { li_l[li] = l_reg[0]; li_l[16 + li] = l_reg[1]; } asm volatile("s_waitcnt lgkmcnt(0)" ::: "memory");
  f32x4a rl[2] = {*reinterpret_cast<const f32x4a*>(li_l + 4 * lg), *reinterpret_cast<const f32x4a*>(li_l + 16 + 4 * lg)};
#pragma unroll
  for (int qb = 0; qb < 2; ++qb)
#pragma unroll
    for (int r = 0; r < 4; ++r) rl[qb][r] = __builtin_amdgcn_rcpf(rl[qb][r]);
  bf16* Ow = Ob + (long)(wid * QBLK + 4 * lg) * LDO + li;
#pragma unroll
  for (int qb = 0; qb < 2; ++qb)
#pragma unroll
    for (int r = 0; r < 4; ++r)
#pragma unroll
      for (int db = 0; db < 8; ++db) { const unsigned w = cvtpk(o[qb][db][r] * rl[qb][r], 0.f); Ow[(long)(16 * qb + r) * LDO + 16 * db] = (bf16)(w & 0xffffu); }
#undef ATT_SLOAD
#undef ATT_SWRITE
#undef ATT_SWAIT
#undef ATT_RESC
}
}
constexpr int DM = 2048, NP = 4096  , NS = 16384  , MT = NP + NS  ;
constexpr int SEQ_P = 256, SEQ_S = 4096, PAST = 512, KEYS_S = SEQ_S + PAST  , MK = NP + 4 * KEYS_S  ;
constexpr int ZW = 3840  , AIN = 3648, FF = 5632, NLAYER = 4;
constexpr int ZC_QA = 0, ZC_KA = 1024, ZC_VA = 1280, ZC_QB = 1536, ZC_CKV = 3072, ZC_KR = 3584;
constexpr float EPS = 1e-6f;
constexpr size_t OUT_SK = (size_t)MT * DM, OUT_SV = OUT_SK + 2097152, OUT_SCKV = OUT_SV + 2097152, OUT_SKR = OUT_SCKV + 4194304;

constexpr size_t MiB = 1u << 20;
constexpr size_t WS_CTL = 0, CTL_ZERO_BYTES = 64 * 1024;
constexpr size_t WS_TAB = 1 * MiB;
constexpr size_t WS_MOD = 2 * MiB;
constexpr size_t WS_SS = 3 * MiB;
constexpr size_t WS_WIN = 6 * MiB;
constexpr size_t WS_WKV = 36 * MiB;
constexpr size_t WS_WOUT = 40 * MiB;
constexpr size_t WS_CWIN = 56 * MiB;
constexpr size_t WS_CWOUT = 88 * MiB;
constexpr size_t WS_FGU = 104 * MiB;
constexpr size_t WS_FD = 280 * MiB;
constexpr size_t WS_H = 368 * MiB;
constexpr size_t WS_ACT = 448 * MiB;
constexpr size_t WS_Z = WS_ACT;
constexpr size_t WS_KA = WS_Z + 150 * MiB;
constexpr size_t WS_VA = WS_KA + 11 * MiB;
constexpr size_t WS_CKV = WS_VA + 11 * MiB;
constexpr size_t WS_KR = WS_CKV + 22 * MiB;
constexpr size_t WS_KVB = WS_KR + 3 * MiB;
constexpr size_t WS_O = WS_KVB + 88 * MiB;
constexpr size_t WS_ACT_END = WS_O + 80 * MiB;
constexpr size_t WS_U = WS_ACT, WS_V = WS_ACT + 80 * MiB, WS_MC = WS_ACT + 160 * MiB;
constexpr size_t WS_HH = WS_ACT;
constexpr size_t WS_SSX = WS_ACT_END;
constexpr size_t WS_BIAS1 = WS_ACT_END + 3 * MiB;
constexpr size_t WS_BIAS2 = WS_ACT_END + 4 * MiB;
constexpr size_t WS_XB = WS_ACT_END + 8 * MiB;
constexpr size_t WS_PROBE = WS_ACT_END + 88 * MiB;
constexpr size_t WS_END = WS_ACT_END + 96 * MiB;
constexpr int CW_BAR = 1024;

constexpr int RING_BYTES = 131072;
#ifndef LDS_KB
#define LDS_KB 144
#endif
constexpr int LDS_BYTES = LDS_KB * 1024;
constexpr int MISC_OFF = LDS_BYTES - 64;
constexpr int NWAVES = 8, NTHREADS = 512;

#define GAS __attribute__((address_space(1)))
#define LAS __attribute__((address_space(3)))
typedef unsigned short bf16;
typedef unsigned v4u __attribute__((ext_vector_type(4)));
typedef unsigned v2u __attribute__((ext_vector_type(2)));
typedef float f32x4 __attribute__((ext_vector_type(4)));
typedef short bf16x8 __attribute__((ext_vector_type(8)));
typedef float f32x16 __attribute__((ext_vector_type(16)));
#define LDS_WAIT() asm volatile("s_waitcnt lgkmcnt(0)" ::: "memory")
#define VM_WAIT() asm volatile("s_waitcnt vmcnt(0)" ::: "memory")
__device__ __forceinline__ unsigned pk2(float lo, float hi) { unsigned r; asm volatile("v_cvt_pk_bf16_f32 %0, %1, %2" : "=v"(r) : "v"(lo), "v"(hi)); return r; }
__device__ __forceinline__ float bf_lo(unsigned w) { return __uint_as_float(w << 16); }
__device__ __forceinline__ float bf_hi(unsigned w) { return __uint_as_float(w & 0xffff0000u); }
#define SWZ_XOR(v, m) __int_as_float(__builtin_amdgcn_ds_swizzle(__float_as_int(v), ((m) << 10) | 0x1f))
__device__ __forceinline__ float add_xor32(float v) { auto rr = __builtin_amdgcn_permlane32_swap(__float_as_uint(v), __float_as_uint(v), false, false); return __uint_as_float(rr[0]) + __uint_as_float(rr[1]); }
__device__ __forceinline__ float wave_sum(float v) {
    v += SWZ_XOR(v, 1); v += SWZ_XOR(v, 2); v += SWZ_XOR(v, 4); v += SWZ_XOR(v, 8); v += SWZ_XOR(v, 16);
    return add_xor32(v);
}

#define XB_TMO      128
#define XB_XCNT(j)  (256  + 64 * (j))
#define XB_XSUB(j)  (1280 + 64 * (j))
#define XB_XGEN(j)  (2304 + 64 * (j))
#define XB_TOP      3328
#define XB_TOPGEN   3392
#define XCD_BAR_WORDS 3456
#define XB_SPIN_CAP (1u << 18)
#define LAS __attribute__((address_space(3)))

__device__ __forceinline__ unsigned xb_ld(unsigned* p)              { return __hip_atomic_load(p, __ATOMIC_RELAXED, __HIP_MEMORY_SCOPE_AGENT); }
__device__ __forceinline__ unsigned xb_add(unsigned* p, unsigned v) { return __hip_atomic_fetch_add(p, v, __ATOMIC_RELAXED, __HIP_MEMORY_SCOPE_AGENT); }
__device__ __forceinline__ unsigned xb_xcc_id() { return (unsigned)__builtin_amdgcn_s_getreg((3 << 11) | 20) & 0xFu; }
#define XB_SPIN(cond, bar) do { unsigned _sp = 0; while (cond) { __builtin_amdgcn_s_sleep(1); \
    if ((++_sp & 255u) == 0u) { if (xb_ld(&(bar)[XB_TMO])) break; if (_sp > XB_SPIN_CAP) { atomicAdd(&(bar)[XB_TMO], 1u); break; } } } } while (0)

struct XcdBarrier {
    unsigned* bar; unsigned x;
    volatile LAS unsigned* st;
};

__device__ __forceinline__ XcdBarrier xcd_barrier_post(unsigned* bar, volatile LAS unsigned* st) {
    XcdBarrier b; b.bar = bar; b.x = xb_xcc_id(); b.st = st;
    if (threadIdx.x == 0) (void)xb_add(&bar[XB_XCNT(b.x)], 1u);
    return b;
}
__device__ __forceinline__ void xcd_barrier_complete(unsigned* bar, unsigned x, unsigned& nloc, unsigned& nx) {
    const unsigned G = gridDim.x * gridDim.y * gridDim.z;
    unsigned sum, cnt, mine, sp = 0u;
    for (;;) {
        sum = 0u; cnt = 0u; mine = 0u;
#pragma unroll
        for (unsigned j = 0; j < 16; ++j) { const unsigned c = xb_ld(&bar[XB_XCNT(j)]); sum += c; cnt += (c > 0u) ? 1u : 0u; mine = (j == x) ? c : mine; }
        if (sum == G) break;
        __builtin_amdgcn_s_sleep(1);
        if ((++sp & 255u) == 0u) { if (xb_ld(&bar[XB_TMO])) break; if (sp > XB_SPIN_CAP) { atomicAdd(&bar[XB_TMO], 1u); break; } }
    }
    nloc = mine > 0u ? mine : 1u; nx = cnt > 0u ? cnt : 1u;
}

__device__ __forceinline__ void xcd_barrier(const XcdBarrier& b) {
    asm volatile("s_waitcnt vmcnt(0)" ::: "memory");
    __syncthreads();
    if (threadIdx.x == 0) {
        unsigned* bar = b.bar;
        __builtin_amdgcn_s_waitcnt(0);
        unsigned nloc = b.st[0], nx = b.st[1];
        if (nloc == 0u) { xcd_barrier_complete(bar, b.x, nloc, nx); b.st[0] = nloc; b.st[1] = nx; }
        const unsigned old = xb_add(&bar[XB_XSUB(b.x)], 1u);
        const unsigned gen = old / nloc;
        if (old + 1u == (gen + 1u) * nloc) {
            __builtin_amdgcn_fence(__ATOMIC_RELEASE, "agent");
            asm volatile("s_waitcnt vmcnt(0)" ::: "memory");
            const unsigned og = xb_add(&bar[XB_TOP], 1u);
            const unsigned tg = og / nx;
            if (og + 1u == (tg + 1u) * nx) xb_add(&bar[XB_TOPGEN], 1u);
            else XB_SPIN(xb_ld(&bar[XB_TOPGEN]) == tg, bar);
            __builtin_amdgcn_fence(__ATOMIC_ACQUIRE, "agent");
            xb_add(&bar[XB_XGEN(b.x)], 1u);
            asm volatile("s_waitcnt vmcnt(0)" ::: "memory");
        } else {
            XB_SPIN(xb_ld(&bar[XB_XGEN(b.x)]) == gen, bar);
            __builtin_amdgcn_fence(__ATOMIC_ACQUIRE, "agent");
            asm volatile("s_waitcnt vmcnt(0)" ::: "memory");
        }
    }
    __syncthreads();
}

struct Args { const GAS float* in[27]; GAS float* out_f; GAS unsigned char* ws_b; int ph_lo, ph_hi; };
typedef __attribute__((address_space(4))) const Args* KArgsPtr;
struct InProxy { KArgsPtr ka; __device__ __forceinline__ const float* operator[](int i) const { return (const float*)ka->in[i]; } };
struct Frame {
    LAS unsigned char* lds;
    char* ldsg;
    int tid, lane, wave, bid, G;
    InProxy in;
    float* out; unsigned char* ws;
};
#define PHASE_BEGIN(F) do { GAS unsigned char* w_ = (F).in.ka->ws_b; GAS float* o_ = (F).in.ka->out_f; int g_ = (int)gridDim.x, b_ = (int)blockIdx.x, t_ = (int)threadIdx.x; \
    asm volatile("" : "+s"(w_), "+s"(o_), "+s"(g_), "+s"(b_), "+v"(t_)); (F).ws = (unsigned char*)w_; (F).out = (float*)o_; (F).G = g_; (F).bid = b_; (F).tid = t_; (F).lane = t_ & 63; (F).wave = __builtin_amdgcn_readfirstlane(t_ >> 6); } while (0)
#define FRAME_REFRESH(F) do { } while (0)
#ifndef PROBE_T
#define PROBE_T 0
#endif
#define PROBE_STAMP(F, k) do { if (PROBE_T && blockIdx.x == 0 && threadIdx.x == 0) { ((unsigned long long*)((F).ws + WS_PROBE))[(k)] = __builtin_amdgcn_s_memrealtime(); ((unsigned long long*)((F).ws + WS_PROBE))[64 + (k)] = __builtin_amdgcn_s_memtime(); } } while (0)
enum { I_XP = 0, I_XS, I_C, I_CK, I_CV, I_CCKV, I_CKR, I_CCTX, I_ADAW, I_ADAB, I_NMIX, I_NFFN, I_FG, I_FU, I_FD, I_AWIN, I_AQN, I_AKN, I_AKVN, I_AWKV, I_AWOUT, I_CWIN, I_CVN, I_CWS, I_CBS, I_CWOUT, I_FNORM };

#ifndef NT_WEIGHTS
#define NT_WEIGHTS 1
#endif
#if NT_WEIGHTS
#define NT_LOAD4(p) __builtin_nontemporal_load(p)
#else
#define NT_LOAD4(p) (*(p))
#endif
struct ConvItem { const float* W; bf16* WT; int K, N, k0, n0, drow0; };
__device__ __forceinline__ void conv_issue(const ConvItem& c, f32x4 (&v)[16], int lane) {
    const int kr = lane >> 4, n4 = (lane & 15) * 4;
#pragma unroll
    for (int i = 0; i < 16; ++i) v[i] = NT_LOAD4((const GAS f32x4*)(c.W + (size_t)(c.k0 + 4 * i + kr) * c.N + c.n0 + n4));
}
__device__ __forceinline__ void conv_finish(const ConvItem& c, const f32x4 (&v)[16], LAS float* scr, int lane) {
    const int kr = lane >> 4, n4 = (lane & 15) * 4;
#pragma unroll
    for (int i = 0; i < 16; ++i) { LAS float* d = scr + (4 * i + kr) * 65 + n4; d[0] = v[i].x; d[1] = v[i].y; d[2] = v[i].z; d[3] = v[i].w; }
    LDS_WAIT(); asm volatile("" ::: "memory");
    const int cc = lane & 7;
#pragma unroll
    for (int j = 0; j < 8; ++j) { const int n = (lane >> 3) + 8 * j; const LAS float* s = scr + (8 * cc) * 65 + n;
        v4u o; o.x = pk2(s[0 * 65], s[1 * 65]); o.y = pk2(s[2 * 65], s[3 * 65]); o.z = pk2(s[4 * 65], s[5 * 65]); o.w = pk2(s[6 * 65], s[7 * 65]);
        *(GAS v4u*)(c.WT + (size_t)(c.drow0 + n) * c.K + c.k0 + 8 * cc) = o; }
    LDS_WAIT(); asm volatile("" ::: "memory");
}
__device__ __forceinline__ void rope_entry(int pos, int i, double r, float& co, float& si) {
    double inv = 1.0; for (int k = 0; k < i; ++k) inv *= r;
    const double ang = (double)pos * inv;
    const double n = __builtin_rint(ang * 0.63661977236758134308);
    const double x = (ang - n * 1.57079632679489655800) - n * 6.12323399573676603587e-17;
    const double x2 = x * x;
    const double s = x * (1.0 + x2 * (-1.0 / 6 + x2 * (1.0 / 120 + x2 * (-1.0 / 5040 + x2 * (1.0 / 362880 + x2 * (-1.0 / 39916800 + x2 * (1.0 / 6227020800.0 + x2 * (-1.0 / 1307674368000.0))))))));
    const double c = 1.0 + x2 * (-0.5 + x2 * (1.0 / 24 + x2 * (-1.0 / 720 + x2 * (1.0 / 40320 + x2 * (-1.0 / 3628800 + x2 * (1.0 / 479001600 + x2 * (-1.0 / 87178291200.0 + x2 * (1.0 / 20922789888000.0))))))));
    const int q = ((int)n) & 3;
    const double cc = (q == 0) ? c : (q == 1) ? -s : (q == 2) ? -c : s;
    const double ss = (q == 0) ? s : (q == 1) ? c : (q == 2) ? -s : -c;
    co = (float)cc; si = (float)ss;
}
__device__ __forceinline__ void ada_layer(Frame& F, int layer, int it_lo, int it_hi, int widx, int nwg) {
    LAS float* SC = (LAS float*)F.lds;
    LAS float* RED = (LAS float*)(F.lds + 40960);
    __syncthreads();
    for (int idx = F.tid; idx < 5 * DM; idx += NTHREADS) { const int cd = idx >> 11, k = idx & 2047; const float v = cd == 0 ? F.in[I_CCTX][k] : F.in[I_C][(cd - 1) * DM + k];
        SC[idx] = v / (1.0f + __expf(-v)); }
    __syncthreads();
    float* MOD = (float*)(F.ws + WS_MOD);
    for (int it = it_lo + widx; it < it_hi; it += nwg) {
        const int c0 = it * 32, cg = F.lane & 7, rsub = F.lane >> 3;
        const float* W = F.in[I_ADAW] + (size_t)layer * DM * 12288 + c0 + 4 * cg;
        f32x4 acc[5];
#pragma unroll
        for (int cd = 0; cd < 5; ++cd) acc[cd] = (f32x4){0.f, 0.f, 0.f, 0.f};
        f32x4 w[32];
#pragma unroll
        for (int i = 0; i < 32; ++i) w[i] = NT_LOAD4((const GAS f32x4*)(W + (size_t)(256 * F.wave + 8 * i + rsub) * 12288));
#pragma unroll
        for (int i = 0; i < 32; ++i) { const int k = 256 * F.wave + 8 * i + rsub;
#pragma unroll
            for (int cd = 0; cd < 5; ++cd) acc[cd] += SC[cd * DM + k] * w[i]; }
#pragma unroll
        for (int cd = 0; cd < 5; ++cd)
#pragma unroll
            for (int e = 0; e < 4; ++e) { float v = acc[cd][e]; v += SWZ_XOR(v, 8); v += SWZ_XOR(v, 16); v = add_xor32(v); acc[cd][e] = v; }
        if (rsub == 0) {
#pragma unroll
            for (int cd = 0; cd < 5; ++cd) *(LAS f32x4*)(RED + (F.wave * 5 + cd) * 32 + 4 * cg) = acc[cd]; }
        __syncthreads();
        if (F.tid < 160) { const int cd = F.tid >> 5, col = F.tid & 31; float s = 0.f;
#pragma unroll
            for (int w = 0; w < 8; ++w) s += RED[(w * 5 + cd) * 32 + col];
            MOD[((size_t)layer * 5 + cd) * 12288 + c0 + col] = s + F.in[I_ADAB][layer * 12288 + c0 + col]; }
        __syncthreads();
    }
}
__device__ __forceinline__ ConvItem conv_decode(Frame& F, int L, int part, int it) {
    constexpr int I_WIN = 32 * 57, I_WKV = 8 * 32, I_WOUT = 32 * 32, I_CWI = 32 * 64, I_FGU = 32 * 88;
    const int j = L >> 1; const bool attn = (L & 1) == 0;
    const float* W; bf16* WT; int K, N, r, gu = -1;
    if (part) { const int m = it / I_FGU; r = it % I_FGU;
        if (m < 2) { gu = m; K = DM; N = FF; W = (gu ? F.in[I_FU] : F.in[I_FG]) + (size_t)L * DM * FF; WT = (bf16*)(F.ws + WS_FGU) + (size_t)L * 2 * FF * DM; }
        else { K = FF; N = DM; W = F.in[I_FD] + (size_t)L * FF * DM; WT = (bf16*)(F.ws + WS_FD) + (size_t)L * DM * FF; } }
    else if (attn) {
        if (it < I_WIN) { r = it; K = DM; N = AIN; W = F.in[I_AWIN] + (size_t)j * DM * AIN; WT = (bf16*)(F.ws + WS_WIN) + (size_t)j * ZW * DM; }
        else if (it < I_WIN + I_WKV) { r = it - I_WIN; K = 512; N = 2048; W = F.in[I_AWKV] + (size_t)j * 512 * 2048; WT = (bf16*)(F.ws + WS_WKV) + (size_t)j * 2048 * 512; }
        else { r = it - I_WIN - I_WKV; K = DM; N = DM; W = F.in[I_AWOUT] + (size_t)j * DM * DM; WT = (bf16*)(F.ws + WS_WOUT) + (size_t)j * DM * DM; } }
    else {
        if (it < I_CWI) { r = it; K = DM; N = 4096; W = F.in[I_CWIN] + (size_t)j * DM * 4096; WT = (bf16*)(F.ws + WS_CWIN) + (size_t)j * 4096 * DM; }
        else { r = it - I_CWI; K = DM; N = DM; W = F.in[I_CWOUT] + (size_t)j * DM * DM; WT = (bf16*)(F.ws + WS_CWOUT) + (size_t)j * DM * DM; } }
    const int nblk = N / 64, kb = r / nblk, nb = r % nblk, n0 = 64 * nb;
    const int drow0 = (gu < 0) ? n0 : ((n0 >> 7) * 256 + gu * 128 + (n0 & 127));
    return ConvItem{W, WT, K, N, 64 * kb, n0, drow0};
}
__device__ __forceinline__ void conv_items(Frame& F, int L, int part, int widx, int nw, int it_lo = 0, int it_hi = 0x7fffffff) {
    LAS float* scr = (LAS float*)(F.lds + F.wave * 16640);
    constexpr int I_WIN = 32 * 57, I_WKV = 8 * 32, I_WOUT = 32 * 32, I_CWI = 32 * 64, I_FGU = 32 * 88;
    const bool attn = (L & 1) == 0;
    const int count_ = part ? 3 * I_FGU : (attn ? I_WIN + I_WKV + I_WOUT : I_CWI + I_WOUT), count = count_ < it_hi ? count_ : it_hi;
    f32x4 va[16], vb[16]; ConvItem ca, cb;
    int it = it_lo + widx;
    if (it < count) { ca = conv_decode(F, L, part, it); conv_issue(ca, va, F.lane); }
    while (it < count) {
        const int itb = it + nw; const bool hb = itb < count;
        if (hb) { cb = conv_decode(F, L, part, itb); conv_issue(cb, vb, F.lane); }
        conv_finish(ca, va, scr, F.lane);
        it = itb + nw;
        if (it < count) { ca = conv_decode(F, L, part, it); conv_issue(ca, va, F.lane); }
        if (hb) conv_finish(cb, vb, scr, F.lane);
    }
}
__device__ __forceinline__ void tail_slot(Frame& F, int first_idle, int& widx, int& nwg) {
    const int fi = (first_idle > 0 && first_idle < F.G) ? first_idle : 0; widx = F.bid - fi; nwg = F.G - fi;
}
#ifndef P0_DEFER8
#define P0_DEFER8 0
#endif
constexpr int P0_FFN_ITEMS = (3 * 32 * 88) * (8 - P0_DEFER8) / 8;
#ifndef SPAT_MRU
#define SPAT_MRU 0
#endif
#ifndef TAIL_CONV
#define TAIL_CONV 1
#endif
__device__ __forceinline__ void p0_prologue(Frame& F) {
    FRAME_REFRESH(F);
    for (int layer = 0; layer < (TAIL_CONV ? 1 : NLAYER); ++layer) ada_layer(F, layer, 0, 384, F.bid, F.G);
    if (F.bid == F.G - 1) {
        float* T128 = (float*)(F.ws + WS_TAB); float* T64 = (float*)(F.ws + WS_TAB + 16384);
        for (int e = F.tid; e < 64 * 32 + 64 * 16; e += NTHREADS) {
            float co, si;
            if (e < 2048) { rope_entry(e >> 5, e & 31, 0.74989420933245582730, co, si); T128[2 * e] = co; T128[2 * e + 1] = si; }
            else { const int f = e - 2048; rope_entry(f >> 4, f & 15, 0.56234132519034908039, co, si); T64[2 * f] = co; T64[2 * f + 1] = si; }
        }
    }
    { const size_t n16 = (size_t)(ZW - AIN) * DM * 2 / 16;
      for (size_t i = (size_t)F.bid * NTHREADS + F.tid; i < 2 * n16; i += (size_t)F.G * NTHREADS) { const size_t l = i / n16, r = i % n16;
          *(GAS v4u*)(F.ws + WS_WIN + l * ((size_t)ZW * DM * 2) + (size_t)AIN * DM * 2 + r * 16) = (v4u){0u, 0u, 0u, 0u}; } }
    __syncthreads();
    const int gw = F.bid * NWAVES + F.wave, NGW = F.G * NWAVES;
    for (int L = 0; L < (TAIL_CONV ? 1 : NLAYER); ++L) { conv_items(F, L, 0, gw, NGW); conv_items(F, L, 1, gw, NGW, 0, (L == 0 && TAIL_CONV) ? P0_FFN_ITEMS : 0x7fffffff); }
}

__device__ __forceinline__ void unpack8(const v4u w, float (&x)[8]) { x[0] = bf_lo(w.x); x[1] = bf_hi(w.x); x[2] = bf_lo(w.y); x[3] = bf_hi(w.y); x[4] = bf_lo(w.z); x[5] = bf_hi(w.z); x[6] = bf_lo(w.w); x[7] = bf_hi(w.w); }
__device__ __forceinline__ void mod0_phase(Frame& F, const float* x_lo, const float* x_hi, const float* gain, const float* modl  ) {
    bf16* H = (bf16*)(F.ws + WS_H); float* SSX = (float*)(F.ws + WS_SSX);
    const int gw = F.bid * NWAVES + F.wave, NGW = F.G * NWAVES;
    LAS float* GS = (LAS float*)F.lds;
    __syncthreads();
    for (int i = F.tid; i < 5 * DM / 4; i += NTHREADS) { const int cd = i >> 9, c4 = i & 511; const f32x4 g = ((const GAS f32x4*)gain)[c4], a = ((const GAS f32x4*)(modl + (size_t)cd * 12288 + DM))[c4];
        ((LAS f32x4*)GS)[i] = g * (1.0f + a); }
    __syncthreads();
#define MOD0_ROW(m_) (((m_) < NP) ? x_lo + (size_t)(m_) * DM : x_hi + (size_t)((m_) - NP) * DM)
    f32x4 v[8]; int m = gw;
    if (m < MT) { const float* xr = MOD0_ROW(m);
#pragma unroll
        for (int j = 0; j < 8; ++j) v[j] = ((const GAS f32x4*)xr)[F.lane + 64 * j]; }
    for (; m < MT; m += NGW) {
        const int mn = m + NGW; f32x4 vn[8];
        if (mn < MT) { const float* xn = MOD0_ROW(mn);
#pragma unroll
            for (int j = 0; j < 8; ++j) vn[j] = ((const GAS f32x4*)xn)[F.lane + 64 * j]; }
        const int cd = (m < NP) ? 0 : 1 + ((m - NP) >> 12);
        float s = 0.f;
#pragma unroll
        for (int j = 0; j < 8; ++j) s += (v[j].x * v[j].x + v[j].y * v[j].y) + (v[j].z * v[j].z + v[j].w * v[j].w);
        s = wave_sum(s);
        if (F.lane < 32) SSX[(size_t)m * 32 + F.lane] = F.lane == 0 ? s : 0.f;
        GAS v2u* o8 = (GAS v2u*)(H + (size_t)m * DM) + F.lane;
#pragma unroll
        for (int j = 0; j < 8; ++j) { const f32x4 y = v[j] * ((LAS f32x4*)GS)[cd * 512 + F.lane + 64 * j];
            v2u w; w.x = pk2(y.x, y.y); w.y = pk2(y.z, y.w); o8[64 * j] = w; }
#pragma unroll
        for (int j = 0; j < 8; ++j) v[j] = vn[j];
    }
#undef MOD0_ROW
}
__device__ __forceinline__ void bias_rows(Frame& F, const bf16* Bt, int nrows, const float* sh  , float* out, int ldb, int widx, int nw) {
    LAS float* SH = (LAS float*)F.lds;
    __syncthreads();
    for (int idx = F.tid; idx < 5 * DM; idx += NTHREADS) SH[idx] = sh[(size_t)(idx >> 11) * 12288 + (idx & 2047)];
    __syncthreads();
    v4u wn[4];
    if (widx < nrows) { const GAS v4u* bp = (const GAS v4u*)(Bt + (size_t)widx * DM) + F.lane;
#pragma unroll
        for (int i = 0; i < 4; ++i) wn[i] = bp[64 * i]; }
    for (int n = widx; n < nrows; n += nw) {
        v4u w[4];
#pragma unroll
        for (int i = 0; i < 4; ++i) w[i] = wn[i];
        if (n + nw < nrows) { const GAS v4u* bp = (const GAS v4u*)(Bt + (size_t)(n + nw) * DM) + F.lane;
#pragma unroll
            for (int i = 0; i < 4; ++i) wn[i] = bp[64 * i]; }
        float acc[5] = {0.f, 0.f, 0.f, 0.f, 0.f};
#pragma unroll
        for (int i = 0; i < 4; ++i) { float x[8]; unpack8(w[i], x);
#pragma unroll
            for (int cd = 0; cd < 5; ++cd) { const LAS f32x4* sp = (const LAS f32x4*)(SH + cd * DM + 8 * F.lane + 512 * i); const f32x4 a = sp[0], b = sp[1];
                acc[cd] += (x[0] * a.x + x[1] * a.y) + (x[2] * a.z + x[3] * a.w) + (x[4] * b.x + x[5] * b.y) + (x[6] * b.z + x[7] * b.w); } }
#pragma unroll
        for (int cd = 0; cd < 5; ++cd) { const float s = wave_sum(acc[cd]); if (F.lane == 0) out[(size_t)cd * ldb + n] = s; }
    }
    __syncthreads();
}
__device__ __forceinline__ void final_row(Frame& F, int m) {
    const bf16* HB = (const bf16*)(F.ws + WS_H); const float* SSX = (const float*)(F.ws + WS_SSX);
    const GAS v4u* xr = (const GAS v4u*)(HB + (size_t)m * DM); GAS f32x4* yr = (GAS f32x4*)(F.out + (size_t)m * DM);
    v4u w[4];
#pragma unroll
    for (int j = 0; j < 4; ++j) w[j] = xr[F.lane + 64 * j];
    float s = SSX[(size_t)m * 32 + (F.lane & 31)]; s += SWZ_XOR(s, 1); s += SWZ_XOR(s, 2); s += SWZ_XOR(s, 4); s += SWZ_XOR(s, 8); s += SWZ_XOR(s, 16);
    const float rstd = 1.0f / sqrtf(s * (1.0f / DM) + EPS);
#pragma unroll
    for (int j = 0; j < 4; ++j) { float v[8]; unpack8(w[j], v);
        yr[2 * (F.lane + 64 * j)] = (f32x4){v[0], v[1], v[2], v[3]} * rstd; yr[2 * (F.lane + 64 * j) + 1] = (f32x4){v[4], v[5], v[6], v[7]} * rstd; }
}
__device__ __forceinline__ void final_phase(Frame& F) {
    FRAME_REFRESH(F);
    const int gw = F.bid * NWAVES + F.wave, NGW = F.G * NWAVES;
    for (int m = gw; m < MT; m += NGW) final_row(F, m);
}

__device__ __forceinline__ void head_norm_rope16(float (&x)[16], int s, const float* gain128, bool rope, int prow, int pcol, const float* T128) {
    float ss = 0.f;
#pragma unroll
    for (int e = 0; e < 16; ++e) ss += x[e] * x[e];
    ss += SWZ_XOR(ss, 1); ss += SWZ_XOR(ss, 2); ss += SWZ_XOR(ss, 4);
    const float rstd = 1.0f / sqrtf(ss * (1.0f / 128.0f) + EPS);
#pragma unroll
    for (int e = 0; e < 16; ++e) x[e] = x[e] * rstd * gain128[16 * s + e];
    if (rope) {
        const int pos = (s >> 2) ? pcol : prow; const bool second = (s >> 1) & 1; const float* t = T128 + ((size_t)pos * 32 + 16 * (s & 1)) * 2;
#pragma unroll
        for (int e = 0; e < 16; ++e) { const float xp = SWZ_XOR(x[e], 2); const float co = t[2 * e], si = t[2 * e + 1];
            x[e] = x[e] * co + (second ? xp * si : -xp * si); }
    }
}
__device__ __forceinline__ void rope8(float (&x)[8], int s, int prow, int pcol, const float* T64) {
    const int pos = (s >> 2) ? pcol : prow; const bool second = (s >> 1) & 1; const float* t = T64 + ((size_t)pos * 16 + 8 * (s & 1)) * 2;
#pragma unroll
    for (int e = 0; e < 8; ++e) { const float xp = SWZ_XOR(x[e], 2); const float co = t[2 * e], si = t[2 * e + 1];
        x[e] = x[e] * co + (second ? xp * si : -xp * si); }
}
__device__ __forceinline__ v4u pack8(const float* x) { v4u w; w.x = pk2(x[0], x[1]); w.y = pk2(x[2], x[3]); w.z = pk2(x[4], x[5]); w.w = pk2(x[6], x[7]); return w; }
__device__ __forceinline__ void post_phase(Frame& F, int j, bool dry = false) {
    FRAME_REFRESH(F);
    bf16* Z = (bf16*)(F.ws + WS_Z); bf16* KA = (bf16*)(F.ws + WS_KA); bf16* VA = (bf16*)(F.ws + WS_VA); bf16* CKV = (bf16*)(F.ws + WS_CKV); bf16* KR = (bf16*)(F.ws + WS_KR);
    const float* T128 = (const float*)(F.ws + WS_TAB); const float* T64 = (const float*)(F.ws + WS_TAB + 16384);
    const float* qn = F.in[I_AQN] + j * 128; const float* kn = F.in[I_AKN] + j * 128; const float* kvn = F.in[I_AKVN] + j * 512;
    const int gw = F.bid * NWAVES + F.wave, NGW = F.G * NWAVES, lane = F.lane, s = lane & 7;
    for (int m = MT + gw; m < MT + 4 * PAST; m += NGW) {
            const int ci = m - MT, b = ci >> 9, p = ci & 511; const size_t krow = (size_t)NP + (size_t)b * KEYS_S + SEQ_S + p; const size_t src = ((size_t)(b * 2 + j) * PAST + p);
            { const f32x4 a = ((const GAS f32x4*)(F.in[I_CK] + src * 256))[lane]; v2u w; w.x = pk2(a.x, a.y); w.y = pk2(a.z, a.w); ((GAS v2u*)(KA + krow * 256))[lane] = w; }
            { const f32x4 a = ((const GAS f32x4*)(F.in[I_CV] + src * 256))[lane]; v2u w; w.x = pk2(a.x, a.y); w.y = pk2(a.z, a.w); ((GAS v2u*)(VA + krow * 256))[lane] = w; }
            { const f32x4 a = ((const GAS f32x4*)(F.in[I_CCKV] + src * 512))[2 * lane], c = ((const GAS f32x4*)(F.in[I_CCKV] + src * 512))[2 * lane + 1];
              v4u w; w.x = pk2(a.x, a.y); w.y = pk2(a.z, a.w); w.z = pk2(c.x, c.y); w.w = pk2(c.z, c.w); ((GAS v4u*)(CKV + krow * 512))[lane] = w; }
            if (lane < 16) { const f32x4 a = ((const GAS f32x4*)(F.in[I_CKR] + src * 64))[lane]; v2u w; w.x = pk2(a.x, a.y); w.y = pk2(a.z, a.w); ((GAS v2u*)(KR + krow * 64))[lane] = w; }
    }
    v4u nk0, nk1, nvv, ncw, nrw;
#define POST_LOAD(mm) do { const bf16* z_ = Z + (size_t)(mm) * ZW; \
        nk0 = ((const GAS v4u*)(z_ + ZC_KA))[2 * (lane & 15)]; nk1 = ((const GAS v4u*)(z_ + ZC_KA))[2 * (lane & 15) + 1]; \
        nvv = ((const GAS v4u*)(z_ + ZC_VA))[lane & 31]; \
        ncw = ((const GAS v4u*)(z_ + ZC_CKV))[lane]; nrw = ((const GAS v4u*)(z_ + ZC_KR))[s]; } while (0)
    if (gw < MT) POST_LOAD(gw);
    for (int m = gw; m < MT; m += NGW) {
        const bool lat = m >= NP; const int t = (m - NP) & 4095, prow = t >> 6, pcol = t & 63;
        const size_t krow = lat ? (size_t)NP + (size_t)((m - NP) >> 12) * KEYS_S + t : (size_t)m;
        bf16* zr = Z + (size_t)m * ZW;
        const v4u k0 = nk0, k1 = nk1, vv = nvv, cw = ncw, rw = nrw;
        if (m + NGW < MT) POST_LOAD(m + NGW);
        { float x[16]; float xa[8], xb[8]; unpack8(k0, xa); unpack8(k1, xb);
#pragma unroll
          for (int e = 0; e < 8; ++e) { x[e] = xa[e]; x[8 + e] = xb[e]; }
          head_norm_rope16(x, s, kn, false, 0, 0, T128);
          if (!lat && lane < 16) { float* so = F.out + OUT_SK + ((size_t)((m >> 8) * 2 + j) * SEQ_P + (m & 255)) * 256 + 16 * lane;
#pragma unroll
              for (int e = 0; e < 4; ++e) ((GAS f32x4*)so)[e] = (f32x4){x[4 * e], x[4 * e + 1], x[4 * e + 2], x[4 * e + 3]}; }
          if (lat) { const int pos = (s >> 2) ? pcol : prow; const bool second = (s >> 1) & 1; const float* tt = T128 + ((size_t)pos * 32 + 16 * (s & 1)) * 2;
#pragma unroll
              for (int e = 0; e < 16; ++e) { const float xp = SWZ_XOR(x[e], 2); x[e] = x[e] * tt[2 * e] + (second ? xp * tt[2 * e + 1] : -xp * tt[2 * e + 1]); } }
          if (lane < 16) { ((GAS v4u*)(KA + krow * 256))[2 * lane] = pack8(x); ((GAS v4u*)(KA + krow * 256))[2 * lane + 1] = pack8(x + 8); } }
        if (lane < 32) { ((GAS v4u*)(VA + krow * 256))[lane] = vv;
            if (!lat) { float x[8]; unpack8(vv, x); float* so = F.out + OUT_SV + ((size_t)((m >> 8) * 2 + j) * SEQ_P + (m & 255)) * 256 + 8 * lane;
                ((GAS f32x4*)so)[0] = (f32x4){x[0], x[1], x[2], x[3]}; ((GAS f32x4*)so)[1] = (f32x4){x[4], x[5], x[6], x[7]}; } }
        { float x[8]; unpack8(cw, x); float ss = 0.f;
#pragma unroll
          for (int e = 0; e < 8; ++e) ss += x[e] * x[e];
          const float rstd = 1.0f / sqrtf(wave_sum(ss) * (1.0f / 512.0f) + EPS);
#pragma unroll
          for (int e = 0; e < 8; ++e) x[e] = x[e] * rstd * kvn[8 * lane + e];
          ((GAS v4u*)(CKV + krow * 512))[lane] = pack8(x);
          if (!lat) { float* so = F.out + OUT_SCKV + ((size_t)((m >> 8) * 2 + j) * SEQ_P + (m & 255)) * 512 + 8 * lane;
              ((GAS f32x4*)so)[0] = (f32x4){x[0], x[1], x[2], x[3]}; ((GAS f32x4*)so)[1] = (f32x4){x[4], x[5], x[6], x[7]}; } }
        { float x[8]; unpack8(rw, x);
          if (!lat && lane < 8) { float* so = F.out + OUT_SKR + ((size_t)((m >> 8) * 2 + j) * SEQ_P + (m & 255)) * 64 + 8 * lane;
              ((GAS f32x4*)so)[0] = (f32x4){x[0], x[1], x[2], x[3]}; ((GAS f32x4*)so)[1] = (f32x4){x[4], x[5], x[6], x[7]}; }
          if (lat) rope8(x, s, prow, pcol, T64);
          if (lane < 8) ((GAS v4u*)(KR + krow * 64))[lane] = pack8(x); }
    }
}

#ifndef ATT_DMA
#define ATT_DMA 0
#endif
#ifndef ATT_MLA_SD
#define ATT_MLA_SD 1
#endif
#ifndef ATT_MLA_NQR
#define ATT_MLA_NQR 6
#endif
#ifndef EN_ATT_GQA
#define EN_ATT_GQA 1
#endif
#ifndef EN_ATT_MLA
#define EN_ATT_MLA 1
#endif
#undef POST_LOAD
constexpr int BIAS_LDS_OFF = RING_BYTES, BIAS_LDS_UNITS = 14;
static_assert(BIAS_LDS_OFF + BIAS_LDS_UNITS * 1024 <= MISC_OFF, "bias table vs the LDS map");
__device__ __forceinline__ void bias_to_lds(Frame& F, const pg8::StaticOrder& S, const float* bias, int ldb) {
    LAS float* tb = (LAS float*)(F.lds + BIAS_LDS_OFF);
    __syncthreads();
    const int half = F.tid >> 8, t = F.tid & 255; pg8::Unit u;
#pragma unroll
    for (int i0 = 0; i0 < BIAS_LDS_UNITS; i0 += 2) { const int i = i0 + half; if (S.next(i, u)) tb[i * 256 + t] = bias[(size_t)pg8::cond_of_pm(u.pm) * ldb + u.pn * 256 + t]; }
    __syncthreads();
}
constexpr int RES_LDS_UNITS = 4;
static_assert(BIAS_LDS_OFF + RES_LDS_UNITS * 3072 <= MISC_OFF, "residual tables vs the LDS map");
__device__ __forceinline__ void res_tables_to_lds(Frame& F, const pg8::StaticOrder& S, const float* gate, const float* gnorm, const float* scale, const float* pnorm, const float* pscale) {
    LAS float* tb = (LAS float*)(F.lds + BIAS_LDS_OFF);
    __syncthreads();
    const int half = F.tid >> 8, t = F.tid & 255; pg8::Unit u;
#pragma unroll
    for (int i0 = 0; i0 < RES_LDS_UNITS; i0 += 2) { const int i = i0 + half;
        if (S.next(i, u)) { const int cd = pg8::cond_of_pm(u.pm), col = u.pn * 256 + t;
            tb[i * 768 + t] = gate[(size_t)cd * 12288 + col];
            tb[i * 768 + 256 + t] = gnorm[col] * (scale ? 1.0f + scale[(size_t)cd * 12288 + col] : 1.0f);
            const float tp = pnorm[col] * (1.0f + pscale[(size_t)cd * 12288 + col]); tb[i * 768 + 512 + t] = tp != 0.f ? 1.0f / tp : 0.f; } }
    __syncthreads();
}
static_assert(2 * 16384 + 2 * 64 * 192 * 2 + 2048 + 8 * (12 - ATT_MLA_NQR) * 1024 <= MISC_OFF, "attention LDS use vs the LDS map");
static_assert(384 * 272 + 1024 <= MISC_OFF && 8 * 16640 <= MISC_OFF, "phase scratch vs the LDS map");
#if ATT_DMA
#ifndef ATT_DMA_NQR
#define ATT_DMA_NQR 10
#endif
#error the LDS-DMA attention variant does not carry the fused Q-side norm/rope
#define ATT_GQA_UNIT(QM) att::attn_unit_dma<128, ZW, 256, 256, DM, 8>
#define ATT_MLA_UNIT(QM) att::attn_unit_dma<192, ZW, DM, DM, DM, ATT_DMA_NQR>
#define ATT_LDSL , F.lds
static_assert(3 * (64 * 192 * 2 + 16384) + 2048 + 8 * (12 - ATT_DMA_NQR) * 1024 <= MISC_OFF, "attention ring vs the LDS map");
#else
#ifndef ATT16
#define ATT16 0
#endif
#ifndef ATT16_GSD
#define ATT16_GSD 2
#endif
#ifndef ATT16_GNQR
#define ATT16_GNQR 8
#endif
#if ATT16 & 1
#define ATT_GQA_UNIT(QM) att::attn_unit16<128, ZW, 256, 256, DM, ATT16_GSD, ATT16_GNQR, QM>
#else
#define ATT_GQA_UNIT(QM) att::attn_unit<128, ZW, 256, 256, DM, 2, 8, QM>
#endif
#if ATT16 & 2
#define ATT_MLA_UNIT(QM) att::attn_unit16<192, ZW, DM, DM, DM, ATT_MLA_SD, ATT_MLA_NQR, QM>
#else
#define ATT_MLA_UNIT(QM) att::attn_unit<192, ZW, DM, DM, DM, ATT_MLA_SD, ATT_MLA_NQR, QM>
#endif
#define ATT_LDSL
#endif
__device__ __forceinline__ void attn_phase(Frame& F, int j) {
    const float* qn = F.in[I_AQN] + j * 128; const float* T128 = (const float*)(F.ws + WS_TAB); const float* T64 = (const float*)(F.ws + WS_TAB + 16384);
    const bf16* Z = (const bf16*)(F.ws + WS_Z); const bf16* KA = (const bf16*)(F.ws + WS_KA); const bf16* VA = (const bf16*)(F.ws + WS_VA);
    const bf16* KR = (const bf16*)(F.ws + WS_KR); const bf16* KVB = (const bf16*)(F.ws + WS_KVB); bf16* O = (bf16*)(F.ws + WS_O);
#if EN_ATT_GQA
    for (int L = F.bid; L < 512; L += F.G) {
        const int x = L & 7, s = L >> 3, b = x >> 1, kvh = x & 1, h = kvh * 4 + (s >> 4), qb = s & 15;
        const size_t qrow = (size_t)NP + (size_t)b * SEQ_S + qb * 256, krow = (size_t)NP + (size_t)b * KEYS_S;
        ATT_GQA_UNIT(2)(Z + qrow * ZW + ZC_QA + h * 128, KA + krow * 256 + kvh * 128, nullptr, VA + krow * 256 + kvh * 128, O + qrow * DM + h * 128, KEYS_S, F.ldsg ATT_LDSL, qn, T128, qb * 256);
    }
#endif
#if EN_ATT_MLA
    for (int L = F.bid; L < 512; L += F.G) {
        const int x = L & 7, s = L >> 3, b = x >> 1, h = (x & 1) * 4 + (s >> 4), qb = s & 15;
        const size_t qrow = (size_t)NP + (size_t)b * SEQ_S + qb * 256, krow = (size_t)NP + (size_t)b * KEYS_S;
        ATT_MLA_UNIT(3)(Z + qrow * ZW + ZC_QB + h * 192, KVB + krow * DM + h * 256, KR + krow * 64, KVB + krow * DM + h * 256 + 128, O + qrow * DM + 1024 + h * 128, KEYS_S, F.ldsg ATT_LDSL, nullptr, T64, qb * 256);
    }
#endif
#if EN_ATT_GQA
    for (int L = F.bid; L < 128; L += F.G) {
        const int b = L >> 3, h = L & 7, kvh = h >> 2; const size_t row = (size_t)b * SEQ_P;
        ATT_GQA_UNIT(1)(Z + row * ZW + ZC_QA + h * 128, KA + row * 256 + kvh * 128, nullptr, VA + row * 256 + kvh * 128, O + row * DM + h * 128, SEQ_P, F.ldsg ATT_LDSL, qn, nullptr, 0);
    }
#endif
#if EN_ATT_MLA
    for (int L2 = F.bid; L2 < 256; L2 += F.G) { if (L2 < 128 && F.G > 128) continue; const int L = L2 & 127;
        const int b = L >> 3, h = L & 7; const size_t row = (size_t)b * SEQ_P;
        ATT_MLA_UNIT(0)(Z + row * ZW + ZC_QB + h * 192, KVB + row * DM + h * 256, KR + row * 64, KVB + row * DM + h * 256 + 128, O + row * DM + 1024 + h * 128, SEQ_P, F.ldsg ATT_LDSL, nullptr, nullptr, 0);
    }
#endif
    __syncthreads();
}

__device__ __forceinline__ void spatial_phase(Frame& F, int j) {
    FRAME_REFRESH(F);
    const bf16* U = (const bf16*)(F.ws + WS_U); const bf16* V = (const bf16*)(F.ws + WS_V); bf16* MC = (bf16*)(F.ws + WS_MC); const float* SS = (const float*)(F.ws + WS_SS);
    const float* Ws = F.in[I_CWS] + (size_t)j * 8 * 128 * 128; const float* bs = F.in[I_CBS] + j * 8 * 128; const float* gn = F.in[I_CVN] + j * DM;
    constexpr int RSB = 272, UTB = 528;
    LAS unsigned char* As = F.lds; LAS unsigned char* Vt = F.lds + 128 * RSB; LAS float* RS = (LAS float*)(F.lds + 384 * RSB); LAS float* BS = RS + 128; LAS unsigned char* UT = Vt;
    static_assert(128 * UTB <= 256 * RSB, "UT overlays Vt");
    const int tid0 = F.tid, wr = F.wave >> 2, wc = F.wave & 3;
    v4u vr[8], ur[8]; f32x4 ssa, ssb; int g_built = -1;
#define SPAT_ITEM(it_, n_, g_) const int g_ = (it_) & 7; int n_ = (it_) >> 3; \
        if (SPAT_MRU && F.G == 256) { const int r_ = (it_) >> 8, q_ = ((it_) >> 3) & 31, off_ = r_ == 0 ? 16 : r_ == 1 ? 4 : r_ == 2 ? 12 : r_ == 3 ? 8 : 0; n_ = 2 * (20 * (q_ >> 3) + off_ + ((q_ >> 1) & 3)) + (q_ & 1); }
#define SPAT_LOADS(it_) do { SPAT_ITEM(it_, nn_, gg_); const int rr0_ = nn_ * 128; int tid = tid0; asm volatile("" : "+v"(tid)); \
        { const GAS f32x4* sp = (const GAS f32x4*)(SS + (size_t)rr0_ * 32) + 2 * tid; ssa = sp[0]; ssb = sp[1]; }     \
        _Pragma("unroll") for (int i = 0; i < 8; ++i) { const int idx = tid + NTHREADS * i, q = idx >> 5, c8 = (idx & 31) * 8; vr[i] = *(const GAS v4u*)(V + (size_t)(rr0_ + q) * DM + gg_ * 256 + c8); } } while (0)
    if (F.bid < 160 * 8) SPAT_LOADS(F.bid);
    for (int it = F.bid; it < 160 * 8; it += F.G) {
        SPAT_ITEM(it, n, g); const int r0 = n * 128;
        int tid = tid0; asm volatile("" : "+v"(tid)); const int lane = tid & 63, r32 = lane & 31, hi = lane >> 5;
        __syncthreads();
        { float s = ((ssa.x + ssa.y) + (ssa.z + ssa.w)) + ((ssb.x + ssb.y) + (ssb.z + ssb.w)); s += SWZ_XOR(s, 1); s += SWZ_XOR(s, 2);
          if ((tid & 3) == 0) RS[tid >> 2] = 1.0f / sqrtf(s * (1.0f / 2048.0f) + EPS); }
        if (g != g_built) { g_built = g;
            if (tid < 128) BS[tid] = bs[g * 128 + tid];
#pragma unroll
            for (int i = 0; i < 8; ++i) { const int idx = tid + NTHREADS * i, p = idx >> 5, q4 = (idx & 31) * 4; const f32x4 w = *(const GAS f32x4*)(Ws + (size_t)g * 16384 + p * 128 + q4);
                v2u o; o.x = pk2(w.x, w.y); o.y = pk2(w.z, w.w); *(LAS v2u*)(As + p * RSB + q4 * 2) = o; } }
#pragma unroll
        for (int i = 0; i < 8; ++i) { const int idx = tid + NTHREADS * i, p = idx >> 5, c8 = (idx & 31) * 8; ur[i] = *(const GAS v4u*)(U + (size_t)(r0 + p) * DM + g * 256 + c8); }
        __syncthreads();
#pragma unroll
        for (int i = 0; i < 8; ++i) { const int idx = tid + NTHREADS * i, q = idx >> 5, cb = idx & 31; const v4u w = vr[i]; const float rs = RS[q];
            const unsigned w0 = pk2(bf_lo(w.x) * rs, bf_hi(w.x) * rs), w1 = pk2(bf_lo(w.y) * rs, bf_hi(w.y) * rs), w2 = pk2(bf_lo(w.z) * rs, bf_hi(w.z) * rs), w3 = pk2(bf_lo(w.w) * rs, bf_hi(w.w) * rs);
            LAS unsigned short* d = (LAS unsigned short*)(Vt + (cb * 8) * RSB + ((((q >> 3) ^ (cb & 15)) << 4) | ((q & 7) * 2)));
            d[0 * (RSB / 2)] = (unsigned short)(w0 & 0xffffu); d[1 * (RSB / 2)] = (unsigned short)(w0 >> 16); d[2 * (RSB / 2)] = (unsigned short)(w1 & 0xffffu); d[3 * (RSB / 2)] = (unsigned short)(w1 >> 16);
            d[4 * (RSB / 2)] = (unsigned short)(w2 & 0xffffu); d[5 * (RSB / 2)] = (unsigned short)(w2 >> 16); d[6 * (RSB / 2)] = (unsigned short)(w3 & 0xffffu); d[7 * (RSB / 2)] = (unsigned short)(w3 >> 16); }
        __syncthreads();
        f32x16 acc[2][2];
#pragma unroll
        for (int a = 0; a < 2; ++a)
#pragma unroll
            for (int b = 0; b < 2; ++b) acc[a][b] = (f32x16){};
#pragma unroll
        for (int ks = 0; ks < 8; ++ks) { bf16x8 af[2], bfr[2];
#pragma unroll
            for (int a = 0; a < 2; ++a) af[a] = *(LAS bf16x8*)(As + (64 * wr + 32 * a + r32) * RSB + (16 * ks + 8 * hi) * 2);
#pragma unroll
            for (int b = 0; b < 2; ++b) { const int c = 64 * wc + 32 * b + r32; bfr[b] = *(LAS bf16x8*)(Vt + c * RSB + (((2 * ks + hi) ^ ((c >> 3) & 15)) << 4)); }
#pragma unroll
            for (int a = 0; a < 2; ++a)
#pragma unroll
                for (int b = 0; b < 2; ++b) acc[a][b] = __builtin_amdgcn_mfma_f32_32x32x16_bf16(af[a], bfr[b], acc[a][b], 0, 0, 0); }
        __syncthreads();
#pragma unroll
        for (int i = 0; i < 8; ++i) { const int idx = tid + NTHREADS * i, p = idx >> 5, c8 = (idx & 31) * 8; *(LAS v4u*)(UT + p * UTB + c8 * 2) = ur[i]; }
        __syncthreads();
        if (it + F.G < 160 * 8) SPAT_LOADS(it + F.G);
#pragma unroll
        for (int b = 0; b < 2; ++b) { const int cl = 64 * wc + 32 * b + r32; const float gnc = gn[g * 256 + cl];
#pragma unroll
            for (int a = 0; a < 2; ++a)
#pragma unroll
                for (int r = 0; r < 16; ++r) { const int p = 64 * wr + 32 * a + (r & 3) + 8 * (r >> 2) + 4 * hi; LAS unsigned short* e = (LAS unsigned short*)(UT + p * UTB + cl * 2);
                    const float u = __uint_as_float(((unsigned)*e) << 16);
                    const unsigned w = pk2(u * (gnc * acc[a][b][r] + BS[p]), 0.f); *e = (unsigned short)(w & 0xffffu); } }
        __syncthreads();
#pragma unroll
        for (int i = 0; i < 8; ++i) { const int idx = tid + NTHREADS * i, p = idx >> 5, c8 = (idx & 31) * 8; *(GAS v4u*)(MC + (size_t)(r0 + p) * DM + g * 256 + c8) = *(LAS v4u*)(UT + p * UTB + c8 * 2); }
    }
#undef SPAT_ITEM
#undef SPAT_LOADS
}

#ifndef EN_DEFAULT
#define EN_DEFAULT 1
#endif
#ifndef EN_P0
#define EN_P0 EN_DEFAULT
#endif
#ifndef EN_MOD
#define EN_MOD EN_DEFAULT
#endif
#ifndef EN_G1
#define EN_G1 EN_DEFAULT
#endif
#ifndef EN_POST
#define EN_POST EN_DEFAULT
#endif
#ifndef EN_KVUP
#define EN_KVUP EN_DEFAULT
#endif
#ifndef EN_ATT
#define EN_ATT EN_DEFAULT
#endif
#ifndef EN_G4
#define EN_G4 EN_DEFAULT
#endif
#ifndef EN_SPAT
#define EN_SPAT EN_DEFAULT
#endif
#ifndef EN_OUT
#define EN_OUT EN_DEFAULT
#endif
#ifndef EN_FUP
#define EN_FUP EN_DEFAULT
#endif
#ifndef EN_FDN
#define EN_FDN EN_DEFAULT
#endif
#ifndef EN_FIN
#define EN_FIN EN_DEFAULT
#endif
#ifndef REP_POST
#define REP_POST 1
#endif
#ifndef REP_BAR
#define REP_BAR 1
#endif
#ifndef REP_P0
#define REP_P0 1
#endif
#ifndef REP_MOD
#define REP_MOD 1
#endif
#ifndef REP_G1
#define REP_G1 1
#endif
#ifndef REP_KVUP
#define REP_KVUP 1
#endif
#ifndef REP_ATT
#define REP_ATT 1
#endif
#ifndef REP_G4
#define REP_G4 1
#endif
#ifndef REP_SPAT
#define REP_SPAT 1
#endif
#ifndef REP_FUP
#define REP_FUP 1
#endif
#ifndef REP_OUT
#define REP_OUT 1
#endif
#ifndef REP_FDN
#define REP_FDN 1
#endif
#ifndef WGM_G1
#define WGM_G1 PG8_WGM
#endif
#ifndef WGM_KV
#define WGM_KV PG8_WGM
#endif
#ifndef WGM_G4
#define WGM_G4 PG8_WGM
#endif
#ifndef WGM_FUP
#define WGM_FUP PG8_WGM
#endif
#ifndef WGM_RES
#define WGM_RES PG8_WGM
#endif
#ifndef STAGGER_TICKS
#define STAGGER_TICKS 0
#endif
#define STAGGER(F) do { if (STAGGER_TICKS > 0) { const unsigned long long t0_ = __builtin_amdgcn_s_memrealtime(), d_ = (unsigned long long)(((F).bid >> 3) & 3) * STAGGER_TICKS; \
    while (__builtin_amdgcn_s_memrealtime() - t0_ < d_) __builtin_amdgcn_s_sleep(4); } } while (0)
#ifndef FDN_REV
#define FDN_REV 1
#endif
#ifndef G1_DEFER2
#define G1_DEFER2 1
#endif
#ifndef DEFER_DOWN3
#define DEFER_DOWN3 1
#endif
#ifndef DEFER2_8
#define DEFER2_8 P0_DEFER8
#endif
constexpr int P2_FFN_ITEMS = (3 * 32 * 88) * (8 - DEFER2_8) / 8;
#ifndef FDN_ALL_ITEMS
#define FDN_ALL_ITEMS 0
#endif
#ifndef FUP_ALIGN_EPI
#define FUP_ALIGN_EPI true
#endif
#ifndef G1_ALIGN_EPI
#define G1_ALIGN_EPI true
#endif
#ifndef G4_ALIGN_EPI
#define G4_ALIGN_EPI true
#endif
#ifndef KV_ALIGN_EPI
#define KV_ALIGN_EPI true
#endif
#ifndef ADA_FUP_ITEMS
#define ADA_FUP_ITEMS 128
#endif
#ifndef ADA_IN_FUP
#define ADA_IN_FUP 1
#endif
#ifndef EARLY_FIN
#define EARLY_FIN 1
#endif
constexpr int CW_RDY = 6144;
static_assert(CW_RDY >= CW_BAR + XCD_BAR_WORDS && (CW_RDY + 64 * 80) * 4 <= (int)CTL_ZERO_BYTES, "arrival counters vs the control block");
__device__ __forceinline__ void fdn_panel_lists(Frame& F, LAS unsigned* lst) {
    LAS unsigned* msk = lst + 60;
    __syncthreads();
    if (F.tid < 3) msk[F.tid] = 0u;
    __syncthreads();
    if (F.tid < F.G) { pg8::StaticOrder S; S.init(MT, DM, F.G, F.tid, WGM_RES, FDN_REV); pg8::Unit u; if (S.next(2, u)) (void)__hip_atomic_fetch_or(&msk[u.pm >> 5], 1u << (u.pm & 31), __ATOMIC_RELAXED, __HIP_MEMORY_SCOPE_WORKGROUP); }
    __syncthreads();
    if (F.tid == 0) { unsigned ne = 0, nl = 0; LAS unsigned char* eb = (LAS unsigned char*)lst + 16; LAS unsigned char* lb = (LAS unsigned char*)lst + 112;
        for (int pm = 0; pm < MT / 256; ++pm) { if ((msk[pm >> 5] >> (pm & 31)) & 1u) lb[nl++] = (unsigned char)pm; else eb[ne++] = (unsigned char)pm; }
        lst[0] = ne; lst[1] = nl; }
    __syncthreads();
}
#define EARLY_FIN_ON(F) (EARLY_FIN && (F).G == 256)
__device__ __forceinline__ void early_final(Frame& F, int widx) {
    LAS unsigned* lst = (LAS unsigned*)F.lds;
    fdn_panel_lists(F, lst);
    const int ne = (int)lst[0];
    if (widx < 2 * ne && widx < 128) {
        const int pm = ((LAS unsigned char*)lst)[16 + (widx >> 1)];
        if (F.tid < 64) { unsigned* arr = (unsigned*)(F.ws + WS_CTL) + CW_RDY; unsigned sp = 0;
            while ((unsigned)__builtin_amdgcn_readfirstlane(__hip_atomic_load(arr, __ATOMIC_RELAXED, __HIP_MEMORY_SCOPE_AGENT)) < (unsigned)F.G) { __builtin_amdgcn_s_sleep(4); if (++sp > (1u << 20)) break; }
            __builtin_amdgcn_fence(__ATOMIC_ACQUIRE, "agent"); asm volatile("s_waitcnt vmcnt(0)" ::: "memory"); }
        __syncthreads();
        for (int r = F.wave; r < 128; r += NWAVES) final_row(F, pm * 256 + (widx & 1) * 128 + r);
    }
}
__device__ __forceinline__ void final_phase_rest(Frame& F) {
    LAS unsigned* lst = (LAS unsigned*)F.lds;
    fdn_panel_lists(F, lst);
    const int ne = (int)lst[0], nl = (int)lst[1], nx = ne > 64 ? ne - 64 : 0, rows = (nl + nx) * 256;
    const int gw = F.bid * NWAVES + F.wave, NGW = F.G * NWAVES;
    for (int idx = gw; idx < rows; idx += NGW) { const int pi = idx >> 8; const int pm = pi < nl ? ((LAS unsigned char*)lst)[112 + pi] : ((LAS unsigned char*)lst)[16 + 64 + (pi - nl)];
        final_row(F, pm * 256 + (idx & 255)); }
}
constexpr int NPHASE = 38;
__global__ void __launch_bounds__(NTHREADS, 2) fwd(Args args) {
    extern __shared__ __attribute__((aligned(1024))) unsigned char lds[];
    Frame F;
    F.lds = (LAS unsigned char*)lds; F.ldsg = (char*)lds;
    F.in.ka = (KArgsPtr)__builtin_amdgcn_kernarg_segment_ptr();
    PHASE_BEGIN(F);
    const int lo = args.ph_lo, hi = args.ph_hi; const bool multi = (hi - lo) > 1;
    if (F.tid < 4) ((LAS unsigned*)(F.lds + MISC_OFF))[F.tid] = 0u;
    __syncthreads();
    if (multi) (void)xcd_barrier_post((unsigned*)(F.ws + WS_CTL) + CW_BAR, (volatile LAS unsigned*)(F.lds + MISC_OFF));
#define IN(k) (lo <= (k) && (k) < hi)
#ifndef CODE_WARM
#define CODE_WARM 0
#endif
#if CODE_WARM
    if (lo == 0) { const char* pc = (const char*)(__builtin_amdgcn_s_getpc() & ~0xFFull); unsigned acc = 0;
#pragma unroll 8
        for (int i = F.tid; i < 14848; i += NTHREADS) { const v4u w = *(const GAS v4u*)(pc + (size_t)i * 16); acc ^= (w.x ^ w.y) ^ (w.z ^ w.w); }
        if (acc == 0x9e3779b9u && F.tid == 12345) ((GAS unsigned*)(F.ws + WS_PROBE))[0] = acc; }
#endif
#define SEAM(k) do { if (multi && (k) + 1 < hi) { XcdBarrier b_; b_.bar = (unsigned*)(F.ws + WS_CTL) + CW_BAR; b_.x = xb_xcc_id(); b_.st = (volatile LAS unsigned*)(F.lds + MISC_OFF); for (int rb_ = 0; rb_ < REP_BAR; ++rb_) xcd_barrier(b_); } } while (0)

#define X (F.out)
#define H ((bf16*)(F.ws + WS_H))
#define LAYER_VARS() PHASE_BEGIN(F); int L = L_; asm volatile("" : "+s"(L)); const int j = L >> 1; const bool attn = (L & 1) == 0; const float* modl = (const float*)(F.ws + WS_MOD) + (size_t)L * 5 * 12288; (void)j; (void)attn; (void)modl

    #if EN_P0
    if (IN(0)) { PHASE_BEGIN(F); PROBE_STAMP(F, 0); for (int rep_ = 0; rep_ < REP_P0; ++rep_) { p0_prologue(F); __syncthreads(); } SEAM(0); }
#endif

    for (int L_ = 0; L_ < NLAYER; ++L_) {
        const int pb = 1 + 9 * L_; const bool attn_ = (L_ & 1) == 0;
#if EN_MOD
        if (L_ == 0 && IN(pb + 0)) { LAYER_VARS(); PROBE_STAMP(F, pb + 0);
            mod0_phase(F, F.in[I_XP], F.in[I_XS], F.in[I_NMIX], modl);
            const int gw = F.bid * NWAVES + F.wave, NGW = F.G * NWAVES;
            bias_rows(F, (const bf16*)(F.ws + WS_WIN), ZW, modl, (float*)(F.ws + WS_BIAS1), 4096, gw, NGW);
            if (P0_DEFER8 == 0) bias_rows(F, (const bf16*)(F.ws + WS_FGU), 2 * FF, modl + 3 * DM, (float*)(F.ws + WS_BIAS2), 2 * FF, gw, NGW);
            SEAM(pb + 0);
        }
#endif
        if (attn_) {
#if EN_G1
            if (IN(pb + 1)) { LAYER_VARS(); PROBE_STAMP(F, pb + 1);
                pg8::Gemm g{H, (const bf16*)(F.ws + WS_WIN) + (size_t)j * ZW * DM, MT, ZW, DM}; pg8::StaticOrder S; S.init(MT, ZW, F.G, F.bid, WGM_G1);
                pg8::EpiBf16Plain E{(bf16*)(F.ws + WS_Z), ZW, (const float*)(F.ws + WS_SSX), (const float*)(F.ws + WS_BIAS1) + (size_t)L * 5 * 4096, 4096, -1, (PG8_LAS const float*)(F.lds + BIAS_LDS_OFF), 0};
                if (P0_DEFER8 > 0 && (L == 0 || G1_DEFER2)) { int widx, nwg; tail_slot(F, 1200 - 4 * F.G, widx, nwg);
                    if (widx >= 0) conv_items(F, L, 1, widx * NWAVES + F.wave, nwg * NWAVES, L == 0 ? P0_FFN_ITEMS : P2_FFN_ITEMS); __syncthreads(); }
                bias_to_lds(F, S, E.bias, 4096);
                for (int rep_ = 0; rep_ < REP_G1; ++rep_) pg8::gemm_phase<pg8::EpiBf16Plain, pg8::StaticOrder, G1_ALIGN_EPI, true>(F.lds, g, S, E);
                SEAM(pb + 1);
            }
#endif
#if EN_POST
            if (IN(pb + 2)) { LAYER_VARS(); PROBE_STAMP(F, pb + 2); post_phase(F, j);
#if REP_POST > 1
              for (int rep_ = 1; rep_ < REP_POST; ++rep_) post_phase(F, j, true);
#endif
              SEAM(pb + 2); }
#endif
#if EN_KVUP
            if (IN(pb + 3)) { LAYER_VARS(); PROBE_STAMP(F, pb + 3);
                pg8::Gemm g{(const bf16*)(F.ws + WS_CKV), (const bf16*)(F.ws + WS_WKV) + (size_t)j * 2048 * 512, MK, 2048, 512}; pg8::StaticOrder S; S.init(MK, 2048, F.G, F.bid, WGM_KV);
                pg8::EpiBf16Plain E{(bf16*)(F.ws + WS_KVB), DM, nullptr, nullptr, 0, -1, nullptr, 0};
                for (int rep_ = 0; rep_ < REP_KVUP; ++rep_) pg8::gemm_phase<pg8::EpiBf16Plain, pg8::StaticOrder, KV_ALIGN_EPI, true>(F.lds, g, S, E);
                SEAM(pb + 3);
            }
#endif
#if EN_ATT
            if (IN(pb + 4)) { LAYER_VARS(); PROBE_STAMP(F, pb + 4); for (int rep_ = 0; rep_ < REP_ATT; ++rep_) attn_phase(F, j); SEAM(pb + 4); }
#endif
        } else {
#if EN_G4
            if (IN(pb + 1)) { LAYER_VARS(); PROBE_STAMP(F, pb + 1);
                pg8::Gemm g{H, (const bf16*)(F.ws + WS_CWIN) + (size_t)j * 4096 * DM, MT, 4096, DM}; pg8::StaticOrder S; S.init(MT, 4096, F.G, F.bid, WGM_G4);
                pg8::EpiGeluUV E{(bf16*)(F.ws + WS_U), (bf16*)(F.ws + WS_V), (float*)(F.ws + WS_SS), (const float*)(F.ws + WS_SSX), (const float*)(F.ws + WS_BIAS1) + (size_t)L * 5 * 4096, 4096, -1, (PG8_LAS const float*)(F.lds + BIAS_LDS_OFF), 0};
                bias_to_lds(F, S, E.bias, 4096);
                for (int rep_ = 0; rep_ < REP_G4; ++rep_) pg8::gemm_phase<pg8::EpiGeluUV, pg8::StaticOrder, G4_ALIGN_EPI, true>(F.lds, g, S, E);
                SEAM(pb + 1);
            }
#endif
#if EN_SPAT
            if (IN(pb + 2)) { LAYER_VARS(); PROBE_STAMP(F, pb + 2); for (int rep_ = 0; rep_ < REP_SPAT; ++rep_) spatial_phase(F, j); SEAM(pb + 2); }
#endif
        }
#if EN_OUT
        if (IN(pb + 5)) { LAYER_VARS(); PROBE_STAMP(F, pb + 5);
            const bf16* A = attn ? (const bf16*)(F.ws + WS_O) : (const bf16*)(F.ws + WS_MC);
            const bf16* Bt = (attn ? (const bf16*)(F.ws + WS_WOUT) : (const bf16*)(F.ws + WS_CWOUT)) + (size_t)j * DM * DM;
            pg8::Gemm g{A, Bt, MT, DM, DM}; pg8::StaticOrder S; S.init(MT, DM, F.G, F.bid, WGM_RES);
            pg8::EpiRes E{H, (float*)(F.ws + WS_SSX), (PG8_LAS const float*)(F.lds + BIAS_LDS_OFF), 0};
#if 1
            { int widx, nwg; tail_slot(F, 640 - 2 * F.G, widx, nwg); if (widx >= 0) {
                if (L > 0 || P0_DEFER8 > 0) bias_rows(F, (const bf16*)(F.ws + WS_FGU) + (size_t)L * 2 * FF * DM, 2 * FF, modl + 3 * DM, (float*)(F.ws + WS_BIAS2) + (size_t)L * 5 * 2 * FF, 2 * FF, widx * NWAVES + F.wave, nwg * NWAVES);
                if (L + 1 < NLAYER) { if (!ADA_IN_FUP) ada_layer(F, L + 1, 0, 128, widx, nwg); __syncthreads(); conv_items(F, L + 1, 0, widx * NWAVES + F.wave, nwg * NWAVES); }
                else if (DEFER_DOWN3) { __syncthreads(); conv_items(F, L, 1, widx * NWAVES + F.wave, nwg * NWAVES, 2 * 32 * 88); } } }
            __syncthreads();
#endif
            res_tables_to_lds(F, S, modl + 2 * DM, F.in[I_NFFN] + L * DM, modl + 4 * DM, F.in[I_NMIX] + L * DM, modl + 1 * DM);
            STAGGER(F);
            pg8::gemm_phase<pg8::EpiRes, pg8::StaticOrder, true, true>(F.lds, g, S, E);
#if REP_OUT > 1
            { pg8::EpiBf16Plain E2{(bf16*)(F.ws + WS_PROBE), DM, nullptr, nullptr, 0, -1, nullptr, 0}; pg8::gemm_phase<pg8::EpiBf16Plain, pg8::StaticOrder, true, true>(F.lds, g, S, E2); }
#endif
            SEAM(pb + 5);
        }
#endif
#if EN_FUP
        if (IN(pb + 7)) { LAYER_VARS(); PROBE_STAMP(F, pb + 7);
            pg8::Gemm g{H, (const bf16*)(F.ws + WS_FGU) + (size_t)L * 2 * FF * DM, MT, 2 * FF, DM}; pg8::StaticOrder S; S.init(MT, 2 * FF, F.G, F.bid, WGM_FUP);
            pg8::EpiSwiGLU E{(bf16*)(F.ws + WS_HH), FF, (const float*)(F.ws + WS_SSX), (const float*)(F.ws + WS_BIAS2) + (size_t)L * 5 * 2 * FF, 2 * FF, -1, (PG8_LAS const float*)(F.lds + BIAS_LDS_OFF), 0};
            if (ADA_IN_FUP && TAIL_CONV && L + 1 < NLAYER) { int widx, nwg; tail_slot(F, 3520 - 13 * F.G, widx, nwg);
                if (widx >= 0) ada_layer(F, L + 1, 0, ADA_FUP_ITEMS, widx, nwg); __syncthreads(); }
            bias_to_lds(F, S, E.bias, 2 * FF);
            for (int rep_ = 0; rep_ < REP_FUP; ++rep_) pg8::gemm_phase<pg8::EpiSwiGLU, pg8::StaticOrder, FUP_ALIGN_EPI, true>(F.lds, g, S, E);
            SEAM(pb + 7);
        }
#endif
#if EN_FDN
        if (IN(pb + 8)) { LAYER_VARS(); PROBE_STAMP(F, pb + 8);
            pg8::Gemm g{(const bf16*)(F.ws + WS_HH), (const bf16*)(F.ws + WS_FD) + (size_t)L * DM * FF, MT, DM, FF}; pg8::CountedDone S; S.init(MT, DM, F.G, F.bid, WGM_RES, FDN_REV);
            const bool more = L + 1 < NLAYER;
            S.arrive = (!more && EARLY_FIN_ON(F)) ? (unsigned*)(F.ws + WS_CTL) + CW_RDY : nullptr; S.nd = 0;
            pg8::EpiRes E{H, (float*)(F.ws + WS_SSX), (PG8_LAS const float*)(F.lds + BIAS_LDS_OFF), 0};
#if TAIL_CONV
            if (L + 1 < NLAYER) { int widx, nwg; tail_slot(F, 640 - 2 * F.G, widx, nwg);
              if (FDN_ALL_ITEMS > 0 && widx != F.bid) conv_items(F, L + 1, 1, F.bid * NWAVES + F.wave, F.G * NWAVES, 0, FDN_ALL_ITEMS);
              if (widx >= 0) { ada_layer(F, L + 1, (ADA_IN_FUP ? ADA_FUP_ITEMS : 128), 384, widx, nwg); __syncthreads(); conv_items(F, L + 1, 1, widx * NWAVES + F.wave, nwg * NWAVES, (FDN_ALL_ITEMS > 0 && widx != F.bid) ? FDN_ALL_ITEMS : 0, (G1_DEFER2 && P0_DEFER8 > 0 && L + 1 == 2) ? P2_FFN_ITEMS : (DEFER_DOWN3 && L + 1 == 3) ? 2 * 32 * 88 : 0x7fffffff);
                const int j1 = (L + 1) >> 1; const bool attn1 = ((L + 1) & 1) == 0;
                bias_rows(F, attn1 ? (const bf16*)(F.ws + WS_WIN) + (size_t)j1 * ZW * DM : (const bf16*)(F.ws + WS_CWIN) + (size_t)j1 * 4096 * DM, attn1 ? ZW : 4096, modl + 5 * 12288, (float*)(F.ws + WS_BIAS1) + (size_t)(L + 1) * 5 * 4096, 4096, widx * NWAVES + F.wave, nwg * NWAVES); } }
            __syncthreads();
#endif
            res_tables_to_lds(F, S, modl + 5 * DM, more ? F.in[I_NMIX] + (L + 1) * DM : F.in[I_FNORM], more ? modl + 5 * 12288 + DM : nullptr, F.in[I_NFFN] + L * DM, modl + 4 * DM);
            STAGGER(F);
            pg8::gemm_phase<pg8::EpiRes, pg8::CountedDone, true, true>(F.lds, g, S, E);
            if (!more && EARLY_FIN_ON(F) && F.bid >= 128) early_final(F, F.bid - 128);
#if REP_FDN > 1
            { pg8::EpiBf16Plain E2{(bf16*)(F.ws + WS_PROBE), DM, nullptr, nullptr, 0, -1, nullptr, 0}; pg8::gemm_phase<pg8::EpiBf16Plain, pg8::StaticOrder, true, true>(F.lds, g, S, E2); }
#endif
            SEAM(pb + 8);
        }
#endif
    }
#if EN_FIN
    if (IN(37)) { PHASE_BEGIN(F); PROBE_STAMP(F, 37);
#ifdef IDLE_US
        { const unsigned long long t0_ = __builtin_amdgcn_s_memrealtime(); while (__builtin_amdgcn_s_memrealtime() - t0_ < (unsigned long long)(IDLE_US) * 100ull) __builtin_amdgcn_s_sleep(16); }
#endif
        if (EARLY_FIN_ON(F)) final_phase_rest(F); else final_phase(F); asm volatile("s_waitcnt vmcnt(0)" ::: "memory"); __syncthreads(); PROBE_STAMP(F, 38);
#if PROBE_T
#ifndef PROBE_SA
#define PROBE_SA 1e-4f
#endif
#ifndef PROBE_OA
#define PROBE_OA 0.0f
#endif
#ifndef PROBE_SB
#define PROBE_SB 1e-3f
#endif
        if (blockIdx.x == 0) {
            __syncthreads(); asm volatile("s_waitcnt vmcnt(0)" ::: "memory");
            const unsigned long long* ts = (const unsigned long long*)(F.ws + WS_PROBE);
            const float ta = (float)(long long)(__hip_atomic_load(ts + PROBE_A1, __ATOMIC_RELAXED, __HIP_MEMORY_SCOPE_AGENT) - __hip_atomic_load(ts + PROBE_A0, __ATOMIC_RELAXED, __HIP_MEMORY_SCOPE_AGENT)) * 0.01f - PROBE_OA;
            const float tb = (float)(long long)(__hip_atomic_load(ts + PROBE_B1, __ATOMIC_RELAXED, __HIP_MEMORY_SCOPE_AGENT) - __hip_atomic_load(ts + PROBE_B0, __ATOMIC_RELAXED, __HIP_MEMORY_SCOPE_AGENT)) * 0.01f;
            for (int i = F.tid; i < 524288; i += NTHREADS) F.out[OUT_SKR + i] *= (1.0f + ta * PROBE_SA);
            if (F.tid == 0) F.out[0] += tb * PROBE_SB;
        }
#endif
    }
#endif
#undef IN
#undef SEAM
#undef X
#undef H
}

#ifndef MK_ONE_LAUNCH
#define MK_ONE_LAUNCH 0
#endif
extern "C" void kernel_launch(void* const* d_in, const int* in_sizes, int n_in, void* d_out, int out_size, void* d_ws, size_t ws_size, hipStream_t stream) {
    static int grid = 0;
    if (grid == 0) {
        if (n_in != 27 || out_size != 50855936 || ws_size < WS_END) { fprintf(stderr, "kernel_launch: built for 27 inputs, 50855936 outputs, >= %zu bytes of workspace; got n_in %d, out %d, ws %zu\n", (size_t)WS_END, n_in, out_size, ws_size); grid = -1; return; }
        int dev = 0, cus = 0, per_cu = 0;
        if (hipGetDevice(&dev) != hipSuccess || hipDeviceGetAttribute(&cus, hipDeviceAttributeMultiprocessorCount, dev) != hipSuccess) { fprintf(stderr, "kernel_launch: device query failed\n"); grid = -1; return; }
        if (hipFuncSetAttribute((const void*)fwd, hipFuncAttributeMaxDynamicSharedMemorySize, LDS_BYTES) != hipSuccess) { fprintf(stderr, "kernel_launch: hipFuncSetAttribute failed\n"); grid = -1; return; }
        if (hipOccupancyMaxActiveBlocksPerMultiprocessor(&per_cu, (const void*)fwd, NTHREADS, LDS_BYTES) != hipSuccess || per_cu < 1)
            fprintf(stderr, "kernel_launch: note: occupancy query reports %d workgroups per CU\n", per_cu);
        (void)hipGetLastError();
        grid = cus;
    }
    if (grid < 0) return;
    if (hipMemsetAsync((char*)d_ws + WS_CTL, 0, CTL_ZERO_BYTES, stream) != hipSuccess) { fprintf(stderr, "kernel_launch: memset failed\n"); return; }
    Args a{};
    for (int i = 0; i < 27; ++i) a.in[i] = (const GAS float*)d_in[i];
    a.out_f = (GAS float*)d_out; a.ws_b = (GAS unsigned char*)d_ws;
#if MK_ONE_LAUNCH
    a.ph_lo = 0; a.ph_hi = NPHASE;
    hipLaunchKernelGGL(fwd, dim3(grid), dim3(NTHREADS), LDS_BYTES, stream, a);
#else
    for (int ph = 0; ph < NPHASE; ++ph) {
        if (ph >= 1 && ph < 37) { const int L = (ph - 1) / 9, s = (ph - 1) % 9; if (((L & 1) && (s == 3 || s == 4)) || s == 6 || (s == 0 && L > 0)) continue; }
        a.ph_lo = ph; a.ph_hi = ph + 1;
        hipLaunchKernelGGL(fwd, dim3(grid), dim3(NTHREADS), LDS_BYTES, stream, a);
    }
#endif
    const hipError_t le = hipPeekAtLastError();
    if (le != hipSuccess) fprintf(stderr, "kernel_launch: launch failed: %s\n", hipGetErrorName(le));
}
```
